# Optimizing an MI355X kernel written in HIP

```python
import jax, jax.numpy as jnp
from jax import lax
import numpy as np

D_MODEL = 1024
BATCH = 8
SEQ = 4096
DEPTH = 2

CTX_LEN = 256
GRID_W = 64
EXPAND = 2
D_INNER = EXPAND * D_MODEL
D_A = D_INNER // 2
D_B = D_INNER - D_A
N_HEADS_A = 4
HEAD_DIM_A = D_A // N_HEADS_A
N_GROUPS_B = 4
GROUP_B = D_B // N_GROUPS_B
N_GROUPS_C = 4
GROUP_C = D_INNER // N_GROUPS_C
POOL_WINDOWS = (2, 4, 8, 16)
CONV_W = 3
CHUNK = 64
N_GATES = 4 * N_HEADS_A
W_IN_EVEN = 5 * D_A + 2 * D_B + N_GATES
W_IN_ODD = 2 * D_INNER
EPS = 1e-6

kernel_name = 'hybrid_mlstm_fourier_pool_dit'

f32 = jnp.float32


def _rmsnorm(a, g):
    af = a.astype(f32)
    af = af * lax.rsqrt(jnp.mean(af * af, axis=-1, keepdims=True) + EPS)
    return (af * g.astype(f32)).astype(a.dtype)


def _short_conv(u, w):
    T = u.shape[1]
    pad = CONV_W // 2
    up = jnp.pad(u, ((0, 0), (pad, CONV_W - 1 - pad), (0, 0)))
    out = w[0] * up[:, 0:T]
    for j in range(1, CONV_W):
        out = out + w[j] * up[:, j:j + T]
    return out


def _mlstm_chunked(q, k, v, ig, lf, state):
    B, H, T, Dh = q.shape
    nc = T // CHUNK

    def to_chunks(a):
        return jnp.moveaxis(a.reshape(a.shape[:2] + (nc, CHUNK) + a.shape[3:]), 2, 0)

    mask = jnp.tril(jnp.ones((CHUNK, CHUNK), dtype=bool))

    def step(carry, inp):
        C, n, m = carry
        qc, kc, vc, ic, fc = inp
        b = jnp.cumsum(fc, axis=-1)
        dm = b[..., :, None] - b[..., None, :] + ic[..., None, :]
        dm = jnp.where(mask, dm, -jnp.inf)
        m_inter = b + m[..., None]
        m_t = jnp.maximum(jnp.max(dm, axis=-1), m_inter)
        s = jnp.einsum('bhtd,bhsd->bhts', qc, kc) * jnp.exp(dm - m_t[..., None])
        inter = jnp.exp(m_inter - m_t)
        num = jnp.einsum('bhts,bhsd->bhtd', s, vc) + inter[..., None] * jnp.einsum('bhtd,bhde->bhte', qc, C)
        den = jnp.sum(s, axis=-1) + inter * jnp.einsum('bhtd,bhd->bht', qc, n)
        h = num / jnp.maximum(jnp.abs(den), jnp.exp(-m_t))[..., None]
        b_end = b[..., -1]
        w_s = b_end[..., None] - b + ic
        m_new = jnp.maximum(b_end + m, jnp.max(w_s, axis=-1))
        decay = jnp.exp(b_end + m - m_new)
        ws = jnp.exp(w_s - m_new[..., None])
        C_new = decay[..., None, None] * C + jnp.einsum('bhs,bhsd,bhse->bhde', ws, kc, vc)
        n_new = decay[..., None] * n + jnp.einsum('bhs,bhsd->bhd', ws, kc)
        return (C_new, n_new, m_new), h

    final, hs = lax.scan(step, state, (to_chunks(q), to_chunks(k), to_chunks(v), to_chunks(ig), to_chunks(lf)))
    h = jnp.moveaxis(hs, 0, 2).reshape(B, H, T, Dh)
    return h, final


def _to_heads(a):
    B, T, _ = a.shape
    return a.reshape(B, T, N_HEADS_A, HEAD_DIM_A).transpose(0, 2, 1, 3).astype(f32)


def _project_even(h, win, gate_b, conv_qk):
    B, T, _ = h.shape
    p = h @ win
    qk = jax.nn.silu(_short_conv(p[..., :2 * D_A], conv_qk))
    q = _to_heads(qk[..., :D_A]) * (HEAD_DIM_A ** -0.5)
    k = _to_heads(qk[..., D_A:])
    v = _to_heads(p[..., 2 * D_A:3 * D_A])
    o = p[..., 3 * D_A:4 * D_A]
    z_a = p[..., 4 * D_A:5 * D_A]
    u_b = p[..., 5 * D_A:5 * D_A + D_B]
    z_b = p[..., 5 * D_A + D_B:5 * D_A + 2 * D_B]
    g = (p[..., 5 * D_A + 2 * D_B:] + gate_b).astype(f32)
    g = g.reshape(B, T, 4, N_HEADS_A).transpose(2, 0, 3, 1)
    gates = (g[0], jax.nn.log_sigmoid(g[1]), g[2], jax.nn.log_sigmoid(g[3]))
    return (q, k, v), gates, (o, z_a, u_b, z_b)


def _mlstm_bidir(qkv_c, gates_c, qkv_x, gates_x):
    B, H, _, Dh = qkv_c[0].shape
    zero = (jnp.zeros((B, H, Dh, Dh), f32), jnp.zeros((B, H, Dh), f32), jnp.zeros((B, H), f32))

    def flip(a):
        return jnp.flip(a, axis=2)

    hc_f, st_f = _mlstm_chunked(*qkv_c, gates_c[0], gates_c[1], zero)
    hx_f, _ = _mlstm_chunked(*qkv_x, gates_x[0], gates_x[1], st_f)
    hc_b, st_b = _mlstm_chunked(*map(flip, qkv_c), flip(gates_c[2]), flip(gates_c[3]), zero)
    hx_b, _ = _mlstm_chunked(*map(flip, qkv_x), flip(gates_x[2]), flip(gates_x[3]), st_b)
    return hc_f + flip(hc_b), hx_f + flip(hx_b)


def _fourier_mix(u, fw):
    B, T, _ = u.shape
    ug = u.astype(f32).reshape(B, T, N_GROUPS_B, GROUP_B)
    y = jnp.fft.fft2(ug, axes=(1, 3), norm='ortho').real
    return jnp.einsum('btgc,gcd->btgd', y, fw.astype(f32)).reshape(B, T, D_B)


def _even_out(h, extra, head_g, fw, wout, dtype):
    o, z_a, u_b, z_b = extra
    B, H, T, Dh = h.shape
    h = jax.nn.sigmoid(o.astype(f32)).reshape(B, T, H, Dh) * h.transpose(0, 2, 1, 3)
    h = h * lax.rsqrt(jnp.mean(h * h, axis=-1, keepdims=True) + EPS)
    y_a = h.reshape(B, T, D_A) * head_g.astype(f32) * jax.nn.silu(z_a.astype(f32))
    y_b = _fourier_mix(u_b, fw) * jax.nn.silu(z_b.astype(f32))
    y = jnp.concatenate([y_a, y_b], axis=-1).astype(dtype)
    return y @ wout


def _box_mean(u, axis, w):
    n = u.shape[axis]
    pads = [(1, 0) if a == axis else (0, 0) for a in range(u.ndim)]
    P = jnp.pad(jnp.cumsum(u, axis=axis), pads)
    idx = jnp.arange(n)
    lo = jnp.clip(idx - w // 2, 0, n)
    hi = jnp.clip(idx + w - w // 2, 0, n)
    s = jnp.take(P, hi, axis=axis) - jnp.take(P, lo, axis=axis)
    cnt = (hi - lo).astype(u.dtype).reshape((n,) + (1,) * (u.ndim - axis - 1))
    return s / cnt


def _pool_mix(u, pool_w, scale, rows):
    B, T, _ = u.shape
    parts = []
    for g, w in enumerate(POOL_WINDOWS):
        ug = u[..., g * GROUP_C:(g + 1) * GROUP_C].astype(f32)
        if rows is None:
            m = _box_mean(ug, 1, w)
        else:
            grid = ug.reshape(B, rows, GRID_W, GROUP_C)
            m = _box_mean(_box_mean(grid, 1, w), 2, w).reshape(B, T, GROUP_C)
        parts.append(m - ug)
    y = jnp.stack(parts, axis=2)
    y = jnp.einsum('btgc,gcd->btgd', y, pool_w.astype(f32)).reshape(B, T, D_INNER)
    return y * scale.astype(f32)


def _odd_branch(h, win, pool_w, scale, wout, rows):
    p = h @ win
    y = _pool_mix(p[..., :D_INNER], pool_w, scale, rows) * jax.nn.silu(p[..., D_INNER:].astype(f32))
    return y.astype(h.dtype) @ wout


def setup_inputs(seed: int = 0) -> dict:
    key = jax.random.key(seed)
    ks = jax.random.split(key, 20)
    n_even = (DEPTH + 1) // 2
    n_odd = DEPTH // 2
    nrm = jax.random.normal
    x = nrm(ks[0], (BATCH, SEQ, D_MODEL), f32)
    c = nrm(ks[1], (BATCH, D_MODEL), f32)
    ctx = nrm(ks[2], (BATCH, CTX_LEN, D_MODEL), f32)
    c_ctx = nrm(ks[3], (D_MODEL,), f32)
    ada_w = nrm(ks[4], (DEPTH, D_MODEL, 3 * D_MODEL), f32) * (0.5 * D_MODEL ** -0.5)
    ada_b = 0.02 * nrm(ks[5], (DEPTH, 3 * D_MODEL), f32)
    norm_g = 1.0 + 0.1 * nrm(ks[6], (DEPTH, D_MODEL), f32)
    win_even = nrm(ks[7], (n_even, D_MODEL, W_IN_EVEN), f32) * (D_MODEL ** -0.5)
    i_bias = 0.1 * nrm(ks[8], (n_even, 2, N_HEADS_A), f32)
    f_bias = jnp.linspace(3.0, 6.0, N_HEADS_A, dtype=f32) + 0.1 * nrm(ks[9], (n_even, 2, N_HEADS_A), f32)
    gate_b_even = jnp.stack([i_bias[:, 0], f_bias[:, 0], i_bias[:, 1], f_bias[:, 1]], axis=1).reshape(n_even, N_GATES)
    conv_qk_even = nrm(ks[10], (n_even, CONV_W, 2 * D_A), f32) * (CONV_W ** -0.5)
    head_norm_even = 1.0 + 0.1 * nrm(ks[11], (n_even, D_A), f32)
    fourier_w_even = nrm(ks[12], (n_even, N_GROUPS_B, GROUP_B, GROUP_B), f32) * (GROUP_B ** -0.5)
    wout_even = nrm(ks[13], (n_even, D_INNER, D_MODEL), f32) * (D_INNER ** -0.5)
    win_odd = nrm(ks[14], (n_odd, D_MODEL, W_IN_ODD), f32) * (D_MODEL ** -0.5)
    pool_w_odd = nrm(ks[15], (n_odd, N_GROUPS_C, GROUP_C, GROUP_C), f32) * (GROUP_C ** -0.5)
    pool_scale_odd = 1.0 + 0.1 * nrm(ks[16], (n_odd, D_INNER), f32)
    wout_odd = nrm(ks[17], (n_odd, D_INNER, D_MODEL), f32) * (D_INNER ** -0.5)
    final_g = 1.0 + 0.1 * nrm(ks[18], (D_MODEL,), f32)
    return {'x': x, 'c': c, 'ctx': ctx, 'c_ctx': c_ctx, 'ada_w': ada_w, 'ada_b': ada_b, 'norm_g': norm_g,
            'win_even': win_even, 'gate_b_even': gate_b_even, 'conv_qk_even': conv_qk_even,
            'head_norm_even': head_norm_even, 'fourier_w_even': fourier_w_even, 'wout_even': wout_even,
            'win_odd': win_odd, 'pool_w_odd': pool_w_odd, 'pool_scale_odd': pool_scale_odd,
            'wout_odd': wout_odd, 'final_g': final_g}


def reference(x, c, ctx, c_ctx, ada_w, ada_b, norm_g, win_even, gate_b_even, conv_qk_even,
              head_norm_even, fourier_w_even, wout_even, win_odd, pool_w_odd, pool_scale_odd,
              wout_odd, final_g):
    rows = x.shape[1] // GRID_W
    for l in range(DEPTH):
        even = (l % 2 == 0)
        ctx_out = l < DEPTH - 1
        mod_x = jax.nn.silu(c) @ ada_w[l] + ada_b[l]
        shift_x, scale_x, gate_x = jnp.split(mod_x[:, None, :], 3, axis=-1)
        hx = _rmsnorm(x, norm_g[l]) * (1 + scale_x) + shift_x
        if even or ctx_out:
            mod_c = jax.nn.silu(c_ctx) @ ada_w[l] + ada_b[l]
            shift_c, scale_c, gate_c = jnp.split(mod_c, 3, axis=-1)
            hc = _rmsnorm(ctx, norm_g[l]) * (1 + scale_c) + shift_c
        if even:
            e = l // 2
            qkv_x, gates_x, extra_x = _project_even(hx, win_even[e], gate_b_even[e], conv_qk_even[e])
            qkv_c, gates_c, extra_c = _project_even(hc, win_even[e], gate_b_even[e], conv_qk_even[e])
            h_c, h_x = _mlstm_bidir(qkv_c, gates_c, qkv_x, gates_x)
            y_x = _even_out(h_x, extra_x, head_norm_even[e], fourier_w_even[e], wout_even[e], x.dtype)
            if ctx_out:
                y_c = _even_out(h_c, extra_c, head_norm_even[e], fourier_w_even[e], wout_even[e], ctx.dtype)
        else:
            o = l // 2
            y_x = _odd_branch(hx, win_odd[o], pool_w_odd[o], pool_scale_odd[o], wout_odd[o], rows)
            if ctx_out:
                y_c = _odd_branch(hc, win_odd[o], pool_w_odd[o], pool_scale_odd[o], wout_odd[o], None)
        x = x + gate_x * y_x
        if ctx_out:
            ctx = ctx + gate_c * y_c
    return _rmsnorm(x, final_g)
```

```cpp
#include <hip/hip_runtime.h>
#include <hip/hip_cooperative_groups.h>
#include <cstdio>
namespace cg = cooperative_groups;

#ifndef MK_MULTI
#define MK_MULTI 0
#endif

#define LAS __attribute__((address_space(3)))
typedef unsigned short bf16_t;
typedef short bf16x8 __attribute__((ext_vector_type(8)));
typedef short s16x4 __attribute__((ext_vector_type(4)));
typedef float f32x4 __attribute__((ext_vector_type(4)));
typedef unsigned u32x4 __attribute__((ext_vector_type(4)));
typedef unsigned u32x2 __attribute__((ext_vector_type(2)));

constexpr int NX = 32768, NCX = 2048, NR = NX + NCX;
constexpr size_t PLANE = (size_t)NX * 1024 * 2;
constexpr size_t WS_EXTRA = 7 * PLANE;
constexpr size_t WS_WINE  = WS_EXTRA;
constexpr size_t WS_WOUTE = WS_WINE  + (size_t)7168 * 1024 * 2;
constexpr size_t WS_WINO  = WS_WOUTE + (size_t)1024 * 2048 * 2;
constexpr size_t WS_WPOOL = WS_WINO  + (size_t)4096 * 1024 * 2;
constexpr size_t WS_WOUTO = WS_WPOOL + (size_t)4 * 512 * 512 * 2;
constexpr size_t WS_WF    = WS_WOUTO + (size_t)1024 * 2048 * 2;
constexpr size_t WS_MOD   = WS_WF    + (size_t)4 * 512 * 256 * 2;
constexpr size_t WS_GATES = WS_MOD   + 262144;
constexpr size_t WS_CRAW  = WS_GATES + (size_t)NR * 16 * 4;
constexpr size_t WS_CQC   = WS_CRAW  + (size_t)3 * NCX * 1024 * 2;
constexpr size_t WS_CKC   = WS_CQC   + (size_t)NCX * 1024 * 2;
constexpr size_t WS_END   = WS_CKC   + (size_t)NCX * 1024 * 2;
static_assert(WS_END <= (size_t)512 * 1024 * 1024, "workspace map exceeds 512 MiB");

constexpr int LDS_BYTES = 143360;

struct Params {
    const float* x; const float* c; const float* ctx; const float* c_ctx; const float* ada_w; const float* ada_b; const float* norm_g;
    const float* win_even; const float* gate_b; const float* conv_qk; const float* head_norm; const float* fourier_w; const float* wout_even;
    const float* win_odd; const float* pool_w; const float* pool_scale; const float* wout_odd; const float* final_g;
    float* out; unsigned char* ws;
};

#define DI __device__ __forceinline__
DI float bf2f(unsigned short b) { return __uint_as_float(((unsigned)b) << 16); }
DI float lo_f(unsigned u) { return __uint_as_float(u << 16); }
DI float hi_f(unsigned u) { return __uint_as_float(u & 0xffff0000u); }
typedef __bf16 bf16v2_t __attribute__((ext_vector_type(2)));
typedef float f32v2_t __attribute__((ext_vector_type(2)));
DI unsigned pk2(float lo, float hi) { const f32v2_t v = {lo, hi}; const bf16v2_t b = __builtin_convertvector(v, bf16v2_t); return __builtin_bit_cast(unsigned, b); }
DI float silu_f(float x) { return x / (1.0f + __expf(-x)); }
DI float sigmoid_f(float x) { return 1.0f / (1.0f + __expf(-x)); }
DI int opaque_tid() { int t = threadIdx.x; asm volatile("" : "+v"(t)); return t; }
DI float wave_sum(float v) { for (int o = 32; o > 0; o >>= 1) v += __shfl_xor(v, o); return v; }
DI float wave_max(float v) { for (int o = 32; o > 0; o >>= 1) v = fmaxf(v, __shfl_xor(v, o)); return v; }
DI f32x4 mfma16(bf16x8 a, bf16x8 b, f32x4 c) { return __builtin_amdgcn_mfma_f32_16x16x32_bf16(a, b, c, 0, 0, 0); }
DI bf16x8 tr_frag(LAS unsigned char* img, int pitch, int krow0, int col0, int lane) {
    const int g = lane >> 4, q = (lane & 15) >> 2, pp = lane & 3;
    LAS unsigned char* a0 = img + (krow0 + 8 * g + q) * pitch + col0 * 2 + 8 * pp;
    s16x4 lo = __builtin_amdgcn_ds_read_tr16_b64_v4i16((LAS s16x4*)a0);
    s16x4 hi = __builtin_amdgcn_ds_read_tr16_b64_v4i16((LAS s16x4*)(a0 + 4 * pitch));
    return __builtin_shufflevector(lo, hi, 0, 1, 2, 3, 4, 5, 6, 7);
}

constexpr int HTB = 128 * 64 * 2;
DI int lds_byte(int r, int c) { const int st = (r >> 4) * 2 + (c >> 5), rr = r & 15, cc = c & 31, ob = rr * 64 + cc * 2; return st * 1024 + (ob ^ (((ob >> 9) & 1) << 5)); }
DI void stage_rc(int b, int& R, int& C) { const int st = b / 1024, sb = b % 1024, swz = sb ^ (((sb >> 9) & 1) << 5); R = (st >> 1) * 16 + swz / 64; C = (st & 1) * 32 + (swz % 64) / 2; }
DI int perm32(int rho) { const int n = rho >> 4, i = rho & 15; return 8 * (i >> 2) + 4 * n + (i & 3); }

struct Unit { int pm, pn, g; };
struct GemmD { const bf16_t* A; const bf16_t* Bt; int lda, ldb; long a_gs, b_gs; int K; };
struct Sched {
    int nM, nN, nG, nM2, nN2, pm2off, G, c;
    DI bool next(int i, Unit& u) const {
        const int L = i * G + c; const int nwg = nM * nN, tot1 = nwg * nG;
        const bool first = L < tot1;
        const int L1 = first ? L : 0;
        const int g = L1 / nwg; int wgid = L1 - g * nwg;
        { const int q = nwg / 8, r = nwg % 8, xcd = wgid % 8, off = wgid / 8; wgid = (xcd < r ? xcd * (q + 1) : r * (q + 1) + (xcd - r) * q) + off; }
        const int nig = 8 * nN, gid = wgid / nig, fm = gid * 8, gsz = (nM - fm) < 8 ? (nM - fm) : 8;
        const int pm1 = fm + ((wgid % nig) % gsz), pn1 = (wgid % nig) / gsz;
        const int L2 = first ? 0 : L - tot1, d2 = nM2 > 0 ? nM2 : 1;
        const int pm2 = pm2off + L2 % d2, pn2 = L2 / d2;
        u.pm = first ? pm1 : pm2; u.pn = first ? pn1 : pn2; u.g = first ? g : 0;
        return first || (L2 < nM2 * nN2);
    }
};

template <class Epi>
DI void gemm_phase(LAS unsigned char* lds, const GemmD g, const Sched& S, const Epi& E) {
    const int tid = opaque_tid(), wid = __builtin_amdgcn_readfirstlane(tid >> 6), lane = tid & 63, wr = wid >> 2, wc = wid & 3, fr = lane & 15, fq = lane >> 4;
    const int K = g.K, nt = K / 64;
    unsigned voffA[2], voffB[2];
#pragma unroll
    for (int i = 0; i < 2; ++i) { int R, C; stage_rc(tid * 16 + i * 8192, R, C); const int Rb = Epi::PERM ? ((R & ~31) + perm32(R & 31)) : R;
        voffA[i] = (unsigned)(R * g.lda + C) * 2u; voffB[i] = (unsigned)(Rb * g.ldb + C) * 2u; }
    const size_t kstep = 128;
    const size_t hstepA = (size_t)128 * g.lda * 2, hstepB = (size_t)128 * g.ldb * 2;
    const unsigned ldsw = (unsigned)wid * 1024u;
    const int aoff = lds_byte(wr * 64 + fr, fq * 8), boff = lds_byte(wc * 32 + fr, fq * 8);
#define G_SA(b, h) (((b) * 2 + (h)) * HTB)
#define G_SB(b, h) ((4 + (b) * 2 + (h)) * HTB)
#define G_STAGE(bufoff, gbase, voff) do { _Pragma("unroll") for (int _i = 0; _i < 2; ++_i) \
        __builtin_amdgcn_global_load_lds((const unsigned*)((const char*)(gbase) + (voff)[_i]), (LAS unsigned*)(lds + (bufoff) + ldsw + _i * 8192), 16, 0, 0); } while (0)
#define G_LDA(dst, b, h) do { _Pragma("unroll") for (int m = 0; m < 4; ++m) _Pragma("unroll") for (int k = 0; k < 2; ++k) dst[m][k] = *(const LAS bf16x8*)(lds + G_SA(b, h) + aoff + m * 2048 + k * 1024); } while (0)
#define G_LDB(dst, b, h) do { _Pragma("unroll") for (int n = 0; n < 2; ++n) _Pragma("unroll") for (int k = 0; k < 2; ++k) dst[n][k] = *(const LAS bf16x8*)(lds + G_SB(b, h) + boff + n * 2048 + k * 1024); } while (0)
#define G_MMA(ai, bj, At, Bt) do { __builtin_amdgcn_s_setprio(1); _Pragma("unroll") for (int m = 0; m < 4; ++m) _Pragma("unroll") for (int n = 0; n < 2; ++n) _Pragma("unroll") for (int k = 0; k < 2; ++k) \
        acc[ai][bj][m][n] = __builtin_amdgcn_mfma_f32_16x16x32_bf16(Bt[n][k], At[m][k], acc[ai][bj][m][n], 0, 0, 0); __builtin_amdgcn_s_setprio(0); } while (0)
#define G_WAIT_V(n) asm volatile("s_waitcnt vmcnt(" #n ")" ::: "memory")
#define G_WAIT_L(n) asm volatile("s_waitcnt lgkmcnt(" #n ")" ::: "memory")
#define G_BAR __builtin_amdgcn_s_barrier()
#define G_SCHED __builtin_amdgcn_sched_barrier(0)
    Unit cur, nxt; int ui = 0;
    if (!S.next(0, cur)) return;
    f32x4 acc[2][2][4][2];
#pragma unroll
    for (int a = 0; a < 2; ++a)
#pragma unroll
        for (int b = 0; b < 2; ++b)
#pragma unroll
            for (int m = 0; m < 4; ++m)
#pragma unroll
                for (int n = 0; n < 2; ++n) acc[a][b][m][n] = (f32x4){0.f, 0.f, 0.f, 0.f};
    bf16x8 At[4][2], B0[2][2], B1[2][2];
    const char* cA = (const char*)(g.A + (long)cur.g * g.a_gs) + (size_t)cur.pm * 2 * hstepA;
    const char* cB = (const char*)(g.Bt + (long)cur.g * g.b_gs) + (size_t)cur.pn * 2 * hstepB;
    G_STAGE(G_SB(0, 0), cB, voffB); G_STAGE(G_SA(0, 0), cA, voffA); G_STAGE(G_SB(0, 1), cB + hstepB, voffB); G_STAGE(G_SA(0, 1), cA + hstepA, voffA);
    if (wr == 1) G_BAR;
    G_WAIT_V(4); G_BAR;
    G_STAGE(G_SB(1, 0), cB + kstep, voffB); G_STAGE(G_SA(1, 0), cA + kstep, voffA); G_STAGE(G_SB(1, 1), cB + hstepB + kstep, voffB);
    G_WAIT_V(6); G_BAR;
    for (;;) {
        const bool has_next = S.next(ui + 1, nxt);
        const char* nA = has_next ? (const char*)(g.A + (long)nxt.g * g.a_gs) + (size_t)nxt.pm * 2 * hstepA : cA;
        const char* nB = has_next ? (const char*)(g.Bt + (long)nxt.g * g.b_gs) + (size_t)nxt.pn * 2 * hstepB : cB;
        for (int t = 0; t < nt; t += 2) {
            const bool last = (t == nt - 2);
            const char* a1 = cA + (size_t)(t + 1) * kstep;
            const char* a2 = last ? nA : cA + (size_t)(t + 2) * kstep; const char* b2 = last ? nB : cB + (size_t)(t + 2) * kstep;
            const char* a3 = a2 + kstep; const char* b3 = b2 + kstep;
            G_LDB(B0, 0, 0); G_SCHED; G_LDA(At, 0, 0); G_STAGE(G_SA(1, 1), a1 + hstepA, voffA);
            G_WAIT_L(8); G_BAR; G_WAIT_L(0); G_MMA(0, 0, At, B0); G_BAR; G_SCHED;
            G_LDB(B1, 0, 1); G_STAGE(G_SB(0, 0), b2, voffB);
            G_BAR; G_WAIT_L(0); G_MMA(0, 1, At, B1); G_BAR;
            G_LDA(At, 0, 1); G_STAGE(G_SA(0, 0), a2, voffA);
            G_BAR; G_WAIT_L(0); G_MMA(1, 0, At, B0); G_BAR; G_SCHED;
            G_STAGE(G_SB(0, 1), b2 + hstepB, voffB);
            G_WAIT_V(6); G_BAR; G_MMA(1, 1, At, B1); G_BAR;
            G_LDB(B0, 1, 0); G_SCHED; G_LDA(At, 1, 0); G_STAGE(G_SA(0, 1), a2 + hstepA, voffA);
            G_WAIT_L(8); G_BAR; G_WAIT_L(0); G_MMA(0, 0, At, B0); G_BAR; G_SCHED;
            G_LDB(B1, 1, 1); G_STAGE(G_SB(1, 0), b3, voffB);
            G_BAR; G_WAIT_L(0); G_MMA(0, 1, At, B1); G_BAR;
            G_LDA(At, 1, 1); G_STAGE(G_SA(1, 0), a3, voffA);
            G_BAR; G_WAIT_L(0); G_MMA(1, 0, At, B0); G_BAR; G_SCHED;
            G_STAGE(G_SB(1, 1), b3 + hstepB, voffB);
            G_WAIT_V(6); G_BAR; G_MMA(1, 1, At, B1); G_BAR;
        }
        E(acc, cur, wr, wc, fr, fq);
        if (!has_next) break;
#pragma unroll
        for (int a = 0; a < 2; ++a)
#pragma unroll
            for (int b = 0; b < 2; ++b)
#pragma unroll
                for (int m = 0; m < 4; ++m)
#pragma unroll
                    for (int n = 0; n < 2; ++n) acc[a][b][m][n] = (f32x4){0.f, 0.f, 0.f, 0.f};
        cur = nxt; cA = nA; cB = nB; ++ui;
    }
    G_WAIT_V(0);
    if (wr == 0) G_BAR;
    G_BAR;
}

struct EpiPlanes {
    static constexpr bool PERM = true;
    bf16_t* xbase; bf16_t* cbase;
    DI void operator()(const f32x4 (&acc)[2][2][4][2], const Unit& u, int wr, int wc, int fr, int fq) const {
        const int plane = u.pn >> 2, colt = (u.pn & 3) * 256;
        bf16_t* base; int row0;
        if (u.pm < 128) { base = xbase + (size_t)plane * NX * 1024; row0 = u.pm * 256 + wr * 64 + fr; }
        else { base = cbase + (size_t)plane * NCX * 1024; row0 = (u.pm - 128) * 256 + wr * 64 + fr; }
        const int col0 = colt + wc * 32 + 8 * fq;
#pragma unroll
        for (int ai = 0; ai < 2; ++ai)
#pragma unroll
            for (int m = 0; m < 4; ++m) { bf16_t* rowp = base + (size_t)(row0 + ai * 128 + m * 16) * 1024 + col0;
#pragma unroll
                for (int bj = 0; bj < 2; ++bj) { const f32x4 v0 = acc[ai][bj][m][0], v1 = acc[ai][bj][m][1];
                    u32x4 w; w.x = pk2(v0[0], v0[1]); w.y = pk2(v0[2], v0[3]); w.z = pk2(v1[0], v1[1]); w.w = pk2(v1[2], v1[3]);
                    *(u32x4*)(rowp + bj * 128) = w; } }
    }
};
struct EpiBf {
    static constexpr bool PERM = true;
    bf16_t* O; bf16_t* O2; int ldc; int gcol; int mode; const float* scale; const bf16_t* zc;
    DI void operator()(const f32x4 (&acc)[2][2][4][2], const Unit& u, int wr, int wc, int fr, int fq) const {
        const int row0 = u.pm * 256 + wr * 64 + fr;
        bf16_t* base = O; int pn = u.pn; bool act = false;
        if (mode == 1 && pn >= 8) { base = O2; pn -= 8; act = true; }
        const int col0 = u.g * gcol + pn * 256 + wc * 32 + 8 * fq;
#pragma unroll
        for (int ai = 0; ai < 2; ++ai)
#pragma unroll
            for (int m = 0; m < 4; ++m) { const size_t ro = (size_t)(row0 + ai * 128 + m * 16) * ldc + col0;
#pragma unroll
                for (int bj = 0; bj < 2; ++bj) { f32x4 v0 = acc[ai][bj][m][0], v1 = acc[ai][bj][m][1];
                    if (act) {
#pragma unroll
                        for (int j = 0; j < 4; ++j) { v0[j] = silu_f(v0[j]); v1[j] = silu_f(v1[j]); } }
                    if (mode == 2) {
                        const u32x4 z = *(const u32x4*)(zc + ro + bj * 128);
                        const f32x4 s0 = *(const f32x4*)(scale + col0 + bj * 128), s1 = *(const f32x4*)(scale + col0 + bj * 128 + 4);
                        v0[0] *= s0[0] * lo_f(z.x); v0[1] *= s0[1] * hi_f(z.x); v0[2] *= s0[2] * lo_f(z.y); v0[3] *= s0[3] * hi_f(z.y);
                        v1[0] *= s1[0] * lo_f(z.z); v1[1] *= s1[1] * hi_f(z.z); v1[2] *= s1[2] * lo_f(z.w); v1[3] *= s1[3] * hi_f(z.w);
                    }
                    u32x4 w; w.x = pk2(v0[0], v0[1]); w.y = pk2(v0[2], v0[3]); w.z = pk2(v1[0], v1[1]); w.w = pk2(v1[2], v1[3]);
                    *(u32x4*)(base + ro + bj * 128) = w; } }
    }
};
struct EpiRes {
    static constexpr bool PERM = false;
    float* O; const float* res; const float* gate;
    DI void operator()(const f32x4 (&acc)[2][2][4][2], const Unit& u, int wr, int wc, int fr, int fq) const {
        const int row0 = u.pm * 256 + wr * 64 + fr, col0 = u.pn * 256 + wc * 32 + 4 * fq;
        const float* gp = gate + (size_t)(u.pm >> 4) * 3072 + col0;
        f32x4 gv[2][2];
#pragma unroll
        for (int bj = 0; bj < 2; ++bj)
#pragma unroll
            for (int n = 0; n < 2; ++n) gv[bj][n] = *(const f32x4*)(gp + bj * 128 + n * 16);
#pragma unroll
        for (int ai = 0; ai < 2; ++ai)
#pragma unroll
            for (int m = 0; m < 4; ++m) { const size_t ro = (size_t)(row0 + ai * 128 + m * 16) * 1024 + col0;
#pragma unroll
                for (int bj = 0; bj < 2; ++bj)
#pragma unroll
                    for (int n = 0; n < 2; ++n) { const f32x4 r = *(const f32x4*)(res + ro + bj * 128 + n * 16);
                        *(f32x4*)(O + ro + bj * 128 + n * 16) = r + gv[bj][n] * acc[ai][bj][m][n]; } }
    }
};

DI void ph_prep(const Params& p, LAS unsigned char* lds) {
    const int tid = opaque_tid();
    LAS float* tile = (LAS float*)lds;
    for (int job = blockIdx.x; job < 4096; job += gridDim.x) {
        const float* src; bf16_t* dst; int K, Nt, tk, tn; int j = job;
        if (j < 1792) { src = p.win_even; dst = (bf16_t*)(p.ws + WS_WINE); K = 1024; Nt = 7184; tk = j & 15; tn = j >> 4; }
        else if ((j -= 1792) < 512) { src = p.wout_even; dst = (bf16_t*)(p.ws + WS_WOUTE); K = 2048; Nt = 1024; tk = j & 31; tn = j >> 5; }
        else if ((j -= 512) < 1024) { src = p.win_odd; dst = (bf16_t*)(p.ws + WS_WINO); K = 1024; Nt = 4096; tk = j & 15; tn = j >> 4; }
        else if ((j -= 1024) < 256) { const int g = j >> 6, jj = j & 63; src = p.pool_w + (size_t)g * 512 * 512; dst = (bf16_t*)(p.ws + WS_WPOOL) + (size_t)g * 512 * 512; K = 512; Nt = 512; tk = jj & 7; tn = jj >> 3; }
        else { j -= 256; src = p.wout_odd; dst = (bf16_t*)(p.ws + WS_WOUTO); K = 2048; Nt = 1024; tk = j & 31; tn = j >> 5; }
        const int k0 = tk * 64, n0 = tn * 64;
#pragma unroll
        for (int i = 0; i < 8; ++i) { const int idx = tid + 512 * i, k = idx >> 6, n = idx & 63; tile[k * 65 + n] = src[(size_t)(k0 + k) * Nt + n0 + n]; }
        __syncthreads();
#pragma unroll
        for (int i = 0; i < 4; ++i) { const int idx = tid + 512 * i, n = idx >> 5, k = (idx & 31) * 2;
            *(unsigned*)(dst + (size_t)(n0 + n) * K + k0 + k) = pk2(tile[k * 65 + n], tile[(k + 1) * 65 + n]); }
        __syncthreads();
    }
    LAS float* sv = (LAS float*)(lds + 32768);
    LAS float* red = (LAS float*)(lds + 32768 + 36864);
    LAS float* ct = (LAS float*)(lds + 90112); LAS float* st = ct + 256;
    for (int idx = tid; idx < 9216; idx += 512) { const int v = idx >> 10, k = idx & 1023; const float cv = (v < 8) ? p.c[v * 1024 + k] : p.c_ctx[k]; sv[idx] = silu_f(cv); }
    if (tid < 256) { float s, c; sincospif((float)tid / 128.0f, &s, &c); ct[tid] = c; st[tid] = s; }
    __syncthreads();
    float* MOD = (float*)(p.ws + WS_MOD);
    for (int item = blockIdx.x; item < 192; item += gridDim.x) {
        const int l = item / 96, c0 = (item % 96) * 32, kg = tid >> 5, col = tid & 31;
        float a[9];
#pragma unroll
        for (int v = 0; v < 9; ++v) a[v] = 0.f;
        const float* w = p.ada_w + (size_t)l * 1024 * 3072 + c0 + col;
        for (int k = kg; k < 1024; k += 16) { const float wv = w[(size_t)k * 3072];
#pragma unroll
            for (int v = 0; v < 9; ++v) a[v] += sv[v * 1024 + k] * wv; }
#pragma unroll
        for (int v = 0; v < 9; ++v) red[(kg * 32 + col) * 9 + v] = a[v];
        __syncthreads();
        if (tid < 288) { const int v = tid >> 5, cc = tid & 31; float s = 0.f; for (int q = 0; q < 16; ++q) s += red[(q * 32 + cc) * 9 + v];
            MOD[(size_t)(l * 9 + v) * 3072 + c0 + cc] = s + p.ada_b[l * 3072 + c0 + cc]; }
        __syncthreads();
    }
    bf16_t* WF = (bf16_t*)(p.ws + WS_WF);
    for (int it = blockIdx.x; it < 512; it += gridDim.x) {
        const int idx = it * 512 + tid, d = idx & 255, c = (idx >> 8) & 255, g = idx >> 16;
        const float* f = p.fourier_w + (size_t)g * 65536 + d;
        float aP = 0.f, aQ = 0.f;
        for (int cp = 0; cp < 256; ++cp) { const float fv = f[cp * 256]; const int a = (c * cp) & 255; aP += ct[a] * fv; aQ += st[a] * fv; }
        WF[(size_t)(g * 512 + d) * 256 + c] = (bf16_t)(pk2(aP * 0.0625f, 0.f) & 0xffffu);
        WF[(size_t)(g * 512 + 256 + d) * 256 + c] = (bf16_t)(pk2(-aQ * 0.0625f, 0.f) & 0xffffu);
    }
}

DI void ph_norm0(const Params& p, LAS unsigned char* lds) {
    const int tid = opaque_tid(), wid = tid >> 6, lane = tid & 63;
    LAS float* wg = (LAS float*)lds;
#pragma unroll 4
    for (int i = 0; i < 32; ++i) { const int idx = tid + 512 * i, k = idx >> 4, j = idx & 15; wg[j * 1024 + k] = p.win_even[(size_t)k * 7184 + 7168 + j]; }
    __syncthreads();
    f32x4 g[4];
#pragma unroll
    for (int i = 0; i < 4; ++i) g[i] = *(const f32x4*)(p.norm_g + lane * 4 + 256 * i);
    const float* MOD = (const float*)(p.ws + WS_MOD);
    bf16_t* HX = (bf16_t*)p.out;
    float* GATES = (float*)(p.ws + WS_GATES);
    for (int r = blockIdx.x * 8 + wid; r < NR; r += gridDim.x * 8) {
        const float* src; const float* md;
        if (r < NX) { src = p.x + (size_t)r * 1024; md = MOD + (size_t)(r >> 12) * 3072; } else { src = p.ctx + (size_t)(r - NX) * 1024; md = MOD + (size_t)8 * 3072; }
        f32x4 v[4]; float ss = 0.f;
#pragma unroll
        for (int i = 0; i < 4; ++i) { v[i] = *(const f32x4*)(src + lane * 4 + 256 * i); ss += v[i][0] * v[i][0] + v[i][1] * v[i][1] + v[i][2] * v[i][2] + v[i][3] * v[i][3]; }
        ss = wave_sum(ss);
        const float rstd = rsqrtf(ss * (1.0f / 1024.0f) + 1e-6f);
#pragma unroll
        for (int i = 0; i < 4; ++i) { const f32x4 sh = *(const f32x4*)(md + lane * 4 + 256 * i), sc = *(const f32x4*)(md + 1024 + lane * 4 + 256 * i);
            v[i] = v[i] * rstd * g[i] * (sc + 1.0f) + sh;
            u32x2 w; w.x = pk2(v[i][0], v[i][1]); w.y = pk2(v[i][2], v[i][3]);
            *(u32x2*)(HX + (size_t)r * 1024 + lane * 4 + 256 * i) = w; }
        float mine = 0.f;
#pragma unroll 1
        for (int j = 0; j < 16; ++j) { float pt = 0.f;
#pragma unroll
            for (int i = 0; i < 4; ++i) { const f32x4 w4 = *(const LAS f32x4*)(wg + j * 1024 + lane * 4 + 256 * i); pt += v[i][0] * w4[0] + v[i][1] * w4[1] + v[i][2] * w4[2] + v[i][3] * w4[3]; }
            pt = wave_sum(pt); mine = (lane == j) ? pt : mine; }
        if (lane < 16) { float val = mine + p.gate_b[lane];
            if ((lane >> 2) & 1) val = fminf(val, 0.f) - log1pf(__expf(-fabsf(val)));
            GATES[(size_t)r * 16 + lane] = val; }
    }
}
DI void ph_norm1(const Params& p, int mode) {
    const int tid = opaque_tid(), wid = tid >> 6, lane = tid & 63;
    const float* gsrc = mode ? p.final_g : p.norm_g + 1024;
    f32x4 g[4];
#pragma unroll
    for (int i = 0; i < 4; ++i) g[i] = *(const f32x4*)(gsrc + lane * 4 + 256 * i);
    const float* MOD = (const float*)(p.ws + WS_MOD) + (size_t)9 * 3072;
    const float* X1 = (const float*)p.ws;
    bf16_t* HX1 = (bf16_t*)(p.ws + 2 * PLANE);
    for (int r = blockIdx.x * 8 + wid; r < NX; r += gridDim.x * 8) {
        const float* src = X1 + (size_t)r * 1024; const float* md = MOD + (size_t)(r >> 12) * 3072;
        f32x4 v[4]; float ss = 0.f;
#pragma unroll
        for (int i = 0; i < 4; ++i) { v[i] = *(const f32x4*)(src + lane * 4 + 256 * i); ss += v[i][0] * v[i][0] + v[i][1] * v[i][1] + v[i][2] * v[i][2] + v[i][3] * v[i][3]; }
        ss = wave_sum(ss);
        const float rstd = rsqrtf(ss * (1.0f / 1024.0f) + 1e-6f);
#pragma unroll
        for (int i = 0; i < 4; ++i) {
            if (mode) { *(f32x4*)(p.out + (size_t)r * 1024 + lane * 4 + 256 * i) = v[i] * rstd * g[i]; }
            else { const f32x4 sh = *(const f32x4*)(md + lane * 4 + 256 * i), sc = *(const f32x4*)(md + 1024 + lane * 4 + 256 * i);
                const f32x4 h = v[i] * rstd * g[i] * (sc + 1.0f) + sh;
                u32x2 w; w.x = pk2(h[0], h[1]); w.y = pk2(h[2], h[3]);
                *(u32x2*)(HX1 + (size_t)r * 1024 + lane * 4 + 256 * i) = w; } }
    }
}

DI void ph_conv(const Params& p) {
    const bf16_t* QRAW = (const bf16_t*)p.ws; const bf16_t* KRAW = (const bf16_t*)(p.ws + PLANE);
    const bf16_t* CQ = (const bf16_t*)(p.ws + WS_CRAW); const bf16_t* CK = CQ + (size_t)NCX * 1024;
    bf16_t* QC = (bf16_t*)p.out; bf16_t* KC = QC + (size_t)NX * 1024;
    bf16_t* CQC = (bf16_t*)(p.ws + WS_CQC); bf16_t* CKC = (bf16_t*)(p.ws + WS_CKC);
    const int total = NR * 256;
    const int tid = opaque_tid();
    for (int idx = blockIdx.x * 512 + tid; idx < total; idx += gridDim.x * 512) {
        const int oct = idx & 127, which = (idx >> 7) & 1, r = idx >> 8, ch = oct * 8;
        const bf16_t* src; bf16_t* dst; int t, T;
        if (r < NX) { src = (which ? KRAW : QRAW) + (size_t)r * 1024 + ch; dst = (which ? KC : QC) + (size_t)r * 1024 + ch; t = r & 4095; T = 4096; }
        else { const int rr = r - NX; src = (which ? CK : CQ) + (size_t)rr * 1024 + ch; dst = (which ? CKC : CQC) + (size_t)rr * 1024 + ch; t = rr & 255; T = 256; }
        const u32x4 z = {0u, 0u, 0u, 0u};
        const u32x4 cc = *(const u32x4*)src;
        const u32x4 aa = (t > 0) ? *(const u32x4*)(src - 1024) : z;
        const u32x4 bb = (t < T - 1) ? *(const u32x4*)(src + 1024) : z;
        const float* w = p.conv_qk + which * 1024 + ch;
        float o[8];
#pragma unroll
        for (int e = 0; e < 4; ++e) {
            const float w0l = w[2 * e], w0h = w[2 * e + 1], w1l = w[2048 + 2 * e], w1h = w[2048 + 2 * e + 1], w2l = w[4096 + 2 * e], w2h = w[4096 + 2 * e + 1];
            float lo = w0l * lo_f(aa[e]) + w1l * lo_f(cc[e]) + w2l * lo_f(bb[e]);
            float hi = w0h * hi_f(aa[e]) + w1h * hi_f(cc[e]) + w2h * hi_f(bb[e]);
            lo = silu_f(lo); hi = silu_f(hi);
            if (!which) { lo *= 0.0625f; hi *= 0.0625f; }
            o[2 * e] = lo; o[2 * e + 1] = hi;
        }
        u32x4 wv; wv.x = pk2(o[0], o[1]); wv.y = pk2(o[2], o[3]); wv.z = pk2(o[4], o[5]); wv.w = pk2(o[6], o[7]);
        *(u32x4*)dst = wv;
    }
}

DI void ph_mlstm(const Params& p, LAS unsigned char* lds) {
    constexpr int QP = 528, VP = 144;
    LAS unsigned char* Qi = lds; LAS unsigned char* Ki = lds + 33792; LAS unsigned char* Vi = lds + 67584; LAS unsigned char* Vwi = Vi + 9216;
    LAS unsigned char* Sgi = Vwi + 9216; LAS unsigned char* Ci = Sgi + 9216; LAS float* fl = (LAS float*)(Ci + 33792);
    LAS float* f_bt = fl; LAS float* f_aa = fl + 64; LAS float* f_inter = fl + 128; LAS float* f_ws = fl + 192; LAS float* f_enm = fl + 256; LAS float* f_nvec = fl + 320; LAS float* f_sc = fl + 576;
    const int tid = opaque_tid(), wid = tid >> 6, lane = tid & 63, fr = lane & 15, fq = lane >> 4;
    const bf16_t* QC = (const bf16_t*)p.out; const bf16_t* KC = QC + (size_t)NX * 1024; const bf16_t* VPL = (const bf16_t*)(p.ws + 2 * PLANE);
    const bf16_t* CQC = (const bf16_t*)(p.ws + WS_CQC); const bf16_t* CKC = (const bf16_t*)(p.ws + WS_CKC); const bf16_t* CV = (const bf16_t*)(p.ws + WS_CRAW) + (size_t)2 * NCX * 1024;
    const float* GATES = (const float*)(p.ws + WS_GATES);
    for (int wi = blockIdx.x; wi < 256; wi += gridDim.x) {
        const int b = wi >> 5, h = (wi >> 3) & 3, dir = (wi >> 2) & 1, es = wi & 3;
        bf16_t* Hout = (bf16_t*)(p.ws + (dir ? PLANE : 0));
        f32x4 Cst[2][4];
#pragma unroll
        for (int i = 0; i < 2; ++i)
#pragma unroll
            for (int n = 0; n < 4; ++n) Cst[i][n] = (f32x4){0.f, 0.f, 0.f, 0.f};
        float nst = 0.f, m_prev = 0.f;
        __syncthreads();
        for (int i = tid; i < 33792 / 4; i += 512) ((LAS unsigned*)Ci)[i] = 0u;
        if (tid < 256) f_nvec[tid] = 0.f;
        u32x4 rq[4], rk[4], rv; float g_i = 0.f, g_f = 0.f;
        const int mt = wid >> 1, nt0 = 2 * (wid & 1);
#define ML_LOAD(ST) do { const int _st = (ST); const bf16_t *_q, *_k, *_v; const float* _g; \
            if (_st < 4) { const int cc = dir ? 3 - _st : _st; const size_t row0 = (size_t)b * 256 + cc * 64; _q = CQC + row0 * 1024 + h * 256; _k = CKC + row0 * 1024 + h * 256; _v = CV + row0 * 1024 + h * 256 + es * 64; _g = GATES + ((size_t)NX + row0) * 16; } \
            else { const int xc = _st - 4, cc = dir ? 63 - xc : xc; const size_t row0 = (size_t)b * 4096 + cc * 64; _q = QC + row0 * 1024 + h * 256; _k = KC + row0 * 1024 + h * 256; _v = VPL + row0 * 1024 + h * 256 + es * 64; _g = GATES + row0 * 16; } \
            _Pragma("unroll") for (int i = 0; i < 4; ++i) { const int id = tid + 512 * i, row = id >> 5, chk = id & 31; rq[i] = *(const u32x4*)(_q + (size_t)row * 1024 + chk * 8); rk[i] = *(const u32x4*)(_k + (size_t)row * 1024 + chk * 8); } \
            rv = *(const u32x4*)(_v + (size_t)(tid >> 3) * 1024 + (tid & 7) * 8); \
            if (wid == 0) { g_i = _g[lane * 16 + (dir ? 8 : 0) + h]; g_f = _g[lane * 16 + (dir ? 12 : 4) + h]; } } while (0)
        ML_LOAD(0);
        for (int st = 0; st < 68; ++st) {
            const bool isx = st >= 4;
            __syncthreads();
#pragma unroll
            for (int i = 0; i < 4; ++i) { const int id = tid + 512 * i, row = id >> 5, chk = id & 31;
                *(LAS u32x4*)(Qi + row * QP + chk * 16) = rq[i]; *(LAS u32x4*)(Ki + row * QP + chk * 16) = rk[i]; }
            *(LAS u32x4*)(Vi + (tid >> 3) * VP + (tid & 7) * 16) = rv;
            if (wid == 0) {
                const float lf = g_f, ig = g_i;
                float bs = lf;
#pragma unroll
                for (int o = 1; o < 64; o <<= 1) { const float ov = dir ? __shfl_down(bs, o) : __shfl_up(bs, o); const bool ok = dir ? (lane + o < 64) : (lane >= o); if (ok) bs += ov; }
                const float a = ig - bs;
                float mx = a;
#pragma unroll
                for (int o = 1; o < 64; o <<= 1) { const float ov = dir ? __shfl_down(mx, o) : __shfl_up(mx, o); const bool ok = dir ? (lane + o < 64) : (lane >= o); if (ok) mx = fmaxf(mx, ov); }
                const float total = __shfl(bs, dir ? 0 : 63);
                const float m_inter = bs + m_prev, m_t = fmaxf(bs + mx, m_inter);
                const float wsl = total - bs + ig;
                const float m_new = fmaxf(total + m_prev, wave_max(wsl));
                f_bt[lane] = bs - m_t; f_aa[lane] = a; f_inter[lane] = __expf(m_inter - m_t); f_ws[lane] = __expf(wsl - m_new); f_enm[lane] = __expf(-m_t);
                if (lane == 0) f_sc[0] = __expf(total + m_prev - m_new);
                m_prev = m_new;
            }
            __syncthreads();
            { const float w = f_ws[tid >> 3]; u32x4 o;
              o.x = pk2(w * lo_f(rv.x), w * hi_f(rv.x)); o.y = pk2(w * lo_f(rv.y), w * hi_f(rv.y)); o.z = pk2(w * lo_f(rv.z), w * hi_f(rv.z)); o.w = pk2(w * lo_f(rv.w), w * hi_f(rv.w));
              *(LAS u32x4*)(Vwi + (tid >> 3) * VP + (tid & 7) * 16) = o; }
            if (st + 1 < 68) ML_LOAD(st + 1);
            const float decay = f_sc[0];
            const int t = 16 * mt + fr;
            if (isx) {
                f32x4 sacc[2] = {(f32x4){0.f, 0.f, 0.f, 0.f}, (f32x4){0.f, 0.f, 0.f, 0.f}};
#pragma unroll
                for (int ks = 0; ks < 8; ++ks) { const bf16x8 qf = *(const LAS bf16x8*)(Qi + t * QP + (32 * ks + 8 * fq) * 2);
#pragma unroll
                    for (int n = 0; n < 2; ++n) { const bf16x8 kf = *(const LAS bf16x8*)(Ki + (16 * (nt0 + n) + fr) * QP + (32 * ks + 8 * fq) * 2); sacc[n] = mfma16(kf, qf, sacc[n]); } }
                const float btm = f_bt[t];
#pragma unroll
                for (int n = 0; n < 2; ++n) { const int s0 = 16 * (nt0 + n) + 4 * fq; const f32x4 a4 = *(const LAS f32x4*)(f_aa + s0); float vv[4];
#pragma unroll
                    for (int j = 0; j < 4; ++j) { const int s = s0 + j; const bool ok = dir ? (s >= t) : (s <= t); const float e = __expf(btm + a4[j]); vv[j] = ok ? sacc[n][j] * e : 0.f; }
                    u32x2 w; w.x = pk2(vv[0], vv[1]); w.y = pk2(vv[2], vv[3]); *(LAS u32x2*)(Sgi + t * VP + s0 * 2) = w; }
            }
            __syncthreads();
            if (isx) {
                float rs = 0.f, qn = 0.f;
#pragma unroll
                for (int i = 0; i < 2; ++i) { const bf16x8 sg = *(const LAS bf16x8*)(Sgi + t * VP + (16 * fq + 8 * i) * 2);
#pragma unroll
                    for (int e = 0; e < 8; ++e) rs += bf2f((unsigned short)sg[e]); }
#pragma unroll
                for (int i = 0; i < 8; ++i) { const bf16x8 qv = *(const LAS bf16x8*)(Qi + t * QP + (64 * fq + 8 * i) * 2);
                    const f32x4 n0 = *(const LAS f32x4*)(f_nvec + 64 * fq + 8 * i), n1 = *(const LAS f32x4*)(f_nvec + 64 * fq + 8 * i + 4);
#pragma unroll
                    for (int e = 0; e < 4; ++e) qn += bf2f((unsigned short)qv[e]) * n0[e] + bf2f((unsigned short)qv[4 + e]) * n1[e]; }
                rs += __shfl_xor(rs, 16); rs += __shfl_xor(rs, 32); qn += __shfl_xor(qn, 16); qn += __shfl_xor(qn, 32);
                const float inter_t = f_inter[t];
                const float rden = 1.0f / fmaxf(fabsf(rs + inter_t * qn), f_enm[t]);
                f32x4 accC[2] = {(f32x4){0.f, 0.f, 0.f, 0.f}, (f32x4){0.f, 0.f, 0.f, 0.f}}, accD[2] = {(f32x4){0.f, 0.f, 0.f, 0.f}, (f32x4){0.f, 0.f, 0.f, 0.f}};
#pragma unroll
                for (int ks = 0; ks < 8; ++ks) { const bf16x8 qf = *(const LAS bf16x8*)(Qi + t * QP + (32 * ks + 8 * fq) * 2);
#pragma unroll
                    for (int n = 0; n < 2; ++n) { const bf16x8 cf = *(const LAS bf16x8*)(Ci + (16 * (nt0 + n) + fr) * QP + (32 * ks + 8 * fq) * 2); accC[n] = mfma16(cf, qf, accC[n]); } }
#pragma unroll
                for (int ks = 0; ks < 2; ++ks) { const bf16x8 sgf = *(const LAS bf16x8*)(Sgi + t * VP + (32 * ks + 8 * fq) * 2);
#pragma unroll
                    for (int n = 0; n < 2; ++n) { const bf16x8 vf = tr_frag(Vi, VP, 32 * ks, 16 * (nt0 + n), lane); accD[n] = mfma16(vf, sgf, accD[n]); } }
                const int xc = st - 4, cc = dir ? 63 - xc : xc;
                bf16_t* hp = Hout + ((size_t)b * 4096 + cc * 64 + t) * 1024 + h * 256 + es * 64 + 4 * fq;
#pragma unroll
                for (int n = 0; n < 2; ++n) { const f32x4 hv = (accD[n] + accC[n] * inter_t) * rden;
                    u32x2 w; w.x = pk2(hv[0], hv[1]); w.y = pk2(hv[2], hv[3]); *(u32x2*)(hp + 16 * (nt0 + n)) = w; }
            }
#pragma unroll
            for (int i = 0; i < 2; ++i)
#pragma unroll
                for (int n = 0; n < 4; ++n) Cst[i][n] = Cst[i][n] * decay;
#pragma unroll
            for (int ks = 0; ks < 2; ++ks) { bf16x8 kf[2];
#pragma unroll
                for (int i = 0; i < 2; ++i) kf[i] = tr_frag(Ki, QP, 32 * ks, 16 * (2 * wid + i), lane);
#pragma unroll
                for (int n = 0; n < 4; ++n) { const bf16x8 vw = tr_frag(Vwi, VP, 32 * ks, 16 * n, lane);
#pragma unroll
                    for (int i = 0; i < 2; ++i) Cst[i][n] = mfma16(kf[i], vw, Cst[i][n]); } }
            if (tid < 256) { float a = 0.f; for (int s = 0; s < 64; ++s) a += f_ws[s] * bf2f(*(const LAS unsigned short*)(Ki + s * QP + tid * 2)); nst = decay * nst + a; }
            __syncthreads();
#pragma unroll
            for (int i = 0; i < 2; ++i)
#pragma unroll
                for (int n = 0; n < 4; ++n) { u32x2 w; w.x = pk2(Cst[i][n][0], Cst[i][n][1]); w.y = pk2(Cst[i][n][2], Cst[i][n][3]);
                    *(LAS u32x2*)(Ci + (16 * n + fr) * QP + (16 * (2 * wid + i) + 4 * fq) * 2) = w; }
            if (tid < 256) f_nvec[tid] = nst;
        }
#undef ML_LOAD
    }
}

template <int KK, int NN, class Cfg>
DI void axis_mix(const Cfg& cfg, LAS unsigned char* lds, int n_items) {
    constexpr int TP = 528, BP = KK * 2 + 16, NCH = KK / 16;
    LAS unsigned char* Ti = lds; LAS unsigned char* Bi = lds + 128 * TP;
    const int tid = opaque_tid(), wid = tid >> 6, lane = tid & 63, fr = lane & 15, fq = lane >> 4;
    __syncthreads();
    cfg.fill_tables(Bi, tid);
    u32x4 r[NCH];
    int item = blockIdx.x;
    if (item < n_items) {
#pragma unroll
        for (int i = 0; i < NCH; ++i) { const int id = tid + 512 * i; r[i] = *(const u32x4*)(cfg.row_ptr(item, id >> 5) + (id & 31) * 8); } }
    for (; item < n_items; item += gridDim.x) {
        __syncthreads();
#pragma unroll
        for (int i = 0; i < NCH; ++i) { const int id = tid + 512 * i; *(LAS u32x4*)(Ti + (id >> 5) * TP + (id & 31) * 16) = r[i]; }
        __syncthreads();
        const int nxt = item + gridDim.x;
        if (nxt < n_items) {
#pragma unroll
            for (int i = 0; i < NCH; ++i) { const int id = tid + 512 * i; r[i] = *(const u32x4*)(cfg.row_ptr(nxt, id >> 5) + (id & 31) * 8); } }
        f32x4 acc[2][NN / 16];
#pragma unroll
        for (int i = 0; i < 2; ++i)
#pragma unroll
            for (int n = 0; n < NN / 16; ++n) acc[i][n] = (f32x4){0.f, 0.f, 0.f, 0.f};
        LAS unsigned char* tb = Bi + cfg.table_off(item);
#pragma unroll
        for (int ks = 0; ks < KK / 32; ++ks) { bf16x8 af[2];
#pragma unroll
            for (int i = 0; i < 2; ++i) af[i] = tr_frag(Ti, TP, 32 * ks, 32 * wid + 16 * i, lane);
#pragma unroll
            for (int n = 0; n < NN / 16; ++n) { const bf16x8 bfr = *(const LAS bf16x8*)(tb + (16 * n + fr) * BP + (32 * ks + 8 * fq) * 2);
#pragma unroll
                for (int i = 0; i < 2; ++i) acc[i][n] = mfma16(af[i], bfr, acc[i][n]); } }
        cfg.epilogue(acc, item, wid, fr, fq, Bi);
    }
}
DI void fill_dft_table(LAS unsigned char* Bi, int tid, int nrows) {
    for (int idx = tid; idx < nrows * 128; idx += 512) { const int n = idx >> 7, k = idx & 127, ap = n & 63, kk = k & 63; float s, c; sincospif((float)((kk * ap) & 63) / 32.0f, &s, &c);
        float v; if (n < 64) v = (k < 64) ? c : s; else v = (k < 64) ? -s : c;
        *(LAS unsigned short*)(Bi + n * 272 + k * 2) = (unsigned short)(pk2(v * 0.125f, 0.f) & 0xffffu); }
}
struct CfgDft1 {
    const bf16_t* Z; bf16_t* S1re; bf16_t* S1im;
    DI void fill_tables(LAS unsigned char* Bi, int tid) const { fill_dft_table(Bi, tid, 128);
        LAS float* tw = (LAS float*)(Bi + 34816);
        for (int j = tid; j < 4096; j += 512) { float s, c; sincospif((float)j / 2048.0f, &s, &c); tw[2 * j] = c; tw[2 * j + 1] = s; } }
    DI int table_off(int) const { return 0; }
    DI const bf16_t* row_ptr(int item, int k) const { const int g = item & 3, b = (item >> 2) & 63, batch = item >> 8;
        return Z + ((size_t)batch * 4096 + 64 * (k & 63) + b) * 2048 + g * 512 + (k >> 6) * 256; }
    DI void epilogue(const f32x4 (&acc)[2][8], int item, int wid, int fr, int fq, LAS unsigned char* Bi) const {
        const int g = item & 3, b = (item >> 2) & 63, batch = item >> 8;
        const LAS float* tw = (const LAS float*)(Bi + 34816);
#pragma unroll
        for (int ni = 0; ni < 4; ++ni) { const int ap = 16 * ni + fr; float s, c; sincospif((float)(b * ap) * (1.0f / 2048.0f), &s, &c);
            const size_t tok = (size_t)batch * 4096 + 64 * ap + b;
#pragma unroll
            for (int i = 0; i < 2; ++i) { const f32x4 re = acc[i][ni], im = acc[i][ni + 4]; const f32x4 r2 = re * c + im * s, i2 = im * c - re * s;
                const size_t o = tok * 1024 + g * 256 + 32 * wid + 16 * i + 4 * fq;
                u32x2 w; w.x = pk2(r2[0], r2[1]); w.y = pk2(r2[2], r2[3]); *(u32x2*)(S1re + o) = w;
                w.x = pk2(i2[0], i2[1]); w.y = pk2(i2[2], i2[3]); *(u32x2*)(S1im + o) = w; } }
    }
};
struct CfgDft2 {
    const bf16_t* S1re; const bf16_t* S1im; const bf16_t* ZB; bf16_t* Y;
    DI void fill_tables(LAS unsigned char* Bi, int tid) const { fill_dft_table(Bi, tid, 64); }
    DI int table_off(int) const { return 0; }
    DI const bf16_t* row_ptr(int item, int k) const { const int g = item & 3, ap = (item >> 2) & 63, batch = item >> 8;
        return ((k >> 6) ? S1im : S1re) + ((size_t)batch * 4096 + 64 * ap + (k & 63)) * 1024 + g * 256; }
    DI void epilogue(const f32x4 (&acc)[2][4], int item, int wid, int fr, int fq, LAS unsigned char*) const {
        const int g = item & 3, ap = (item >> 2) & 63, batch = item >> 8;
#pragma unroll
        for (int ni = 0; ni < 4; ++ni) { const size_t tok = (size_t)batch * 4096 + ap + 64 * (16 * ni + fr);
#pragma unroll
            for (int i = 0; i < 2; ++i) { const int ch = g * 256 + 32 * wid + 16 * i + 4 * fq; const u32x2 z = *(const u32x2*)(ZB + tok * 1024 + ch); const f32x4 a = acc[i][ni];
                u32x2 w; w.x = pk2(a[0] * silu_f(lo_f(z.x)), a[1] * silu_f(hi_f(z.x))); w.y = pk2(a[2] * silu_f(lo_f(z.y)), a[3] * silu_f(hi_f(z.y)));
                *(u32x2*)(Y + tok * 2048 + 1024 + ch) = w; } }
    }
};
DI void fill_pool_tables(LAS unsigned char* Bi, int tid) {
    for (int idx = tid; idx < 4 * 4096; idx += 512) { const int g = idx >> 12, n = (idx >> 6) & 63, k = idx & 63, w = 2 << g, lo = n - w / 2, hi = n + w - w / 2;
        *(LAS unsigned short*)(Bi + g * 9216 + n * 144 + k * 2) = (k >= lo && k < hi) ? (unsigned short)0x3F80 : (unsigned short)0; }
}
DI float pool_rcnt(int g, int n) { const int w = 2 << g; int lo = n - w / 2, hi = n + w - w / 2; lo = lo < 0 ? 0 : lo; hi = hi > 64 ? 64 : hi; return 1.0f / (float)(hi - lo); }
struct CfgPoolA {
    const bf16_t* UC; bf16_t* PA;
    DI void fill_tables(LAS unsigned char* Bi, int tid) const { fill_pool_tables(Bi, tid); }
    DI int table_off(int item) const { return ((item & 7) >> 1) * 9216; }
    DI const bf16_t* row_ptr(int item, int k) const { const int ct = item & 7, c = (item >> 3) & 63, batch = item >> 9; return UC + ((size_t)batch * 4096 + 64 * k + c) * 2048 + ct * 256; }
    DI void epilogue(const f32x4 (&acc)[2][4], int item, int wid, int fr, int fq, LAS unsigned char*) const {
        const int ct = item & 7, c = (item >> 3) & 63, batch = item >> 9, g = ct >> 1;
#pragma unroll
        for (int ni = 0; ni < 4; ++ni) { const int n = 16 * ni + fr; const float rc = pool_rcnt(g, n); const size_t tok = (size_t)batch * 4096 + 64 * n + c;
#pragma unroll
            for (int i = 0; i < 2; ++i) { const f32x4 a = acc[i][ni] * rc; u32x2 w; w.x = pk2(a[0], a[1]); w.y = pk2(a[2], a[3]);
                *(u32x2*)(PA + tok * 2048 + ct * 256 + 32 * wid + 16 * i + 4 * fq) = w; } }
    }
};
struct CfgPoolB {
    const bf16_t* PA; bf16_t* UC;
    DI void fill_tables(LAS unsigned char* Bi, int tid) const { fill_pool_tables(Bi, tid); }
    DI int table_off(int item) const { return ((item & 7) >> 1) * 9216; }
    DI const bf16_t* row_ptr(int item, int k) const { const int ct = item & 7, rp = (item >> 3) & 63, batch = item >> 9; return PA + ((size_t)batch * 4096 + 64 * rp + k) * 2048 + ct * 256; }
    DI void epilogue(const f32x4 (&acc)[2][4], int item, int wid, int fr, int fq, LAS unsigned char*) const {
        const int ct = item & 7, rp = (item >> 3) & 63, batch = item >> 9, g = ct >> 1;
#pragma unroll
        for (int ni = 0; ni < 4; ++ni) { const int n = 16 * ni + fr; const float rc = pool_rcnt(g, n); const size_t tok = (size_t)batch * 4096 + 64 * rp + n;
#pragma unroll
            for (int i = 0; i < 2; ++i) { bf16_t* up = UC + tok * 2048 + ct * 256 + 32 * wid + 16 * i + 4 * fq; const u32x2 u = *(const u32x2*)up; const f32x4 a = acc[i][ni] * rc;
                u32x2 w; w.x = pk2(a[0] - lo_f(u.x), a[1] - hi_f(u.x)); w.y = pk2(a[2] - lo_f(u.y), a[3] - hi_f(u.y)); *(u32x2*)up = w; } }
    }
};

DI void ph_ya(const Params& p) {
    const int tid = opaque_tid(), wid = tid >> 6, lane = tid & 63;
    const bf16_t* HF = (const bf16_t*)p.ws; const bf16_t* HB = (const bf16_t*)(p.ws + PLANE); const bf16_t* O = (const bf16_t*)(p.ws + 3 * PLANE); const bf16_t* ZA = (const bf16_t*)(p.ws + 4 * PLANE);
    bf16_t* Y = (bf16_t*)p.out;
    f32x4 hg[4];
#pragma unroll
    for (int i = 0; i < 4; ++i) hg[i] = *(const f32x4*)(p.head_norm + lane * 16 + 4 * i);
    for (int r = blockIdx.x * 8 + wid; r < NX; r += gridDim.x * 8) {
        const size_t o = (size_t)r * 1024 + lane * 16;
        float gv[16], za[16]; float ss = 0.f;
#pragma unroll
        for (int hh = 0; hh < 2; ++hh) { const u32x4 a = *(const u32x4*)(HF + o + 8 * hh), bq = *(const u32x4*)(HB + o + 8 * hh), oo = *(const u32x4*)(O + o + 8 * hh), zz = *(const u32x4*)(ZA + o + 8 * hh);
#pragma unroll
            for (int e = 0; e < 4; ++e) { const float h0 = lo_f(a[e]) + lo_f(bq[e]), h1 = hi_f(a[e]) + hi_f(bq[e]);
                const float g0 = sigmoid_f(lo_f(oo[e])) * h0, g1 = sigmoid_f(hi_f(oo[e])) * h1;
                gv[8 * hh + 2 * e] = g0; gv[8 * hh + 2 * e + 1] = g1; ss += g0 * g0 + g1 * g1; za[8 * hh + 2 * e] = lo_f(zz[e]); za[8 * hh + 2 * e + 1] = hi_f(zz[e]); } }
        ss += __shfl_xor(ss, 1); ss += __shfl_xor(ss, 2); ss += __shfl_xor(ss, 4); ss += __shfl_xor(ss, 8);
        const float rstd = rsqrtf(ss * (1.0f / 256.0f) + 1e-6f);
        u32x4 w[2];
#pragma unroll
        for (int q = 0; q < 8; ++q) { const float y0 = gv[2 * q] * rstd * hg[q >> 1][(2 * q) & 3] * silu_f(za[2 * q]), y1 = gv[2 * q + 1] * rstd * hg[q >> 1][(2 * q + 1) & 3] * silu_f(za[2 * q + 1]);
            w[q >> 2][q & 3] = pk2(y0, y1); }
        *(u32x4*)(Y + (size_t)r * 2048 + lane * 16) = w[0]; *(u32x4*)(Y + (size_t)r * 2048 + lane * 16 + 8) = w[1];
    }
}

__global__ void __launch_bounds__(512, 2) mk_fwd(Params p, int ph_lo, int ph_hi) {
    extern __shared__ __attribute__((aligned(16))) unsigned char shm[];
    LAS unsigned char* lds = (LAS unsigned char*)shm;
    cg::grid_group grid = cg::this_grid();
    unsigned char* ws = p.ws;
    const int G = gridDim.x, c = blockIdx.x;
#ifndef PHMASK
#define PHMASK 0xFFFF
#endif
#define GSYNC() do { asm volatile("s_waitcnt vmcnt(0) lgkmcnt(0)" ::: "memory"); grid.sync(); __builtin_amdgcn_fence(__ATOMIC_ACQUIRE, "agent"); asm volatile("s_waitcnt vmcnt(0)" ::: "memory"); } while (0)
#define PHASE(i, ...) if constexpr ((PHMASK >> (i)) & 1) if (ph_lo <= (i) && (i) < ph_hi) { __VA_ARGS__; if ((i) + 1 < ph_hi) GSYNC(); }
    PHASE(0, ph_prep(p, lds));
    PHASE(1, ph_norm0(p, lds));
    PHASE(2, { GemmD g{(const bf16_t*)p.out, (const bf16_t*)(ws + WS_WINE), 1024, 1024, 0, 0, 1024}; Sched S{128, 28, 1, 8, 12, 128, G, c};
               EpiPlanes E{(bf16_t*)ws, (bf16_t*)(ws + WS_CRAW)}; gemm_phase(lds, g, S, E); });
    PHASE(3, ph_conv(p));
    PHASE(4, ph_mlstm(p, lds));
    PHASE(5, { GemmD g{(const bf16_t*)(ws + 5 * PLANE), (const bf16_t*)(ws + WS_WF), 1024, 256, 256, 512 * 256, 256}; Sched S{128, 2, 4, 0, 0, 0, G, c};
               EpiBf E{(bf16_t*)p.out, nullptr, 2048, 512, 0, nullptr, nullptr}; gemm_phase(lds, g, S, E); });
    PHASE(6, { CfgDft1 cf{(const bf16_t*)p.out, (bf16_t*)(ws + 2 * PLANE), (bf16_t*)(ws + 5 * PLANE)}; axis_mix<128, 128>(cf, lds, 2048); });
    PHASE(7, { CfgDft2 cf{(const bf16_t*)(ws + 2 * PLANE), (const bf16_t*)(ws + 5 * PLANE), (const bf16_t*)(ws + 6 * PLANE), (bf16_t*)p.out}; axis_mix<128, 64>(cf, lds, 2048); ph_ya(p); });
    PHASE(8, { GemmD g{(const bf16_t*)p.out, (const bf16_t*)(ws + WS_WOUTE), 2048, 2048, 0, 0, 2048}; Sched S{128, 4, 1, 0, 0, 0, G, c};
               EpiRes E{(float*)ws, p.x, (const float*)(ws + WS_MOD) + 2048}; gemm_phase(lds, g, S, E); });
    PHASE(9, ph_norm1(p, 0));
    PHASE(10, { GemmD g{(const bf16_t*)(ws + 2 * PLANE), (const bf16_t*)(ws + WS_WINO), 1024, 1024, 0, 0, 1024}; Sched S{128, 16, 1, 0, 0, 0, G, c};
                EpiBf E{(bf16_t*)(ws + 3 * PLANE), (bf16_t*)(ws + 5 * PLANE), 2048, 0, 1, nullptr, nullptr}; gemm_phase(lds, g, S, E); });
    PHASE(11, { CfgPoolA cf{(const bf16_t*)(ws + 3 * PLANE), (bf16_t*)p.out}; axis_mix<64, 64>(cf, lds, 4096); });
    PHASE(12, { CfgPoolB cf{(const bf16_t*)p.out, (bf16_t*)(ws + 3 * PLANE)}; axis_mix<64, 64>(cf, lds, 4096); });
    PHASE(13, { GemmD g{(const bf16_t*)(ws + 3 * PLANE), (const bf16_t*)(ws + WS_WPOOL), 2048, 512, 512, 512 * 512, 512}; Sched S{128, 2, 4, 0, 0, 0, G, c};
                EpiBf E{(bf16_t*)p.out, nullptr, 2048, 512, 2, p.pool_scale, (const bf16_t*)(ws + 5 * PLANE)}; gemm_phase(lds, g, S, E); });
    PHASE(14, { GemmD g{(const bf16_t*)p.out, (const bf16_t*)(ws + WS_WOUTO), 2048, 2048, 0, 0, 2048}; Sched S{128, 4, 1, 0, 0, 0, G, c};
                EpiRes E{(float*)ws, (const float*)ws, (const float*)(ws + WS_MOD) + 9 * 3072 + 2048}; gemm_phase(lds, g, S, E); });
    PHASE(15, ph_norm1(p, 1));
#undef PHASE
#ifdef DBG_STOP
    GSYNC();
    {   const size_t n = (size_t)NX * 1024; unsigned* o32 = (unsigned*)p.out;
        for (size_t i = (size_t)blockIdx.x * 512 + threadIdx.x; i < n; i += (size_t)gridDim.x * 512) {
            float v = 0.f;
            if (DBG_PLANES == -1) { const unsigned u = o32[i]; v = lo_f(u) + hi_f(u); }
            else if (DBG_PLANES == -2) { v = ((const float*)p.ws)[i]; }
            else { for (int pl = 0; pl < 7; ++pl) if ((DBG_PLANES >> pl) & 1) v += bf2f(((const bf16_t*)(p.ws + pl * PLANE))[i]); }
            if (!(fabsf(v) < 1e30f)) v = 12345.f;
            p.out[i] = v; } }
#endif
}

extern "C" void kernel_launch(void* const* d_in, const int* in_sizes, int n_in, void* d_out, int out_size, void* d_ws, size_t ws_size, hipStream_t stream) {
    static int grid = 0;
    if (grid == 0) {
        int dev = 0, cus = 0, per_cu = 0;
        hipGetDevice(&dev);
        hipDeviceGetAttribute(&cus, hipDeviceAttributeMultiprocessorCount, dev);
        if (hipFuncSetAttribute((const void*)mk_fwd, hipFuncAttributeMaxDynamicSharedMemorySize, LDS_BYTES) != hipSuccess) fprintf(stderr, "hipFuncSetAttribute failed\n");
        if (hipOccupancyMaxActiveBlocksPerMultiprocessor(&per_cu, (const void*)mk_fwd, 512, LDS_BYTES) != hipSuccess || per_cu < 1) { fprintf(stderr, "occupancy query: %d\n", per_cu); per_cu = 1; }
        (void)hipGetLastError();
        grid = cus * per_cu; if (grid > 256) grid = 256; if (grid < 1) grid = 1;
        if (ws_size < WS_END) fprintf(stderr, "workspace too small: %zu < %zu\n", ws_size, (size_t)WS_END);
    }
    Params p{};
    p.x = (const float*)d_in[0]; p.c = (const float*)d_in[1]; p.ctx = (const float*)d_in[2]; p.c_ctx = (const float*)d_in[3]; p.ada_w = (const float*)d_in[4]; p.ada_b = (const float*)d_in[5];
    p.norm_g = (const float*)d_in[6]; p.win_even = (const float*)d_in[7]; p.gate_b = (const float*)d_in[8]; p.conv_qk = (const float*)d_in[9]; p.head_norm = (const float*)d_in[10];
    p.fourier_w = (const float*)d_in[11]; p.wout_even = (const float*)d_in[12]; p.win_odd = (const float*)d_in[13]; p.pool_w = (const float*)d_in[14]; p.pool_scale = (const float*)d_in[15];
    p.wout_odd = (const float*)d_in[16]; p.final_g = (const float*)d_in[17]; p.out = (float*)d_out; p.ws = (unsigned char*)d_ws;
#if MK_MULTI
    for (int ph = 0; ph < 16; ++ph) { hipLaunchKernelGGL(mk_fwd, dim3(grid), dim3(512), LDS_BYTES, stream, p, ph, ph + 1); }
#else
#ifdef DBG_STOP
    int lo = 0, hi = DBG_STOP;
#else
    int lo = 0, hi = 16;
#endif
    void* args[] = {&p, &lo, &hi};
    hipError_t e = hipLaunchCooperativeKernel((void*)mk_fwd, dim3(grid), dim3(512), args, LDS_BYTES, stream);
    if (e != hipSuccess) fprintf(stderr, "cooperative launch failed: %s (grid %d)\n", hipGetErrorString(e), grid);
#endif
}
```

```cpp
#include <hip/hip_runtime.h>
#include <hip/hip_cooperative_groups.h>
#include <cstdio>
namespace cg = cooperative_groups;

#ifndef MK_MULTI
#define MK_MULTI 0
#endif

#define LAS __attribute__((address_space(3)))
typedef unsigned short bf16_t;
typedef short bf16x8 __attribute__((ext_vector_type(8)));
typedef short s16x4 __attribute__((ext_vector_type(4)));
typedef float f32x4 __attribute__((ext_vector_type(4)));
typedef unsigned u32x4 __attribute__((ext_vector_type(4)));
typedef unsigned u32x2 __attribute__((ext_vector_type(2)));

constexpr int NX = 32768, NCX = 2048, NR = NX + NCX;
constexpr size_t PLANE = (size_t)NX * 1024 * 2;
constexpr size_t WS_EXTRA = 7 * PLANE;
constexpr size_t WS_WINE  = WS_EXTRA;
constexpr size_t WS_WOUTE = WS_WINE  + (size_t)7168 * 1024 * 2;
constexpr size_t WS_WINO  = WS_WOUTE + (size_t)1024 * 2048 * 2;
constexpr size_t WS_WPOOL = WS_WINO  + (size_t)4096 * 1024 * 2;
constexpr size_t WS_WOUTO = WS_WPOOL + (size_t)4 * 512 * 512 * 2;
constexpr size_t WS_WF    = WS_WOUTO + (size_t)1024 * 2048 * 2;
constexpr size_t WS_MOD   = WS_WF    + (size_t)4 * 512 * 256 * 2;
constexpr size_t WS_GATES = WS_MOD   + 262144;
constexpr size_t WS_CRAW  = WS_GATES + (size_t)NR * 16 * 4;
constexpr size_t WS_CQC   = WS_CRAW  + (size_t)3 * NCX * 1024 * 2;
constexpr size_t WS_CKC   = WS_CQC   + (size_t)NCX * 1024 * 2;
constexpr size_t WS_END   = WS_CKC   + (size_t)NCX * 1024 * 2;
constexpr size_t WS_BAR   = WS_END;
static_assert(WS_BAR + 16384 <= (size_t)512 * 1024 * 1024, "workspace map exceeds 512 MiB");

constexpr int LDS_BYTES = 143360;

struct Params {
    const float* x; const float* c; const float* ctx; const float* c_ctx; const float* ada_w; const float* ada_b; const float* norm_g;
    const float* win_even; const float* gate_b; const float* conv_qk; const float* head_norm; const float* fourier_w; const float* wout_even;
    const float* win_odd; const float* pool_w; const float* pool_scale; const float* wout_odd; const float* final_g;
    float* out; unsigned char* ws;
};

#define DI __device__ __forceinline__
DI float bf2f(unsigned short b) { return __uint_as_float(((unsigned)b) << 16); }
DI float lo_f(unsigned u) { return __uint_as_float(u << 16); }
DI float hi_f(unsigned u) { return __uint_as_float(u & 0xffff0000u); }
typedef __bf16 bf16v2_t __attribute__((ext_vector_type(2)));
typedef float f32v2_t __attribute__((ext_vector_type(2)));
DI unsigned pk2(float lo, float hi) { const f32v2_t v = {lo, hi}; const bf16v2_t b = __builtin_convertvector(v, bf16v2_t); return __builtin_bit_cast(unsigned, b); }
DI float silu_f(float x) { return x / (1.0f + __expf(-x)); }
DI float sigmoid_f(float x) { return 1.0f / (1.0f + __expf(-x)); }
DI int opaque_tid() { int t = threadIdx.x; asm volatile("" : "+v"(t)); return t; }
DI float wave_sum(float v) { for (int o = 32; o > 0; o >>= 1) v += __shfl_xor(v, o); return v; }
DI float wave_max(float v) { for (int o = 32; o > 0; o >>= 1) v = fmaxf(v, __shfl_xor(v, o)); return v; }
DI f32x4 mfma16(bf16x8 a, bf16x8 b, f32x4 c) { return __builtin_amdgcn_mfma_f32_16x16x32_bf16(a, b, c, 0, 0, 0); }
DI bf16x8 tr_frag(LAS unsigned char* img, int pitch, int krow0, int col0, int lane) {
    const int g = lane >> 4, q = (lane & 15) >> 2, pp = lane & 3;
    LAS unsigned char* a0 = img + (krow0 + 8 * g + q) * pitch + col0 * 2 + 8 * pp;
    s16x4 lo = __builtin_amdgcn_ds_read_tr16_b64_v4i16((LAS s16x4*)a0);
    s16x4 hi = __builtin_amdgcn_ds_read_tr16_b64_v4i16((LAS s16x4*)(a0 + 4 * pitch));
    return __builtin_shufflevector(lo, hi, 0, 1, 2, 3, 4, 5, 6, 7);
}

constexpr int HTB = 128 * 64 * 2;
DI int lds_byte(int r, int c) { const int st = (r >> 4) * 2 + (c >> 5), rr = r & 15, cc = c & 31, ob = rr * 64 + cc * 2; return st * 1024 + (ob ^ (((ob >> 9) & 1) << 5)); }
DI void stage_rc(int b, int& R, int& C) { const int st = b / 1024, sb = b % 1024, swz = sb ^ (((sb >> 9) & 1) << 5); R = (st >> 1) * 16 + swz / 64; C = (st & 1) * 32 + (swz % 64) / 2; }
DI int perm32(int rho) { const int n = rho >> 4, i = rho & 15; return 8 * (i >> 2) + 4 * n + (i & 3); }

struct Unit { int pm, pn, g; };
struct GemmD { const bf16_t* A; const bf16_t* Bt; int lda, ldb; long a_gs, b_gs; int K; };
struct Sched {
    int nM, nN, nG, nM2, nN2, pm2off, G, c;
    DI bool next(int i, Unit& u) const {
        const int L = i * G + c; const int nwg = nM * nN, tot1 = nwg * nG;
        const bool first = L < tot1;
        const int L1 = first ? L : 0;
        const int g = L1 / nwg; int wgid = L1 - g * nwg;
        { const int q = nwg / 8, r = nwg % 8, xcd = wgid % 8, off = wgid / 8; wgid = (xcd < r ? xcd * (q + 1) : r * (q + 1) + (xcd - r) * q) + off; }
        const int nig = 8 * nN, gid = wgid / nig, fm = gid * 8, gsz = (nM - fm) < 8 ? (nM - fm) : 8;
        const int pm1 = fm + ((wgid % nig) % gsz), pn1 = (wgid % nig) / gsz;
        const int L2 = first ? 0 : L - tot1, d2 = nM2 > 0 ? nM2 : 1;
        const int pm2 = pm2off + L2 % d2, pn2 = L2 / d2;
        u.pm = first ? pm1 : pm2; u.pn = first ? pn1 : pn2; u.g = first ? g : 0;
        return first || (L2 < nM2 * nN2);
    }
};

template <class Epi>
DI void gemm_phase(LAS unsigned char* lds, const GemmD g, const Sched& S, const Epi& E) {
    const int tid = opaque_tid(), wid = __builtin_amdgcn_readfirstlane(tid >> 6), lane = tid & 63, wr = wid >> 2, wc = wid & 3, fr = lane & 15, fq = lane >> 4;
    const int K = g.K, nt = K / 64;
    unsigned voffA[2], voffB[2];
#pragma unroll
    for (int i = 0; i < 2; ++i) { int R, C; stage_rc(tid * 16 + i * 8192, R, C); const int Rb = Epi::PERM ? ((R & ~31) + perm32(R & 31)) : R;
        voffA[i] = (unsigned)(R * g.lda + C) * 2u; voffB[i] = (unsigned)(Rb * g.ldb + C) * 2u; }
    const size_t kstep = 128;
    const size_t hstepA = (size_t)128 * g.lda * 2, hstepB = (size_t)128 * g.ldb * 2;
    const unsigned ldsw = (unsigned)wid * 1024u;
    const int aoff = lds_byte(wr * 64 + fr, fq * 8), boff = lds_byte(wc * 32 + fr, fq * 8);
#define G_SA(b, h) (((b) * 2 + (h)) * HTB)
#define G_SB(b, h) ((4 + (b) * 2 + (h)) * HTB)
#define G_STAGE(bufoff, gbase, voff) do { _Pragma("unroll") for (int _i = 0; _i < 2; ++_i) \
        __builtin_amdgcn_global_load_lds((const unsigned*)((const char*)(gbase) + (voff)[_i]), (LAS unsigned*)(lds + (bufoff) + ldsw + _i * 8192), 16, 0, 0); } while (0)
#define G_LDA(dst, b, h) do { _Pragma("unroll") for (int m = 0; m < 4; ++m) _Pragma("unroll") for (int k = 0; k < 2; ++k) dst[m][k] = *(const LAS bf16x8*)(lds + G_SA(b, h) + aoff + m * 2048 + k * 1024); } while (0)
#define G_LDB(dst, b, h) do { _Pragma("unroll") for (int n = 0; n < 2; ++n) _Pragma("unroll") for (int k = 0; k < 2; ++k) dst[n][k] = *(const LAS bf16x8*)(lds + G_SB(b, h) + boff + n * 2048 + k * 1024); } while (0)
#define G_MMA(ai, bj, At, Bt) do { __builtin_amdgcn_s_setprio(1); _Pragma("unroll") for (int m = 0; m < 4; ++m) _Pragma("unroll") for (int n = 0; n < 2; ++n) _Pragma("unroll") for (int k = 0; k < 2; ++k) \
        acc[ai][bj][m][n] = __builtin_amdgcn_mfma_f32_16x16x32_bf16(Bt[n][k], At[m][k], acc[ai][bj][m][n], 0, 0, 0); __builtin_amdgcn_s_setprio(0); } while (0)
#define G_WAIT_V(n) asm volatile("s_waitcnt vmcnt(" #n ")" ::: "memory")
#define G_WAIT_L(n) asm volatile("s_waitcnt lgkmcnt(" #n ")" ::: "memory")
#define G_BAR __builtin_amdgcn_s_barrier()
#define G_SCHED __builtin_amdgcn_sched_barrier(0)
    Unit cur, nxt; int ui = 0;
    if (!S.next(0, cur)) return;
    f32x4 acc[2][2][4][2];
#pragma unroll
    for (int a = 0; a < 2; ++a)
#pragma unroll
        for (int b = 0; b < 2; ++b)
#pragma unroll
            for (int m = 0; m < 4; ++m)
#pragma unroll
                for (int n = 0; n < 2; ++n) acc[a][b][m][n] = (f32x4){0.f, 0.f, 0.f, 0.f};
    bf16x8 At[4][2], B0[2][2], B1[2][2];
    const char* cA = (const char*)(g.A + (long)cur.g * g.a_gs) + (size_t)cur.pm * 2 * hstepA;
    const char* cB = (const char*)(g.Bt + (long)cur.g * g.b_gs) + (size_t)cur.pn * 2 * hstepB;
    G_STAGE(G_SB(0, 0), cB, voffB); G_STAGE(G_SA(0, 0), cA, voffA); G_STAGE(G_SB(0, 1), cB + hstepB, voffB); G_STAGE(G_SA(0, 1), cA + hstepA, voffA);
    if (wr == 1) G_BAR;
    G_WAIT_V(4); G_BAR;
    G_STAGE(G_SB(1, 0), cB + kstep, voffB); G_STAGE(G_SA(1, 0), cA + kstep, voffA); G_STAGE(G_SB(1, 1), cB + hstepB + kstep, voffB);
    G_WAIT_V(6); G_BAR;
    for (;;) {
        const bool has_next = S.next(ui + 1, nxt);
        const char* nA = has_next ? (const char*)(g.A + (long)nxt.g * g.a_gs) + (size_t)nxt.pm * 2 * hstepA : cA;
        const char* nB = has_next ? (const char*)(g.Bt + (long)nxt.g * g.b_gs) + (size_t)nxt.pn * 2 * hstepB : cB;
        for (int t = 0; t < nt; t += 2) {
            const bool last = (t == nt - 2);
            const char* a1 = cA + (size_t)(t + 1) * kstep;
            const char* a2 = last ? nA : cA + (size_t)(t + 2) * kstep; const char* b2 = last ? nB : cB + (size_t)(t + 2) * kstep;
            const char* a3 = a2 + kstep; const char* b3 = b2 + kstep;
            G_LDB(B0, 0, 0); G_SCHED; G_LDA(At, 0, 0); G_STAGE(G_SA(1, 1), a1 + hstepA, voffA);
            G_WAIT_L(8); G_BAR; G_WAIT_L(0); G_MMA(0, 0, At, B0); G_BAR; G_SCHED;
            G_LDB(B1, 0, 1); G_STAGE(G_SB(0, 0), b2, voffB);
            G_BAR; G_WAIT_L(0); G_MMA(0, 1, At, B1); G_BAR;
            G_LDA(At, 0, 1); G_STAGE(G_SA(0, 0), a2, voffA);
            G_BAR; G_WAIT_L(0); G_MMA(1, 0, At, B0); G_BAR; G_SCHED;
            G_STAGE(G_SB(0, 1), b2 + hstepB, voffB);
            G_WAIT_V(6); G_BAR; G_MMA(1, 1, At, B1); G_BAR;
            G_LDB(B0, 1, 0); G_SCHED; G_LDA(At, 1, 0); G_STAGE(G_SA(0, 1), a2 + hstepA, voffA);
            G_WAIT_L(8); G_BAR; G_WAIT_L(0); G_MMA(0, 0, At, B0); G_BAR; G_SCHED;
            G_LDB(B1, 1, 1); G_STAGE(G_SB(1, 0), b3, voffB);
            G_BAR; G_WAIT_L(0); G_MMA(0, 1, At, B1); G_BAR;
            G_LDA(At, 1, 1); G_STAGE(G_SA(1, 0), a3, voffA);
            G_BAR; G_WAIT_L(0); G_MMA(1, 0, At, B0); G_BAR; G_SCHED;
            G_STAGE(G_SB(1, 1), b3 + hstepB, voffB);
            G_WAIT_V(6); G_BAR; G_MMA(1, 1, At, B1); G_BAR;
        }
        E(acc, cur, wr, wc, fr, fq);
        if (!has_next) break;
#pragma unroll
        for (int a = 0; a < 2; ++a)
#pragma unroll
            for (int b = 0; b < 2; ++b)
#pragma unroll
                for (int m = 0; m < 4; ++m)
#pragma unroll
                    for (int n = 0; n < 2; ++n) acc[a][b][m][n] = (f32x4){0.f, 0.f, 0.f, 0.f};
        cur = nxt; cA = nA; cB = nB; ++ui;
    }
    G_WAIT_V(0);
    if (wr == 0) G_BAR;
    G_BAR;
}

struct EpiPlanes {
    static constexpr bool PERM = true;
    bf16_t* xbase; bf16_t* cbase;
    DI void operator()(const f32x4 (&acc)[2][2][4][2], const Unit& u, int wr, int wc, int fr, int fq) const {
        const int plane = u.pn >> 2, colt = (u.pn & 3) * 256;
        bf16_t* base; int row0;
        if (u.pm < 128) { base = xbase + (size_t)plane * NX * 1024; row0 = u.pm * 256 + wr * 64 + fr; }
        else { base = cbase + (size_t)plane * NCX * 1024; row0 = (u.pm - 128) * 256 + wr * 64 + fr; }
        const int col0 = colt + wc * 32 + 8 * fq;
#pragma unroll
        for (int ai = 0; ai < 2; ++ai)
#pragma unroll
            for (int m = 0; m < 4; ++m) { bf16_t* rowp = base + (size_t)(row0 + ai * 128 + m * 16) * 1024 + col0;
#pragma unroll
                for (int bj = 0; bj < 2; ++bj) { const f32x4 v0 = acc[ai][bj][m][0], v1 = acc[ai][bj][m][1];
                    u32x4 w; w.x = pk2(v0[0], v0[1]); w.y = pk2(v0[2], v0[3]); w.z = pk2(v1[0], v1[1]); w.w = pk2(v1[2], v1[3]);
                    *(u32x4*)(rowp + bj * 128) = w; } }
    }
};
struct EpiBf {
    static constexpr bool PERM = true;
    bf16_t* O; bf16_t* O2; int ldc; int gcol; int mode; const float* scale; const bf16_t* zc;
    DI void operator()(const f32x4 (&acc)[2][2][4][2], const Unit& u, int wr, int wc, int fr, int fq) const {
        const int row0 = u.pm * 256 + wr * 64 + fr;
        bf16_t* base = O; int pn = u.pn; bool act = false;
        if (mode == 1 && pn >= 8) { base = O2; pn -= 8; act = true; }
        const int col0 = u.g * gcol + pn * 256 + wc * 32 + 8 * fq;
#pragma unroll
        for (int ai = 0; ai < 2; ++ai)
#pragma unroll
            for (int m = 0; m < 4; ++m) { const size_t ro = (size_t)(row0 + ai * 128 + m * 16) * ldc + col0;
#pragma unroll
                for (int bj = 0; bj < 2; ++bj) { f32x4 v0 = acc[ai][bj][m][0], v1 = acc[ai][bj][m][1];
                    if (act) {
#pragma unroll
                        for (int j = 0; j < 4; ++j) { v0[j] = silu_f(v0[j]); v1[j] = silu_f(v1[j]); } }
                    if (mode == 2) {
                        const u32x4 z = *(const u32x4*)(zc + ro + bj * 128);
                        const f32x4 s0 = *(const f32x4*)(scale + col0 + bj * 128), s1 = *(const f32x4*)(scale + col0 + bj * 128 + 4);
                        v0[0] *= s0[0] * lo_f(z.x); v0[1] *= s0[1] * hi_f(z.x); v0[2] *= s0[2] * lo_f(z.y); v0[3] *= s0[3] * hi_f(z.y);
                        v1[0] *= s1[0] * lo_f(z.z); v1[1] *= s1[1] * hi_f(z.z); v1[2] *= s1[2] * lo_f(z.w); v1[3] *= s1[3] * hi_f(z.w);
                    }
                    u32x4 w; w.x = pk2(v0[0], v0[1]); w.y = pk2(v0[2], v0[3]); w.z = pk2(v1[0], v1[1]); w.w = pk2(v1[2], v1[3]);
                    *(u32x4*)(base + ro + bj * 128) = w; } }
    }
};
struct EpiRes {
    static constexpr bool PERM = false;
    float* O; const float* res; const float* gate;
    DI void operator()(const f32x4 (&acc)[2][2][4][2], const Unit& u, int wr, int wc, int fr, int fq) const {
        const int row0 = u.pm * 256 + wr * 64 + fr, col0 = u.pn * 256 + wc * 32 + 4 * fq;
        const float* gp = gate + (size_t)(u.pm >> 4) * 3072 + col0;
        f32x4 gv[2][2];
#pragma unroll
        for (int bj = 0; bj < 2; ++bj)
#pragma unroll
            for (int n = 0; n < 2; ++n) gv[bj][n] = *(const f32x4*)(gp + bj * 128 + n * 16);
#pragma unroll
        for (int ai = 0; ai < 2; ++ai)
#pragma unroll
            for (int m = 0; m < 4; ++m) { const size_t ro = (size_t)(row0 + ai * 128 + m * 16) * 1024 + col0;
#pragma unroll
                for (int bj = 0; bj < 2; ++bj)
#pragma unroll
                    for (int n = 0; n < 2; ++n) { const f32x4 r = *(const f32x4*)(res + ro + bj * 128 + n * 16);
                        *(f32x4*)(O + ro + bj * 128 + n * 16) = r + gv[bj][n] * acc[ai][bj][m][n]; } }
    }
};

DI void ph_prep(const Params& p, LAS unsigned char* lds) {
    const int tid = opaque_tid();
    LAS float* tile = (LAS float*)lds;
    for (int job = blockIdx.x; job < 4096; job += gridDim.x) {
        const float* src; bf16_t* dst; int K, Nt, tk, tn; int j = job;
        if (j < 1792) { src = p.win_even; dst = (bf16_t*)(p.ws + WS_WINE); K = 1024; Nt = 7184; tk = j & 15; tn = j >> 4; }
        else if ((j -= 1792) < 512) { src = p.wout_even; dst = (bf16_t*)(p.ws + WS_WOUTE); K = 2048; Nt = 1024; tk = j & 31; tn = j >> 5; }
        else if ((j -= 512) < 1024) { src = p.win_odd; dst = (bf16_t*)(p.ws + WS_WINO); K = 1024; Nt = 4096; tk = j & 15; tn = j >> 4; }
        else if ((j -= 1024) < 256) { const int g = j >> 6, jj = j & 63; src = p.pool_w + (size_t)g * 512 * 512; dst = (bf16_t*)(p.ws + WS_WPOOL) + (size_t)g * 512 * 512; K = 512; Nt = 512; tk = jj & 7; tn = jj >> 3; }
        else { j -= 256; src = p.wout_odd; dst = (bf16_t*)(p.ws + WS_WOUTO); K = 2048; Nt = 1024; tk = j & 31; tn = j >> 5; }
        const int k0 = tk * 64, n0 = tn * 64;
#pragma unroll
        for (int i = 0; i < 8; ++i) { const int idx = tid + 512 * i, k = idx >> 6, n = idx & 63; tile[k * 65 + n] = src[(size_t)(k0 + k) * Nt + n0 + n]; }
        __syncthreads();
#pragma unroll
        for (int i = 0; i < 4; ++i) { const int idx = tid + 512 * i, n = idx >> 5, k = (idx & 31) * 2;
            *(unsigned*)(dst + (size_t)(n0 + n) * K + k0 + k) = pk2(tile[k * 65 + n], tile[(k + 1) * 65 + n]); }
        __syncthreads();
    }
    LAS float* sv = (LAS float*)(lds + 32768);
    LAS float* red = (LAS float*)(lds + 32768 + 36864);
    LAS float* ct = (LAS float*)(lds + 90112); LAS float* st = ct + 256;
    for (int idx = tid; idx < 9216; idx += 512) { const int v = idx >> 10, k = idx & 1023; const float cv = (v < 8) ? p.c[v * 1024 + k] : p.c_ctx[k]; sv[idx] = silu_f(cv); }
    if (tid < 256) { float s, c; sincospif((float)tid / 128.0f, &s, &c); ct[tid] = c; st[tid] = s; }
    __syncthreads();
    float* MOD = (float*)(p.ws + WS_MOD);
    for (int item = blockIdx.x; item < 192; item += gridDim.x) {
        const int l = item / 96, c0 = (item % 96) * 32, kg = tid >> 5, col = tid & 31;
        float a[9];
#pragma unroll
        for (int v = 0; v < 9; ++v) a[v] = 0.f;
        const float* w = p.ada_w + (size_t)l * 1024 * 3072 + c0 + col;
        for (int k = kg; k < 1024; k += 16) { const float wv = w[(size_t)k * 3072];
#pragma unroll
            for (int v = 0; v < 9; ++v) a[v] += sv[v * 1024 + k] * wv; }
#pragma unroll
        for (int v = 0; v < 9; ++v) red[(kg * 32 + col) * 9 + v] = a[v];
        __syncthreads();
        if (tid < 288) { const int v = tid >> 5, cc = tid & 31; float s = 0.f; for (int q = 0; q < 16; ++q) s += red[(q * 32 + cc) * 9 + v];
            MOD[(size_t)(l * 9 + v) * 3072 + c0 + cc] = s + p.ada_b[l * 3072 + c0 + cc]; }
        __syncthreads();
    }
    bf16_t* WF = (bf16_t*)(p.ws + WS_WF);
    for (int it = blockIdx.x; it < 512; it += gridDim.x) {
        const int idx = it * 512 + tid, d = idx & 255, c = (idx >> 8) & 255, g = idx >> 16;
        const float* f = p.fourier_w + (size_t)g * 65536 + d;
        float aP = 0.f, aQ = 0.f;
        for (int cp = 0; cp < 256; ++cp) { const float fv = f[cp * 256]; const int a = (c * cp) & 255; aP += ct[a] * fv; aQ += st[a] * fv; }
        WF[(size_t)(g * 512 + d) * 256 + c] = (bf16_t)(pk2(aP * 0.0625f, 0.f) & 0xffffu);
        WF[(size_t)(g * 512 + 256 + d) * 256 + c] = (bf16_t)(pk2(-aQ * 0.0625f, 0.f) & 0xffffu);
    }
}

DI void ph_norm0(const Params& p, LAS unsigned char* lds) {
    const int tid = opaque_tid(), wid = tid >> 6, lane = tid & 63;
    LAS float* wg = (LAS float*)lds;
#pragma unroll 4
    for (int i = 0; i < 32; ++i) { const int idx = tid + 512 * i, k = idx >> 4, j = idx & 15; wg[j * 1024 + k] = p.win_even[(size_t)k * 7184 + 7168 + j]; }
    __syncthreads();
    f32x4 g[4];
#pragma unroll
    for (int i = 0; i < 4; ++i) g[i] = *(const f32x4*)(p.norm_g + lane * 4 + 256 * i);
    const float* MOD = (const float*)(p.ws + WS_MOD);
    bf16_t* HX = (bf16_t*)p.out;
    float* GATES = (float*)(p.ws + WS_GATES);
    for (int r = blockIdx.x * 8 + wid; r < NR; r += gridDim.x * 8) {
        const float* src; const float* md;
        if (r < NX) { src = p.x + (size_t)r * 1024; md = MOD + (size_t)(r >> 12) * 3072; } else { src = p.ctx + (size_t)(r - NX) * 1024; md = MOD + (size_t)8 * 3072; }
        f32x4 v[4]; float ss = 0.f;
#pragma unroll
        for (int i = 0; i < 4; ++i) { v[i] = *(const f32x4*)(src + lane * 4 + 256 * i); ss += v[i][0] * v[i][0] + v[i][1] * v[i][1] + v[i][2] * v[i][2] + v[i][3] * v[i][3]; }
        ss = wave_sum(ss);
        const float rstd = rsqrtf(ss * (1.0f / 1024.0f) + 1e-6f);
#pragma unroll
        for (int i = 0; i < 4; ++i) { const f32x4 sh = *(const f32x4*)(md + lane * 4 + 256 * i), sc = *(const f32x4*)(md + 1024 + lane * 4 + 256 * i);
            v[i] = v[i] * rstd * g[i] * (sc + 1.0f) + sh;
            u32x2 w; w.x = pk2(v[i][0], v[i][1]); w.y = pk2(v[i][2], v[i][3]);
            *(u32x2*)(HX + (size_t)r * 1024 + lane * 4 + 256 * i) = w; }
        float mine = 0.f;
#pragma unroll 1
        for (int j = 0; j < 16; ++j) { float pt = 0.f;
#pragma unroll
            for (int i = 0; i < 4; ++i) { const f32x4 w4 = *(const LAS f32x4*)(wg + j * 1024 + lane * 4 + 256 * i); pt += v[i][0] * w4[0] + v[i][1] * w4[1] + v[i][2] * w4[2] + v[i][3] * w4[3]; }
            pt = wave_sum(pt); mine = (lane == j) ? pt : mine; }
        if (lane < 16) { float val = mine + p.gate_b[lane];
            if ((lane >> 2) & 1) val = fminf(val, 0.f) - log1pf(__expf(-fabsf(val)));
            GATES[(size_t)r * 16 + lane] = val; }
    }
}
DI void ph_norm1(const Params& p, int mode) {
    const int tid = opaque_tid(), wid = tid >> 6, lane = tid & 63;
    const float* gsrc = mode ? p.final_g : p.norm_g + 1024;
    f32x4 g[4];
#pragma unroll
    for (int i = 0; i < 4; ++i) g[i] = *(const f32x4*)(gsrc + lane * 4 + 256 * i);
    const float* MOD = (const float*)(p.ws + WS_MOD) + (size_t)9 * 3072;
    const float* X1 = (const float*)p.ws;
    bf16_t* HX1 = (bf16_t*)(p.ws + 2 * PLANE);
    for (int r = blockIdx.x * 8 + wid; r < NX; r += gridDim.x * 8) {
        const float* src = X1 + (size_t)r * 1024; const float* md = MOD + (size_t)(r >> 12) * 3072;
        f32x4 v[4]; float ss = 0.f;
#pragma unroll
        for (int i = 0; i < 4; ++i) { v[i] = *(const f32x4*)(src + lane * 4 + 256 * i); ss += v[i][0] * v[i][0] + v[i][1] * v[i][1] + v[i][2] * v[i][2] + v[i][3] * v[i][3]; }
        ss = wave_sum(ss);
        const float rstd = rsqrtf(ss * (1.0f / 1024.0f) + 1e-6f);
#pragma unroll
        for (int i = 0; i < 4; ++i) {
            if (mode) { *(f32x4*)(p.out + (size_t)r * 1024 + lane * 4 + 256 * i) = v[i] * rstd * g[i]; }
            else { const f32x4 sh = *(const f32x4*)(md + lane * 4 + 256 * i), sc = *(const f32x4*)(md + 1024 + lane * 4 + 256 * i);
                const f32x4 h = v[i] * rstd * g[i] * (sc + 1.0f) + sh;
                u32x2 w; w.x = pk2(h[0], h[1]); w.y = pk2(h[2], h[3]);
                *(u32x2*)(HX1 + (size_t)r * 1024 + lane * 4 + 256 * i) = w; } }
    }
}

DI void ph_conv(const Params& p) {
    const bf16_t* QRAW = (const bf16_t*)p.ws; const bf16_t* KRAW = (const bf16_t*)(p.ws + PLANE);
    const bf16_t* CQ = (const bf16_t*)(p.ws + WS_CRAW); const bf16_t* CK = CQ + (size_t)NCX * 1024;
    bf16_t* QC = (bf16_t*)p.out; bf16_t* KC = QC + (size_t)NX * 1024;
    bf16_t* CQC = (bf16_t*)(p.ws + WS_CQC); bf16_t* CKC = (bf16_t*)(p.ws + WS_CKC);
    const int total = NR * 256;
    const int tid = opaque_tid();
    for (int idx = blockIdx.x * 512 + tid; idx < total; idx += gridDim.x * 512) {
        const int oct = idx & 127, which = (idx >> 7) & 1, r = idx >> 8, ch = oct * 8;
        const bf16_t* src; bf16_t* dst; int t, T;
        if (r < NX) { src = (which ? KRAW : QRAW) + (size_t)r * 1024 + ch; dst = (which ? KC : QC) + (size_t)r * 1024 + ch; t = r & 4095; T = 4096; }
        else { const int rr = r - NX; src = (which ? CK : CQ) + (size_t)rr * 1024 + ch; dst = (which ? CKC : CQC) + (size_t)rr * 1024 + ch; t = rr & 255; T = 256; }
        const u32x4 z = {0u, 0u, 0u, 0u};
        const u32x4 cc = *(const u32x4*)src;
        const u32x4 aa = (t > 0) ? *(const u32x4*)(src - 1024) : z;
        const u32x4 bb = (t < T - 1) ? *(const u32x4*)(src + 1024) : z;
        const float* w = p.conv_qk + which * 1024 + ch;
        float o[8];
#pragma unroll
        for (int e = 0; e < 4; ++e) {
            const float w0l = w[2 * e], w0h = w[2 * e + 1], w1l = w[2048 + 2 * e], w1h = w[2048 + 2 * e + 1], w2l = w[4096 + 2 * e], w2h = w[4096 + 2 * e + 1];
            float lo = w0l * lo_f(aa[e]) + w1l * lo_f(cc[e]) + w2l * lo_f(bb[e]);
            float hi = w0h * hi_f(aa[e]) + w1h * hi_f(cc[e]) + w2h * hi_f(bb[e]);
            lo = silu_f(lo); hi = silu_f(hi);
            if (!which) { lo *= 0.0625f; hi *= 0.0625f; }
            o[2 * e] = lo; o[2 * e + 1] = hi;
        }
        u32x4 wv; wv.x = pk2(o[0], o[1]); wv.y = pk2(o[2], o[3]); wv.z = pk2(o[4], o[5]); wv.w = pk2(o[6], o[7]);
        *(u32x4*)dst = wv;
    }
}

DI void ph_mlstm(const Params& p, LAS unsigned char* lds) {
    constexpr int QP = 528, VP = 144;
    LAS unsigned char* Qi = lds; LAS unsigned char* Ki = lds + 33792; LAS unsigned char* Vi = lds + 67584; LAS unsigned char* Vwi = Vi + 9216;
    LAS unsigned char* Sgi = Vwi + 9216; LAS unsigned char* Ci = Sgi + 9216; LAS float* fl = (LAS float*)(Ci + 33792);
    LAS float* f_bt = fl; LAS float* f_aa = fl + 64; LAS float* f_inter = fl + 128; LAS float* f_ws = fl + 192; LAS float* f_enm = fl + 256; LAS float* f_nvec = fl + 320; LAS float* f_sc = fl + 576;
    const int tid = opaque_tid(), wid = tid >> 6, lane = tid & 63, fr = lane & 15, fq = lane >> 4;
    const bf16_t* QC = (const bf16_t*)p.out; const bf16_t* KC = QC + (size_t)NX * 1024; const bf16_t* VPL = (const bf16_t*)(p.ws + 2 * PLANE);
    const bf16_t* CQC = (const bf16_t*)(p.ws + WS_CQC); const bf16_t* CKC = (const bf16_t*)(p.ws + WS_CKC); const bf16_t* CV = (const bf16_t*)(p.ws + WS_CRAW) + (size_t)2 * NCX * 1024;
    const float* GATES = (const float*)(p.ws + WS_GATES);
    for (int wi = blockIdx.x; wi < 256; wi += gridDim.x) {
        const int b = wi >> 5, h = (wi >> 3) & 3, dir = (wi >> 2) & 1, es = wi & 3;
        bf16_t* Hout = (bf16_t*)(p.ws + (dir ? PLANE : 0));
        f32x4 Cst[2][4];
#pragma unroll
        for (int i = 0; i < 2; ++i)
#pragma unroll
            for (int n = 0; n < 4; ++n) Cst[i][n] = (f32x4){0.f, 0.f, 0.f, 0.f};
        float nst = 0.f, m_prev = 0.f;
        __syncthreads();
        for (int i = tid; i < 33792 / 4; i += 512) ((LAS unsigned*)Ci)[i] = 0u;
        if (tid < 256) f_nvec[tid] = 0.f;
        u32x4 rq[4], rk[4], rv; float g_i = 0.f, g_f = 0.f;
        const int mt = wid >> 1, nt0 = 2 * (wid & 1);
#define ML_LOAD(ST) do { const int _st = (ST); const bf16_t *_q, *_k, *_v; const float* _g; \
            if (_st < 4) { const int cc = dir ? 3 - _st : _st; const size_t row0 = (size_t)b * 256 + cc * 64; _q = CQC + row0 * 1024 + h * 256; _k = CKC + row0 * 1024 + h * 256; _v = CV + row0 * 1024 + h * 256 + es * 64; _g = GATES + ((size_t)NX + row0) * 16; } \
            else { const int xc = _st - 4, cc = dir ? 63 - xc : xc; const size_t row0 = (size_t)b * 4096 + cc * 64; _q = QC + row0 * 1024 + h * 256; _k = KC + row0 * 1024 + h * 256; _v = VPL + row0 * 1024 + h * 256 + es * 64; _g = GATES + row0 * 16; } \
            _Pragma("unroll") for (int i = 0; i < 4; ++i) { const int id = tid + 512 * i, row = id >> 5, chk = id & 31; rq[i] = *(const u32x4*)(_q + (size_t)row * 1024 + chk * 8); rk[i] = *(const u32x4*)(_k + (size_t)row * 1024 + chk * 8); } \
            rv = *(const u32x4*)(_v + (size_t)(tid >> 3) * 1024 + (tid & 7) * 8); \
            if (wid == 0) { g_i = _g[lane * 16 + (dir ? 8 : 0) + h]; g_f = _g[lane * 16 + (dir ? 12 : 4) + h]; } } while (0)
        ML_LOAD(0);
        for (int st = 0; st < 68; ++st) {
            const bool isx = st >= 4;
            __syncthreads();
#pragma unroll
            for (int i = 0; i < 4; ++i) { const int id = tid + 512 * i, row = id >> 5, chk = id & 31;
                *(LAS u32x4*)(Qi + row * QP + chk * 16) = rq[i]; *(LAS u32x4*)(Ki + row * QP + chk * 16) = rk[i]; }
            *(LAS u32x4*)(Vi + (tid >> 3) * VP + (tid & 7) * 16) = rv;
            if (wid == 0) {
                const float lf = g_f, ig = g_i;
                float bs = lf;
#pragma unroll
                for (int o = 1; o < 64; o <<= 1) { const float ov = dir ? __shfl_down(bs, o) : __shfl_up(bs, o); const bool ok = dir ? (lane + o < 64) : (lane >= o); if (ok) bs += ov; }
                const float a = ig - bs;
                float mx = a;
#pragma unroll
                for (int o = 1; o < 64; o <<= 1) { const float ov = dir ? __shfl_down(mx, o) : __shfl_up(mx, o); const bool ok = dir ? (lane + o < 64) : (lane >= o); if (ok) mx = fmaxf(mx, ov); }
                const float total = __shfl(bs, dir ? 0 : 63);
                const float m_inter = bs + m_prev, m_t = fmaxf(bs + mx, m_inter);
                const float wsl = total - bs + ig;
                const float m_new = fmaxf(total + m_prev, wave_max(wsl));
                f_bt[lane] = bs - m_t; f_aa[lane] = a; f_inter[lane] = __expf(m_inter - m_t); f_ws[lane] = __expf(wsl - m_new); f_enm[lane] = __expf(-m_t);
                if (lane == 0) f_sc[0] = __expf(total + m_prev - m_new);
                m_prev = m_new;
            }
            __syncthreads();
            { const float w = f_ws[tid >> 3]; u32x4 o;
              o.x = pk2(w * lo_f(rv.x), w * hi_f(rv.x)); o.y = pk2(w * lo_f(rv.y), w * hi_f(rv.y)); o.z = pk2(w * lo_f(rv.z), w * hi_f(rv.z)); o.w = pk2(w * lo_f(rv.w), w * hi_f(rv.w));
              *(LAS u32x4*)(Vwi + (tid >> 3) * VP + (tid & 7) * 16) = o; }
            if (st + 1 < 68) ML_LOAD(st + 1);
            const float decay = f_sc[0];
            const int t = 16 * mt + fr;
            if (isx) {
                f32x4 sacc[2] = {(f32x4){0.f, 0.f, 0.f, 0.f}, (f32x4){0.f, 0.f, 0.f, 0.f}};
#pragma unroll
                for (int ks = 0; ks < 8; ++ks) { const bf16x8 qf = *(const LAS bf16x8*)(Qi + t * QP + (32 * ks + 8 * fq) * 2);
#pragma unroll
                    for (int n = 0; n < 2; ++n) { const bf16x8 kf = *(const LAS bf16x8*)(Ki + (16 * (nt0 + n) + fr) * QP + (32 * ks + 8 * fq) * 2); sacc[n] = mfma16(kf, qf, sacc[n]); } }
                const float btm = f_bt[t];
#pragma unroll
                for (int n = 0; n < 2; ++n) { const int s0 = 16 * (nt0 + n) + 4 * fq; const f32x4 a4 = *(const LAS f32x4*)(f_aa + s0); float vv[4];
#pragma unroll
                    for (int j = 0; j < 4; ++j) { const int s = s0 + j; const bool ok = dir ? (s >= t) : (s <= t); const float e = __expf(btm + a4[j]); vv[j] = ok ? sacc[n][j] * e : 0.f; }
                    u32x2 w; w.x = pk2(vv[0], vv[1]); w.y = pk2(vv[2], vv[3]); *(LAS u32x2*)(Sgi + t * VP + s0 * 2) = w; }
            }
            __syncthreads();
            if (isx) {
                float rs = 0.f, qn = 0.f;
#pragma unroll
                for (int i = 0; i < 2; ++i) { const bf16x8 sg = *(const LAS bf16x8*)(Sgi + t * VP + (16 * fq + 8 * i) * 2);
#pragma unroll
                    for (int e = 0; e < 8; ++e) rs += bf2f((unsigned short)sg[e]); }
#pragma unroll
                for (int i = 0; i < 8; ++i) { const bf16x8 qv = *(const LAS bf16x8*)(Qi + t * QP + (64 * fq + 8 * i) * 2);
                    const f32x4 n0 = *(const LAS f32x4*)(f_nvec + 64 * fq + 8 * i), n1 = *(const LAS f32x4*)(f_nvec + 64 * fq + 8 * i + 4);
#pragma unroll
                    for (int e = 0; e < 4; ++e) qn += bf2f((unsigned short)qv[e]) * n0[e] + bf2f((unsigned short)qv[4 + e]) * n1[e]; }
                rs += __shfl_xor(rs, 16); rs += __shfl_xor(rs, 32); qn += __shfl_xor(qn, 16); qn += __shfl_xor(qn, 32);
                const float inter_t = f_inter[t];
                const float rden = 1.0f / fmaxf(fabsf(rs + inter_t * qn), f_enm[t]);
                f32x4 accC[2] = {(f32x4){0.f, 0.f, 0.f, 0.f}, (f32x4){0.f, 0.f, 0.f, 0.f}}, accD[2] = {(f32x4){0.f, 0.f, 0.f, 0.f}, (f32x4){0.f, 0.f, 0.f, 0.f}};
#pragma unroll
                for (int ks = 0; ks < 8; ++ks) { const bf16x8 qf = *(const LAS bf16x8*)(Qi + t * QP + (32 * ks + 8 * fq) * 2);
#pragma unroll
                    for (int n = 0; n < 2; ++n) { const bf16x8 cf = *(const LAS bf16x8*)(Ci + (16 * (nt0 + n) + fr) * QP + (32 * ks + 8 * fq) * 2); accC[n] = mfma16(cf, qf, accC[n]); } }
#pragma unroll
                for (int ks = 0; ks < 2; ++ks) { const bf16x8 sgf = *(const LAS bf16x8*)(Sgi + t * VP + (32 * ks + 8 * fq) * 2);
#pragma unroll
                    for (int n = 0; n < 2; ++n) { const bf16x8 vf = tr_frag(Vi, VP, 32 * ks, 16 * (nt0 + n), lane); accD[n] = mfma16(vf, sgf, accD[n]); } }
                const int xc = st - 4, cc = dir ? 63 - xc : xc;
                bf16_t* hp = Hout + ((size_t)b * 4096 + cc * 64 + t) * 1024 + h * 256 + es * 64 + 4 * fq;
#pragma unroll
                for (int n = 0; n < 2; ++n) { const f32x4 hv = (accD[n] + accC[n] * inter_t) * rden;
                    u32x2 w; w.x = pk2(hv[0], hv[1]); w.y = pk2(hv[2], hv[3]); *(u32x2*)(hp + 16 * (nt0 + n)) = w; }
            }
#pragma unroll
            for (int i = 0; i < 2; ++i)
#pragma unroll
                for (int n = 0; n < 4; ++n) Cst[i][n] = Cst[i][n] * decay;
#pragma unroll
            for (int ks = 0; ks < 2; ++ks) { bf16x8 kf[2];
#pragma unroll
                for (int i = 0; i < 2; ++i) kf[i] = tr_frag(Ki, QP, 32 * ks, 16 * (2 * wid + i), lane);
#pragma unroll
                for (int n = 0; n < 4; ++n) { const bf16x8 vw = tr_frag(Vwi, VP, 32 * ks, 16 * n, lane);
#pragma unroll
                    for (int i = 0; i < 2; ++i) Cst[i][n] = mfma16(kf[i], vw, Cst[i][n]); } }
            if (tid < 256) { float a = 0.f; for (int s = 0; s < 64; ++s) a += f_ws[s] * bf2f(*(const LAS unsigned short*)(Ki + s * QP + tid * 2)); nst = decay * nst + a; }
            __syncthreads();
#pragma unroll
            for (int i = 0; i < 2; ++i)
#pragma unroll
                for (int n = 0; n < 4; ++n) { u32x2 w; w.x = pk2(Cst[i][n][0], Cst[i][n][1]); w.y = pk2(Cst[i][n][2], Cst[i][n][3]);
                    *(LAS u32x2*)(Ci + (16 * n + fr) * QP + (16 * (2 * wid + i) + 4 * fq) * 2) = w; }
            if (tid < 256) f_nvec[tid] = nst;
        }
#undef ML_LOAD
    }
}

template <int KK, int NN, class Cfg>
DI void axis_mix(const Cfg& cfg, LAS unsigned char* lds, int n_items) {
    constexpr int TP = 528, BP = KK * 2 + 16, NCH = KK / 16;
    LAS unsigned char* Ti = lds; LAS unsigned char* Bi = lds + 128 * TP;
    const int tid = opaque_tid(), wid = tid >> 6, lane = tid & 63, fr = lane & 15, fq = lane >> 4;
    __syncthreads();
    cfg.fill_tables(Bi, tid);
    u32x4 r[NCH];
    int item = blockIdx.x;
    if (item < n_items) {
#pragma unroll
        for (int i = 0; i < NCH; ++i) { const int id = tid + 512 * i; r[i] = *(const u32x4*)(cfg.row_ptr(item, id >> 5) + (id & 31) * 8); } }
    for (; item < n_items; item += gridDim.x) {
        __syncthreads();
#pragma unroll
        for (int i = 0; i < NCH; ++i) { const int id = tid + 512 * i; *(LAS u32x4*)(Ti + (id >> 5) * TP + (id & 31) * 16) = r[i]; }
        __syncthreads();
        const int nxt = item + gridDim.x;
        if (nxt < n_items) {
#pragma unroll
            for (int i = 0; i < NCH; ++i) { const int id = tid + 512 * i; r[i] = *(const u32x4*)(cfg.row_ptr(nxt, id >> 5) + (id & 31) * 8); } }
        f32x4 acc[2][NN / 16];
#pragma unroll
        for (int i = 0; i < 2; ++i)
#pragma unroll
            for (int n = 0; n < NN / 16; ++n) acc[i][n] = (f32x4){0.f, 0.f, 0.f, 0.f};
        LAS unsigned char* tb = Bi + cfg.table_off(item);
#pragma unroll
        for (int ks = 0; ks < KK / 32; ++ks) { bf16x8 af[2];
#pragma unroll
            for (int i = 0; i < 2; ++i) af[i] = tr_frag(Ti, TP, 32 * ks, 32 * wid + 16 * i, lane);
#pragma unroll
            for (int n = 0; n < NN / 16; ++n) { const bf16x8 bfr = *(const LAS bf16x8*)(tb + (16 * n + fr) * BP + (32 * ks + 8 * fq) * 2);
#pragma unroll
                for (int i = 0; i < 2; ++i) acc[i][n] = mfma16(af[i], bfr, acc[i][n]); } }
        cfg.epilogue(acc, item, wid, fr, fq, Bi);
    }
}
DI void fill_dft_table(LAS unsigned char* Bi, int tid, int nrows) {
    for (int idx = tid; idx < nrows * 128; idx += 512) { const int n = idx >> 7, k = idx & 127, ap = n & 63, kk = k & 63; float s, c; sincospif((float)((kk * ap) & 63) / 32.0f, &s, &c);
        float v; if (n < 64) v = (k < 64) ? c : s; else v = (k < 64) ? -s : c;
        *(LAS unsigned short*)(Bi + n * 272 + k * 2) = (unsigned short)(pk2(v * 0.125f, 0.f) & 0xffffu); }
}
struct CfgDft1 {
    const bf16_t* Z; bf16_t* S1re; bf16_t* S1im;
    DI void fill_tables(LAS unsigned char* Bi, int tid) const { fill_dft_table(Bi, tid, 128);
        LAS float* tw = (LAS float*)(Bi + 34816);
        for (int j = tid; j < 4096; j += 512) { float s, c; sincospif((float)j / 2048.0f, &s, &c); tw[2 * j] = c; tw[2 * j + 1] = s; } }
    DI int table_off(int) const { return 0; }
    DI const bf16_t* row_ptr(int item, int k) const { const int g = item & 3, b = (item >> 2) & 63, batch = item >> 8;
        return Z + ((size_t)batch * 4096 + 64 * (k & 63) + b) * 2048 + g * 512 + (k >> 6) * 256; }
    DI void epilogue(const f32x4 (&acc)[2][8], int item, int wid, int fr, int fq, LAS unsigned char* Bi) const {
        const int g = item & 3, b = (item >> 2) & 63, batch = item >> 8;
        const LAS float* tw = (const LAS float*)(Bi + 34816);
#pragma unroll
        for (int ni = 0; ni < 4; ++ni) { const int ap = 16 * ni + fr; float s, c; sincospif((float)(b * ap) * (1.0f / 2048.0f), &s, &c);
            const size_t tok = (size_t)batch * 4096 + 64 * ap + b;
#pragma unroll
            for (int i = 0; i < 2; ++i) { const f32x4 re = acc[i][ni], im = acc[i][ni + 4]; const f32x4 r2 = re * c + im * s, i2 = im * c - re * s;
                const size_t o = tok * 1024 + g * 256 + 32 * wid + 16 * i + 4 * fq;
                u32x2 w; w.x = pk2(r2[0], r2[1]); w.y = pk2(r2[2], r2[3]); *(u32x2*)(S1re + o) = w;
                w.x = pk2(i2[0], i2[1]); w.y = pk2(i2[2], i2[3]); *(u32x2*)(S1im + o) = w; } }
    }
};
struct CfgDft2 {
    const bf16_t* S1re; const bf16_t* S1im; const bf16_t* ZB; bf16_t* Y;
    DI void fill_tables(LAS unsigned char* Bi, int tid) const { fill_dft_table(Bi, tid, 64); }
    DI int table_off(int) const { return 0; }
    DI const bf16_t* row_ptr(int item, int k) const { const int g = item & 3, ap = (item >> 2) & 63, batch = item >> 8;
        return ((k >> 6) ? S1im : S1re) + ((size_t)batch * 4096 + 64 * ap + (k & 63)) * 1024 + g * 256; }
    DI void epilogue(const f32x4 (&acc)[2][4], int item, int wid, int fr, int fq, LAS unsigned char*) const {
        const int g = item & 3, ap = (item >> 2) & 63, batch = item >> 8;
#pragma unroll
        for (int ni = 0; ni < 4; ++ni) { const size_t tok = (size_t)batch * 4096 + ap + 64 * (16 * ni + fr);
#pragma unroll
            for (int i = 0; i < 2; ++i) { const int ch = g * 256 + 32 * wid + 16 * i + 4 * fq; const u32x2 z = *(const u32x2*)(ZB + tok * 1024 + ch); const f32x4 a = acc[i][ni];
                u32x2 w; w.x = pk2(a[0] * silu_f(lo_f(z.x)), a[1] * silu_f(hi_f(z.x))); w.y = pk2(a[2] * silu_f(lo_f(z.y)), a[3] * silu_f(hi_f(z.y)));
                *(u32x2*)(Y + tok * 2048 + 1024 + ch) = w; } }
    }
};
DI void fill_pool_tables(LAS unsigned char* Bi, int tid) {
    for (int idx = tid; idx < 4 * 4096; idx += 512) { const int g = idx >> 12, n = (idx >> 6) & 63, k = idx & 63, w = 2 << g, lo = n - w / 2, hi = n + w - w / 2;
        *(LAS unsigned short*)(Bi + g * 9216 + n * 144 + k * 2) = (k >= lo && k < hi) ? (unsigned short)0x3F80 : (unsigned short)0; }
}
DI float pool_rcnt(int g, int n) { const int w = 2 << g; int lo = n - w / 2, hi = n + w - w / 2; lo = lo < 0 ? 0 : lo; hi = hi > 64 ? 64 : hi; return 1.0f / (float)(hi - lo); }
struct CfgPoolA {
    const bf16_t* UC; bf16_t* PA;
    DI void fill_tables(LAS unsigned char* Bi, int tid) const { fill_pool_tables(Bi, tid); }
    DI int table_off(int item) const { return ((item & 7) >> 1) * 9216; }
    DI const bf16_t* row_ptr(int item, int k) const { const int ct = item & 7, c = (item >> 3) & 63, batch = item >> 9; return UC + ((size_t)batch * 4096 + 64 * k + c) * 2048 + ct * 256; }
    DI void epilogue(const f32x4 (&acc)[2][4], int item, int wid, int fr, int fq, LAS unsigned char*) const {
        const int ct = item & 7, c = (item >> 3) & 63, batch = item >> 9, g = ct >> 1;
#pragma unroll
        for (int ni = 0; ni < 4; ++ni) { const int n = 16 * ni + fr; const float rc = pool_rcnt(g, n); const size_t tok = (size_t)batch * 4096 + 64 * n + c;
#pragma unroll
            for (int i = 0; i < 2; ++i) { const f32x4 a = acc[i][ni] * rc; u32x2 w; w.x = pk2(a[0], a[1]); w.y = pk2(a[2], a[3]);
                *(u32x2*)(PA + tok * 2048 + ct * 256 + 32 * wid + 16 * i + 4 * fq) = w; } }
    }
};
struct CfgPoolB {
    const bf16_t* PA; bf16_t* UC;
    DI void fill_tables(LAS unsigned char* Bi, int tid) const { fill_pool_tables(Bi, tid); }
    DI int table_off(int item) const { return ((item & 7) >> 1) * 9216; }
    DI const bf16_t* row_ptr(int item, int k) const { const int ct = item & 7, rp = (item >> 3) & 63, batch = item >> 9; return PA + ((size_t)batch * 4096 + 64 * rp + k) * 2048 + ct * 256; }
    DI void epilogue(const f32x4 (&acc)[2][4], int item, int wid, int fr, int fq, LAS unsigned char*) const {
        const int ct = item & 7, rp = (item >> 3) & 63, batch = item >> 9, g = ct >> 1;
#pragma unroll
        for (int ni = 0; ni < 4; ++ni) { const int n = 16 * ni + fr; const float rc = pool_rcnt(g, n); const size_t tok = (size_t)batch * 4096 + 64 * rp + n;
#pragma unroll
            for (int i = 0; i < 2; ++i) { bf16_t* up = UC + tok * 2048 + ct * 256 + 32 * wid + 16 * i + 4 * fq; const u32x2 u = *(const u32x2*)up; const f32x4 a = acc[i][ni] * rc;
                u32x2 w; w.x = pk2(a[0] - lo_f(u.x), a[1] - hi_f(u.x)); w.y = pk2(a[2] - lo_f(u.y), a[3] - hi_f(u.y)); *(u32x2*)up = w; } }
    }
};

DI void ph_ya(const Params& p) {
    const int tid = opaque_tid(), wid = tid >> 6, lane = tid & 63;
    const bf16_t* HF = (const bf16_t*)p.ws; const bf16_t* HB = (const bf16_t*)(p.ws + PLANE); const bf16_t* O = (const bf16_t*)(p.ws + 3 * PLANE); const bf16_t* ZA = (const bf16_t*)(p.ws + 4 * PLANE);
    bf16_t* Y = (bf16_t*)p.out;
    f32x4 hg[4];
#pragma unroll
    for (int i = 0; i < 4; ++i) hg[i] = *(const f32x4*)(p.head_norm + lane * 16 + 4 * i);
    for (int r = blockIdx.x * 8 + wid; r < NX; r += gridDim.x * 8) {
        const size_t o = (size_t)r * 1024 + lane * 16;
        float gv[16], za[16]; float ss = 0.f;
#pragma unroll
        for (int hh = 0; hh < 2; ++hh) { const u32x4 a = *(const u32x4*)(HF + o + 8 * hh), bq = *(const u32x4*)(HB + o + 8 * hh), oo = *(const u32x4*)(O + o + 8 * hh), zz = *(const u32x4*)(ZA + o + 8 * hh);
#pragma unroll
            for (int e = 0; e < 4; ++e) { const float h0 = lo_f(a[e]) + lo_f(bq[e]), h1 = hi_f(a[e]) + hi_f(bq[e]);
                const float g0 = sigmoid_f(lo_f(oo[e])) * h0, g1 = sigmoid_f(hi_f(oo[e])) * h1;
                gv[8 * hh + 2 * e] = g0; gv[8 * hh + 2 * e + 1] = g1; ss += g0 * g0 + g1 * g1; za[8 * hh + 2 * e] = lo_f(zz[e]); za[8 * hh + 2 * e + 1] = hi_f(zz[e]); } }
        ss += __shfl_xor(ss, 1); ss += __shfl_xor(ss, 2); ss += __shfl_xor(ss, 4); ss += __shfl_xor(ss, 8);
        const float rstd = rsqrtf(ss * (1.0f / 256.0f) + 1e-6f);
        u32x4 w[2];
#pragma unroll
        for (int q = 0; q < 8; ++q) { const float y0 = gv[2 * q] * rstd * hg[q >> 1][(2 * q) & 3] * silu_f(za[2 * q]), y1 = gv[2 * q + 1] * rstd * hg[q >> 1][(2 * q + 1) & 3] * silu_f(za[2 * q + 1]);
            w[q >> 2][q & 3] = pk2(y0, y1); }
        *(u32x4*)(Y + (size_t)r * 2048 + lane * 16) = w[0]; *(u32x4*)(Y + (size_t)r * 2048 + lane * 16 + 8) = w[1];
    }
}


#define XB_TMO      128
#define XB_XCNT(j)  (256  + 64 * (j))
#define XB_XSUB(j)  (1280 + 64 * (j))
#define XB_XGEN(j)  (2304 + 64 * (j))
#define XB_TOP      3328
#define XB_TOPGEN   3392
#define XCD_BAR_WORDS 3456
#define XB_SPIN_CAP (1u << 18)
DI unsigned xb_ld(unsigned* p)              { return __hip_atomic_load(p, __ATOMIC_RELAXED, __HIP_MEMORY_SCOPE_AGENT); }
DI unsigned xb_add(unsigned* p, unsigned v) { return __hip_atomic_fetch_add(p, v, __ATOMIC_RELAXED, __HIP_MEMORY_SCOPE_AGENT); }
DI unsigned xb_xcc_id() { return (unsigned)__builtin_amdgcn_s_getreg((3 << 11) | 20) & 0xFu; }
#define XB_SPIN(cond, bar) do { unsigned _sp = 0; while (cond) { __builtin_amdgcn_s_sleep(1); \
    if ((++_sp & 255u) == 0u) { if (xb_ld(&(bar)[XB_TMO])) break; if (_sp > XB_SPIN_CAP) { atomicAdd(&(bar)[XB_TMO], 1u); break; } } } } while (0)
struct XcdBarrier { unsigned* bar; unsigned x; volatile LAS unsigned* st; };
DI XcdBarrier xcd_barrier_post(unsigned* bar, volatile LAS unsigned* st) {
    XcdBarrier b; b.bar = bar; b.x = xb_xcc_id(); b.st = st;
    if (threadIdx.x == 0) (void)xb_add(&bar[XB_XCNT(b.x)], 1u);
    return b;
}
DI void xcd_barrier_complete(unsigned* bar, unsigned x, unsigned& nloc, unsigned& nx) {
    const unsigned G = gridDim.x * gridDim.y * gridDim.z;
    unsigned sum, cnt, mine, sp = 0u;
    for (;;) {
        sum = 0u; cnt = 0u; mine = 0u;
#pragma unroll
        for (unsigned j = 0; j < 16; ++j) { const unsigned c = xb_ld(&bar[XB_XCNT(j)]); sum += c; cnt += (c > 0u) ? 1u : 0u; mine = (j == x) ? c : mine; }
        if (sum == G) break;
        __builtin_amdgcn_s_sleep(1);
        if ((++sp & 255u) == 0u) { if (xb_ld(&bar[XB_TMO])) break; if (sp > XB_SPIN_CAP) { atomicAdd(&bar[XB_TMO], 1u); break; } }
    }
    nloc = mine > 0u ? mine : 1u; nx = cnt > 0u ? cnt : 1u;
}
DI void xcd_barrier(const XcdBarrier& b) {
    asm volatile("s_waitcnt vmcnt(0)" ::: "memory");
    __syncthreads();
    if (threadIdx.x == 0) {
        unsigned* bar = b.bar;
        __builtin_amdgcn_s_waitcnt(0);
        unsigned nloc = b.st[0], nx = b.st[1];
        if (nloc == 0u) { xcd_barrier_complete(bar, b.x, nloc, nx); b.st[0] = nloc; b.st[1] = nx; }
        const unsigned old = xb_add(&bar[XB_XSUB(b.x)], 1u);
        const unsigned gen = old / nloc;
        if (old + 1u == (gen + 1u) * nloc) {
            __builtin_amdgcn_fence(__ATOMIC_RELEASE, "agent");
            asm volatile("s_waitcnt vmcnt(0)" ::: "memory");
            const unsigned og = xb_add(&bar[XB_TOP], 1u);
            const unsigned tg = og / nx;
            if (og + 1u == (tg + 1u) * nx) xb_add(&bar[XB_TOPGEN], 1u);
            else XB_SPIN(xb_ld(&bar[XB_TOPGEN]) == tg, bar);
            __builtin_amdgcn_fence(__ATOMIC_ACQUIRE, "agent");
            xb_add(&bar[XB_XGEN(b.x)], 1u);
            asm volatile("s_waitcnt vmcnt(0)" ::: "memory");
        } else {
            XB_SPIN(xb_ld(&bar[XB_XGEN(b.x)]) == gen, bar);
            __builtin_amdgcn_fence(__ATOMIC_ACQUIRE, "agent");
            asm volatile("s_waitcnt vmcnt(0)" ::: "memory");
        }
    }
    __syncthreads();
}

__global__ void __launch_bounds__(512, 2) mk_fwd(Params p, int ph_lo, int ph_hi) {
    extern __shared__ __attribute__((aligned(16))) unsigned char shm[];
    LAS unsigned char* lds = (LAS unsigned char*)shm;
    cg::grid_group grid = cg::this_grid();
    unsigned char* ws = p.ws;
    const int G = gridDim.x, c = blockIdx.x;
    volatile LAS unsigned* xst = (volatile LAS unsigned*)(lds + LDS_BYTES - 16);
    if (threadIdx.x == 0) { xst[0] = 0u; xst[1] = 0u; }
    __syncthreads();
    XcdBarrier xbar; xbar.bar = (unsigned*)(ws + WS_BAR); xbar.x = 0u; xbar.st = xst;
    if (ph_hi - ph_lo > 1) xbar = xcd_barrier_post((unsigned*)(ws + WS_BAR), xst);
    if (ph_lo > 1000) grid.sync();
#ifndef PHMASK
#define PHMASK 0xFFFF
#endif
#define GSYNC() xcd_barrier(xbar)
#ifndef REP_MASK
#define REP_MASK 0
#endif
#define PHASE(i, ...) if constexpr ((PHMASK >> (i)) & 1) if (ph_lo <= (i) && (i) < ph_hi) { __VA_ARGS__; if constexpr ((REP_MASK >> (i)) & 1) { __syncthreads(); __VA_ARGS__; } if ((i) + 1 < ph_hi) GSYNC(); }
    PHASE(0, ph_prep(p, lds));
    PHASE(1, ph_norm0(p, lds));
    PHASE(2, { GemmD g{(const bf16_t*)p.out, (const bf16_t*)(ws + WS_WINE), 1024, 1024, 0, 0, 1024}; Sched S{128, 28, 1, 8, 12, 128, G, c};
               EpiPlanes E{(bf16_t*)ws, (bf16_t*)(ws + WS_CRAW)}; gemm_phase(lds, g, S, E); });
    PHASE(3, ph_conv(p));
    PHASE(4, ph_mlstm(p, lds));
    PHASE(5, { GemmD g{(const bf16_t*)(ws + 5 * PLANE), (const bf16_t*)(ws + WS_WF), 1024, 256, 256, 512 * 256, 256}; Sched S{128, 2, 4, 0, 0, 0, G, c};
               EpiBf E{(bf16_t*)p.out, nullptr, 2048, 512, 0, nullptr, nullptr}; gemm_phase(lds, g, S, E); });
    PHASE(6, { CfgDft1 cf{(const bf16_t*)p.out, (bf16_t*)(ws + 2 * PLANE), (bf16_t*)(ws + 5 * PLANE)}; axis_mix<128, 128>(cf, lds, 2048); });
    PHASE(7, { CfgDft2 cf{(const bf16_t*)(ws + 2 * PLANE), (const bf16_t*)(ws + 5 * PLANE), (const bf16_t*)(ws + 6 * PLANE), (bf16_t*)p.out}; axis_mix<128, 64>(cf, lds, 2048); ph_ya(p); });
    PHASE(8, { GemmD g{(const bf16_t*)p.out, (const bf16_t*)(ws + WS_WOUTE), 2048, 2048, 0, 0, 2048}; Sched S{128, 4, 1, 0, 0, 0, G, c};
               EpiRes E{(float*)ws, p.x, (const float*)(ws + WS_MOD) + 2048}; gemm_phase(lds, g, S, E); });
    PHASE(9, ph_norm1(p, 0));
    PHASE(10, { GemmD g{(const bf16_t*)(ws + 2 * PLANE), (const bf16_t*)(ws + WS_WINO), 1024, 1024, 0, 0, 1024}; Sched S{128, 16, 1, 0, 0, 0, G, c};
                EpiBf E{(bf16_t*)(ws + 3 * PLANE), (bf16_t*)(ws + 5 * PLANE), 2048, 0, 1, nullptr, nullptr}; gemm_phase(lds, g, S, E); });
    PHASE(11, { CfgPoolA cf{(const bf16_t*)(ws + 3 * PLANE), (bf16_t*)p.out}; axis_mix<64, 64>(cf, lds, 4096); });
    PHASE(12, { CfgPoolB cf{(const bf16_t*)p.out, (bf16_t*)(ws + 3 * PLANE)}; axis_mix<64, 64>(cf, lds, 4096); });
    PHASE(13, { GemmD g{(const bf16_t*)(ws + 3 * PLANE), (const bf16_t*)(ws + WS_WPOOL), 2048, 512, 512, 512 * 512, 512}; Sched S{128, 2, 4, 0, 0, 0, G, c};
                EpiBf E{(bf16_t*)p.out, nullptr, 2048, 512, 2, p.pool_scale, (const bf16_t*)(ws + 5 * PLANE)}; gemm_phase(lds, g, S, E); });
    PHASE(14, { GemmD g{(const bf16_t*)p.out, (const bf16_t*)(ws + WS_WOUTO), 2048, 2048, 0, 0, 2048}; Sched S{128, 4, 1, 0, 0, 0, G, c};
                EpiRes E{(float*)ws, (const float*)ws, (const float*)(ws + WS_MOD) + 9 * 3072 + 2048}; gemm_phase(lds, g, S, E); });
    PHASE(15, ph_norm1(p, 1));
#undef PHASE
#ifdef XSYNC
    for (int k = 0; k < XSYNC; ++k) GSYNC();
#endif
#ifdef DBG_STOP
    GSYNC();
    {   const size_t n = (size_t)NX * 1024; unsigned* o32 = (unsigned*)p.out;
        for (size_t i = (size_t)blockIdx.x * 512 + threadIdx.x; i < n; i += (size_t)gridDim.x * 512) {
            float v = 0.f;
            if (DBG_PLANES == -1) { const unsigned u = o32[i]; v = lo_f(u) + hi_f(u); }
            else if (DBG_PLANES == -2) { v = ((const float*)p.ws)[i]; }
            else { for (int pl = 0; pl < 7; ++pl) if ((DBG_PLANES >> pl) & 1) v += bf2f(((const bf16_t*)(p.ws + pl * PLANE))[i]); }
            if (!(fabsf(v) < 1e30f)) v = 12345.f;
            p.out[i] = v; } }
#endif
}

extern "C" void kernel_launch(void* const* d_in, const int* in_sizes, int n_in, void* d_out, int out_size, void* d_ws, size_t ws_size, hipStream_t stream) {
    static int grid = 0;
    if (grid == 0) {
        int dev = 0, cus = 0, per_cu = 0;
        hipGetDevice(&dev);
        hipDeviceGetAttribute(&cus, hipDeviceAttributeMultiprocessorCount, dev);
        if (hipFuncSetAttribute((const void*)mk_fwd, hipFuncAttributeMaxDynamicSharedMemorySize, LDS_BYTES) != hipSuccess) fprintf(stderr, "hipFuncSetAttribute failed\n");
        if (hipOccupancyMaxActiveBlocksPerMultiprocessor(&per_cu, (const void*)mk_fwd, 512, LDS_BYTES) != hipSuccess || per_cu < 1) { fprintf(stderr, "occupancy query: %d\n", per_cu); per_cu = 1; }
        (void)hipGetLastError();
        grid = cus * per_cu; if (grid > 256) grid = 256; if (grid < 1) grid = 1;
        if (ws_size < WS_END) fprintf(stderr, "workspace too small: %zu < %zu\n", ws_size, (size_t)WS_END);
    }
    Params p{};
    p.x = (const float*)d_in[0]; p.c = (const float*)d_in[1]; p.ctx = (const float*)d_in[2]; p.c_ctx = (const float*)d_in[3]; p.ada_w = (const float*)d_in[4]; p.ada_b = (const float*)d_in[5];
    p.norm_g = (const float*)d_in[6]; p.win_even = (const float*)d_in[7]; p.gate_b = (const float*)d_in[8]; p.conv_qk = (const float*)d_in[9]; p.head_norm = (const float*)d_in[10];
    p.fourier_w = (const float*)d_in[11]; p.wout_even = (const float*)d_in[12]; p.win_odd = (const float*)d_in[13]; p.pool_w = (const float*)d_in[14]; p.pool_scale = (const float*)d_in[15];
    p.wout_odd = (const float*)d_in[16]; p.final_g = (const float*)d_in[17]; p.out = (float*)d_out; p.ws = (unsigned char*)d_ws;
    (void)hipMemsetAsync((unsigned char*)d_ws + WS_BAR, 0, XCD_BAR_WORDS * 4, stream);
#if MK_MULTI
    for (int ph = 0; ph < 16; ++ph) { hipLaunchKernelGGL(mk_fwd, dim3(grid), dim3(512), LDS_BYTES, stream, p, ph, ph + 1); }
#else
#ifdef DBG_STOP
    int lo = 0, hi = DBG_STOP;
#else
    int lo = 0, hi = 16;
#endif
    void* args[] = {&p, &lo, &hi};
    hipError_t e = hipLaunchCooperativeKernel((void*)mk_fwd, dim3(grid), dim3(512), args, LDS_BYTES, stream);
    if (e != hipSuccess) fprintf(stderr, "cooperative launch failed: %s (grid %d)\n", hipGetErrorString(e), grid);
#endif
}
```

```cpp
#include <hip/hip_runtime.h>
#include <hip/hip_cooperative_groups.h>
#include <cstdio>
namespace cg = cooperative_groups;

#ifndef MK_MULTI
#define MK_MULTI 0
#endif

#define LAS __attribute__((address_space(3)))
typedef unsigned short bf16_t;
typedef short bf16x8 __attribute__((ext_vector_type(8)));
typedef short s16x4 __attribute__((ext_vector_type(4)));
typedef float f32x4 __attribute__((ext_vector_type(4)));
typedef unsigned u32x4 __attribute__((ext_vector_type(4)));
typedef unsigned u32x2 __attribute__((ext_vector_type(2)));

constexpr int NX = 32768, NCX = 2048, NR = NX + NCX;
constexpr size_t PLANE = (size_t)NX * 1024 * 2;
constexpr size_t WS_EXTRA = 7 * PLANE;
constexpr size_t WS_WINE  = WS_EXTRA;
constexpr size_t WS_WOUTE = WS_WINE  + (size_t)7168 * 1024 * 2;
constexpr size_t WS_WINO  = WS_WOUTE + (size_t)1024 * 2048 * 2;
constexpr size_t WS_WPOOL = WS_WINO  + (size_t)4096 * 1024 * 2;
constexpr size_t WS_WOUTO = WS_WPOOL + (size_t)4 * 512 * 512 * 2;
constexpr size_t WS_WF    = WS_WOUTO + (size_t)1024 * 2048 * 2;
constexpr size_t WS_MOD   = WS_WF    + (size_t)4 * 512 * 256 * 2;
constexpr size_t WS_GATES = WS_MOD   + 262144;
constexpr size_t WS_CRAW  = WS_GATES + (size_t)NR * 16 * 4;
constexpr size_t WS_CQC   = WS_CRAW  + (size_t)3 * NCX * 1024 * 2;
constexpr size_t WS_CKC   = WS_CQC   + (size_t)NCX * 1024 * 2;
constexpr size_t WS_END   = WS_CKC   + (size_t)NCX * 1024 * 2;
constexpr size_t WS_GPRE  = WS_END + 16384;
constexpr size_t WS_GPRE_END = WS_GPRE + (size_t)64 * 68 * 384 * 4;
static_assert(WS_GPRE_END <= (size_t)512 * 1024 * 1024, "gate tables exceed the workspace");
constexpr size_t WS_BAR   = WS_END;
static_assert(WS_BAR + 16384 <= (size_t)512 * 1024 * 1024, "workspace map exceeds 512 MiB");

constexpr int LDS_BYTES = 143360;

struct Params {
    const float* x; const float* c; const float* ctx; const float* c_ctx; const float* ada_w; const float* ada_b; const float* norm_g;
    const float* win_even; const float* gate_b; const float* conv_qk; const float* head_norm; const float* fourier_w; const float* wout_even;
    const float* win_odd; const float* pool_w; const float* pool_scale; const float* wout_odd; const float* final_g;
    float* out; unsigned char* ws;
};

#define DI __device__ __forceinline__
DI float bf2f(unsigned short b) { return __uint_as_float(((unsigned)b) << 16); }
DI float lo_f(unsigned u) { return __uint_as_float(u << 16); }
DI float hi_f(unsigned u) { return __uint_as_float(u & 0xffff0000u); }
typedef __bf16 bf16v2_t __attribute__((ext_vector_type(2)));
typedef float f32v2_t __attribute__((ext_vector_type(2)));
DI unsigned pk2(float lo, float hi) { const f32v2_t v = {lo, hi}; const bf16v2_t b = __builtin_convertvector(v, bf16v2_t); return __builtin_bit_cast(unsigned, b); }
DI float silu_f(float x) { return x / (1.0f + __expf(-x)); }
DI float sigmoid_f(float x) { return 1.0f / (1.0f + __expf(-x)); }
DI int opaque_tid() { int t = threadIdx.x; asm volatile("" : "+v"(t)); return t; }
DI float wave_sum(float v) { for (int o = 32; o > 0; o >>= 1) v += __shfl_xor(v, o); return v; }
DI float wave_max(float v) { for (int o = 32; o > 0; o >>= 1) v = fmaxf(v, __shfl_xor(v, o)); return v; }
DI f32x4 mfma16(bf16x8 a, bf16x8 b, f32x4 c) { return __builtin_amdgcn_mfma_f32_16x16x32_bf16(a, b, c, 0, 0, 0); }
DI bf16x8 tr_frag(LAS unsigned char* img, int pitch, int krow0, int col0, int lane) {
    const int g = lane >> 4, q = (lane & 15) >> 2, pp = lane & 3;
    LAS unsigned char* a0 = img + (krow0 + 8 * g + q) * pitch + col0 * 2 + 8 * pp;
    s16x4 lo = __builtin_amdgcn_ds_read_tr16_b64_v4i16((LAS s16x4*)a0);
    s16x4 hi = __builtin_amdgcn_ds_read_tr16_b64_v4i16((LAS s16x4*)(a0 + 4 * pitch));
    return __builtin_shufflevector(lo, hi, 0, 1, 2, 3, 4, 5, 6, 7);
}

constexpr int HTB = 128 * 64 * 2;
DI int lds_byte(int r, int c) { const int st = (r >> 4) * 2 + (c >> 5), rr = r & 15, cc = c & 31, ob = rr * 64 + cc * 2; return st * 1024 + (ob ^ (((ob >> 9) & 1) << 5)); }
DI void stage_rc(int b, int& R, int& C) { const int st = b / 1024, sb = b % 1024, swz = sb ^ (((sb >> 9) & 1) << 5); R = (st >> 1) * 16 + swz / 64; C = (st & 1) * 32 + (swz % 64) / 2; }
DI int perm32(int rho) { const int n = rho >> 4, i = rho & 15; return 8 * (i >> 2) + 4 * n + (i & 3); }

struct Unit { int pm, pn, g; };
struct GemmD { const bf16_t* A; const bf16_t* Bt; int lda, ldb; long a_gs, b_gs; int K; };
struct Sched {
    int nM, nN, nG, nM2, nN2, pm2off, G, c;
    DI bool next(int i, Unit& u) const {
        const int L = i * G + c; const int nwg = nM * nN, tot1 = nwg * nG;
        const bool first = L < tot1;
        const int L1 = first ? L : 0;
        const int g = L1 / nwg; int wgid = L1 - g * nwg;
        { const int q = nwg / 8, r = nwg % 8, xcd = wgid % 8, off = wgid / 8; wgid = (xcd < r ? xcd * (q + 1) : r * (q + 1) + (xcd - r) * q) + off; }
        const int nig = 8 * nN, gid = wgid / nig, fm = gid * 8, gsz = (nM - fm) < 8 ? (nM - fm) : 8;
        const int pm1 = fm + ((wgid % nig) % gsz), pn1 = (wgid % nig) / gsz;
        const int L2 = first ? 0 : L - tot1, d2 = nM2 > 0 ? nM2 : 1;
        const int pm2 = pm2off + L2 % d2, pn2 = L2 / d2;
        u.pm = first ? pm1 : pm2; u.pn = first ? pn1 : pn2; u.g = first ? g : 0;
        return first || (L2 < nM2 * nN2);
    }
};

template <class Epi>
DI void gemm_phase(LAS unsigned char* lds, const GemmD g, const Sched& S, const Epi& E) {
    const int tid = opaque_tid(), wid = __builtin_amdgcn_readfirstlane(tid >> 6), lane = tid & 63, wr = wid >> 2, wc = wid & 3, fr = lane & 15, fq = lane >> 4;
    const int K = g.K, nt = K / 64;
    unsigned voffA[2], voffB[2];
#pragma unroll
    for (int i = 0; i < 2; ++i) { int R, C; stage_rc(tid * 16 + i * 8192, R, C); const int Rb = Epi::PERM ? ((R & ~31) + perm32(R & 31)) : R;
        voffA[i] = (unsigned)(R * g.lda + C) * 2u; voffB[i] = (unsigned)(Rb * g.ldb + C) * 2u; }
    const size_t kstep = 128;
    const size_t hstepA = (size_t)128 * g.lda * 2, hstepB = (size_t)128 * g.ldb * 2;
    const unsigned ldsw = (unsigned)wid * 1024u;
    const int aoff = lds_byte(wr * 64 + fr, fq * 8), boff = lds_byte(wc * 32 + fr, fq * 8);
#define G_SA(b, h) (((b) * 2 + (h)) * HTB)
#define G_SB(b, h) ((4 + (b) * 2 + (h)) * HTB)
#define G_STAGE(bufoff, gbase, voff) do { _Pragma("unroll") for (int _i = 0; _i < 2; ++_i) \
        __builtin_amdgcn_global_load_lds((const unsigned*)((const char*)(gbase) + (voff)[_i]), (LAS unsigned*)(lds + (bufoff) + ldsw + _i * 8192), 16, 0, 0); } while (0)
#define G_LDA(dst, b, h) do { _Pragma("unroll") for (int m = 0; m < 4; ++m) _Pragma("unroll") for (int k = 0; k < 2; ++k) dst[m][k] = *(const LAS bf16x8*)(lds + G_SA(b, h) + aoff + m * 2048 + k * 1024); } while (0)
#define G_LDB(dst, b, h) do { _Pragma("unroll") for (int n = 0; n < 2; ++n) _Pragma("unroll") for (int k = 0; k < 2; ++k) dst[n][k] = *(const LAS bf16x8*)(lds + G_SB(b, h) + boff + n * 2048 + k * 1024); } while (0)
#define G_MMA(ai, bj, At, Bt) do { __builtin_amdgcn_s_setprio(1); _Pragma("unroll") for (int m = 0; m < 4; ++m) _Pragma("unroll") for (int n = 0; n < 2; ++n) _Pragma("unroll") for (int k = 0; k < 2; ++k) \
        acc[ai][bj][m][n] = __builtin_amdgcn_mfma_f32_16x16x32_bf16(Bt[n][k], At[m][k], acc[ai][bj][m][n], 0, 0, 0); __builtin_amdgcn_s_setprio(0); } while (0)
#define G_WAIT_V(n) asm volatile("s_waitcnt vmcnt(" #n ")" ::: "memory")
#define G_WAIT_L(n) asm volatile("s_waitcnt lgkmcnt(" #n ")" ::: "memory")
#define G_BAR __builtin_amdgcn_s_barrier()
#define G_SCHED __builtin_amdgcn_sched_barrier(0)
    Unit cur, nxt; int ui = 0;
    if (!S.next(0, cur)) return;
    f32x4 acc[2][2][4][2];
#pragma unroll
    for (int a = 0; a < 2; ++a)
#pragma unroll
        for (int b = 0; b < 2; ++b)
#pragma unroll
            for (int m = 0; m < 4; ++m)
#pragma unroll
                for (int n = 0; n < 2; ++n) acc[a][b][m][n] = (f32x4){0.f, 0.f, 0.f, 0.f};
    bf16x8 At[4][2], B0[2][2], B1[2][2];
    const char* cA = (const char*)(g.A + (long)cur.g * g.a_gs) + (size_t)cur.pm * 2 * hstepA;
    const char* cB = (const char*)(g.Bt + (long)cur.g * g.b_gs) + (size_t)cur.pn * 2 * hstepB;
    G_STAGE(G_SB(0, 0), cB, voffB); G_STAGE(G_SA(0, 0), cA, voffA); G_STAGE(G_SB(0, 1), cB + hstepB, voffB); G_STAGE(G_SA(0, 1), cA + hstepA, voffA);
    if (wr == 1) G_BAR;
    G_WAIT_V(4); G_BAR;
    G_STAGE(G_SB(1, 0), cB + kstep, voffB); G_STAGE(G_SA(1, 0), cA + kstep, voffA); G_STAGE(G_SB(1, 1), cB + hstepB + kstep, voffB);
    G_WAIT_V(6); G_BAR;
    for (;;) {
        const bool has_next = S.next(ui + 1, nxt);
        const char* nA = has_next ? (const char*)(g.A + (long)nxt.g * g.a_gs) + (size_t)nxt.pm * 2 * hstepA : cA;
        const char* nB = has_next ? (const char*)(g.Bt + (long)nxt.g * g.b_gs) + (size_t)nxt.pn * 2 * hstepB : cB;
        for (int t = 0; t < nt; t += 2) {
            const bool last = (t == nt - 2);
            const char* a1 = cA + (size_t)(t + 1) * kstep;
            const char* a2 = last ? nA : cA + (size_t)(t + 2) * kstep; const char* b2 = last ? nB : cB + (size_t)(t + 2) * kstep;
            const char* a3 = a2 + kstep; const char* b3 = b2 + kstep;
            G_LDB(B0, 0, 0); G_SCHED; G_LDA(At, 0, 0); G_STAGE(G_SA(1, 1), a1 + hstepA, voffA);
            G_WAIT_L(8); G_BAR; G_WAIT_L(0); G_MMA(0, 0, At, B0); G_BAR; G_SCHED;
            G_LDB(B1, 0, 1); G_STAGE(G_SB(0, 0), b2, voffB);
            G_BAR; G_WAIT_L(0); G_MMA(0, 1, At, B1); G_BAR;
            G_LDA(At, 0, 1); G_STAGE(G_SA(0, 0), a2, voffA);
            G_BAR; G_WAIT_L(0); G_MMA(1, 0, At, B0); G_BAR; G_SCHED;
            G_STAGE(G_SB(0, 1), b2 + hstepB, voffB);
            G_WAIT_V(6); G_BAR; G_MMA(1, 1, At, B1); G_BAR;
            G_LDB(B0, 1, 0); G_SCHED; G_LDA(At, 1, 0); G_STAGE(G_SA(0, 1), a2 + hstepA, voffA);
            G_WAIT_L(8); G_BAR; G_WAIT_L(0); G_MMA(0, 0, At, B0); G_BAR; G_SCHED;
            G_LDB(B1, 1, 1); G_STAGE(G_SB(1, 0), b3, voffB);
            G_BAR; G_WAIT_L(0); G_MMA(0, 1, At, B1); G_BAR;
            G_LDA(At, 1, 1); G_STAGE(G_SA(1, 0), a3, voffA);
            G_BAR; G_WAIT_L(0); G_MMA(1, 0, At, B0); G_BAR; G_SCHED;
            G_STAGE(G_SB(1, 1), b3 + hstepB, voffB);
            G_WAIT_V(6); G_BAR; G_MMA(1, 1, At, B1); G_BAR;
        }
        E(acc, cur, wr, wc, fr, fq);
        if (!has_next) break;
#pragma unroll
        for (int a = 0; a < 2; ++a)
#pragma unroll
            for (int b = 0; b < 2; ++b)
#pragma unroll
                for (int m = 0; m < 4; ++m)
#pragma unroll
                    for (int n = 0; n < 2; ++n) acc[a][b][m][n] = (f32x4){0.f, 0.f, 0.f, 0.f};
        cur = nxt; cA = nA; cB = nB; ++ui;
    }
    G_WAIT_V(0);
    if (wr == 0) G_BAR;
    G_BAR;
}

struct EpiPlanes {
    static constexpr bool PERM = true;
    bf16_t* xbase; bf16_t* cbase;
    DI void operator()(const f32x4 (&acc)[2][2][4][2], const Unit& u, int wr, int wc, int fr, int fq) const {
        const int plane = u.pn >> 2, colt = (u.pn & 3) * 256;
        bf16_t* base; int row0;
        if (u.pm < 128) { base = xbase + (size_t)plane * NX * 1024; row0 = u.pm * 256 + wr * 64 + fr; }
        else { base = cbase + (size_t)plane * NCX * 1024; row0 = (u.pm - 128) * 256 + wr * 64 + fr; }
        const int col0 = colt + wc * 32 + 8 * fq;
#pragma unroll
        for (int ai = 0; ai < 2; ++ai)
#pragma unroll
            for (int m = 0; m < 4; ++m) { bf16_t* rowp = base + (size_t)(row0 + ai * 128 + m * 16) * 1024 + col0;
#pragma unroll
                for (int bj = 0; bj < 2; ++bj) { const f32x4 v0 = acc[ai][bj][m][0], v1 = acc[ai][bj][m][1];
                    u32x4 w; w.x = pk2(v0[0], v0[1]); w.y = pk2(v0[2], v0[3]); w.z = pk2(v1[0], v1[1]); w.w = pk2(v1[2], v1[3]);
                    *(u32x4*)(rowp + bj * 128) = w; } }
    }
};
struct EpiBf {
    static constexpr bool PERM = true;
    bf16_t* O; bf16_t* O2; int ldc; int gcol; int mode; const float* scale; const bf16_t* zc;
    DI void operator()(const f32x4 (&acc)[2][2][4][2], const Unit& u, int wr, int wc, int fr, int fq) const {
        const int row0 = u.pm * 256 + wr * 64 + fr;
        bf16_t* base = O; int pn = u.pn; bool act = false;
        if (mode == 1 && pn >= 8) { base = O2; pn -= 8; act = true; }
        const int col0 = u.g * gcol + pn * 256 + wc * 32 + 8 * fq;
#pragma unroll
        for (int ai = 0; ai < 2; ++ai)
#pragma unroll
            for (int m = 0; m < 4; ++m) { const size_t ro = (size_t)(row0 + ai * 128 + m * 16) * ldc + col0;
#pragma unroll
                for (int bj = 0; bj < 2; ++bj) { f32x4 v0 = acc[ai][bj][m][0], v1 = acc[ai][bj][m][1];
                    if (act) {
#pragma unroll
                        for (int j = 0; j < 4; ++j) { v0[j] = silu_f(v0[j]); v1[j] = silu_f(v1[j]); } }
                    if (mode == 2) {
                        const u32x4 z = *(const u32x4*)(zc + ro + bj * 128);
                        const f32x4 s0 = *(const f32x4*)(scale + col0 + bj * 128), s1 = *(const f32x4*)(scale + col0 + bj * 128 + 4);
                        v0[0] *= s0[0] * lo_f(z.x); v0[1] *= s0[1] * hi_f(z.x); v0[2] *= s0[2] * lo_f(z.y); v0[3] *= s0[3] * hi_f(z.y);
                        v1[0] *= s1[0] * lo_f(z.z); v1[1] *= s1[1] * hi_f(z.z); v1[2] *= s1[2] * lo_f(z.w); v1[3] *= s1[3] * hi_f(z.w);
                    }
                    u32x4 w; w.x = pk2(v0[0], v0[1]); w.y = pk2(v0[2], v0[3]); w.z = pk2(v1[0], v1[1]); w.w = pk2(v1[2], v1[3]);
                    *(u32x4*)(base + ro + bj * 128) = w; } }
    }
};
struct EpiRes {
    static constexpr bool PERM = false;
    float* O; const float* res; const float* gate;
    DI void operator()(const f32x4 (&acc)[2][2][4][2], const Unit& u, int wr, int wc, int fr, int fq) const {
        const int row0 = u.pm * 256 + wr * 64 + fr, col0 = u.pn * 256 + wc * 32 + 4 * fq;
        const float* gp = gate + (size_t)(u.pm >> 4) * 3072 + col0;
        f32x4 gv[2][2];
#pragma unroll
        for (int bj = 0; bj < 2; ++bj)
#pragma unroll
            for (int n = 0; n < 2; ++n) gv[bj][n] = *(const f32x4*)(gp + bj * 128 + n * 16);
#pragma unroll
        for (int ai = 0; ai < 2; ++ai)
#pragma unroll
            for (int m = 0; m < 4; ++m) { const size_t ro = (size_t)(row0 + ai * 128 + m * 16) * 1024 + col0;
#pragma unroll
                for (int bj = 0; bj < 2; ++bj)
#pragma unroll
                    for (int n = 0; n < 2; ++n) { const f32x4 r = *(const f32x4*)(res + ro + bj * 128 + n * 16);
                        *(f32x4*)(O + ro + bj * 128 + n * 16) = r + gv[bj][n] * acc[ai][bj][m][n]; } }
    }
};

DI void ph_prep(const Params& p, LAS unsigned char* lds) {
    const int tid = opaque_tid();
    LAS float* tile = (LAS float*)lds;
    for (int job = blockIdx.x; job < 4096; job += gridDim.x) {
        const float* src; bf16_t* dst; int K, Nt, tk, tn; int j = job;
        if (j < 1792) { src = p.win_even; dst = (bf16_t*)(p.ws + WS_WINE); K = 1024; Nt = 7184; tk = j & 15; tn = j >> 4; }
        else if ((j -= 1792) < 512) { src = p.wout_even; dst = (bf16_t*)(p.ws + WS_WOUTE); K = 2048; Nt = 1024; tk = j & 31; tn = j >> 5; }
        else if ((j -= 512) < 1024) { src = p.win_odd; dst = (bf16_t*)(p.ws + WS_WINO); K = 1024; Nt = 4096; tk = j & 15; tn = j >> 4; }
        else if ((j -= 1024) < 256) { const int g = j >> 6, jj = j & 63; src = p.pool_w + (size_t)g * 512 * 512; dst = (bf16_t*)(p.ws + WS_WPOOL) + (size_t)g * 512 * 512; K = 512; Nt = 512; tk = jj & 7; tn = jj >> 3; }
        else { j -= 256; src = p.wout_odd; dst = (bf16_t*)(p.ws + WS_WOUTO); K = 2048; Nt = 1024; tk = j & 31; tn = j >> 5; }
        const int k0 = tk * 64, n0 = tn * 64;
#pragma unroll
        for (int i = 0; i < 8; ++i) { const int idx = tid + 512 * i, k = idx >> 6, n = idx & 63; tile[k * 65 + n] = src[(size_t)(k0 + k) * Nt + n0 + n]; }
        __syncthreads();
#pragma unroll
        for (int i = 0; i < 4; ++i) { const int idx = tid + 512 * i, n = idx >> 5, k = (idx & 31) * 2;
            *(unsigned*)(dst + (size_t)(n0 + n) * K + k0 + k) = pk2(tile[k * 65 + n], tile[(k + 1) * 65 + n]); }
        __syncthreads();
    }
    LAS float* sv = (LAS float*)(lds + 32768);
    LAS float* red = (LAS float*)(lds + 32768 + 36864);
    LAS float* ct = (LAS float*)(lds + 90112); LAS float* st = ct + 256;
    for (int idx = tid; idx < 9216; idx += 512) { const int v = idx >> 10, k = idx & 1023; const float cv = (v < 8) ? p.c[v * 1024 + k] : p.c_ctx[k]; sv[idx] = silu_f(cv); }
    if (tid < 256) { float s, c; sincospif((float)tid / 128.0f, &s, &c); ct[tid] = c; st[tid] = s; }
    __syncthreads();
    float* MOD = (float*)(p.ws + WS_MOD);
    for (int item = blockIdx.x; item < 192; item += gridDim.x) {
        const int l = item / 96, c0 = (item % 96) * 32, kg = tid >> 5, col = tid & 31;
        float a[9];
#pragma unroll
        for (int v = 0; v < 9; ++v) a[v] = 0.f;
        const float* w = p.ada_w + (size_t)l * 1024 * 3072 + c0 + col;
        for (int k = kg; k < 1024; k += 16) { const float wv = w[(size_t)k * 3072];
#pragma unroll
            for (int v = 0; v < 9; ++v) a[v] += sv[v * 1024 + k] * wv; }
#pragma unroll
        for (int v = 0; v < 9; ++v) red[(kg * 32 + col) * 9 + v] = a[v];
        __syncthreads();
        if (tid < 288) { const int v = tid >> 5, cc = tid & 31; float s = 0.f; for (int q = 0; q < 16; ++q) s += red[(q * 32 + cc) * 9 + v];
            MOD[(size_t)(l * 9 + v) * 3072 + c0 + cc] = s + p.ada_b[l * 3072 + c0 + cc]; }
        __syncthreads();
    }
    bf16_t* WF = (bf16_t*)(p.ws + WS_WF);
    for (int it = blockIdx.x; it < 512; it += gridDim.x) {
        const int idx = it * 512 + tid, d = idx & 255, c = (idx >> 8) & 255, g = idx >> 16;
        const float* f = p.fourier_w + (size_t)g * 65536 + d;
        float aP = 0.f, aQ = 0.f;
        for (int cp = 0; cp < 256; ++cp) { const float fv = f[cp * 256]; const int a = (c * cp) & 255; aP += ct[a] * fv; aQ += st[a] * fv; }
        WF[(size_t)(g * 512 + d) * 256 + c] = (bf16_t)(pk2(aP * 0.0625f, 0.f) & 0xffffu);
        WF[(size_t)(g * 512 + 256 + d) * 256 + c] = (bf16_t)(pk2(-aQ * 0.0625f, 0.f) & 0xffffu);
    }
}

DI void ph_norm0(const Params& p, LAS unsigned char* lds) {
    const int tid = opaque_tid(), wid = tid >> 6, lane = tid & 63;
    LAS float* wg = (LAS float*)lds;
#pragma unroll 4
    for (int i = 0; i < 32; ++i) { const int idx = tid + 512 * i, k = idx >> 4, j = idx & 15; wg[j * 1024 + k] = p.win_even[(size_t)k * 7184 + 7168 + j]; }
    __syncthreads();
    f32x4 g[4];
#pragma unroll
    for (int i = 0; i < 4; ++i) g[i] = *(const f32x4*)(p.norm_g + lane * 4 + 256 * i);
    const float* MOD = (const float*)(p.ws + WS_MOD);
    bf16_t* HX = (bf16_t*)p.out;
    float* GATES = (float*)(p.ws + WS_GATES);
    for (int r = blockIdx.x * 8 + wid; r < NR; r += gridDim.x * 8) {
        const float* src; const float* md;
        if (r < NX) { src = p.x + (size_t)r * 1024; md = MOD + (size_t)(r >> 12) * 3072; } else { src = p.ctx + (size_t)(r - NX) * 1024; md = MOD + (size_t)8 * 3072; }
        f32x4 v[4]; float ss = 0.f;
#pragma unroll
        for (int i = 0; i < 4; ++i) { v[i] = *(const f32x4*)(src + lane * 4 + 256 * i); ss += v[i][0] * v[i][0] + v[i][1] * v[i][1] + v[i][2] * v[i][2] + v[i][3] * v[i][3]; }
        ss = wave_sum(ss);
        const float rstd = rsqrtf(ss * (1.0f / 1024.0f) + 1e-6f);
#pragma unroll
        for (int i = 0; i < 4; ++i) { const f32x4 sh = *(const f32x4*)(md + lane * 4 + 256 * i), sc = *(const f32x4*)(md + 1024 + lane * 4 + 256 * i);
            v[i] = v[i] * rstd * g[i] * (sc + 1.0f) + sh;
            u32x2 w; w.x = pk2(v[i][0], v[i][1]); w.y = pk2(v[i][2], v[i][3]);
            *(u32x2*)(HX + (size_t)r * 1024 + lane * 4 + 256 * i) = w; }
        float pt[16];
#pragma unroll
        for (int j = 0; j < 16; ++j) { float a = 0.f;
#pragma unroll
            for (int i = 0; i < 4; ++i) { const f32x4 w4 = *(const LAS f32x4*)(wg + j * 1024 + lane * 4 + 256 * i); a += v[i][0] * w4[0] + v[i][1] * w4[1] + v[i][2] * w4[2] + v[i][3] * w4[3]; }
            pt[j] = a; if ((j & 3) == 3) __builtin_amdgcn_sched_barrier(0); }
        { const bool b5 = lane & 32;
#pragma unroll
          for (int j = 0; j < 8; ++j) { const float snd = b5 ? pt[j] : pt[j + 8], kp = b5 ? pt[j + 8] : pt[j]; pt[j] = kp + __shfl_xor(snd, 32); } }
        { const bool b4 = lane & 16;
#pragma unroll
          for (int j = 0; j < 4; ++j) { const float snd = b4 ? pt[j] : pt[j + 4], kp = b4 ? pt[j + 4] : pt[j]; pt[j] = kp + __shfl_xor(snd, 16); } }
        { const bool b3 = lane & 8;
#pragma unroll
          for (int j = 0; j < 2; ++j) { const float snd = b3 ? pt[j] : pt[j + 2], kp = b3 ? pt[j + 2] : pt[j]; pt[j] = kp + __shfl_xor(snd, 8); } }
        { const bool b2 = lane & 4; const float snd = b2 ? pt[0] : pt[1], kp = b2 ? pt[1] : pt[0]; pt[0] = kp + __shfl_xor(snd, 4); }
        pt[0] += __shfl_xor(pt[0], 2); pt[0] += __shfl_xor(pt[0], 1);
        if ((lane & 3) == 0) { const int j = ((lane >> 5) & 1) * 8 + ((lane >> 4) & 1) * 4 + ((lane >> 3) & 1) * 2 + ((lane >> 2) & 1);
            float val = pt[0] + p.gate_b[j];
            if ((j >> 2) & 1) val = fminf(val, 0.f) - log1pf(__expf(-fabsf(val)));
            GATES[(size_t)r * 16 + j] = val; }
    }
}
DI void ph_norm1(const Params& p, int mode) {
    const int tid = opaque_tid(), wid = tid >> 6, lane = tid & 63;
    const float* gsrc = mode ? p.final_g : p.norm_g + 1024;
    f32x4 g[4];
#pragma unroll
    for (int i = 0; i < 4; ++i) g[i] = *(const f32x4*)(gsrc + lane * 4 + 256 * i);
    const float* MOD = (const float*)(p.ws + WS_MOD) + (size_t)9 * 3072;
    const float* X1 = (const float*)p.ws;
    bf16_t* HX1 = (bf16_t*)(p.ws + 2 * PLANE);
    for (int r = blockIdx.x * 8 + wid; r < NX; r += gridDim.x * 8) {
        const float* src = X1 + (size_t)r * 1024; const float* md = MOD + (size_t)(r >> 12) * 3072;
        f32x4 v[4]; float ss = 0.f;
#pragma unroll
        for (int i = 0; i < 4; ++i) { v[i] = *(const f32x4*)(src + lane * 4 + 256 * i); ss += v[i][0] * v[i][0] + v[i][1] * v[i][1] + v[i][2] * v[i][2] + v[i][3] * v[i][3]; }
        ss = wave_sum(ss);
        const float rstd = rsqrtf(ss * (1.0f / 1024.0f) + 1e-6f);
#pragma unroll
        for (int i = 0; i < 4; ++i) {
            if (mode) { *(f32x4*)(p.out + (size_t)r * 1024 + lane * 4 + 256 * i) = v[i] * rstd * g[i]; }
            else { const f32x4 sh = *(const f32x4*)(md + lane * 4 + 256 * i), sc = *(const f32x4*)(md + 1024 + lane * 4 + 256 * i);
                const f32x4 h = v[i] * rstd * g[i] * (sc + 1.0f) + sh;
                u32x2 w; w.x = pk2(h[0], h[1]); w.y = pk2(h[2], h[3]);
                *(u32x2*)(HX1 + (size_t)r * 1024 + lane * 4 + 256 * i) = w; } }
    }
}

DI void ph_conv(const Params& p) {
    const bf16_t* QRAW = (const bf16_t*)p.ws; const bf16_t* KRAW = (const bf16_t*)(p.ws + PLANE);
    const bf16_t* CQ = (const bf16_t*)(p.ws + WS_CRAW); const bf16_t* CK = CQ + (size_t)NCX * 1024;
    bf16_t* QC = (bf16_t*)p.out; bf16_t* KC = QC + (size_t)NX * 1024;
    bf16_t* CQC = (bf16_t*)(p.ws + WS_CQC); bf16_t* CKC = (bf16_t*)(p.ws + WS_CKC);
    const int total = NR * 256;
    const int tid = opaque_tid();
    const bool scanner = (blockIdx.x < 64) && (tid < 64) && (gridDim.x >= 64);
    const int nscan = gridDim.x >= 64 ? 64 : 0;
    const int active_id = (int)blockIdx.x < nscan ? (int)blockIdx.x * 448 + (tid - 64) : nscan * 448 + ((int)blockIdx.x - nscan) * 512 + tid;
    const int active_n = nscan * 448 + ((int)gridDim.x - nscan) * 512;
    if (!scanner)
    for (int idx = active_id; idx < total; idx += active_n) {
        const int oct = idx & 127, which = (idx >> 7) & 1, r = idx >> 8, ch = oct * 8;
        const bf16_t* src; bf16_t* dst; int t, T;
        if (r < NX) { src = (which ? KRAW : QRAW) + (size_t)r * 1024 + ch; dst = (which ? KC : QC) + (size_t)r * 1024 + ch; t = r & 4095; T = 4096; }
        else { const int rr = r - NX; src = (which ? CK : CQ) + (size_t)rr * 1024 + ch; dst = (which ? CKC : CQC) + (size_t)rr * 1024 + ch; t = rr & 255; T = 256; }
        const u32x4 z = {0u, 0u, 0u, 0u};
        const u32x4 cc = *(const u32x4*)src;
        const u32x4 aa = (t > 0) ? *(const u32x4*)(src - 1024) : z;
        const u32x4 bb = (t < T - 1) ? *(const u32x4*)(src + 1024) : z;
        const float* w = p.conv_qk + which * 1024 + ch;
        float o[8];
#pragma unroll
        for (int e = 0; e < 4; ++e) {
            const float w0l = w[2 * e], w0h = w[2 * e + 1], w1l = w[2048 + 2 * e], w1h = w[2048 + 2 * e + 1], w2l = w[4096 + 2 * e], w2h = w[4096 + 2 * e + 1];
            float lo = w0l * lo_f(aa[e]) + w1l * lo_f(cc[e]) + w2l * lo_f(bb[e]);
            float hi = w0h * hi_f(aa[e]) + w1h * hi_f(cc[e]) + w2h * hi_f(bb[e]);
            lo = silu_f(lo); hi = silu_f(hi);
            if (!which) { lo *= 0.0625f; hi *= 0.0625f; }
            o[2 * e] = lo; o[2 * e + 1] = hi;
        }
        u32x4 wv; wv.x = pk2(o[0], o[1]); wv.y = pk2(o[2], o[3]); wv.z = pk2(o[4], o[5]); wv.w = pk2(o[6], o[7]);
        *(u32x4*)dst = wv;
    }
    const int lane = tid & 63;
    const int n_sc = nscan ? 1 : 64;
    if (scanner || (nscan == 0 && blockIdx.x == 0 && tid < 64))
    for (int sc = 0; sc < n_sc; ++sc) {
        const int gw = nscan ? (int)blockIdx.x : sc;
        const int b = gw >> 3, h = (gw >> 1) & 3, dir = gw & 1;
        const float* GATES = (const float*)(p.ws + WS_GATES);
        float* GP = (float*)(p.ws + WS_GPRE) + (size_t)gw * 68 * 384;
        float m_prev = 0.f;
        auto grow_of = [&](int st) -> size_t { if (st < 4) { const int cc = dir ? 3 - st : st; return (size_t)NX + (size_t)b * 256 + cc * 64; } const int xc = st - 4, cc = dir ? 63 - xc : xc; return (size_t)b * 4096 + cc * 64; };
        const int oi = (dir ? 8 : 0) + h, of = (dir ? 12 : 4) + h;
        float nig = GATES[(grow_of(0) + lane) * 16 + oi], nlf = GATES[(grow_of(0) + lane) * 16 + of];
        for (int st = 0; st < 68; ++st) {
            const float ig = nig, lf = nlf;
            if (st + 1 < 68) { const size_t g2 = grow_of(st + 1); nig = GATES[(g2 + lane) * 16 + oi]; nlf = GATES[(g2 + lane) * 16 + of]; }
            float bs = lf;
#pragma unroll
            for (int o = 1; o < 64; o <<= 1) { const float ov = dir ? __shfl_down(bs, o) : __shfl_up(bs, o); const bool ok = dir ? (lane + o < 64) : (lane >= o); if (ok) bs += ov; }
            const float a = ig - bs;
            float mx = a;
#pragma unroll
            for (int o = 1; o < 64; o <<= 1) { const float ov = dir ? __shfl_down(mx, o) : __shfl_up(mx, o); const bool ok = dir ? (lane + o < 64) : (lane >= o); if (ok) mx = fmaxf(mx, ov); }
            const float total = __shfl(bs, dir ? 0 : 63);
            const float m_inter = bs + m_prev, m_t = fmaxf(bs + mx, m_inter);
            const float wsl = total - bs + ig;
            const float m_new = fmaxf(total + m_prev, wave_max(wsl));
            float* o = GP + (size_t)st * 384;
            o[lane] = bs - m_t; o[64 + lane] = a; o[128 + lane] = __expf(m_inter - m_t); o[192 + lane] = __expf(wsl - m_new); o[256 + lane] = __expf(-m_t);
            if (lane == 0) o[320] = __expf(total + m_prev - m_new);
            m_prev = m_new;
        }
    }
}

DI void ph_mlstm(const Params& p, LAS unsigned char* lds) {
    constexpr int QP = 528, VP = 176, SP = 144;
    LAS unsigned char* Qi = lds; LAS unsigned char* Ki = lds + 33792; LAS unsigned char* Vi = lds + 67584; LAS unsigned char* Vwi = Vi + 11264;
    LAS unsigned char* Sgi = Vwi + 11264; LAS unsigned char* Ci = Sgi + 9216; LAS float* fl = (LAS float*)(Ci + 42240);
    LAS float* f_bt = fl; LAS float* f_aa = fl + 64; LAS float* f_inter = fl + 128; LAS float* f_enm = fl + 256;
    const int tid = opaque_tid(), wid = tid >> 6, lane = tid & 63, fr = lane & 15, fq = lane >> 4;
    const bf16_t* QC = (const bf16_t*)p.out; const bf16_t* KC = QC + (size_t)NX * 1024; const bf16_t* VPL = (const bf16_t*)(p.ws + 2 * PLANE);
    const bf16_t* CQC = (const bf16_t*)(p.ws + WS_CQC); const bf16_t* CKC = (const bf16_t*)(p.ws + WS_CKC); const bf16_t* CV = (const bf16_t*)(p.ws + WS_CRAW) + (size_t)2 * NCX * 1024;
    for (int wi = blockIdx.x; wi < 256; wi += gridDim.x) {
        const int b = wi >> 5, h = (wi >> 3) & 3, dir = (wi >> 2) & 1, es = wi & 3;
        bf16_t* Hout = (bf16_t*)(p.ws + (dir ? PLANE : 0));
        const float* GP = (const float*)(p.ws + WS_GPRE) + (size_t)((b * 4 + h) * 2 + dir) * 68 * 384;
        f32x4 Cst[2][5];
#pragma unroll
        for (int i = 0; i < 2; ++i)
#pragma unroll
            for (int n = 0; n < 5; ++n) Cst[i][n] = (f32x4){0.f, 0.f, 0.f, 0.f};
        __syncthreads();
        for (int i = tid; i < 64 * 8; i += 512) { const int row = i >> 3, c = i & 7; *(LAS unsigned*)(Vi + row * VP + 128 + c * 4) = 0x3F803F80u; *(LAS unsigned*)(Vwi + row * VP + 128 + c * 4) = 0u; }
        u32x4 rq[4], rk[4], rv; float pg = 0.f, pws = 0.f, pdecay = 0.f;
        const int mt = wid >> 1, nt0 = 2 * (wid & 1);
#define ML_LOAD(ST) do { const int _st = (ST); const bf16_t *_q, *_k, *_v; \
            if (_st < 4) { const int cc = dir ? 3 - _st : _st; const size_t row0 = (size_t)b * 256 + cc * 64; _q = CQC + row0 * 1024 + h * 256; _k = CKC + row0 * 1024 + h * 256; _v = CV + row0 * 1024 + h * 256 + es * 64; } \
            else { const int xc = _st - 4, cc = dir ? 63 - xc : xc; const size_t row0 = (size_t)b * 4096 + cc * 64; _q = QC + row0 * 1024 + h * 256; _k = KC + row0 * 1024 + h * 256; _v = VPL + row0 * 1024 + h * 256 + es * 64; } \
            _Pragma("unroll") for (int i = 0; i < 4; ++i) { const int id = tid + 512 * i, row = id >> 5, chk = id & 31; rq[i] = *(const u32x4*)(_q + (size_t)row * 1024 + chk * 8); rk[i] = *(const u32x4*)(_k + (size_t)row * 1024 + chk * 8); } \
            rv = *(const u32x4*)(_v + (size_t)(tid >> 3) * 1024 + (tid & 7) * 8); \
            const float* _g = GP + (size_t)_st * 384; pg = _g[tid < 320 ? tid : 0]; pws = _g[192 + (tid >> 3)]; pdecay = _g[320]; } while (0)
        ML_LOAD(0);
        for (int st = 0; st < 68; ++st) {
            const bool isx = st >= 4;
            __syncthreads();
#pragma unroll
            for (int i = 0; i < 4; ++i) { const int id = tid + 512 * i, row = id >> 5, chk = id & 31;
                *(LAS u32x4*)(Qi + row * QP + chk * 16) = rq[i]; *(LAS u32x4*)(Ki + row * QP + chk * 16) = rk[i]; }
            *(LAS u32x4*)(Vi + (tid >> 3) * VP + (tid & 7) * 16) = rv;
            { const float w = pws; u32x4 o;
              o.x = pk2(w * lo_f(rv.x), w * hi_f(rv.x)); o.y = pk2(w * lo_f(rv.y), w * hi_f(rv.y)); o.z = pk2(w * lo_f(rv.z), w * hi_f(rv.z)); o.w = pk2(w * lo_f(rv.w), w * hi_f(rv.w));
              *(LAS u32x4*)(Vwi + (tid >> 3) * VP + (tid & 7) * 16) = o;
              if ((tid & 7) == 0) *(LAS unsigned*)(Vwi + (tid >> 3) * VP + 128) = pk2(w, 0.f); }
            if (tid < 320) fl[tid] = pg;
#pragma unroll
            for (int i = 0; i < 2; ++i)
#pragma unroll
                for (int n = 0; n < 5; ++n) { u32x2 w; w.x = pk2(Cst[i][n][0], Cst[i][n][1]); w.y = pk2(Cst[i][n][2], Cst[i][n][3]);
                    *(LAS u32x2*)(Ci + (16 * n + fr) * QP + (16 * (2 * wid + i) + 4 * fq) * 2) = w; }
            const float decay = pdecay;
            __syncthreads();
            if (st + 1 < 68) ML_LOAD(st + 1);
            const int t = 16 * mt + fr;
            f32x4 accC[3];
#pragma unroll
            for (int n = 0; n < 3; ++n) accC[n] = (f32x4){0.f, 0.f, 0.f, 0.f};
            if (isx) {
                f32x4 sacc[2] = {(f32x4){0.f, 0.f, 0.f, 0.f}, (f32x4){0.f, 0.f, 0.f, 0.f}};
#pragma unroll
                for (int ks = 0; ks < 8; ++ks) { const bf16x8 qf = *(const LAS bf16x8*)(Qi + t * QP + (32 * ks + 8 * fq) * 2);
#pragma unroll
                    for (int n = 0; n < 2; ++n) { const bf16x8 kf = *(const LAS bf16x8*)(Ki + (16 * (nt0 + n) + fr) * QP + (32 * ks + 8 * fq) * 2); sacc[n] = mfma16(kf, qf, sacc[n]); }
#pragma unroll
                    for (int n = 0; n < 3; ++n) { const int et = (n < 2) ? nt0 + n : 4; const bf16x8 cf = *(const LAS bf16x8*)(Ci + (16 * et + fr) * QP + (32 * ks + 8 * fq) * 2); accC[n] = mfma16(cf, qf, accC[n]); } }
                const float btm = f_bt[t];
#pragma unroll
                for (int n = 0; n < 2; ++n) { const int s0 = 16 * (nt0 + n) + 4 * fq; const f32x4 a4 = *(const LAS f32x4*)(f_aa + s0); float vv[4];
#pragma unroll
                    for (int j = 0; j < 4; ++j) { const int s = s0 + j; const bool ok = dir ? (s >= t) : (s <= t); const float e = __expf(btm + a4[j]); vv[j] = ok ? sacc[n][j] * e : 0.f; }
                    u32x2 w; w.x = pk2(vv[0], vv[1]); w.y = pk2(vv[2], vv[3]); *(LAS u32x2*)(Sgi + t * SP + s0 * 2) = w; }
            }
#pragma unroll
            for (int i = 0; i < 2; ++i)
#pragma unroll
                for (int n = 0; n < 5; ++n) Cst[i][n] = Cst[i][n] * decay;
#pragma unroll
            for (int ks = 0; ks < 2; ++ks) { bf16x8 kf[2];
#pragma unroll
                for (int i = 0; i < 2; ++i) kf[i] = tr_frag(Ki, QP, 32 * ks, 16 * (2 * wid + i), lane);
#pragma unroll
                for (int n = 0; n < 5; ++n) { const bf16x8 vw = tr_frag(Vwi, VP, 32 * ks, 16 * n, lane);
#pragma unroll
                    for (int i = 0; i < 2; ++i) Cst[i][n] = mfma16(kf[i], vw, Cst[i][n]); } }
            __syncthreads();
            if (isx) {
                f32x4 accD[3];
#pragma unroll
                for (int n = 0; n < 3; ++n) accD[n] = (f32x4){0.f, 0.f, 0.f, 0.f};
#pragma unroll
                for (int ks = 0; ks < 2; ++ks) { const bf16x8 sgf = *(const LAS bf16x8*)(Sgi + t * SP + (32 * ks + 8 * fq) * 2);
#pragma unroll
                    for (int n = 0; n < 3; ++n) { const int et = (n < 2) ? nt0 + n : 4; const bf16x8 vf = tr_frag(Vi, VP, 32 * ks, 16 * et, lane); accD[n] = mfma16(vf, sgf, accD[n]); } }
                const float inter_t = f_inter[t];
                const float den0 = accD[2][0] + inter_t * accC[2][0];
                const float den = __shfl(den0, fr);
                const float rden = 1.0f / fmaxf(fabsf(den), f_enm[t]);
                const int xc = st - 4, cc = dir ? 63 - xc : xc;
                bf16_t* hp = Hout + ((size_t)b * 4096 + cc * 64 + t) * 1024 + h * 256 + es * 64 + 4 * fq;
#pragma unroll
                for (int n = 0; n < 2; ++n) { const f32x4 hv = (accD[n] + accC[n] * inter_t) * rden;
                    u32x2 w; w.x = pk2(hv[0], hv[1]); w.y = pk2(hv[2], hv[3]); *(u32x2*)(hp + 16 * (nt0 + n)) = w; }
            }
        }
#undef ML_LOAD
    }
}

template <int KK, int NN, class Cfg>
DI void axis_mix(const Cfg& cfg, LAS unsigned char* lds, int n_items) {
    constexpr int TP = 528, BP = KK * 2 + 16, NCH = KK / 16;
    LAS unsigned char* Ti = lds; LAS unsigned char* Bi = lds + 128 * TP;
    const int tid = opaque_tid(), wid = tid >> 6, lane = tid & 63, fr = lane & 15, fq = lane >> 4;
    __syncthreads();
    cfg.fill_tables(Bi, tid);
    u32x4 r[NCH];
    int item = blockIdx.x;
    if (item < n_items) {
#pragma unroll
        for (int i = 0; i < NCH; ++i) { const int id = tid + 512 * i; r[i] = *(const u32x4*)(cfg.row_ptr(item, id >> 5) + (id & 31) * 8); } }
    for (; item < n_items; item += gridDim.x) {
        __syncthreads();
#pragma unroll
        for (int i = 0; i < NCH; ++i) { const int id = tid + 512 * i; *(LAS u32x4*)(Ti + (id >> 5) * TP + (id & 31) * 16) = r[i]; }
        __syncthreads();
        const int nxt = item + gridDim.x;
        if (nxt < n_items) {
#pragma unroll
            for (int i = 0; i < NCH; ++i) { const int id = tid + 512 * i; r[i] = *(const u32x4*)(cfg.row_ptr(nxt, id >> 5) + (id & 31) * 8); } }
        f32x4 acc[2][NN / 16];
#pragma unroll
        for (int i = 0; i < 2; ++i)
#pragma unroll
            for (int n = 0; n < NN / 16; ++n) acc[i][n] = (f32x4){0.f, 0.f, 0.f, 0.f};
        LAS unsigned char* tb = Bi + cfg.table_off(item);
#pragma unroll
        for (int ks = 0; ks < KK / 32; ++ks) { bf16x8 af[2];
#pragma unroll
            for (int i = 0; i < 2; ++i) af[i] = tr_frag(Ti, TP, 32 * ks, 32 * wid + 16 * i, lane);
#pragma unroll
            for (int n = 0; n < NN / 16; ++n) { const bf16x8 bfr = *(const LAS bf16x8*)(tb + (16 * n + fr) * BP + (32 * ks + 8 * fq) * 2);
#pragma unroll
                for (int i = 0; i < 2; ++i) acc[i][n] = mfma16(af[i], bfr, acc[i][n]); } }
        cfg.epilogue(acc, item, wid, fr, fq, Bi);
    }
}
DI void fill_dft_table(LAS unsigned char* Bi, int tid, int nrows) {
    for (int idx = tid; idx < nrows * 128; idx += 512) { const int n = idx >> 7, k = idx & 127, ap = n & 63, kk = k & 63; float s, c; sincospif((float)((kk * ap) & 63) / 32.0f, &s, &c);
        float v; if (n < 64) v = (k < 64) ? c : s; else v = (k < 64) ? -s : c;
        *(LAS unsigned short*)(Bi + n * 272 + k * 2) = (unsigned short)(pk2(v * 0.125f, 0.f) & 0xffffu); }
}
struct CfgDft1 {
    const bf16_t* Z; bf16_t* S1re; bf16_t* S1im;
    DI void fill_tables(LAS unsigned char* Bi, int tid) const { fill_dft_table(Bi, tid, 128);
        LAS float* tw = (LAS float*)(Bi + 34816);
        for (int j = tid; j < 4096; j += 512) { float s, c; sincospif((float)j / 2048.0f, &s, &c); tw[2 * j] = c; tw[2 * j + 1] = s; } }
    DI int table_off(int) const { return 0; }
    DI const bf16_t* row_ptr(int item, int k) const { const int g = item & 3, b = (item >> 2) & 63, batch = item >> 8;
        return Z + ((size_t)batch * 4096 + 64 * (k & 63) + b) * 2048 + g * 512 + (k >> 6) * 256; }
    DI void epilogue(const f32x4 (&acc)[2][8], int item, int wid, int fr, int fq, LAS unsigned char* Bi) const {
        const int g = item & 3, b = (item >> 2) & 63, batch = item >> 8;
        const LAS float* tw = (const LAS float*)(Bi + 34816);
#pragma unroll
        for (int ni = 0; ni < 4; ++ni) { const int ap = 16 * ni + fr; float s, c; sincospif((float)(b * ap) * (1.0f / 2048.0f), &s, &c);
            const size_t tok = (size_t)batch * 4096 + 64 * ap + b;
#pragma unroll
            for (int i = 0; i < 2; ++i) { const f32x4 re = acc[i][ni], im = acc[i][ni + 4]; const f32x4 r2 = re * c + im * s, i2 = im * c - re * s;
                const size_t o = tok * 1024 + g * 256 + 32 * wid + 16 * i + 4 * fq;
                u32x2 w; w.x = pk2(r2[0], r2[1]); w.y = pk2(r2[2], r2[3]); *(u32x2*)(S1re + o) = w;
                w.x = pk2(i2[0], i2[1]); w.y = pk2(i2[2], i2[3]); *(u32x2*)(S1im + o) = w; } }
    }
};
struct CfgDft2 {
    const bf16_t* S1re; const bf16_t* S1im; const bf16_t* ZB; bf16_t* Y;
    DI void fill_tables(LAS unsigned char* Bi, int tid) const { fill_dft_table(Bi, tid, 64); }
    DI int table_off(int) const { return 0; }
    DI const bf16_t* row_ptr(int item, int k) const { const int g = item & 3, ap = (item >> 2) & 63, batch = item >> 8;
        return ((k >> 6) ? S1im : S1re) + ((size_t)batch * 4096 + 64 * ap + (k & 63)) * 1024 + g * 256; }
    DI void epilogue(const f32x4 (&acc)[2][4], int item, int wid, int fr, int fq, LAS unsigned char*) const {
        const int g = item & 3, ap = (item >> 2) & 63, batch = item >> 8;
#pragma unroll
        for (int ni = 0; ni < 4; ++ni) { const size_t tok = (size_t)batch * 4096 + ap + 64 * (16 * ni + fr);
#pragma unroll
            for (int i = 0; i < 2; ++i) { const int ch = g * 256 + 32 * wid + 16 * i + 4 * fq; const u32x2 z = *(const u32x2*)(ZB + tok * 1024 + ch); const f32x4 a = acc[i][ni];
                u32x2 w; w.x = pk2(a[0] * silu_f(lo_f(z.x)), a[1] * silu_f(hi_f(z.x))); w.y = pk2(a[2] * silu_f(lo_f(z.y)), a[3] * silu_f(hi_f(z.y)));
                *(u32x2*)(Y + tok * 2048 + 1024 + ch) = w; } }
    }
};
DI void fill_pool_tables(LAS unsigned char* Bi, int tid) {
    for (int idx = tid; idx < 4 * 4096; idx += 512) { const int g = idx >> 12, n = (idx >> 6) & 63, k = idx & 63, w = 2 << g, lo = n - w / 2, hi = n + w - w / 2;
        *(LAS unsigned short*)(Bi + g * 9216 + n * 144 + k * 2) = (k >= lo && k < hi) ? (unsigned short)0x3F80 : (unsigned short)0; }
}
DI float pool_rcnt(int g, int n) { const int w = 2 << g; int lo = n - w / 2, hi = n + w - w / 2; lo = lo < 0 ? 0 : lo; hi = hi > 64 ? 64 : hi; return 1.0f / (float)(hi - lo); }
struct CfgPoolA {
    const bf16_t* UC; bf16_t* PA;
    DI void fill_tables(LAS unsigned char* Bi, int tid) const { fill_pool_tables(Bi, tid); }
    DI int table_off(int item) const { return ((item & 7) >> 1) * 9216; }
    DI const bf16_t* row_ptr(int item, int k) const { const int ct = item & 7, c = (item >> 3) & 63, batch = item >> 9; return UC + ((size_t)batch * 4096 + 64 * k + c) * 2048 + ct * 256; }
    DI void epilogue(const f32x4 (&acc)[2][4], int item, int wid, int fr, int fq, LAS unsigned char*) const {
        const int ct = item & 7, c = (item >> 3) & 63, batch = item >> 9, g = ct >> 1;
#pragma unroll
        for (int ni = 0; ni < 4; ++ni) { const int n = 16 * ni + fr; const float rc = pool_rcnt(g, n); const size_t tok = (size_t)batch * 4096 + 64 * n + c;
#pragma unroll
            for (int i = 0; i < 2; ++i) { const f32x4 a = acc[i][ni] * rc; u32x2 w; w.x = pk2(a[0], a[1]); w.y = pk2(a[2], a[3]);
                *(u32x2*)(PA + tok * 2048 + ct * 256 + 32 * wid + 16 * i + 4 * fq) = w; } }
    }
};
struct CfgPoolB {
    const bf16_t* PA; bf16_t* UC;
    DI void fill_tables(LAS unsigned char* Bi, int tid) const { fill_pool_tables(Bi, tid); }
    DI int table_off(int item) const { return ((item & 7) >> 1) * 9216; }
    DI const bf16_t* row_ptr(int item, int k) const { const int ct = item & 7, rp = (item >> 3) & 63, batch = item >> 9; return PA + ((size_t)batch * 4096 + 64 * rp + k) * 2048 + ct * 256; }
    DI void epilogue(const f32x4 (&acc)[2][4], int item, int wid, int fr, int fq, LAS unsigned char*) const {
        const int ct = item & 7, rp = (item >> 3) & 63, batch = item >> 9, g = ct >> 1;
#pragma unroll
        for (int ni = 0; ni < 4; ++ni) { const int n = 16 * ni + fr; const float rc = pool_rcnt(g, n); const size_t tok = (size_t)batch * 4096 + 64 * rp + n;
#pragma unroll
            for (int i = 0; i < 2; ++i) { bf16_t* up = UC + tok * 2048 + ct * 256 + 32 * wid + 16 * i + 4 * fq; const u32x2 u = *(const u32x2*)up; const f32x4 a = acc[i][ni] * rc;
                u32x2 w; w.x = pk2(a[0] - lo_f(u.x), a[1] - hi_f(u.x)); w.y = pk2(a[2] - lo_f(u.y), a[3] - hi_f(u.y)); *(u32x2*)up = w; } }
    }
};

DI void ph_ya(const Params& p) {
    const int tid = opaque_tid(), wid = tid >> 6, lane = tid & 63;
    const bf16_t* HF = (const bf16_t*)p.ws; const bf16_t* HB = (const bf16_t*)(p.ws + PLANE); const bf16_t* O = (const bf16_t*)(p.ws + 3 * PLANE); const bf16_t* ZA = (const bf16_t*)(p.ws + 4 * PLANE);
    bf16_t* Y = (bf16_t*)p.out;
    f32x4 hg[4];
#pragma unroll
    for (int i = 0; i < 4; ++i) hg[i] = *(const f32x4*)(p.head_norm + lane * 16 + 4 * i);
    for (int r = blockIdx.x * 8 + wid; r < NX; r += gridDim.x * 8) {
        const size_t o = (size_t)r * 1024 + lane * 16;
        float gv[16], za[16]; float ss = 0.f;
#pragma unroll
        for (int hh = 0; hh < 2; ++hh) { const u32x4 a = *(const u32x4*)(HF + o + 8 * hh), bq = *(const u32x4*)(HB + o + 8 * hh), oo = *(const u32x4*)(O + o + 8 * hh), zz = *(const u32x4*)(ZA + o + 8 * hh);
#pragma unroll
            for (int e = 0; e < 4; ++e) { const float h0 = lo_f(a[e]) + lo_f(bq[e]), h1 = hi_f(a[e]) + hi_f(bq[e]);
                const float g0 = sigmoid_f(lo_f(oo[e])) * h0, g1 = sigmoid_f(hi_f(oo[e])) * h1;
                gv[8 * hh + 2 * e] = g0; gv[8 * hh + 2 * e + 1] = g1; ss += g0 * g0 + g1 * g1; za[8 * hh + 2 * e] = lo_f(zz[e]); za[8 * hh + 2 * e + 1] = hi_f(zz[e]); } }
        ss += __shfl_xor(ss, 1); ss += __shfl_xor(ss, 2); ss += __shfl_xor(ss, 4); ss += __shfl_xor(ss, 8);
        const float rstd = rsqrtf(ss * (1.0f / 256.0f) + 1e-6f);
        u32x4 w[2];
#pragma unroll
        for (int q = 0; q < 8; ++q) { const float y0 = gv[2 * q] * rstd * hg[q >> 1][(2 * q) & 3] * silu_f(za[2 * q]), y1 = gv[2 * q + 1] * rstd * hg[q >> 1][(2 * q + 1) & 3] * silu_f(za[2 * q + 1]);
            w[q >> 2][q & 3] = pk2(y0, y1); }
        *(u32x4*)(Y + (size_t)r * 2048 + lane * 16) = w[0]; *(u32x4*)(Y + (size_t)r * 2048 + lane * 16 + 8) = w[1];
    }
}


#define XB_TMO      128
#define XB_XCNT(j)  (256  + 64 * (j))
#define XB_XSUB(j)  (1280 + 64 * (j))
#define XB_XGEN(j)  (2304 + 64 * (j))
#define XB_TOP      3328
#define XB_TOPGEN   3392
#define XCD_BAR_WORDS 3456
#define XB_SPIN_CAP (1u << 18)
DI unsigned xb_ld(unsigned* p)              { return __hip_atomic_load(p, __ATOMIC_RELAXED, __HIP_MEMORY_SCOPE_AGENT); }
DI unsigned xb_add(unsigned* p, unsigned v) { return __hip_atomic_fetch_add(p, v, __ATOMIC_RELAXED, __HIP_MEMORY_SCOPE_AGENT); }
DI unsigned xb_xcc_id() { return (unsigned)__builtin_amdgcn_s_getreg((3 << 11) | 20) & 0xFu; }
#define XB_SPIN(cond, bar) do { unsigned _sp = 0; while (cond) { __builtin_amdgcn_s_sleep(1); \
    if ((++_sp & 255u) == 0u) { if (xb_ld(&(bar)[XB_TMO])) break; if (_sp > XB_SPIN_CAP) { atomicAdd(&(bar)[XB_TMO], 1u); break; } } } } while (0)
struct XcdBarrier { unsigned* bar; unsigned x; volatile LAS unsigned* st; };
DI XcdBarrier xcd_barrier_post(unsigned* bar, volatile LAS unsigned* st) {
    XcdBarrier b; b.bar = bar; b.x = xb_xcc_id(); b.st = st;
    if (threadIdx.x == 0) (void)xb_add(&bar[XB_XCNT(b.x)], 1u);
    return b;
}
DI void xcd_barrier_complete(unsigned* bar, unsigned x, unsigned& nloc, unsigned& nx) {
    const unsigned G = gridDim.x * gridDim.y * gridDim.z;
    unsigned sum, cnt, mine, sp = 0u;
    for (;;) {
        sum = 0u; cnt = 0u; mine = 0u;
#pragma unroll
        for (unsigned j = 0; j < 16; ++j) { const unsigned c = xb_ld(&bar[XB_XCNT(j)]); sum += c; cnt += (c > 0u) ? 1u : 0u; mine = (j == x) ? c : mine; }
        if (sum == G) break;
        __builtin_amdgcn_s_sleep(1);
        if ((++sp & 255u) == 0u) { if (xb_ld(&bar[XB_TMO])) break; if (sp > XB_SPIN_CAP) { atomicAdd(&bar[XB_TMO], 1u); break; } }
    }
    nloc = mine > 0u ? mine : 1u; nx = cnt > 0u ? cnt : 1u;
}
DI void xcd_barrier(const XcdBarrier& b) {
    asm volatile("s_waitcnt vmcnt(0)" ::: "memory");
    __syncthreads();
    if (threadIdx.x == 0) {
        unsigned* bar = b.bar;
        __builtin_amdgcn_s_waitcnt(0);
        unsigned nloc = b.st[0], nx = b.st[1];
        if (nloc == 0u) { xcd_barrier_complete(bar, b.x, nloc, nx); b.st[0] = nloc; b.st[1] = nx; }
        const unsigned old = xb_add(&bar[XB_XSUB(b.x)], 1u);
        const unsigned gen = old / nloc;
        if (old + 1u == (gen + 1u) * nloc) {
            __builtin_amdgcn_fence(__ATOMIC_RELEASE, "agent");
            asm volatile("s_waitcnt vmcnt(0)" ::: "memory");
            const unsigned og = xb_add(&bar[XB_TOP], 1u);
            const unsigned tg = og / nx;
            if (og + 1u == (tg + 1u) * nx) xb_add(&bar[XB_TOPGEN], 1u);
            else XB_SPIN(xb_ld(&bar[XB_TOPGEN]) == tg, bar);
            __builtin_amdgcn_fence(__ATOMIC_ACQUIRE, "agent");
            xb_add(&bar[XB_XGEN(b.x)], 1u);
            asm volatile("s_waitcnt vmcnt(0)" ::: "memory");
        } else {
            XB_SPIN(xb_ld(&bar[XB_XGEN(b.x)]) == gen, bar);
            __builtin_amdgcn_fence(__ATOMIC_ACQUIRE, "agent");
            asm volatile("s_waitcnt vmcnt(0)" ::: "memory");
        }
    }
    __syncthreads();
}

__global__ void __launch_bounds__(512, 2) mk_fwd(Params p, int ph_lo, int ph_hi) {
    extern __shared__ __attribute__((aligned(16))) unsigned char shm[];
    LAS unsigned char* lds = (LAS unsigned char*)shm;
    cg::grid_group grid = cg::this_grid();
    unsigned char* ws = p.ws;
    const int G = gridDim.x, c = blockIdx.x;
    volatile LAS unsigned* xst = (volatile LAS unsigned*)(lds + LDS_BYTES - 16);
    if (threadIdx.x == 0) { xst[0] = 0u; xst[1] = 0u; }
    __syncthreads();
    XcdBarrier xbar; xbar.bar = (unsigned*)(ws + WS_BAR); xbar.x = 0u; xbar.st = xst;
    if (ph_hi - ph_lo > 1) xbar = xcd_barrier_post((unsigned*)(ws + WS_BAR), xst);
    if (ph_lo > 1000) grid.sync();
#ifndef PHMASK
#define PHMASK 0xFFFF
#endif
#define GSYNC() xcd_barrier(xbar)
#ifndef REP_MASK
#define REP_MASK 0
#endif
#define PHASE(i, ...) if constexpr ((PHMASK >> (i)) & 1) if (ph_lo <= (i) && (i) < ph_hi) { __VA_ARGS__; if constexpr ((REP_MASK >> (i)) & 1) { __syncthreads(); __VA_ARGS__; } if ((i) + 1 < ph_hi) GSYNC(); }
    PHASE(0, ph_prep(p, lds));
    PHASE(1, ph_norm0(p, lds));
    PHASE(2, { GemmD g{(const bf16_t*)p.out, (const bf16_t*)(ws + WS_WINE), 1024, 1024, 0, 0, 1024}; Sched S{128, 28, 1, 8, 12, 128, G, c};
               EpiPlanes E{(bf16_t*)ws, (bf16_t*)(ws + WS_CRAW)}; gemm_phase(lds, g, S, E); });
    PHASE(3, ph_conv(p));
    PHASE(4, ph_mlstm(p, lds));
    PHASE(5, { GemmD g{(const bf16_t*)(ws + 5 * PLANE), (const bf16_t*)(ws + WS_WF), 1024, 256, 256, 512 * 256, 256}; Sched S{128, 2, 4, 0, 0, 0, G, c};
               EpiBf E{(bf16_t*)p.out, nullptr, 2048, 512, 0, nullptr, nullptr}; gemm_phase(lds, g, S, E); });
    PHASE(6, { CfgDft1 cf{(const bf16_t*)p.out, (bf16_t*)(ws + 2 * PLANE), (bf16_t*)(ws + 5 * PLANE)}; axis_mix<128, 128>(cf, lds, 2048); });
    PHASE(7, { CfgDft2 cf{(const bf16_t*)(ws + 2 * PLANE), (const bf16_t*)(ws + 5 * PLANE), (const bf16_t*)(ws + 6 * PLANE), (bf16_t*)p.out}; axis_mix<128, 64>(cf, lds, 2048); ph_ya(p); });
    PHASE(8, { GemmD g{(const bf16_t*)p.out, (const bf16_t*)(ws + WS_WOUTE), 2048, 2048, 0, 0, 2048}; Sched S{128, 4, 1, 0, 0, 0, G, c};
               EpiRes E{(float*)ws, p.x, (const float*)(ws + WS_MOD) + 2048}; gemm_phase(lds, g, S, E); });
    PHASE(9, ph_norm1(p, 0));
    PHASE(10, { GemmD g{(const bf16_t*)(ws + 2 * PLANE), (const bf16_t*)(ws + WS_WINO), 1024, 1024, 0, 0, 1024}; Sched S{128, 16, 1, 0, 0, 0, G, c};
                EpiBf E{(bf16_t*)(ws + 3 * PLANE), (bf16_t*)(ws + 5 * PLANE), 2048, 0, 1, nullptr, nullptr}; gemm_phase(lds, g, S, E); });
    PHASE(11, { CfgPoolA cf{(const bf16_t*)(ws + 3 * PLANE), (bf16_t*)p.out}; axis_mix<64, 64>(cf, lds, 4096); });
    PHASE(12, { CfgPoolB cf{(const bf16_t*)p.out, (bf16_t*)(ws + 3 * PLANE)}; axis_mix<64, 64>(cf, lds, 4096); });
    PHASE(13, { GemmD g{(const bf16_t*)(ws + 3 * PLANE), (const bf16_t*)(ws + WS_WPOOL), 2048, 512, 512, 512 * 512, 512}; Sched S{128, 2, 4, 0, 0, 0, G, c};
                EpiBf E{(bf16_t*)p.out, nullptr, 2048, 512, 2, p.pool_scale, (const bf16_t*)(ws + 5 * PLANE)}; gemm_phase(lds, g, S, E); });
    PHASE(14, { GemmD g{(const bf16_t*)p.out, (const bf16_t*)(ws + WS_WOUTO), 2048, 2048, 0, 0, 2048}; Sched S{128, 4, 1, 0, 0, 0, G, c};
                EpiRes E{(float*)ws, (const float*)ws, (const float*)(ws + WS_MOD) + 9 * 3072 + 2048}; gemm_phase(lds, g, S, E); });
    PHASE(15, ph_norm1(p, 1));
#undef PHASE
#ifdef XSYNC
    for (int k = 0; k < XSYNC; ++k) GSYNC();
#endif
#ifdef DBG_STOP
    GSYNC();
    {   const size_t n = (size_t)NX * 1024; unsigned* o32 = (unsigned*)p.out;
        for (size_t i = (size_t)blockIdx.x * 512 + threadIdx.x; i < n; i += (size_t)gridDim.x * 512) {
            float v = 0.f;
            if (DBG_PLANES == -1) { const unsigned u = o32[i]; v = lo_f(u) + hi_f(u); }
            else if (DBG_PLANES == -2) { v = ((const float*)p.ws)[i]; }
            else { for (int pl = 0; pl < 7; ++pl) if ((DBG_PLANES >> pl) & 1) v += bf2f(((const bf16_t*)(p.ws + pl * PLANE))[i]); }
            if (!(fabsf(v) < 1e30f)) v = 12345.f;
            p.out[i] = v; } }
#endif
}

extern "C" void kernel_launch(void* const* d_in, const int* in_sizes, int n_in, void* d_out, int out_size, void* d_ws, size_t ws_size, hipStream_t stream) {
    static int grid = 0;
    if (grid == 0) {
        int dev = 0, cus = 0, per_cu = 0;
        hipGetDevice(&dev);
        hipDeviceGetAttribute(&cus, hipDeviceAttributeMultiprocessorCount, dev);
        if (hipFuncSetAttribute((const void*)mk_fwd, hipFuncAttributeMaxDynamicSharedMemorySize, LDS_BYTES) != hipSuccess) fprintf(stderr, "hipFuncSetAttribute failed\n");
        if (hipOccupancyMaxActiveBlocksPerMultiprocessor(&per_cu, (const void*)mk_fwd, 512, LDS_BYTES) != hipSuccess || per_cu < 1) { fprintf(stderr, "occupancy query: %d\n", per_cu); per_cu = 1; }
        (void)hipGetLastError();
        grid = cus * per_cu; if (grid > 256) grid = 256; if (grid < 1) grid = 1;
        if (ws_size < WS_END) fprintf(stderr, "workspace too small: %zu < %zu\n", ws_size, (size_t)WS_END);
    }
    Params p{};
    p.x = (const float*)d_in[0]; p.c = (const float*)d_in[1]; p.ctx = (const float*)d_in[2]; p.c_ctx = (const float*)d_in[3]; p.ada_w = (const float*)d_in[4]; p.ada_b = (const float*)d_in[5];
    p.norm_g = (const float*)d_in[6]; p.win_even = (const float*)d_in[7]; p.gate_b = (const float*)d_in[8]; p.conv_qk = (const float*)d_in[9]; p.head_norm = (const float*)d_in[10];
    p.fourier_w = (const float*)d_in[11]; p.wout_even = (const float*)d_in[12]; p.win_odd = (const float*)d_in[13]; p.pool_w = (const float*)d_in[14]; p.pool_scale = (const float*)d_in[15];
    p.wout_odd = (const float*)d_in[16]; p.final_g = (const float*)d_in[17]; p.out = (float*)d_out; p.ws = (unsigned char*)d_ws;
    (void)hipMemsetAsync((unsigned char*)d_ws + WS_BAR, 0, XCD_BAR_WORDS * 4, stream);
#if MK_MULTI
    for (int ph = 0; ph < 16; ++ph) { hipLaunchKernelGGL(mk_fwd, dim3(grid), dim3(512), LDS_BYTES, stream, p, ph, ph + 1); }
#else
#ifdef DBG_STOP
    int lo = 0, hi = DBG_STOP;
#else
    int lo = 0, hi = 16;
#endif
    void* args[] = {&p, &lo, &hi};
    hipError_t e = hipLaunchCooperativeKernel((void*)mk_fwd, dim3(grid), dim3(512), args, LDS_BYTES, stream);
    if (e != hipSuccess) fprintf(stderr, "cooperative launch failed: %s (grid %d)\n", hipGetErrorString(e), grid);
#endif
}
```

```cpp
#include <hip/hip_runtime.h>
#include <hip/hip_cooperative_groups.h>
#include <cstdio>
namespace cg = cooperative_groups;

#ifndef MK_MULTI
#define MK_MULTI 0
#endif

#define LAS __attribute__((address_space(3)))
typedef unsigned short bf16_t;
typedef short bf16x8 __attribute__((ext_vector_type(8)));
typedef short s16x4 __attribute__((ext_vector_type(4)));
typedef float f32x4 __attribute__((ext_vector_type(4)));
typedef unsigned u32x4 __attribute__((ext_vector_type(4)));
typedef unsigned u32x2 __attribute__((ext_vector_type(2)));

constexpr int NX = 32768, NCX = 2048, NR = NX + NCX;
constexpr size_t PLANE = (size_t)NX * 1024 * 2;
constexpr size_t WS_EXTRA = 7 * PLANE;
constexpr size_t WS_WINE  = WS_EXTRA;
constexpr size_t WS_WOUTE = WS_WINE  + (size_t)7168 * 1024 * 2;
constexpr size_t WS_WINO  = WS_WOUTE + (size_t)1024 * 2048 * 2;
constexpr size_t WS_WPOOL = WS_WINO  + (size_t)4096 * 1024 * 2;
constexpr size_t WS_WOUTO = WS_WPOOL + (size_t)4 * 512 * 512 * 2;
constexpr size_t WS_WF    = WS_WOUTO + (size_t)1024 * 2048 * 2;
constexpr size_t WS_MOD   = WS_WF    + (size_t)4 * 512 * 256 * 2;
constexpr size_t WS_GATES = WS_MOD   + 262144;
constexpr size_t WS_CRAW  = WS_GATES + (size_t)NR * 16 * 4;
constexpr size_t WS_CQC   = WS_CRAW  + (size_t)3 * NCX * 1024 * 2;
constexpr size_t WS_CKC   = WS_CQC   + (size_t)NCX * 1024 * 2;
constexpr size_t WS_END   = WS_CKC   + (size_t)NCX * 1024 * 2;
constexpr size_t WS_GPRE  = WS_END + 16384;
constexpr size_t WS_GPRE_END = WS_GPRE + (size_t)64 * 68 * 384 * 4;
static_assert(WS_GPRE_END <= (size_t)512 * 1024 * 1024, "gate tables exceed the workspace");
constexpr size_t WS_BAR   = WS_END;
static_assert(WS_BAR + 16384 <= (size_t)512 * 1024 * 1024, "workspace map exceeds 512 MiB");

constexpr int LDS_BYTES = 155648;

struct Params {
    const float* x; const float* c; const float* ctx; const float* c_ctx; const float* ada_w; const float* ada_b; const float* norm_g;
    const float* win_even; const float* gate_b; const float* conv_qk; const float* head_norm; const float* fourier_w; const float* wout_even;
    const float* win_odd; const float* pool_w; const float* pool_scale; const float* wout_odd; const float* final_g;
    float* out; unsigned char* ws;
};

#define DI __device__ __forceinline__
DI float bf2f(unsigned short b) { return __uint_as_float(((unsigned)b) << 16); }
DI float lo_f(unsigned u) { return __uint_as_float(u << 16); }
DI float hi_f(unsigned u) { return __uint_as_float(u & 0xffff0000u); }
typedef __bf16 bf16v2_t __attribute__((ext_vector_type(2)));
typedef float f32v2_t __attribute__((ext_vector_type(2)));
DI unsigned pk2(float lo, float hi) { const f32v2_t v = {lo, hi}; const bf16v2_t b = __builtin_convertvector(v, bf16v2_t); return __builtin_bit_cast(unsigned, b); }
DI float silu_f(float x) { return x / (1.0f + __expf(-x)); }
DI float sigmoid_f(float x) { return 1.0f / (1.0f + __expf(-x)); }
DI int opaque_tid() { int t = threadIdx.x; asm volatile("" : "+v"(t)); return t; }
DI float wave_sum(float v) { for (int o = 32; o > 0; o >>= 1) v += __shfl_xor(v, o); return v; }
DI float wave_max(float v) { for (int o = 32; o > 0; o >>= 1) v = fmaxf(v, __shfl_xor(v, o)); return v; }
DI f32x4 mfma16(bf16x8 a, bf16x8 b, f32x4 c) { return __builtin_amdgcn_mfma_f32_16x16x32_bf16(a, b, c, 0, 0, 0); }
DI bf16x8 tr_frag(LAS unsigned char* img, int pitch, int krow0, int col0, int lane) {
    const int g = lane >> 4, q = (lane & 15) >> 2, pp = lane & 3;
    LAS unsigned char* a0 = img + (krow0 + 8 * g + q) * pitch + col0 * 2 + 8 * pp;
    s16x4 lo = __builtin_amdgcn_ds_read_tr16_b64_v4i16((LAS s16x4*)a0);
    s16x4 hi = __builtin_amdgcn_ds_read_tr16_b64_v4i16((LAS s16x4*)(a0 + 4 * pitch));
    return __builtin_shufflevector(lo, hi, 0, 1, 2, 3, 4, 5, 6, 7);
}

constexpr int HTB = 128 * 64 * 2;
DI int lds_byte(int r, int c) { const int st = (r >> 4) * 2 + (c >> 5), rr = r & 15, cc = c & 31, ob = rr * 64 + cc * 2; return st * 1024 + (ob ^ (((ob >> 9) & 1) << 5)); }
DI void stage_rc(int b, int& R, int& C) { const int st = b / 1024, sb = b % 1024, swz = sb ^ (((sb >> 9) & 1) << 5); R = (st >> 1) * 16 + swz / 64; C = (st & 1) * 32 + (swz % 64) / 2; }
DI int perm32(int rho) { const int n = rho >> 4, i = rho & 15; return 8 * (i >> 2) + 4 * n + (i & 3); }

struct Unit { int pm, pn, g; };
struct GemmD { const bf16_t* A; const bf16_t* Bt; int lda, ldb; long a_gs, b_gs; int K; };
struct Sched {
    int nM, nN, nG, nM2, nN2, pm2off, G, c;
    DI bool next(int i, Unit& u) const {
        const int L = i * G + c; const int nwg = nM * nN, tot1 = nwg * nG;
        const bool first = L < tot1;
        const int L1 = first ? L : 0;
        const int g = L1 / nwg; int wgid = L1 - g * nwg;
        { const int q = nwg / 8, r = nwg % 8, xcd = wgid % 8, off = wgid / 8; wgid = (xcd < r ? xcd * (q + 1) : r * (q + 1) + (xcd - r) * q) + off; }
        const int nig = 8 * nN, gid = wgid / nig, fm = gid * 8, gsz = (nM - fm) < 8 ? (nM - fm) : 8;
        const int pm1 = fm + ((wgid % nig) % gsz), pn1 = (wgid % nig) / gsz;
        const int L2 = first ? 0 : L - tot1, d2 = nM2 > 0 ? nM2 : 1;
        const int pm2 = pm2off + L2 % d2, pn2 = L2 / d2;
        u.pm = first ? pm1 : pm2; u.pn = first ? pn1 : pn2; u.g = first ? g : 0;
        return first || (L2 < nM2 * nN2);
    }
};

template <class Epi>
DI void gemm_phase(LAS unsigned char* lds, const GemmD g, const Sched& S, const Epi& E) {
    const int tid = opaque_tid(), wid = __builtin_amdgcn_readfirstlane(tid >> 6), lane = tid & 63, wr = wid >> 2, wc = wid & 3, fr = lane & 15, fq = lane >> 4;
    const int K = g.K, nt = K / 64;
    unsigned voffA[2], voffB[2];
#pragma unroll
    for (int i = 0; i < 2; ++i) { int R, C; stage_rc(tid * 16 + i * 8192, R, C); const int Rb = Epi::PERM ? ((R & ~31) + perm32(R & 31)) : R;
        voffA[i] = (unsigned)(R * g.lda + C) * 2u; voffB[i] = (unsigned)(Rb * g.ldb + C) * 2u; }
    const size_t kstep = 128;
    const size_t hstepA = (size_t)128 * g.lda * 2, hstepB = (size_t)128 * g.ldb * 2;
    const unsigned ldsw = (unsigned)wid * 1024u;
    const int aoff = lds_byte(wr * 64 + fr, fq * 8), boff = lds_byte(wc * 32 + fr, fq * 8);
#define G_SA(b, h) (((b) * 2 + (h)) * HTB)
#define G_SB(b, h) ((4 + (b) * 2 + (h)) * HTB)
#define G_STAGE(bufoff, gbase, voff) do { _Pragma("unroll") for (int _i = 0; _i < 2; ++_i) \
        __builtin_amdgcn_global_load_lds((const unsigned*)((const char*)(gbase) + (voff)[_i]), (LAS unsigned*)(lds + (bufoff) + ldsw + _i * 8192), 16, 0, 0); } while (0)
#define G_LDA(dst, b, h) do { _Pragma("unroll") for (int m = 0; m < 4; ++m) _Pragma("unroll") for (int k = 0; k < 2; ++k) dst[m][k] = *(const LAS bf16x8*)(lds + G_SA(b, h) + aoff + m * 2048 + k * 1024); } while (0)
#define G_LDB(dst, b, h) do { _Pragma("unroll") for (int n = 0; n < 2; ++n) _Pragma("unroll") for (int k = 0; k < 2; ++k) dst[n][k] = *(const LAS bf16x8*)(lds + G_SB(b, h) + boff + n * 2048 + k * 1024); } while (0)
#define G_MMA(ai, bj, At, Bt) do { __builtin_amdgcn_s_setprio(1); _Pragma("unroll") for (int m = 0; m < 4; ++m) _Pragma("unroll") for (int n = 0; n < 2; ++n) _Pragma("unroll") for (int k = 0; k < 2; ++k) \
        acc[ai][bj][m][n] = __builtin_amdgcn_mfma_f32_16x16x32_bf16(Bt[n][k], At[m][k], acc[ai][bj][m][n], 0, 0, 0); __builtin_amdgcn_s_setprio(0); } while (0)
#define G_WAIT_V(n) asm volatile("s_waitcnt vmcnt(" #n ")" ::: "memory")
#define G_WAIT_L(n) asm volatile("s_waitcnt lgkmcnt(" #n ")" ::: "memory")
#define G_BAR __builtin_amdgcn_s_barrier()
#define G_SCHED __builtin_amdgcn_sched_barrier(0)
    Unit cur, nxt; int ui = 0;
    if (!S.next(0, cur)) return;
    f32x4 acc[2][2][4][2];
#pragma unroll
    for (int a = 0; a < 2; ++a)
#pragma unroll
        for (int b = 0; b < 2; ++b)
#pragma unroll
            for (int m = 0; m < 4; ++m)
#pragma unroll
                for (int n = 0; n < 2; ++n) acc[a][b][m][n] = (f32x4){0.f, 0.f, 0.f, 0.f};
    bf16x8 At[4][2], B0[2][2], B1[2][2];
    const char* cA = (const char*)(g.A + (long)cur.g * g.a_gs) + (size_t)cur.pm * 2 * hstepA;
    const char* cB = (const char*)(g.Bt + (long)cur.g * g.b_gs) + (size_t)cur.pn * 2 * hstepB;
    G_STAGE(G_SB(0, 0), cB, voffB); G_STAGE(G_SA(0, 0), cA, voffA); G_STAGE(G_SB(0, 1), cB + hstepB, voffB); G_STAGE(G_SA(0, 1), cA + hstepA, voffA);
    if (wr == 1) G_BAR;
    G_WAIT_V(4); G_BAR;
    G_STAGE(G_SB(1, 0), cB + kstep, voffB); G_STAGE(G_SA(1, 0), cA + kstep, voffA); G_STAGE(G_SB(1, 1), cB + hstepB + kstep, voffB);
    G_WAIT_V(6); G_BAR;
    for (;;) {
        const bool has_next = S.next(ui + 1, nxt);
        const char* nA = has_next ? (const char*)(g.A + (long)nxt.g * g.a_gs) + (size_t)nxt.pm * 2 * hstepA : cA;
        const char* nB = has_next ? (const char*)(g.Bt + (long)nxt.g * g.b_gs) + (size_t)nxt.pn * 2 * hstepB : cB;
        for (int t = 0; t < nt; t += 2) {
            const bool last = (t == nt - 2);
            const char* a1 = cA + (size_t)(t + 1) * kstep;
            const char* a2 = last ? nA : cA + (size_t)(t + 2) * kstep; const char* b2 = last ? nB : cB + (size_t)(t + 2) * kstep;
            const char* a3 = a2 + kstep; const char* b3 = b2 + kstep;
            G_LDB(B0, 0, 0); G_SCHED; G_LDA(At, 0, 0); G_STAGE(G_SA(1, 1), a1 + hstepA, voffA);
            G_WAIT_L(8); G_BAR; G_WAIT_L(0); G_MMA(0, 0, At, B0); G_BAR; G_SCHED;
            G_LDB(B1, 0, 1); G_STAGE(G_SB(0, 0), b2, voffB);
            G_BAR; G_WAIT_L(0); G_MMA(0, 1, At, B1); G_BAR;
            G_LDA(At, 0, 1); G_STAGE(G_SA(0, 0), a2, voffA);
            G_BAR; G_WAIT_L(0); G_MMA(1, 0, At, B0); G_BAR; G_SCHED;
            G_STAGE(G_SB(0, 1), b2 + hstepB, voffB);
            G_WAIT_V(6); G_BAR; G_MMA(1, 1, At, B1); G_BAR;
            G_LDB(B0, 1, 0); G_SCHED; G_LDA(At, 1, 0); G_STAGE(G_SA(0, 1), a2 + hstepA, voffA);
            G_WAIT_L(8); G_BAR; G_WAIT_L(0); G_MMA(0, 0, At, B0); G_BAR; G_SCHED;
            G_LDB(B1, 1, 1); G_STAGE(G_SB(1, 0), b3, voffB);
            G_BAR; G_WAIT_L(0); G_MMA(0, 1, At, B1); G_BAR;
            G_LDA(At, 1, 1); G_STAGE(G_SA(1, 0), a3, voffA);
            G_BAR; G_WAIT_L(0); G_MMA(1, 0, At, B0); G_BAR; G_SCHED;
            G_STAGE(G_SB(1, 1), b3 + hstepB, voffB);
            G_WAIT_V(6); G_BAR; G_MMA(1, 1, At, B1); G_BAR;
        }
        E(acc, cur, wr, wc, fr, fq);
        if (!has_next) break;
#pragma unroll
        for (int a = 0; a < 2; ++a)
#pragma unroll
            for (int b = 0; b < 2; ++b)
#pragma unroll
                for (int m = 0; m < 4; ++m)
#pragma unroll
                    for (int n = 0; n < 2; ++n) acc[a][b][m][n] = (f32x4){0.f, 0.f, 0.f, 0.f};
        cur = nxt; cA = nA; cB = nB; ++ui;
    }
    G_WAIT_V(0);
    if (wr == 0) G_BAR;
    G_BAR;
}

struct EpiPlanes {
    static constexpr bool PERM = true;
    bf16_t* xbase; bf16_t* cbase;
    DI void operator()(const f32x4 (&acc)[2][2][4][2], const Unit& u, int wr, int wc, int fr, int fq) const {
        const int plane = u.pn >> 2, colt = (u.pn & 3) * 256;
        bf16_t* base; int row0;
        if (u.pm < 128) { base = xbase + (size_t)plane * NX * 1024; row0 = u.pm * 256 + wr * 64 + fr; }
        else { base = cbase + (size_t)plane * NCX * 1024; row0 = (u.pm - 128) * 256 + wr * 64 + fr; }
        const int col0 = colt + wc * 32 + 8 * fq;
#pragma unroll
        for (int ai = 0; ai < 2; ++ai)
#pragma unroll
            for (int m = 0; m < 4; ++m) { bf16_t* rowp = base + (size_t)(row0 + ai * 128 + m * 16) * 1024 + col0;
#pragma unroll
                for (int bj = 0; bj < 2; ++bj) { const f32x4 v0 = acc[ai][bj][m][0], v1 = acc[ai][bj][m][1];
                    u32x4 w; w.x = pk2(v0[0], v0[1]); w.y = pk2(v0[2], v0[3]); w.z = pk2(v1[0], v1[1]); w.w = pk2(v1[2], v1[3]);
                    *(u32x4*)(rowp + bj * 128) = w; } }
    }
};
struct EpiBf {
    static constexpr bool PERM = true;
    bf16_t* O; bf16_t* O2; int ldc; int gcol; int mode; const float* scale; const bf16_t* zc;
    DI void operator()(const f32x4 (&acc)[2][2][4][2], const Unit& u, int wr, int wc, int fr, int fq) const {
        const int row0 = u.pm * 256 + wr * 64 + fr;
        bf16_t* base = O; int pn = u.pn; bool act = false;
        if (mode == 1 && pn >= 8) { base = O2; pn -= 8; act = true; }
        const int col0 = u.g * gcol + pn * 256 + wc * 32 + 8 * fq;
        f32x4 sc[2][2];
#pragma unroll
        for (int bj = 0; bj < 2; ++bj) { sc[bj][0] = (mode == 2) ? *(const f32x4*)(scale + col0 + bj * 128) : (f32x4){1.f, 1.f, 1.f, 1.f}; sc[bj][1] = (mode == 2) ? *(const f32x4*)(scale + col0 + bj * 128 + 4) : (f32x4){1.f, 1.f, 1.f, 1.f}; }
#pragma unroll
        for (int ai = 0; ai < 2; ++ai) {
            u32x4 zz[4][2];
            if (mode == 2) {
#pragma unroll
                for (int m = 0; m < 4; ++m)
#pragma unroll
                    for (int bj = 0; bj < 2; ++bj) zz[m][bj] = *(const volatile u32x4*)(zc + (size_t)(row0 + ai * 128 + m * 16) * ldc + col0 + bj * 128); }
#pragma unroll
            for (int m = 0; m < 4; ++m) { const size_t ro = (size_t)(row0 + ai * 128 + m * 16) * ldc + col0;
#pragma unroll
                for (int bj = 0; bj < 2; ++bj) { f32x4 v0 = acc[ai][bj][m][0], v1 = acc[ai][bj][m][1];
                    if (act) {
#pragma unroll
                        for (int j = 0; j < 4; ++j) { v0[j] = silu_f(v0[j]); v1[j] = silu_f(v1[j]); } }
                    if (mode == 2) {
                        const u32x4 z = zz[m][bj]; const f32x4 s0 = sc[bj][0], s1 = sc[bj][1];
                        v0[0] *= s0[0] * lo_f(z.x); v0[1] *= s0[1] * hi_f(z.x); v0[2] *= s0[2] * lo_f(z.y); v0[3] *= s0[3] * hi_f(z.y);
                        v1[0] *= s1[0] * lo_f(z.z); v1[1] *= s1[1] * hi_f(z.z); v1[2] *= s1[2] * lo_f(z.w); v1[3] *= s1[3] * hi_f(z.w);
                    }
                    u32x4 w; w.x = pk2(v0[0], v0[1]); w.y = pk2(v0[2], v0[3]); w.z = pk2(v1[0], v1[1]); w.w = pk2(v1[2], v1[3]);
                    *(u32x4*)(base + ro + bj * 128) = w; } } }
    }
};
struct EpiRes {
    static constexpr bool PERM = false;
    float* O; const float* res; const float* gate;
    DI void operator()(const f32x4 (&acc)[2][2][4][2], const Unit& u, int wr, int wc, int fr, int fq) const {
        const int row0 = u.pm * 256 + wr * 64 + fr, col0 = u.pn * 256 + wc * 32 + 4 * fq;
        const float* gp = gate + (size_t)(u.pm >> 4) * 3072 + col0;
        f32x4 gv[2][2];
#pragma unroll
        for (int bj = 0; bj < 2; ++bj)
#pragma unroll
            for (int n = 0; n < 2; ++n) gv[bj][n] = *(const f32x4*)(gp + bj * 128 + n * 16);
#pragma unroll
        for (int ai = 0; ai < 2; ++ai)
#pragma unroll
            for (int mp = 0; mp < 2; ++mp) {
                f32x4 r[2][2][2];
#pragma unroll
                for (int mm = 0; mm < 2; ++mm) { const size_t ro = (size_t)(row0 + ai * 128 + (2 * mp + mm) * 16) * 1024 + col0;
#pragma unroll
                    for (int bj = 0; bj < 2; ++bj)
#pragma unroll
                        for (int n = 0; n < 2; ++n) r[mm][bj][n] = *(const volatile f32x4*)(res + ro + bj * 128 + n * 16); }
#pragma unroll
                for (int mm = 0; mm < 2; ++mm) { const size_t ro = (size_t)(row0 + ai * 128 + (2 * mp + mm) * 16) * 1024 + col0;
#pragma unroll
                    for (int bj = 0; bj < 2; ++bj)
#pragma unroll
                        for (int n = 0; n < 2; ++n) *(f32x4*)(O + ro + bj * 128 + n * 16) = r[mm][bj][n] + gv[bj][n] * acc[ai][bj][2 * mp + mm][n]; }
            }
    }
};

DI void ph_prep(const Params& p, LAS unsigned char* lds) {
    const int tid = opaque_tid();
    LAS float* tile = (LAS float*)lds;
    {
        auto job_desc = [&](int job, const float*& src, bf16_t*& dst, int& K, int& Nt, int& k0, int& n0) {
            int j = job, tk, tn;
            if (j < 1792) { src = p.win_even; dst = (bf16_t*)(p.ws + WS_WINE); K = 1024; Nt = 7184; tk = j & 15; tn = j >> 4; }
            else if ((j -= 1792) < 512) { src = p.wout_even; dst = (bf16_t*)(p.ws + WS_WOUTE); K = 2048; Nt = 1024; tk = j & 31; tn = j >> 5; }
            else if ((j -= 512) < 1024) { src = p.win_odd; dst = (bf16_t*)(p.ws + WS_WINO); K = 1024; Nt = 4096; tk = j & 15; tn = j >> 4; }
            else if ((j -= 1024) < 256) { const int g = j >> 6, jj = j & 63; src = p.pool_w + (size_t)g * 512 * 512; dst = (bf16_t*)(p.ws + WS_WPOOL) + (size_t)g * 512 * 512; K = 512; Nt = 512; tk = jj & 7; tn = jj >> 3; }
            else { j -= 256; src = p.wout_odd; dst = (bf16_t*)(p.ws + WS_WOUTO); K = 2048; Nt = 1024; tk = j & 31; tn = j >> 5; }
            k0 = tk * 64; n0 = tn * 64; };
        float rg[8];
        int job = blockIdx.x;
        if (job < 4096) { const float* src; bf16_t* dst; int K, Nt, k0, n0; job_desc(job, src, dst, K, Nt, k0, n0);
#pragma unroll
            for (int i = 0; i < 8; ++i) { const int idx = tid + 512 * i, k = idx >> 6, n = idx & 63; rg[i] = src[(size_t)(k0 + k) * Nt + n0 + n]; } }
        for (; job < 4096; job += gridDim.x) {
            const float* src; bf16_t* dst; int K, Nt, k0, n0; job_desc(job, src, dst, K, Nt, k0, n0);
            __syncthreads();
#pragma unroll
            for (int i = 0; i < 8; ++i) { const int idx = tid + 512 * i, k = idx >> 6, n = idx & 63; tile[k * 65 + n] = rg[i]; }
            __syncthreads();
            const int nj = job + gridDim.x;
            if (nj < 4096) { const float* s2; bf16_t* d2; int K2, Nt2, k2, n2; job_desc(nj, s2, d2, K2, Nt2, k2, n2);
#pragma unroll
                for (int i = 0; i < 8; ++i) { const int idx = tid + 512 * i, k = idx >> 6, n = idx & 63; rg[i] = s2[(size_t)(k2 + k) * Nt2 + n2 + n]; } }
#pragma unroll
            for (int i = 0; i < 4; ++i) { const int idx = tid + 512 * i, n = idx >> 5, k = (idx & 31) * 2;
                *(unsigned*)(dst + (size_t)(n0 + n) * K + k0 + k) = pk2(tile[k * 65 + n], tile[(k + 1) * 65 + n]); }
        }
        __syncthreads();
    }
    LAS float* sv = (LAS float*)(lds + 32768);
    LAS float* red = (LAS float*)(lds + 32768 + 36864);
    LAS float* ct = (LAS float*)(lds + 90112); LAS float* st = ct + 256;
    for (int idx = tid; idx < 9216; idx += 512) { const int v = idx >> 10, k = idx & 1023; const float cv = (v < 8) ? p.c[v * 1024 + k] : p.c_ctx[k]; sv[idx] = silu_f(cv); }
    if (tid < 256) { float s, c; sincospif((float)tid / 128.0f, &s, &c); ct[tid] = c; st[tid] = s; }
    __syncthreads();
    float* MOD = (float*)(p.ws + WS_MOD);
    for (int item = blockIdx.x; item < 192; item += gridDim.x) {
        const int l = item / 96, c0 = (item % 96) * 32, kg = tid >> 5, col = tid & 31;
        float a[9];
#pragma unroll
        for (int v = 0; v < 9; ++v) a[v] = 0.f;
        const float* w = p.ada_w + (size_t)l * 1024 * 3072 + c0 + col;
#pragma unroll 16
        for (int k = kg; k < 1024; k += 16) { const float wv = w[(size_t)k * 3072];
#pragma unroll
            for (int v = 0; v < 9; ++v) a[v] += sv[v * 1024 + k] * wv; }
#pragma unroll
        for (int v = 0; v < 9; ++v) red[(kg * 32 + col) * 9 + v] = a[v];
        __syncthreads();
        if (tid < 288) { const int v = tid >> 5, cc = tid & 31; float s = 0.f; for (int q = 0; q < 16; ++q) s += red[(q * 32 + cc) * 9 + v];
            MOD[(size_t)(l * 9 + v) * 3072 + c0 + cc] = s + p.ada_b[l * 3072 + c0 + cc]; }
        __syncthreads();
    }
    bf16_t* WF = (bf16_t*)(p.ws + WS_WF);
    for (int it = blockIdx.x; it < 512; it += gridDim.x) {
        const int idx = it * 512 + tid, d = idx & 255, c = (idx >> 8) & 255, g = idx >> 16;
        const float* f = p.fourier_w + (size_t)g * 65536 + d;
        float aP = 0.f, aQ = 0.f;
#pragma unroll 16
        for (int cp = 0; cp < 256; ++cp) { const float fv = f[cp * 256]; const int a = (c * cp) & 255; aP += ct[a] * fv; aQ += st[a] * fv; }
        WF[(size_t)(g * 512 + d) * 256 + c] = (bf16_t)(pk2(aP * 0.0625f, 0.f) & 0xffffu);
        WF[(size_t)(g * 512 + 256 + d) * 256 + c] = (bf16_t)(pk2(-aQ * 0.0625f, 0.f) & 0xffffu);
    }
}

DI void ph_norm0(const Params& p, LAS unsigned char* lds) {
    const int tid = opaque_tid(), wid = tid >> 6, lane = tid & 63;
    LAS float* wg = (LAS float*)lds;
#pragma unroll 4
    for (int i = 0; i < 32; ++i) { const int idx = tid + 512 * i, k = idx >> 4, j = idx & 15; wg[j * 1024 + k] = p.win_even[(size_t)k * 7184 + 7168 + j]; }
    __syncthreads();
    f32x4 g[4];
#pragma unroll
    for (int i = 0; i < 4; ++i) g[i] = *(const f32x4*)(p.norm_g + lane * 4 + 256 * i);
    const float* MOD = (const float*)(p.ws + WS_MOD);
    bf16_t* HX = (bf16_t*)p.out;
    float* GATES = (float*)(p.ws + WS_GATES);
    f32x4 vn[4];
    { const int r = blockIdx.x * 8 + wid; if (r < NR) { const float* src = (r < NX) ? p.x + (size_t)r * 1024 : p.ctx + (size_t)(r - NX) * 1024;
#pragma unroll
        for (int i = 0; i < 4; ++i) vn[i] = *(const f32x4*)(src + lane * 4 + 256 * i); } }
    for (int r = blockIdx.x * 8 + wid; r < NR; r += gridDim.x * 8) {
        const float* md;
        if (r < NX) { md = MOD + (size_t)(r >> 12) * 3072; } else { md = MOD + (size_t)8 * 3072; }
        f32x4 v[4]; float ss = 0.f;
#pragma unroll
        for (int i = 0; i < 4; ++i) { v[i] = vn[i]; ss += v[i][0] * v[i][0] + v[i][1] * v[i][1] + v[i][2] * v[i][2] + v[i][3] * v[i][3]; }
        { const int r2 = r + gridDim.x * 8; if (r2 < NR) { const float* s2 = (r2 < NX) ? p.x + (size_t)r2 * 1024 : p.ctx + (size_t)(r2 - NX) * 1024;
#pragma unroll
            for (int i = 0; i < 4; ++i) vn[i] = *(const f32x4*)(s2 + lane * 4 + 256 * i); } }
        ss = wave_sum(ss);
        const float rstd = rsqrtf(ss * (1.0f / 1024.0f) + 1e-6f);
#pragma unroll
        for (int i = 0; i < 4; ++i) { const f32x4 sh = *(const f32x4*)(md + lane * 4 + 256 * i), sc = *(const f32x4*)(md + 1024 + lane * 4 + 256 * i);
            v[i] = v[i] * rstd * g[i] * (sc + 1.0f) + sh;
            u32x2 w; w.x = pk2(v[i][0], v[i][1]); w.y = pk2(v[i][2], v[i][3]);
            *(u32x2*)(HX + (size_t)r * 1024 + lane * 4 + 256 * i) = w; }
        float pt[16];
#pragma unroll
        for (int j = 0; j < 16; ++j) { float a = 0.f;
#pragma unroll
            for (int i = 0; i < 4; ++i) { const f32x4 w4 = *(const LAS f32x4*)(wg + j * 1024 + lane * 4 + 256 * i); a += v[i][0] * w4[0] + v[i][1] * w4[1] + v[i][2] * w4[2] + v[i][3] * w4[3]; }
            pt[j] = a; if ((j & 3) == 3) __builtin_amdgcn_sched_barrier(0); }
        { const bool b5 = lane & 32;
#pragma unroll
          for (int j = 0; j < 8; ++j) { const float snd = b5 ? pt[j] : pt[j + 8], kp = b5 ? pt[j + 8] : pt[j]; pt[j] = kp + __shfl_xor(snd, 32); } }
        { const bool b4 = lane & 16;
#pragma unroll
          for (int j = 0; j < 4; ++j) { const float snd = b4 ? pt[j] : pt[j + 4], kp = b4 ? pt[j + 4] : pt[j]; pt[j] = kp + __shfl_xor(snd, 16); } }
        { const bool b3 = lane & 8;
#pragma unroll
          for (int j = 0; j < 2; ++j) { const float snd = b3 ? pt[j] : pt[j + 2], kp = b3 ? pt[j + 2] : pt[j]; pt[j] = kp + __shfl_xor(snd, 8); } }
        { const bool b2 = lane & 4; const float snd = b2 ? pt[0] : pt[1], kp = b2 ? pt[1] : pt[0]; pt[0] = kp + __shfl_xor(snd, 4); }
        pt[0] += __shfl_xor(pt[0], 2); pt[0] += __shfl_xor(pt[0], 1);
        if ((lane & 3) == 0) { const int j = ((lane >> 5) & 1) * 8 + ((lane >> 4) & 1) * 4 + ((lane >> 3) & 1) * 2 + ((lane >> 2) & 1);
            float val = pt[0] + p.gate_b[j];
            if ((j >> 2) & 1) val = fminf(val, 0.f) - log1pf(__expf(-fabsf(val)));
            GATES[(size_t)r * 16 + j] = val; }
    }
}
DI void ph_norm1(const Params& p, int mode) {
    const int tid = opaque_tid(), wid = tid >> 6, lane = tid & 63;
    const float* gsrc = mode ? p.final_g : p.norm_g + 1024;
    f32x4 g[4];
#pragma unroll
    for (int i = 0; i < 4; ++i) g[i] = *(const f32x4*)(gsrc + lane * 4 + 256 * i);
    const float* MOD = (const float*)(p.ws + WS_MOD) + (size_t)9 * 3072;
    const float* X1 = (const float*)p.ws;
    bf16_t* HX1 = (bf16_t*)(p.ws + 2 * PLANE);
    f32x4 vn[4];
    { const int r = blockIdx.x * 8 + wid; if (r < NX) {
#pragma unroll
        for (int i = 0; i < 4; ++i) vn[i] = *(const f32x4*)(X1 + (size_t)r * 1024 + lane * 4 + 256 * i); } }
    for (int r = blockIdx.x * 8 + wid; r < NX; r += gridDim.x * 8) {
        const float* md = MOD + (size_t)(r >> 12) * 3072;
        f32x4 v[4]; float ss = 0.f;
#pragma unroll
        for (int i = 0; i < 4; ++i) { v[i] = vn[i]; ss += v[i][0] * v[i][0] + v[i][1] * v[i][1] + v[i][2] * v[i][2] + v[i][3] * v[i][3]; }
        { const int r2 = r + gridDim.x * 8; if (r2 < NX) {
#pragma unroll
            for (int i = 0; i < 4; ++i) vn[i] = *(const f32x4*)(X1 + (size_t)r2 * 1024 + lane * 4 + 256 * i); } }
        ss = wave_sum(ss);
        const float rstd = rsqrtf(ss * (1.0f / 1024.0f) + 1e-6f);
#pragma unroll
        for (int i = 0; i < 4; ++i) {
            if (mode) { *(f32x4*)(p.out + (size_t)r * 1024 + lane * 4 + 256 * i) = v[i] * rstd * g[i]; }
            else { const f32x4 sh = *(const f32x4*)(md + lane * 4 + 256 * i), sc = *(const f32x4*)(md + 1024 + lane * 4 + 256 * i);
                const f32x4 h = v[i] * rstd * g[i] * (sc + 1.0f) + sh;
                u32x2 w; w.x = pk2(h[0], h[1]); w.y = pk2(h[2], h[3]);
                *(u32x2*)(HX1 + (size_t)r * 1024 + lane * 4 + 256 * i) = w; } }
    }
}

DI void ph_conv(const Params& p) {
    const bf16_t* QRAW = (const bf16_t*)p.ws; const bf16_t* KRAW = (const bf16_t*)(p.ws + PLANE);
    const bf16_t* CQ = (const bf16_t*)(p.ws + WS_CRAW); const bf16_t* CK = CQ + (size_t)NCX * 1024;
    bf16_t* QC = (bf16_t*)p.out; bf16_t* KC = QC + (size_t)NX * 1024;
    bf16_t* CQC = (bf16_t*)(p.ws + WS_CQC); bf16_t* CKC = (bf16_t*)(p.ws + WS_CKC);
    const int tid = opaque_tid();
    const bool scanner = (blockIdx.x < 64) && (tid < 64) && (gridDim.x >= 64);
    const int nscan = gridDim.x >= 64 ? 64 : 0;
    const int active_id = (int)blockIdx.x < nscan ? (int)blockIdx.x * 448 + (tid - 64) : nscan * 448 + ((int)blockIdx.x - nscan) * 512 + tid;
    const int active_n = nscan * 448 + ((int)gridDim.x - nscan) * 512;
    if (!scanner)
    for (int idx = active_id; idx < (NR / 8) * 256; idx += active_n) {
        const int oct = idx & 127, which = (idx >> 7) & 1, r0 = (idx >> 8) * 8, ch = oct * 8;
        const bf16_t* src; bf16_t* dst; int t0, T;
        if (r0 < NX) { src = (which ? KRAW : QRAW) + (size_t)r0 * 1024 + ch; dst = (which ? KC : QC) + (size_t)r0 * 1024 + ch; t0 = r0 & 4095; T = 4096; }
        else { const int rr = r0 - NX; src = (which ? CK : CQ) + (size_t)rr * 1024 + ch; dst = (which ? CKC : CQC) + (size_t)rr * 1024 + ch; t0 = rr & 255; T = 256; }
        const u32x4 z = {0u, 0u, 0u, 0u};
        u32x4 v[10];
        v[0] = (t0 > 0) ? *(const u32x4*)(src - 1024) : z;
#pragma unroll
        for (int i = 0; i < 8; ++i) v[i + 1] = *(const u32x4*)(src + (size_t)i * 1024);
        v[9] = (t0 + 8 < T) ? *(const u32x4*)(src + (size_t)8 * 1024) : z;
        const float* w = p.conv_qk + which * 1024 + ch;
        float wt[3][8];
#pragma unroll
        for (int j = 0; j < 3; ++j) { const f32x4 wa = *(const f32x4*)(w + j * 2048), wb = *(const f32x4*)(w + j * 2048 + 4);
#pragma unroll
            for (int e = 0; e < 4; ++e) { wt[j][e] = wa[e]; wt[j][4 + e] = wb[e]; } }
        const float qs = which ? 1.0f : 0.0625f;
#pragma unroll
        for (int i = 0; i < 8; ++i) {
            float o[8];
#pragma unroll
            for (int e = 0; e < 4; ++e) {
                float lo = wt[0][2 * e] * lo_f(v[i][e]) + wt[1][2 * e] * lo_f(v[i + 1][e]) + wt[2][2 * e] * lo_f(v[i + 2][e]);
                float hi = wt[0][2 * e + 1] * hi_f(v[i][e]) + wt[1][2 * e + 1] * hi_f(v[i + 1][e]) + wt[2][2 * e + 1] * hi_f(v[i + 2][e]);
                o[2 * e] = silu_f(lo) * qs; o[2 * e + 1] = silu_f(hi) * qs;
            }
            u32x4 wv; wv.x = pk2(o[0], o[1]); wv.y = pk2(o[2], o[3]); wv.z = pk2(o[4], o[5]); wv.w = pk2(o[6], o[7]);
            *(u32x4*)(dst + (size_t)i * 1024) = wv;
        }
    }
    const int lane = tid & 63;
    const int n_sc = nscan ? 1 : 64;
    if (scanner || (nscan == 0 && blockIdx.x == 0 && tid < 64))
    for (int sc = 0; sc < n_sc; ++sc) {
        const int gw = nscan ? (int)blockIdx.x : sc;
        const int b = gw >> 3, h = (gw >> 1) & 3, dir = gw & 1;
        const float* GATES = (const float*)(p.ws + WS_GATES);
        float* GP = (float*)(p.ws + WS_GPRE) + (size_t)gw * 68 * 384;
        float m_prev = 0.f;
        auto grow_of = [&](int st) -> size_t { if (st < 4) { const int cc = dir ? 3 - st : st; return (size_t)NX + (size_t)b * 256 + cc * 64; } const int xc = st - 4, cc = dir ? 63 - xc : xc; return (size_t)b * 4096 + cc * 64; };
        const int oi = (dir ? 8 : 0) + h, of = (dir ? 12 : 4) + h;
        float nig = GATES[(grow_of(0) + lane) * 16 + oi], nlf = GATES[(grow_of(0) + lane) * 16 + of];
        for (int st = 0; st < 68; ++st) {
            const float ig = nig, lf = nlf;
            if (st + 1 < 68) { const size_t g2 = grow_of(st + 1); nig = GATES[(g2 + lane) * 16 + oi]; nlf = GATES[(g2 + lane) * 16 + of]; }
            float bs = lf;
#pragma unroll
            for (int o = 1; o < 64; o <<= 1) { const float ov = dir ? __shfl_down(bs, o) : __shfl_up(bs, o); const bool ok = dir ? (lane + o < 64) : (lane >= o); if (ok) bs += ov; }
            const float a = ig - bs;
            float mx = a;
#pragma unroll
            for (int o = 1; o < 64; o <<= 1) { const float ov = dir ? __shfl_down(mx, o) : __shfl_up(mx, o); const bool ok = dir ? (lane + o < 64) : (lane >= o); if (ok) mx = fmaxf(mx, ov); }
            const float total = __shfl(bs, dir ? 0 : 63);
            const float m_inter = bs + m_prev, m_t = fmaxf(bs + mx, m_inter);
            const float wsl = total - bs + ig;
            const float m_new = fmaxf(total + m_prev, wave_max(wsl));
            float* o = GP + (size_t)st * 384;
            o[lane] = bs - m_t; o[64 + lane] = a; o[128 + lane] = __expf(m_inter - m_t); o[192 + lane] = __expf(wsl - m_new); o[256 + lane] = __expf(-m_t);
            if (lane == 0) o[320] = __expf(total + m_prev - m_new);
            m_prev = m_new;
        }
    }
}

DI void ph_mlstm(const Params& p, LAS unsigned char* lds) {
    constexpr int QP = 528, VP = 176, SP = 144;
    LAS unsigned char* Qi = lds; LAS unsigned char* Ki = lds + 33792; LAS unsigned char* Vi0 = lds + 67584; LAS unsigned char* Vwi = Vi0 + 2 * 11264;
    LAS unsigned char* Sgi = Vwi + 11264; LAS unsigned char* Ci = Sgi + 9216; LAS float* fl0 = (LAS float*)(Ci + 42240);
    const int tid = opaque_tid(), wid = tid >> 6, lane = tid & 63, fr = lane & 15, fq = lane >> 4;
    const bf16_t* QC = (const bf16_t*)p.out; const bf16_t* KC = QC + (size_t)NX * 1024; const bf16_t* VPL = (const bf16_t*)(p.ws + 2 * PLANE);
    const bf16_t* CQC = (const bf16_t*)(p.ws + WS_CQC); const bf16_t* CKC = (const bf16_t*)(p.ws + WS_CKC); const bf16_t* CV = (const bf16_t*)(p.ws + WS_CRAW) + (size_t)2 * NCX * 1024;
    for (int wi = blockIdx.x; wi < 256; wi += gridDim.x) {
        const int b = wi >> 5, h = (wi >> 3) & 3, dir = (wi >> 2) & 1, es = wi & 3;
        bf16_t* Hout = (bf16_t*)(p.ws + (dir ? PLANE : 0));
        const float* GP = (const float*)(p.ws + WS_GPRE) + (size_t)((b * 4 + h) * 2 + dir) * 68 * 384;
        f32x4 Cst[2][5];
#pragma unroll
        for (int i = 0; i < 2; ++i)
#pragma unroll
            for (int n = 0; n < 5; ++n) Cst[i][n] = (f32x4){0.f, 0.f, 0.f, 0.f};
        __syncthreads();
        for (int i = tid; i < 64 * 8; i += 512) { const int row = i >> 3, c = i & 7;
            *(LAS unsigned*)(Vi0 + row * VP + 128 + c * 4) = 0x3F803F80u; *(LAS unsigned*)(Vi0 + 11264 + row * VP + 128 + c * 4) = 0x3F803F80u; *(LAS unsigned*)(Vwi + row * VP + 128 + c * 4) = 0u; }
        u32x4 rq[4], rk[4], rv; float pg = 0.f, pws = 0.f, pdecay = 0.f, decay = 0.f;
        const int mt = wid >> 1, nt0 = 2 * (wid & 1);
#define ML_LOAD(ST) do { const int _st = (ST); const bf16_t *_q, *_k, *_v; \
            if (_st < 4) { const int cc = dir ? 3 - _st : _st; const size_t row0 = (size_t)b * 256 + cc * 64; _q = CQC + row0 * 1024 + h * 256; _k = CKC + row0 * 1024 + h * 256; _v = CV + row0 * 1024 + h * 256 + es * 64; } \
            else { const int xc = _st - 4, cc = dir ? 63 - xc : xc; const size_t row0 = (size_t)b * 4096 + cc * 64; _q = QC + row0 * 1024 + h * 256; _k = KC + row0 * 1024 + h * 256; _v = VPL + row0 * 1024 + h * 256 + es * 64; } \
            _Pragma("unroll") for (int i = 0; i < 4; ++i) { const int id = tid + 512 * i, row = id >> 5, chk = id & 31; rq[i] = *(const u32x4*)(_q + (size_t)row * 1024 + chk * 8); rk[i] = *(const u32x4*)(_k + (size_t)row * 1024 + chk * 8); } \
            rv = *(const u32x4*)(_v + (size_t)(tid >> 3) * 1024 + (tid & 7) * 8); \
            const float* _g = GP + (size_t)_st * 384; pg = _g[tid < 320 ? tid : 0]; pws = _g[192 + (tid >> 3)]; pdecay = _g[320]; } while (0)
#define ML_WRITE(ST) do { LAS unsigned char* _Vi = Vi0 + ((ST) & 1) * 11264; LAS float* _fl = fl0 + ((ST) & 1) * 320; \
            _Pragma("unroll") for (int i = 0; i < 4; ++i) { const int id = tid + 512 * i, row = id >> 5, chk = id & 31; \
                *(LAS u32x4*)(Qi + row * QP + chk * 16) = rq[i]; *(LAS u32x4*)(Ki + row * QP + chk * 16) = rk[i]; } \
            *(LAS u32x4*)(_Vi + (tid >> 3) * VP + (tid & 7) * 16) = rv; \
            { const float w = pws; u32x4 o; \
              o.x = pk2(w * lo_f(rv.x), w * hi_f(rv.x)); o.y = pk2(w * lo_f(rv.y), w * hi_f(rv.y)); o.z = pk2(w * lo_f(rv.z), w * hi_f(rv.z)); o.w = pk2(w * lo_f(rv.w), w * hi_f(rv.w)); \
              *(LAS u32x4*)(Vwi + (tid >> 3) * VP + (tid & 7) * 16) = o; \
              if ((tid & 7) == 0) *(LAS unsigned*)(Vwi + (tid >> 3) * VP + 128) = pk2(w, 0.f); } \
            if (tid < 320) _fl[tid] = pg; \
            _Pragma("unroll") for (int i = 0; i < 2; ++i) _Pragma("unroll") for (int n = 0; n < 5; ++n) { u32x2 w; w.x = pk2(Cst[i][n][0], Cst[i][n][1]); w.y = pk2(Cst[i][n][2], Cst[i][n][3]); \
                *(LAS u32x2*)(Ci + (16 * n + fr) * QP + (16 * (2 * wid + i) + 4 * fq) * 2) = w; } \
            decay = pdecay; } while (0)
        ML_LOAD(0);
        __syncthreads();
        ML_WRITE(0);
        ML_LOAD(1);
        for (int st = 0; st < 68; ++st) {
            const bool isx = st >= 4;
            LAS unsigned char* Vi = Vi0 + (st & 1) * 11264; LAS float* fl = fl0 + (st & 1) * 320;
            LAS float* f_bt = fl; LAS float* f_aa = fl + 64; LAS float* f_inter = fl + 128; LAS float* f_enm = fl + 256;
            __syncthreads();
            const float dcy = decay;
            const int t = 16 * mt + fr;
            f32x4 accC[3];
#pragma unroll
            for (int n = 0; n < 3; ++n) accC[n] = (f32x4){0.f, 0.f, 0.f, 0.f};
            if (isx) {
                f32x4 sacc[2] = {(f32x4){0.f, 0.f, 0.f, 0.f}, (f32x4){0.f, 0.f, 0.f, 0.f}};
#pragma unroll
                for (int ks = 0; ks < 8; ++ks) { const bf16x8 qf = *(const LAS bf16x8*)(Qi + t * QP + (32 * ks + 8 * fq) * 2);
#pragma unroll
                    for (int n = 0; n < 2; ++n) { const bf16x8 kf = *(const LAS bf16x8*)(Ki + (16 * (nt0 + n) + fr) * QP + (32 * ks + 8 * fq) * 2); sacc[n] = mfma16(kf, qf, sacc[n]); }
#pragma unroll
                    for (int n = 0; n < 3; ++n) { const int et = (n < 2) ? nt0 + n : 4; const bf16x8 cf = *(const LAS bf16x8*)(Ci + (16 * et + fr) * QP + (32 * ks + 8 * fq) * 2); accC[n] = mfma16(cf, qf, accC[n]); } }
                const float btm = f_bt[t];
#pragma unroll
                for (int n = 0; n < 2; ++n) { const int s0 = 16 * (nt0 + n) + 4 * fq; const f32x4 a4 = *(const LAS f32x4*)(f_aa + s0); float vv[4];
#pragma unroll
                    for (int j = 0; j < 4; ++j) { const int s = s0 + j; const bool ok = dir ? (s >= t) : (s <= t); const float e = __expf(btm + a4[j]); vv[j] = ok ? sacc[n][j] * e : 0.f; }
                    u32x2 w; w.x = pk2(vv[0], vv[1]); w.y = pk2(vv[2], vv[3]); *(LAS u32x2*)(Sgi + t * SP + s0 * 2) = w; }
            }
#pragma unroll
            for (int i = 0; i < 2; ++i)
#pragma unroll
                for (int n = 0; n < 5; ++n) Cst[i][n] = Cst[i][n] * dcy;
#pragma unroll
            for (int ks = 0; ks < 2; ++ks) { bf16x8 kf[2];
#pragma unroll
                for (int i = 0; i < 2; ++i) kf[i] = tr_frag(Ki, QP, 32 * ks, 16 * (2 * wid + i), lane);
#pragma unroll
                for (int n = 0; n < 5; ++n) { const bf16x8 vw = tr_frag(Vwi, VP, 32 * ks, 16 * n, lane);
#pragma unroll
                    for (int i = 0; i < 2; ++i) Cst[i][n] = mfma16(kf[i], vw, Cst[i][n]); } }
            __syncthreads();
            if (isx) {
                f32x4 accD[3];
#pragma unroll
                for (int n = 0; n < 3; ++n) accD[n] = (f32x4){0.f, 0.f, 0.f, 0.f};
#pragma unroll
                for (int ks = 0; ks < 2; ++ks) { const bf16x8 sgf = *(const LAS bf16x8*)(Sgi + t * SP + (32 * ks + 8 * fq) * 2);
#pragma unroll
                    for (int n = 0; n < 3; ++n) { const int et = (n < 2) ? nt0 + n : 4; const bf16x8 vf = tr_frag(Vi, VP, 32 * ks, 16 * et, lane); accD[n] = mfma16(vf, sgf, accD[n]); } }
                const float inter_t = f_inter[t];
                const float den0 = accD[2][0] + inter_t * accC[2][0];
                const float den = __shfl(den0, fr);
                const float rden = 1.0f / fmaxf(fabsf(den), f_enm[t]);
                const int xc = st - 4, cc = dir ? 63 - xc : xc;
                bf16_t* hp = Hout + ((size_t)b * 4096 + cc * 64 + t) * 1024 + h * 256 + es * 64 + 4 * fq;
#pragma unroll
                for (int n = 0; n < 2; ++n) { const f32x4 hv = (accD[n] + accC[n] * inter_t) * rden;
                    u32x2 w; w.x = pk2(hv[0], hv[1]); w.y = pk2(hv[2], hv[3]); *(u32x2*)(hp + 16 * (nt0 + n)) = w; }
            }
            if (st + 1 < 68) { ML_WRITE(st + 1); if (st + 2 < 68) ML_LOAD(st + 2); }
        }
#undef ML_LOAD
#undef ML_WRITE
    }
}

template <int KK, int NN, class Cfg>
DI void axis_mix(const Cfg& cfg, LAS unsigned char* lds, int n_items) {
    constexpr int TP = 528, BP = KK * 2 + 16, NCH = KK / 16;
    LAS unsigned char* Ti = lds; LAS unsigned char* Bi = lds + 128 * TP;
    const int tid = opaque_tid(), wid = tid >> 6, lane = tid & 63, fr = lane & 15, fq = lane >> 4;
    __syncthreads();
    cfg.fill_tables(Bi, tid);
    u32x4 ra[NCH], rb[NCH];
    const int G = gridDim.x;
#define AX_LOAD(R, IT) do { if ((IT) < n_items) { _Pragma("unroll") for (int i = 0; i < NCH; ++i) { const int id = tid + 512 * i; R[i] = *(const u32x4*)(cfg.row_ptr((IT), id >> 5) + (id & 31) * 8); } } } while (0)
#define AX_BODY(R, IT, PRE) do { \
        __syncthreads(); \
        _Pragma("unroll") for (int i = 0; i < NCH; ++i) { const int id = tid + 512 * i; *(LAS u32x4*)(Ti + (id >> 5) * TP + (id & 31) * 16) = R[i]; } \
        __syncthreads(); \
        AX_LOAD(R, PRE); \
        f32x4 acc[2][NN / 16]; \
        _Pragma("unroll") for (int i = 0; i < 2; ++i) _Pragma("unroll") for (int n = 0; n < NN / 16; ++n) acc[i][n] = (f32x4){0.f, 0.f, 0.f, 0.f}; \
        LAS unsigned char* tb = Bi + cfg.table_off(IT); \
        _Pragma("unroll") for (int ks = 0; ks < KK / 32; ++ks) { bf16x8 af[2]; \
            _Pragma("unroll") for (int i = 0; i < 2; ++i) af[i] = tr_frag(Ti, TP, 32 * ks, 32 * wid + 16 * i, lane); \
            _Pragma("unroll") for (int n = 0; n < NN / 16; ++n) { const bf16x8 bfr = *(const LAS bf16x8*)(tb + (16 * n + fr) * BP + (32 * ks + 8 * fq) * 2); \
                _Pragma("unroll") for (int i = 0; i < 2; ++i) acc[i][n] = mfma16(af[i], bfr, acc[i][n]); } } \
        cfg.epilogue(acc, (IT), wid, fr, fq, Bi); } while (0)
    int item = blockIdx.x;
    AX_LOAD(ra, item); AX_LOAD(rb, item + G);
    for (; item < n_items; item += 2 * G) {
        AX_BODY(ra, item, item + 2 * G);
        if (item + G < n_items) AX_BODY(rb, item + G, item + 3 * G);
    }
#undef AX_LOAD
#undef AX_BODY
}
DI void fill_dft_table(LAS unsigned char* Bi, int tid, int nrows) {
    for (int idx = tid; idx < nrows * 128; idx += 512) { const int n = idx >> 7, k = idx & 127, ap = n & 63, kk = k & 63; float s, c; sincospif((float)((kk * ap) & 63) / 32.0f, &s, &c);
        float v; if (n < 64) v = (k < 64) ? c : s; else v = (k < 64) ? -s : c;
        *(LAS unsigned short*)(Bi + n * 272 + k * 2) = (unsigned short)(pk2(v * 0.125f, 0.f) & 0xffffu); }
}
struct CfgDft1 {
    const bf16_t* Z; bf16_t* S1re; bf16_t* S1im;
    DI void fill_tables(LAS unsigned char* Bi, int tid) const { fill_dft_table(Bi, tid, 128); }
    DI int table_off(int) const { return 0; }
    DI const bf16_t* row_ptr(int item, int k) const { const int g = item & 3, b = (item >> 2) & 63, batch = item >> 8;
        return Z + ((size_t)batch * 4096 + 64 * (k & 63) + b) * 2048 + g * 512 + (k >> 6) * 256; }
    DI void epilogue(const f32x4 (&acc)[2][8], int item, int wid, int fr, int fq, LAS unsigned char* Bi) const {
        const int g = item & 3, b = (item >> 2) & 63, batch = item >> 8;
#pragma unroll
        for (int ni = 0; ni < 4; ++ni) { const int ap = 16 * ni + fr; float s, c; sincospif((float)(b * ap) * (1.0f / 2048.0f), &s, &c);
            const size_t tok = (size_t)batch * 4096 + 64 * ap + b;
#pragma unroll
            for (int i = 0; i < 2; ++i) { const f32x4 re = acc[i][ni], im = acc[i][ni + 4]; const f32x4 r2 = re * c + im * s, i2 = im * c - re * s;
                const size_t o = tok * 1024 + g * 256 + 32 * wid + 16 * i + 4 * fq;
                u32x2 w; w.x = pk2(r2[0], r2[1]); w.y = pk2(r2[2], r2[3]); *(u32x2*)(S1re + o) = w;
                w.x = pk2(i2[0], i2[1]); w.y = pk2(i2[2], i2[3]); *(u32x2*)(S1im + o) = w; } }
    }
};
struct CfgDft2 {
    const bf16_t* S1re; const bf16_t* S1im; const bf16_t* ZB; bf16_t* Y;
    DI void fill_tables(LAS unsigned char* Bi, int tid) const { fill_dft_table(Bi, tid, 64); }
    DI int table_off(int) const { return 0; }
    DI const bf16_t* row_ptr(int item, int k) const { const int g = item & 3, ap = (item >> 2) & 63, batch = item >> 8;
        return ((k >> 6) ? S1im : S1re) + ((size_t)batch * 4096 + 64 * ap + (k & 63)) * 1024 + g * 256; }
    DI void epilogue(const f32x4 (&acc)[2][4], int item, int wid, int fr, int fq, LAS unsigned char*) const {
        const int g = item & 3, ap = (item >> 2) & 63, batch = item >> 8;
#pragma unroll
        for (int ni = 0; ni < 4; ++ni) { const size_t tok = (size_t)batch * 4096 + ap + 64 * (16 * ni + fr);
#pragma unroll
            for (int i = 0; i < 2; ++i) { const int ch = g * 256 + 32 * wid + 16 * i + 4 * fq; const u32x2 z = *(const u32x2*)(ZB + tok * 1024 + ch); const f32x4 a = acc[i][ni];
                u32x2 w; w.x = pk2(a[0] * silu_f(lo_f(z.x)), a[1] * silu_f(hi_f(z.x))); w.y = pk2(a[2] * silu_f(lo_f(z.y)), a[3] * silu_f(hi_f(z.y)));
                *(u32x2*)(Y + tok * 2048 + 1024 + ch) = w; } }
    }
};
DI void fill_pool_tables(LAS unsigned char* Bi, int tid) {
    for (int idx = tid; idx < 4 * 4096; idx += 512) { const int g = idx >> 12, n = (idx >> 6) & 63, k = idx & 63, w = 2 << g, lo = n - w / 2, hi = n + w - w / 2;
        *(LAS unsigned short*)(Bi + g * 9216 + n * 144 + k * 2) = (k >= lo && k < hi) ? (unsigned short)0x3F80 : (unsigned short)0; }
}
DI float pool_rcnt(int g, int n) { const int w = 2 << g; int lo = n - w / 2, hi = n + w - w / 2; lo = lo < 0 ? 0 : lo; hi = hi > 64 ? 64 : hi; return 1.0f / (float)(hi - lo); }
struct CfgPoolA {
    const bf16_t* UC; bf16_t* PA;
    DI void fill_tables(LAS unsigned char* Bi, int tid) const { fill_pool_tables(Bi, tid); }
    DI int table_off(int item) const { return ((item & 7) >> 1) * 9216; }
    DI const bf16_t* row_ptr(int item, int k) const { const int ct = item & 7, c = (item >> 3) & 63, batch = item >> 9; return UC + ((size_t)batch * 4096 + 64 * k + c) * 2048 + ct * 256; }
    DI void epilogue(const f32x4 (&acc)[2][4], int item, int wid, int fr, int fq, LAS unsigned char*) const {
        const int ct = item & 7, c = (item >> 3) & 63, batch = item >> 9, g = ct >> 1;
#pragma unroll
        for (int ni = 0; ni < 4; ++ni) { const int n = 16 * ni + fr; const float rc = pool_rcnt(g, n); const size_t tok = (size_t)batch * 4096 + 64 * n + c;
#pragma unroll
            for (int i = 0; i < 2; ++i) { const f32x4 a = acc[i][ni] * rc; u32x2 w; w.x = pk2(a[0], a[1]); w.y = pk2(a[2], a[3]);
                *(u32x2*)(PA + tok * 2048 + ct * 256 + 32 * wid + 16 * i + 4 * fq) = w; } }
    }
};
struct CfgPoolB {
    const bf16_t* PA; bf16_t* UC;
    DI void fill_tables(LAS unsigned char* Bi, int tid) const { fill_pool_tables(Bi, tid); }
    DI int table_off(int item) const { return ((item & 7) >> 1) * 9216; }
    DI const bf16_t* row_ptr(int item, int k) const { const int ct = item & 7, rp = (item >> 3) & 63, batch = item >> 9; return PA + ((size_t)batch * 4096 + 64 * rp + k) * 2048 + ct * 256; }
    DI void epilogue(const f32x4 (&acc)[2][4], int item, int wid, int fr, int fq, LAS unsigned char*) const {
        const int ct = item & 7, rp = (item >> 3) & 63, batch = item >> 9, g = ct >> 1;
#pragma unroll
        for (int ni = 0; ni < 4; ++ni) { const int n = 16 * ni + fr; const float rc = pool_rcnt(g, n); const size_t tok = (size_t)batch * 4096 + 64 * rp + n;
#pragma unroll
            for (int i = 0; i < 2; ++i) { bf16_t* up = UC + tok * 2048 + ct * 256 + 32 * wid + 16 * i + 4 * fq; const u32x2 u = *(const u32x2*)up; const f32x4 a = acc[i][ni] * rc;
                u32x2 w; w.x = pk2(a[0] - lo_f(u.x), a[1] - hi_f(u.x)); w.y = pk2(a[2] - lo_f(u.y), a[3] - hi_f(u.y)); *(u32x2*)up = w; } }
    }
};

DI void ph_ya(const Params& p) {
    const int tid = opaque_tid(), wid = tid >> 6, lane = tid & 63;
    const bf16_t* HF = (const bf16_t*)p.ws; const bf16_t* HB = (const bf16_t*)(p.ws + PLANE); const bf16_t* O = (const bf16_t*)(p.ws + 3 * PLANE); const bf16_t* ZA = (const bf16_t*)(p.ws + 4 * PLANE);
    bf16_t* Y = (bf16_t*)p.out;
    f32x4 hg[4];
#pragma unroll
    for (int i = 0; i < 4; ++i) hg[i] = *(const f32x4*)(p.head_norm + lane * 16 + 4 * i);
    for (int r = blockIdx.x * 8 + wid; r < NX; r += gridDim.x * 8) {
        const size_t o = (size_t)r * 1024 + lane * 16;
        float gv[16], za[16]; float ss = 0.f;
#pragma unroll
        for (int hh = 0; hh < 2; ++hh) { const u32x4 a = *(const u32x4*)(HF + o + 8 * hh), bq = *(const u32x4*)(HB + o + 8 * hh), oo = *(const u32x4*)(O + o + 8 * hh), zz = *(const u32x4*)(ZA + o + 8 * hh);
#pragma unroll
            for (int e = 0; e < 4; ++e) { const float h0 = lo_f(a[e]) + lo_f(bq[e]), h1 = hi_f(a[e]) + hi_f(bq[e]);
                const float g0 = sigmoid_f(lo_f(oo[e])) * h0, g1 = sigmoid_f(hi_f(oo[e])) * h1;
                gv[8 * hh + 2 * e] = g0; gv[8 * hh + 2 * e + 1] = g1; ss += g0 * g0 + g1 * g1; za[8 * hh + 2 * e] = lo_f(zz[e]); za[8 * hh + 2 * e + 1] = hi_f(zz[e]); } }
        ss += __shfl_xor(ss, 1); ss += __shfl_xor(ss, 2); ss += __shfl_xor(ss, 4); ss += __shfl_xor(ss, 8);
        const float rstd = rsqrtf(ss * (1.0f / 256.0f) + 1e-6f);
        u32x4 w[2];
#pragma unroll
        for (int q = 0; q < 8; ++q) { const float y0 = gv[2 * q] * rstd * hg[q >> 1][(2 * q) & 3] * silu_f(za[2 * q]), y1 = gv[2 * q + 1] * rstd * hg[q >> 1][(2 * q + 1) & 3] * silu_f(za[2 * q + 1]);
            w[q >> 2][q & 3] = pk2(y0, y1); }
        *(u32x4*)(Y + (size_t)r * 2048 + lane * 16) = w[0]; *(u32x4*)(Y + (size_t)r * 2048 + lane * 16 + 8) = w[1];
    }
}


#define XB_TMO      128
#define XB_XCNT(j)  (256  + 64 * (j))
#define XB_XSUB(j)  (1280 + 64 * (j))
#define XB_XGEN(j)  (2304 + 64 * (j))
#define XB_TOP      3328
#define XB_TOPGEN   3392
#define XCD_BAR_WORDS 3456
#define XB_SPIN_CAP (1u << 18)
DI unsigned xb_ld(unsigned* p)              { return __hip_atomic_load(p, __ATOMIC_RELAXED, __HIP_MEMORY_SCOPE_AGENT); }
DI unsigned xb_add(unsigned* p, unsigned v) { return __hip_atomic_fetch_add(p, v, __ATOMIC_RELAXED, __HIP_MEMORY_SCOPE_AGENT); }
DI unsigned xb_xcc_id() { return (unsigned)__builtin_amdgcn_s_getreg((3 << 11) | 20) & 0xFu; }
#define XB_SPIN(cond, bar) do { unsigned _sp = 0; while (cond) { __builtin_amdgcn_s_sleep(1); \
    if ((++_sp & 255u) == 0u) { if (xb_ld(&(bar)[XB_TMO])) break; if (_sp > XB_SPIN_CAP) { atomicAdd(&(bar)[XB_TMO], 1u); break; } } } } while (0)
struct XcdBarrier { unsigned* bar; unsigned x; volatile LAS unsigned* st; };
DI XcdBarrier xcd_barrier_post(unsigned* bar, volatile LAS unsigned* st) {
    XcdBarrier b; b.bar = bar; b.x = xb_xcc_id(); b.st = st;
    if (threadIdx.x == 0) (void)xb_add(&bar[XB_XCNT(b.x)], 1u);
    return b;
}
DI void xcd_barrier_complete(unsigned* bar, unsigned x, unsigned& nloc, unsigned& nx) {
    const unsigned G = gridDim.x * gridDim.y * gridDim.z;
    unsigned sum, cnt, mine, sp = 0u;
    for (;;) {
        sum = 0u; cnt = 0u; mine = 0u;
#pragma unroll
        for (unsigned j = 0; j < 16; ++j) { const unsigned c = xb_ld(&bar[XB_XCNT(j)]); sum += c; cnt += (c > 0u) ? 1u : 0u; mine = (j == x) ? c : mine; }
        if (sum == G) break;
        __builtin_amdgcn_s_sleep(1);
        if ((++sp & 255u) == 0u) { if (xb_ld(&bar[XB_TMO])) break; if (sp > XB_SPIN_CAP) { atomicAdd(&bar[XB_TMO], 1u); break; } }
    }
    nloc = mine > 0u ? mine : 1u; nx = cnt > 0u ? cnt : 1u;
}
DI void xcd_barrier(const XcdBarrier& b) {
    asm volatile("s_waitcnt vmcnt(0)" ::: "memory");
    __syncthreads();
    if (threadIdx.x == 0) {
        unsigned* bar = b.bar;
        __builtin_amdgcn_s_waitcnt(0);
        unsigned nloc = b.st[0], nx = b.st[1];
        if (nloc == 0u) { xcd_barrier_complete(bar, b.x, nloc, nx); b.st[0] = nloc; b.st[1] = nx; }
        const unsigned old = xb_add(&bar[XB_XSUB(b.x)], 1u);
        const unsigned gen = old / nloc;
        if (old + 1u == (gen + 1u) * nloc) {
            __builtin_amdgcn_fence(__ATOMIC_RELEASE, "agent");
            asm volatile("s_waitcnt vmcnt(0)" ::: "memory");
            const unsigned og = xb_add(&bar[XB_TOP], 1u);
            const unsigned tg = og / nx;
            if (og + 1u == (tg + 1u) * nx) xb_add(&bar[XB_TOPGEN], 1u);
            else XB_SPIN(xb_ld(&bar[XB_TOPGEN]) == tg, bar);
            __builtin_amdgcn_fence(__ATOMIC_ACQUIRE, "agent");
            xb_add(&bar[XB_XGEN(b.x)], 1u);
            asm volatile("s_waitcnt vmcnt(0)" ::: "memory");
        } else {
            XB_SPIN(xb_ld(&bar[XB_XGEN(b.x)]) == gen, bar);
            __builtin_amdgcn_fence(__ATOMIC_ACQUIRE, "agent");
            asm volatile("s_waitcnt vmcnt(0)" ::: "memory");
        }
    }
    __syncthreads();
}

__global__ void __launch_bounds__(512, 2) mk_fwd(Params p, int ph_lo, int ph_hi) {
    extern __shared__ __attribute__((aligned(16))) unsigned char shm[];
    LAS unsigned char* lds = (LAS unsigned char*)shm;
    cg::grid_group grid = cg::this_grid();
    unsigned char* ws = p.ws;
    const int G = gridDim.x, c = blockIdx.x;
    volatile LAS unsigned* xst = (volatile LAS unsigned*)(lds + LDS_BYTES - 16);
    if (threadIdx.x == 0) { xst[0] = 0u; xst[1] = 0u; }
    __syncthreads();
    XcdBarrier xbar; xbar.bar = (unsigned*)(ws + WS_BAR); xbar.x = 0u; xbar.st = xst;
    if (ph_hi - ph_lo > 1) xbar = xcd_barrier_post((unsigned*)(ws + WS_BAR), xst);
    if (ph_lo > 1000) grid.sync();
#ifndef PHMASK
#define PHMASK 0xFFFF
#endif
#define GSYNC() xcd_barrier(xbar)
#ifndef REP_MASK
#define REP_MASK 0
#endif
#define PHASE(i, ...) if constexpr ((PHMASK >> (i)) & 1) if (ph_lo <= (i) && (i) < ph_hi) { __VA_ARGS__; if constexpr ((REP_MASK >> (i)) & 1) { __syncthreads(); __VA_ARGS__; } if ((i) + 1 < ph_hi) GSYNC(); }
    PHASE(0, ph_prep(p, lds));
    PHASE(1, ph_norm0(p, lds));
    PHASE(2, { GemmD g{(const bf16_t*)p.out, (const bf16_t*)(ws + WS_WINE), 1024, 1024, 0, 0, 1024}; Sched S{128, 28, 1, 8, 12, 128, G, c};
               EpiPlanes E{(bf16_t*)ws, (bf16_t*)(ws + WS_CRAW)}; gemm_phase(lds, g, S, E); });
    PHASE(3, ph_conv(p));
    PHASE(4, ph_mlstm(p, lds));
    PHASE(5, { GemmD g{(const bf16_t*)(ws + 5 * PLANE), (const bf16_t*)(ws + WS_WF), 1024, 256, 256, 512 * 256, 256}; Sched S{128, 2, 4, 0, 0, 0, G, c};
               EpiBf E{(bf16_t*)p.out, nullptr, 2048, 512, 0, nullptr, nullptr}; gemm_phase(lds, g, S, E); });
    PHASE(6, { CfgDft1 cf{(const bf16_t*)p.out, (bf16_t*)(ws + 2 * PLANE), (bf16_t*)(ws + 5 * PLANE)}; axis_mix<128, 128>(cf, lds, 2048); });
    PHASE(7, { CfgDft2 cf{(const bf16_t*)(ws + 2 * PLANE), (const bf16_t*)(ws + 5 * PLANE), (const bf16_t*)(ws + 6 * PLANE), (bf16_t*)p.out}; axis_mix<128, 64>(cf, lds, 2048); ph_ya(p); });
    PHASE(8, { GemmD g{(const bf16_t*)p.out, (const bf16_t*)(ws + WS_WOUTE), 2048, 2048, 0, 0, 2048}; Sched S{128, 4, 1, 0, 0, 0, G, c};
               EpiRes E{(float*)ws, p.x, (const float*)(ws + WS_MOD) + 2048}; gemm_phase(lds, g, S, E); });
    PHASE(9, ph_norm1(p, 0));
    PHASE(10, { GemmD g{(const bf16_t*)(ws + 2 * PLANE), (const bf16_t*)(ws + WS_WINO), 1024, 1024, 0, 0, 1024}; Sched S{128, 16, 1, 0, 0, 0, G, c};
                EpiBf E{(bf16_t*)(ws + 3 * PLANE), (bf16_t*)(ws + 5 * PLANE), 2048, 0, 1, nullptr, nullptr}; gemm_phase(lds, g, S, E); });
    PHASE(11, { CfgPoolA cf{(const bf16_t*)(ws + 3 * PLANE), (bf16_t*)p.out}; axis_mix<64, 64>(cf, lds, 4096); });
    PHASE(12, { CfgPoolB cf{(const bf16_t*)p.out, (bf16_t*)(ws + 3 * PLANE)}; axis_mix<64, 64>(cf, lds, 4096); });
    PHASE(13, { GemmD g{(const bf16_t*)(ws + 3 * PLANE), (const bf16_t*)(ws + WS_WPOOL), 2048, 512, 512, 512 * 512, 512}; Sched S{128, 2, 4, 0, 0, 0, G, c};
                EpiBf E{(bf16_t*)p.out, nullptr, 2048, 512, 2, p.pool_scale, (const bf16_t*)(ws + 5 * PLANE)}; gemm_phase(lds, g, S, E); });
    PHASE(14, { GemmD g{(const bf16_t*)p.out, (const bf16_t*)(ws + WS_WOUTO), 2048, 2048, 0, 0, 2048}; Sched S{128, 4, 1, 0, 0, 0, G, c};
                EpiRes E{(float*)ws, (const float*)ws, (const float*)(ws + WS_MOD) + 9 * 3072 + 2048}; gemm_phase(lds, g, S, E); });
    PHASE(15, ph_norm1(p, 1));
#undef PHASE
#ifdef XSYNC
    for (int k = 0; k < XSYNC; ++k) GSYNC();
#endif
#ifdef DBG_STOP
    GSYNC();
    {   const size_t n = (size_t)NX * 1024; unsigned* o32 = (unsigned*)p.out;
        for (size_t i = (size_t)blockIdx.x * 512 + threadIdx.x; i < n; i += (size_t)gridDim.x * 512) {
            float v = 0.f;
            if (DBG_PLANES == -1) { const unsigned u = o32[i]; v = lo_f(u) + hi_f(u); }
            else if (DBG_PLANES == -2) { v = ((const float*)p.ws)[i]; }
            else { for (int pl = 0; pl < 7; ++pl) if ((DBG_PLANES >> pl) & 1) v += bf2f(((const bf16_t*)(p.ws + pl * PLANE))[i]); }
            if (!(fabsf(v) < 1e30f)) v = 12345.f;
            p.out[i] = v; } }
#endif
}

extern "C" void kernel_launch(void* const* d_in, const int* in_sizes, int n_in, void* d_out, int out_size, void* d_ws, size_t ws_size, hipStream_t stream) {
    static int grid = 0;
    if (grid == 0) {
        int dev = 0, cus = 0, per_cu = 0;
        hipGetDevice(&dev);
        hipDeviceGetAttribute(&cus, hipDeviceAttributeMultiprocessorCount, dev);
        if (hipFuncSetAttribute((const void*)mk_fwd, hipFuncAttributeMaxDynamicSharedMemorySize, LDS_BYTES) != hipSuccess) fprintf(stderr, "hipFuncSetAttribute failed\n");
        if (hipOccupancyMaxActiveBlocksPerMultiprocessor(&per_cu, (const void*)mk_fwd, 512, LDS_BYTES) != hipSuccess || per_cu < 1) { fprintf(stderr, "occupancy query: %d\n", per_cu); per_cu = 1; }
        (void)hipGetLastError();
        grid = cus * per_cu; if (grid > 256) grid = 256; if (grid < 1) grid = 1;
        if (ws_size < WS_END) fprintf(stderr, "workspace too small: %zu < %zu\n", ws_size, (size_t)WS_END);
    }
    Params p{};
    p.x = (const float*)d_in[0]; p.c = (const float*)d_in[1]; p.ctx = (const float*)d_in[2]; p.c_ctx = (const float*)d_in[3]; p.ada_w = (const float*)d_in[4]; p.ada_b = (const float*)d_in[5];
    p.norm_g = (const float*)d_in[6]; p.win_even = (const float*)d_in[7]; p.gate_b = (const float*)d_in[8]; p.conv_qk = (const float*)d_in[9]; p.head_norm = (const float*)d_in[10];
    p.fourier_w = (const float*)d_in[11]; p.wout_even = (const float*)d_in[12]; p.win_odd = (const float*)d_in[13]; p.pool_w = (const float*)d_in[14]; p.pool_scale = (const float*)d_in[15];
    p.wout_odd = (const float*)d_in[16]; p.final_g = (const float*)d_in[17]; p.out = (float*)d_out; p.ws = (unsigned char*)d_ws;
    (void)hipMemsetAsync((unsigned char*)d_ws + WS_BAR, 0, XCD_BAR_WORDS * 4, stream);
#if MK_MULTI
    for (int ph = 0; ph < 16; ++ph) { hipLaunchKernelGGL(mk_fwd, dim3(grid), dim3(512), LDS_BYTES, stream, p, ph, ph + 1); }
#else
#ifdef DBG_STOP
    int lo = 0, hi = DBG_STOP;
#else
    int lo = 0, hi = 16;
#endif
    void* args[] = {&p, &lo, &hi};
    hipError_t e = hipLaunchCooperativeKernel((void*)mk_fwd, dim3(grid), dim3(512), args, LDS_BYTES, stream);
    if (e != hipSuccess) fprintf(stderr, "cooperative launch failed: %s (grid %d)\n", hipGetErrorString(e), grid);
#endif
}
```

```cpp
#include <hip/hip_runtime.h>
#include <hip/hip_cooperative_groups.h>
#include <cstdio>
namespace cg = cooperative_groups;

#ifndef MK_MULTI
#define MK_MULTI 0
#endif

#define LAS __attribute__((address_space(3)))
typedef unsigned short bf16_t;
typedef short bf16x8 __attribute__((ext_vector_type(8)));
typedef short s16x4 __attribute__((ext_vector_type(4)));
typedef float f32x4 __attribute__((ext_vector_type(4)));
typedef unsigned u32x4 __attribute__((ext_vector_type(4)));
typedef unsigned u32x2 __attribute__((ext_vector_type(2)));

constexpr int NX = 32768, NCX = 2048, NR = NX + NCX;
constexpr size_t PLANE = (size_t)NX * 1024 * 2;
constexpr size_t WS_EXTRA = 7 * PLANE;
constexpr size_t WS_WINE  = WS_EXTRA;
constexpr size_t WS_WOUTE = WS_WINE  + (size_t)7168 * 1024 * 2;
constexpr size_t WS_WINO  = WS_WOUTE + (size_t)1024 * 2048 * 2;
constexpr size_t WS_WPOOL = WS_WINO  + (size_t)4096 * 1024 * 2;
constexpr size_t WS_WOUTO = WS_WPOOL + (size_t)4 * 512 * 512 * 2;
constexpr size_t WS_WF    = WS_WOUTO + (size_t)1024 * 2048 * 2;
constexpr size_t WS_MOD   = WS_WF    + (size_t)4 * 512 * 256 * 2;
constexpr size_t WS_GATES = WS_MOD   + 262144;
constexpr size_t WS_CRAW  = WS_GATES + (size_t)NR * 16 * 4;
constexpr size_t WS_CQC   = WS_CRAW  + (size_t)3 * NCX * 1024 * 2;
constexpr size_t WS_CKC   = WS_CQC   + (size_t)NCX * 1024 * 2;
constexpr size_t WS_END   = WS_CKC   + (size_t)NCX * 1024 * 2;
constexpr size_t WS_GPRE  = WS_END + 16384;
constexpr size_t WS_GPRE_END = WS_GPRE + (size_t)64 * 68 * 384 * 4;
static_assert(WS_GPRE_END <= (size_t)512 * 1024 * 1024, "gate tables exceed the workspace");
constexpr size_t WS_BAR   = WS_END;
static_assert(WS_BAR + 16384 <= (size_t)512 * 1024 * 1024, "workspace map exceeds 512 MiB");

constexpr int LDS_BYTES = 155648;

struct Params {
    const float* x; const float* c; const float* ctx; const float* c_ctx; const float* ada_w; const float* ada_b; const float* norm_g;
    const float* win_even; const float* gate_b; const float* conv_qk; const float* head_norm; const float* fourier_w; const float* wout_even;
    const float* win_odd; const float* pool_w; const float* pool_scale; const float* wout_odd; const float* final_g;
    float* out; unsigned char* ws;
};

#define DI __device__ __forceinline__
DI float bf2f(unsigned short b) { return __uint_as_float(((unsigned)b) << 16); }
DI float lo_f(unsigned u) { return __uint_as_float(u << 16); }
DI float hi_f(unsigned u) { return __uint_as_float(u & 0xffff0000u); }
typedef __bf16 bf16v2_t __attribute__((ext_vector_type(2)));
typedef float f32v2_t __attribute__((ext_vector_type(2)));
DI unsigned pk2(float lo, float hi) { const f32v2_t v = {lo, hi}; const bf16v2_t b = __builtin_convertvector(v, bf16v2_t); return __builtin_bit_cast(unsigned, b); }
DI float silu_f(float x) { return x / (1.0f + __expf(-x)); }
DI float sigmoid_f(float x) { return 1.0f / (1.0f + __expf(-x)); }
DI int opaque_tid() { int t = threadIdx.x; asm volatile("" : "+v"(t)); return t; }
DI float wave_sum(float v) { for (int o = 32; o > 0; o >>= 1) v += __shfl_xor(v, o); return v; }
DI float wave_max(float v) { for (int o = 32; o > 0; o >>= 1) v = fmaxf(v, __shfl_xor(v, o)); return v; }
DI f32x4 mfma16(bf16x8 a, bf16x8 b, f32x4 c) { return __builtin_amdgcn_mfma_f32_16x16x32_bf16(a, b, c, 0, 0, 0); }
DI bf16x8 tr_frag(LAS unsigned char* img, int pitch, int krow0, int col0, int lane) {
    const int g = lane >> 4, q = (lane & 15) >> 2, pp = lane & 3;
    LAS unsigned char* a0 = img + (krow0 + 8 * g + q) * pitch + col0 * 2 + 8 * pp;
    s16x4 lo = __builtin_amdgcn_ds_read_tr16_b64_v4i16((LAS s16x4*)a0);
    s16x4 hi = __builtin_amdgcn_ds_read_tr16_b64_v4i16((LAS s16x4*)(a0 + 4 * pitch));
    return __builtin_shufflevector(lo, hi, 0, 1, 2, 3, 4, 5, 6, 7);
}

constexpr int HTB = 128 * 64 * 2;
DI int lds_byte(int r, int c) { const int st = (r >> 4) * 2 + (c >> 5), rr = r & 15, cc = c & 31, ob = rr * 64 + cc * 2; return st * 1024 + (ob ^ (((ob >> 9) & 1) << 5)); }
DI void stage_rc(int b, int& R, int& C) { const int st = b / 1024, sb = b % 1024, swz = sb ^ (((sb >> 9) & 1) << 5); R = (st >> 1) * 16 + swz / 64; C = (st & 1) * 32 + (swz % 64) / 2; }
DI int perm32(int rho) { const int n = rho >> 4, i = rho & 15; return 8 * (i >> 2) + 4 * n + (i & 3); }

struct Unit { int pm, pn, g; };
struct GemmD { const bf16_t* A; const bf16_t* Bt; int lda, ldb; long a_gs, b_gs; int K; };
struct Sched {
    int nM, nN, nG, nM2, nN2, pm2off, G, c;
    DI bool next(int i, Unit& u) const {
        const int L = i * G + c; const int nwg = nM * nN, tot1 = nwg * nG;
        const bool first = L < tot1;
        const int L1 = first ? L : 0;
        const int g = L1 / nwg; int wgid = L1 - g * nwg;
        { const int q = nwg / 8, r = nwg % 8, xcd = wgid % 8, off = wgid / 8; wgid = (xcd < r ? xcd * (q + 1) : r * (q + 1) + (xcd - r) * q) + off; }
        const int nig = 8 * nN, gid = wgid / nig, fm = gid * 8, gsz = (nM - fm) < 8 ? (nM - fm) : 8;
        const int pm1 = fm + ((wgid % nig) % gsz), pn1 = (wgid % nig) / gsz;
        const int L2 = first ? 0 : L - tot1, d2 = nM2 > 0 ? nM2 : 1;
        const int pm2 = pm2off + L2 % d2, pn2 = L2 / d2;
        u.pm = first ? pm1 : pm2; u.pn = first ? pn1 : pn2; u.g = first ? g : 0;
        return first || (L2 < nM2 * nN2);
    }
};

template <class Epi>
DI void gemm_phase(LAS unsigned char* lds, const GemmD g, const Sched& S, const Epi& E) {
    const int tid = opaque_tid(), wid = __builtin_amdgcn_readfirstlane(tid >> 6), lane = tid & 63, wr = wid >> 2, wc = wid & 3, fr = lane & 15, fq = lane >> 4;
    const int K = g.K, nt = K / 64;
    unsigned voffA[2], voffB[2];
#pragma unroll
    for (int i = 0; i < 2; ++i) { int R, C; stage_rc(tid * 16 + i * 8192, R, C); const int Rb = Epi::PERM ? ((R & ~31) + perm32(R & 31)) : R;
        voffA[i] = (unsigned)(R * g.lda + C) * 2u; voffB[i] = (unsigned)(Rb * g.ldb + C) * 2u; }
    const size_t kstep = 128;
    const size_t hstepA = (size_t)128 * g.lda * 2, hstepB = (size_t)128 * g.ldb * 2;
    const unsigned ldsw = (unsigned)wid * 1024u;
    const int aoff = lds_byte(wr * 64 + fr, fq * 8), boff = lds_byte(wc * 32 + fr, fq * 8);
#define G_SA(b, h) (((b) * 2 + (h)) * HTB)
#define G_SB(b, h) ((4 + (b) * 2 + (h)) * HTB)
#define G_STAGE(bufoff, gbase, voff) do { _Pragma("unroll") for (int _i = 0; _i < 2; ++_i) \
        __builtin_amdgcn_global_load_lds((const unsigned*)((const char*)(gbase) + (voff)[_i]), (LAS unsigned*)(lds + (bufoff) + ldsw + _i * 8192), 16, 0, 0); } while (0)
#define G_LDA(dst, b, h) do { _Pragma("unroll") for (int m = 0; m < 4; ++m) _Pragma("unroll") for (int k = 0; k < 2; ++k) dst[m][k] = *(const LAS bf16x8*)(lds + G_SA(b, h) + aoff + m * 2048 + k * 1024); } while (0)
#define G_LDB(dst, b, h) do { _Pragma("unroll") for (int n = 0; n < 2; ++n) _Pragma("unroll") for (int k = 0; k < 2; ++k) dst[n][k] = *(const LAS bf16x8*)(lds + G_SB(b, h) + boff + n * 2048 + k * 1024); } while (0)
#define G_MMA(ai, bj, At, Bt) do { __builtin_amdgcn_s_setprio(1); _Pragma("unroll") for (int m = 0; m < 4; ++m) _Pragma("unroll") for (int n = 0; n < 2; ++n) _Pragma("unroll") for (int k = 0; k < 2; ++k) \
        acc[ai][bj][m][n] = __builtin_amdgcn_mfma_f32_16x16x32_bf16(Bt[n][k], At[m][k], acc[ai][bj][m][n], 0, 0, 0); __builtin_amdgcn_s_setprio(0); } while (0)
#define G_WAIT_V(n) asm volatile("s_waitcnt vmcnt(" #n ")" ::: "memory")
#define G_WAIT_L(n) asm volatile("s_waitcnt lgkmcnt(" #n ")" ::: "memory")
#define G_BAR __builtin_amdgcn_s_barrier()
#define G_SCHED __builtin_amdgcn_sched_barrier(0)
    Unit cur, nxt; int ui = 0;
    if (!S.next(0, cur)) return;
    f32x4 acc[2][2][4][2];
#pragma unroll
    for (int a = 0; a < 2; ++a)
#pragma unroll
        for (int b = 0; b < 2; ++b)
#pragma unroll
            for (int m = 0; m < 4; ++m)
#pragma unroll
                for (int n = 0; n < 2; ++n) acc[a][b][m][n] = (f32x4){0.f, 0.f, 0.f, 0.f};
    bf16x8 At[4][2], B0[2][2], B1[2][2];
    const char* cA = (const char*)(g.A + (long)cur.g * g.a_gs) + (size_t)cur.pm * 2 * hstepA;
    const char* cB = (const char*)(g.Bt + (long)cur.g * g.b_gs) + (size_t)cur.pn * 2 * hstepB;
    G_STAGE(G_SB(0, 0), cB, voffB); G_STAGE(G_SA(0, 0), cA, voffA); G_STAGE(G_SB(0, 1), cB + hstepB, voffB); G_STAGE(G_SA(0, 1), cA + hstepA, voffA);
    if (wr == 1) G_BAR;
    G_WAIT_V(4); G_BAR;
    G_STAGE(G_SB(1, 0), cB + kstep, voffB); G_STAGE(G_SA(1, 0), cA + kstep, voffA); G_STAGE(G_SB(1, 1), cB + hstepB + kstep, voffB);
    G_WAIT_V(6); G_BAR;
    for (;;) {
        const bool has_next = S.next(ui + 1, nxt);
        const char* nA = has_next ? (const char*)(g.A + (long)nxt.g * g.a_gs) + (size_t)nxt.pm * 2 * hstepA : cA;
        const char* nB = has_next ? (const char*)(g.Bt + (long)nxt.g * g.b_gs) + (size_t)nxt.pn * 2 * hstepB : cB;
        for (int t = 0; t < nt; t += 2) {
            const bool last = (t == nt - 2);
            const char* a1 = cA + (size_t)(t + 1) * kstep;
            const char* a2 = last ? nA : cA + (size_t)(t + 2) * kstep; const char* b2 = last ? nB : cB + (size_t)(t + 2) * kstep;
            const char* a3 = a2 + kstep; const char* b3 = b2 + kstep;
            G_LDB(B0, 0, 0); G_SCHED; G_LDA(At, 0, 0); G_STAGE(G_SA(1, 1), a1 + hstepA, voffA);
            G_WAIT_L(8); G_BAR; G_WAIT_L(0); G_MMA(0, 0, At, B0); G_BAR; G_SCHED;
            G_LDB(B1, 0, 1); G_STAGE(G_SB(0, 0), b2, voffB);
            G_BAR; G_WAIT_L(0); G_MMA(0, 1, At, B1); G_BAR;
            G_LDA(At, 0, 1); G_STAGE(G_SA(0, 0), a2, voffA);
            G_BAR; G_WAIT_L(0); G_MMA(1, 0, At, B0); G_BAR; G_SCHED;
            G_STAGE(G_SB(0, 1), b2 + hstepB, voffB);
            G_WAIT_V(6); G_BAR; G_MMA(1, 1, At, B1); G_BAR;
            G_LDB(B0, 1, 0); G_SCHED; G_LDA(At, 1, 0); G_STAGE(G_SA(0, 1), a2 + hstepA, voffA);
            G_WAIT_L(8); G_BAR; G_WAIT_L(0); G_MMA(0, 0, At, B0); G_BAR; G_SCHED;
            G_LDB(B1, 1, 1); G_STAGE(G_SB(1, 0), b3, voffB);
            G_BAR; G_WAIT_L(0); G_MMA(0, 1, At, B1); G_BAR;
            G_LDA(At, 1, 1); G_STAGE(G_SA(1, 0), a3, voffA);
            G_BAR; G_WAIT_L(0); G_MMA(1, 0, At, B0); G_BAR; G_SCHED;
            G_STAGE(G_SB(1, 1), b3 + hstepB, voffB);
            G_WAIT_V(6); G_BAR; G_MMA(1, 1, At, B1); G_BAR;
        }
        E(acc, cur, wr, wc, fr, fq);
        if (!has_next) break;
#pragma unroll
        for (int a = 0; a < 2; ++a)
#pragma unroll
            for (int b = 0; b < 2; ++b)
#pragma unroll
                for (int m = 0; m < 4; ++m)
#pragma unroll
                    for (int n = 0; n < 2; ++n) acc[a][b][m][n] = (f32x4){0.f, 0.f, 0.f, 0.f};
        cur = nxt; cA = nA; cB = nB; ++ui;
    }
    G_WAIT_V(0);
    if (wr == 0) G_BAR;
    G_BAR;
}

struct EpiPlanes {
    static constexpr bool PERM = true;
    bf16_t* xbase; bf16_t* cbase;
    DI void operator()(const f32x4 (&acc)[2][2][4][2], const Unit& u, int wr, int wc, int fr, int fq) const {
        const int plane = u.pn >> 2, colt = (u.pn & 3) * 256;
        bf16_t* base; int row0;
        if (u.pm < 128) { base = xbase + (size_t)plane * NX * 1024; row0 = u.pm * 256 + wr * 64 + fr; }
        else { base = cbase + (size_t)plane * NCX * 1024; row0 = (u.pm - 128) * 256 + wr * 64 + fr; }
        const int col0 = colt + wc * 32 + 8 * fq;
#pragma unroll
        for (int ai = 0; ai < 2; ++ai)
#pragma unroll
            for (int m = 0; m < 4; ++m) { bf16_t* rowp = base + (size_t)(row0 + ai * 128 + m * 16) * 1024 + col0;
#pragma unroll
                for (int bj = 0; bj < 2; ++bj) { const f32x4 v0 = acc[ai][bj][m][0], v1 = acc[ai][bj][m][1];
                    u32x4 w; w.x = pk2(v0[0], v0[1]); w.y = pk2(v0[2], v0[3]); w.z = pk2(v1[0], v1[1]); w.w = pk2(v1[2], v1[3]);
                    *(u32x4*)(rowp + bj * 128) = w; } }
    }
};
struct EpiBf {
    static constexpr bool PERM = true;
    bf16_t* O; bf16_t* O2; int ldc; int gcol; int mode; const float* scale; const bf16_t* zc;
    DI void operator()(const f32x4 (&acc)[2][2][4][2], const Unit& u, int wr, int wc, int fr, int fq) const {
        const int row0 = u.pm * 256 + wr * 64 + fr;
        bf16_t* base = O; int pn = u.pn; bool act = false;
        if (mode == 1 && pn >= 8) { base = O2; pn -= 8; act = true; }
        const int col0 = u.g * gcol + pn * 256 + wc * 32 + 8 * fq;
        f32x4 sc[2][2];
#pragma unroll
        for (int bj = 0; bj < 2; ++bj) { sc[bj][0] = (mode == 2) ? *(const f32x4*)(scale + col0 + bj * 128) : (f32x4){1.f, 1.f, 1.f, 1.f}; sc[bj][1] = (mode == 2) ? *(const f32x4*)(scale + col0 + bj * 128 + 4) : (f32x4){1.f, 1.f, 1.f, 1.f}; }
#pragma unroll
        for (int ai = 0; ai < 2; ++ai) {
            u32x4 zz[4][2];
            if (mode == 2) {
#pragma unroll
                for (int m = 0; m < 4; ++m)
#pragma unroll
                    for (int bj = 0; bj < 2; ++bj) zz[m][bj] = *(const volatile u32x4*)(zc + (size_t)(row0 + ai * 128 + m * 16) * ldc + col0 + bj * 128); }
#pragma unroll
            for (int m = 0; m < 4; ++m) { const size_t ro = (size_t)(row0 + ai * 128 + m * 16) * ldc + col0;
#pragma unroll
                for (int bj = 0; bj < 2; ++bj) { f32x4 v0 = acc[ai][bj][m][0], v1 = acc[ai][bj][m][1];
                    if (act) {
#pragma unroll
                        for (int j = 0; j < 4; ++j) { v0[j] = silu_f(v0[j]); v1[j] = silu_f(v1[j]); } }
                    if (mode == 2) {
                        const u32x4 z = zz[m][bj]; const f32x4 s0 = sc[bj][0], s1 = sc[bj][1];
                        v0[0] *= s0[0] * lo_f(z.x); v0[1] *= s0[1] * hi_f(z.x); v0[2] *= s0[2] * lo_f(z.y); v0[3] *= s0[3] * hi_f(z.y);
                        v1[0] *= s1[0] * lo_f(z.z); v1[1] *= s1[1] * hi_f(z.z); v1[2] *= s1[2] * lo_f(z.w); v1[3] *= s1[3] * hi_f(z.w);
                    }
                    u32x4 w; w.x = pk2(v0[0], v0[1]); w.y = pk2(v0[2], v0[3]); w.z = pk2(v1[0], v1[1]); w.w = pk2(v1[2], v1[3]);
                    *(u32x4*)(base + ro + bj * 128) = w; } } }
    }
};
struct EpiRes {
    static constexpr bool PERM = false;
    float* O; const float* res; const float* gate;
    DI void operator()(const f32x4 (&acc)[2][2][4][2], const Unit& u, int wr, int wc, int fr, int fq) const {
        const int row0 = u.pm * 256 + wr * 64 + fr, col0 = u.pn * 256 + wc * 32 + 4 * fq;
        const float* gp = gate + (size_t)(u.pm >> 4) * 3072 + col0;
        f32x4 gv[2][2];
#pragma unroll
        for (int bj = 0; bj < 2; ++bj)
#pragma unroll
            for (int n = 0; n < 2; ++n) gv[bj][n] = *(const f32x4*)(gp + bj * 128 + n * 16);
#pragma unroll
        for (int ai = 0; ai < 2; ++ai)
#pragma unroll
            for (int mp = 0; mp < 2; ++mp) {
                f32x4 r[2][2][2];
#pragma unroll
                for (int mm = 0; mm < 2; ++mm) { const size_t ro = (size_t)(row0 + ai * 128 + (2 * mp + mm) * 16) * 1024 + col0;
#pragma unroll
                    for (int bj = 0; bj < 2; ++bj)
#pragma unroll
                        for (int n = 0; n < 2; ++n) r[mm][bj][n] = *(const volatile f32x4*)(res + ro + bj * 128 + n * 16); }
#pragma unroll
                for (int mm = 0; mm < 2; ++mm) { const size_t ro = (size_t)(row0 + ai * 128 + (2 * mp + mm) * 16) * 1024 + col0;
#pragma unroll
                    for (int bj = 0; bj < 2; ++bj)
#pragma unroll
                        for (int n = 0; n < 2; ++n) *(f32x4*)(O + ro + bj * 128 + n * 16) = r[mm][bj][n] + gv[bj][n] * acc[ai][bj][2 * mp + mm][n]; }
            }
    }
};

DI void transpose_jobs(const Params& p, LAS unsigned char* lds, int tid, int j_lo, int j_hi, int w, int nw) {
    LAS float* tile = (LAS float*)lds;
    {
        auto job_desc = [&](int job, const float*& src, bf16_t*& dst, int& K, int& Nt, int& k0, int& n0) {
            int j = job, tk, tn;
            if (j < 1792) { src = p.win_even; dst = (bf16_t*)(p.ws + WS_WINE); K = 1024; Nt = 7184; tk = j & 15; tn = j >> 4; }
            else if ((j -= 1792) < 512) { src = p.wout_even; dst = (bf16_t*)(p.ws + WS_WOUTE); K = 2048; Nt = 1024; tk = j & 31; tn = j >> 5; }
            else if ((j -= 512) < 1024) { src = p.win_odd; dst = (bf16_t*)(p.ws + WS_WINO); K = 1024; Nt = 4096; tk = j & 15; tn = j >> 4; }
            else if ((j -= 1024) < 256) { const int g = j >> 6, jj = j & 63; src = p.pool_w + (size_t)g * 512 * 512; dst = (bf16_t*)(p.ws + WS_WPOOL) + (size_t)g * 512 * 512; K = 512; Nt = 512; tk = jj & 7; tn = jj >> 3; }
            else { j -= 256; src = p.wout_odd; dst = (bf16_t*)(p.ws + WS_WOUTO); K = 2048; Nt = 1024; tk = j & 31; tn = j >> 5; }
            k0 = tk * 64; n0 = tn * 64; };
        float rg[8];
        int job = j_lo + w;
        if (job < j_hi) { const float* src; bf16_t* dst; int K, Nt, k0, n0; job_desc(job, src, dst, K, Nt, k0, n0);
#pragma unroll
            for (int i = 0; i < 8; ++i) { const int idx = tid + 512 * i, k = idx >> 6, n = idx & 63; rg[i] = src[(size_t)(k0 + k) * Nt + n0 + n]; } }
        for (; job < j_hi; job += nw) {
            const float* src; bf16_t* dst; int K, Nt, k0, n0; job_desc(job, src, dst, K, Nt, k0, n0);
            __syncthreads();
#pragma unroll
            for (int i = 0; i < 8; ++i) { const int idx = tid + 512 * i, k = idx >> 6, n = idx & 63; tile[k * 65 + n] = rg[i]; }
            __syncthreads();
            const int nj = job + nw;
            if (nj < j_hi) { const float* s2; bf16_t* d2; int K2, Nt2, k2, n2; job_desc(nj, s2, d2, K2, Nt2, k2, n2);
#pragma unroll
                for (int i = 0; i < 8; ++i) { const int idx = tid + 512 * i, k = idx >> 6, n = idx & 63; rg[i] = s2[(size_t)(k2 + k) * Nt2 + n2 + n]; } }
#pragma unroll
            for (int i = 0; i < 4; ++i) { const int idx = tid + 512 * i, n = idx >> 5, k = (idx & 31) * 2;
                *(unsigned*)(dst + (size_t)(n0 + n) * K + k0 + k) = pk2(tile[k * 65 + n], tile[(k + 1) * 65 + n]); }
        }
        __syncthreads();
    }
}
DI void ph_prep(const Params& p, LAS unsigned char* lds) {
    const int tid = opaque_tid();
    transpose_jobs(p, lds, tid, 0, 2304, blockIdx.x, gridDim.x);
    LAS float* sv = (LAS float*)(lds + 32768);
    LAS float* red = (LAS float*)(lds + 32768 + 36864);
    LAS float* ct = (LAS float*)(lds + 90112); LAS float* st = ct + 256;
    for (int idx = tid; idx < 9216; idx += 512) { const int v = idx >> 10, k = idx & 1023; const float cv = (v < 8) ? p.c[v * 1024 + k] : p.c_ctx[k]; sv[idx] = silu_f(cv); }
    if (tid < 256) { float s, c; sincospif((float)tid / 128.0f, &s, &c); ct[tid] = c; st[tid] = s; }
    __syncthreads();
    float* MOD = (float*)(p.ws + WS_MOD);
    for (int item = blockIdx.x; item < 192; item += gridDim.x) {
        const int l = item / 96, c0 = (item % 96) * 32, kg = tid >> 5, col = tid & 31;
        float a[9];
#pragma unroll
        for (int v = 0; v < 9; ++v) a[v] = 0.f;
        const float* w = p.ada_w + (size_t)l * 1024 * 3072 + c0 + col;
#pragma unroll 16
        for (int k = kg; k < 1024; k += 16) { const float wv = w[(size_t)k * 3072];
#pragma unroll
            for (int v = 0; v < 9; ++v) a[v] += sv[v * 1024 + k] * wv; }
#pragma unroll
        for (int v = 0; v < 9; ++v) red[(kg * 32 + col) * 9 + v] = a[v];
        __syncthreads();
        if (tid < 288) { const int v = tid >> 5, cc = tid & 31; float s = 0.f; for (int q = 0; q < 16; ++q) s += red[(q * 32 + cc) * 9 + v];
            MOD[(size_t)(l * 9 + v) * 3072 + c0 + cc] = s + p.ada_b[l * 3072 + c0 + cc]; }
        __syncthreads();
    }
    bf16_t* WF = (bf16_t*)(p.ws + WS_WF);
    for (int it = blockIdx.x; it < 512; it += gridDim.x) {
        const int idx = it * 512 + tid, d = idx & 255, c = (idx >> 8) & 255, g = idx >> 16;
        const float* f = p.fourier_w + (size_t)g * 65536 + d;
        float aP = 0.f, aQ = 0.f;
#pragma unroll 16
        for (int cp = 0; cp < 256; ++cp) { const float fv = f[cp * 256]; const int a = (c * cp) & 255; aP += ct[a] * fv; aQ += st[a] * fv; }
        WF[(size_t)(g * 512 + d) * 256 + c] = (bf16_t)(pk2(aP * 0.0625f, 0.f) & 0xffffu);
        WF[(size_t)(g * 512 + 256 + d) * 256 + c] = (bf16_t)(pk2(-aQ * 0.0625f, 0.f) & 0xffffu);
    }
}

DI void ph_norm0(const Params& p, LAS unsigned char* lds) {
    const int tid = opaque_tid(), wid = tid >> 6, lane = tid & 63;
    LAS float* wg = (LAS float*)lds;
#pragma unroll 4
    for (int i = 0; i < 32; ++i) { const int idx = tid + 512 * i, k = idx >> 4, j = idx & 15; wg[j * 1024 + k] = p.win_even[(size_t)k * 7184 + 7168 + j]; }
    __syncthreads();
    f32x4 g[4];
#pragma unroll
    for (int i = 0; i < 4; ++i) g[i] = *(const f32x4*)(p.norm_g + lane * 4 + 256 * i);
    const float* MOD = (const float*)(p.ws + WS_MOD);
    bf16_t* HX = (bf16_t*)p.out;
    float* GATES = (float*)(p.ws + WS_GATES);
    f32x4 vn[4];
    { const int r = blockIdx.x * 8 + wid; if (r < NR) { const float* src = (r < NX) ? p.x + (size_t)r * 1024 : p.ctx + (size_t)(r - NX) * 1024;
#pragma unroll
        for (int i = 0; i < 4; ++i) vn[i] = *(const f32x4*)(src + lane * 4 + 256 * i); } }
    for (int r = blockIdx.x * 8 + wid; r < NR; r += gridDim.x * 8) {
        const float* md;
        if (r < NX) { md = MOD + (size_t)(r >> 12) * 3072; } else { md = MOD + (size_t)8 * 3072; }
        f32x4 v[4]; float ss = 0.f;
#pragma unroll
        for (int i = 0; i < 4; ++i) { v[i] = vn[i]; ss += v[i][0] * v[i][0] + v[i][1] * v[i][1] + v[i][2] * v[i][2] + v[i][3] * v[i][3]; }
        { const int r2 = r + gridDim.x * 8; if (r2 < NR) { const float* s2 = (r2 < NX) ? p.x + (size_t)r2 * 1024 : p.ctx + (size_t)(r2 - NX) * 1024;
#pragma unroll
            for (int i = 0; i < 4; ++i) vn[i] = *(const f32x4*)(s2 + lane * 4 + 256 * i); } }
        ss = wave_sum(ss);
        const float rstd = rsqrtf(ss * (1.0f / 1024.0f) + 1e-6f);
#pragma unroll
        for (int i = 0; i < 4; ++i) { const f32x4 sh = *(const f32x4*)(md + lane * 4 + 256 * i), sc = *(const f32x4*)(md + 1024 + lane * 4 + 256 * i);
            v[i] = v[i] * rstd * g[i] * (sc + 1.0f) + sh;
            u32x2 w; w.x = pk2(v[i][0], v[i][1]); w.y = pk2(v[i][2], v[i][3]);
            *(u32x2*)(HX + (size_t)r * 1024 + lane * 4 + 256 * i) = w; }
        float pt[16];
#pragma unroll
        for (int j = 0; j < 16; ++j) { float a = 0.f;
#pragma unroll
            for (int i = 0; i < 4; ++i) { const f32x4 w4 = *(const LAS f32x4*)(wg + j * 1024 + lane * 4 + 256 * i); a += v[i][0] * w4[0] + v[i][1] * w4[1] + v[i][2] * w4[2] + v[i][3] * w4[3]; }
            pt[j] = a; if ((j & 3) == 3) __builtin_amdgcn_sched_barrier(0); }
        { const bool b5 = lane & 32;
#pragma unroll
          for (int j = 0; j < 8; ++j) { const float snd = b5 ? pt[j] : pt[j + 8], kp = b5 ? pt[j + 8] : pt[j]; pt[j] = kp + __shfl_xor(snd, 32); } }
        { const bool b4 = lane & 16;
#pragma unroll
          for (int j = 0; j < 4; ++j) { const float snd = b4 ? pt[j] : pt[j + 4], kp = b4 ? pt[j + 4] : pt[j]; pt[j] = kp + __shfl_xor(snd, 16); } }
        { const bool b3 = lane & 8;
#pragma unroll
          for (int j = 0; j < 2; ++j) { const float snd = b3 ? pt[j] : pt[j + 2], kp = b3 ? pt[j + 2] : pt[j]; pt[j] = kp + __shfl_xor(snd, 8); } }
        { const bool b2 = lane & 4; const float snd = b2 ? pt[0] : pt[1], kp = b2 ? pt[1] : pt[0]; pt[0] = kp + __shfl_xor(snd, 4); }
        pt[0] += __shfl_xor(pt[0], 2); pt[0] += __shfl_xor(pt[0], 1);
        if ((lane & 3) == 0) { const int j = ((lane >> 5) & 1) * 8 + ((lane >> 4) & 1) * 4 + ((lane >> 3) & 1) * 2 + ((lane >> 2) & 1);
            float val = pt[0] + p.gate_b[j];
            if ((j >> 2) & 1) val = fminf(val, 0.f) - log1pf(__expf(-fabsf(val)));
            GATES[(size_t)r * 16 + j] = val; }
    }
}
DI void ph_norm1(const Params& p, int mode) {
    const int tid = opaque_tid(), wid = tid >> 6, lane = tid & 63;
    const float* gsrc = mode ? p.final_g : p.norm_g + 1024;
    f32x4 g[4];
#pragma unroll
    for (int i = 0; i < 4; ++i) g[i] = *(const f32x4*)(gsrc + lane * 4 + 256 * i);
    const float* MOD = (const float*)(p.ws + WS_MOD) + (size_t)9 * 3072;
    const float* X1 = (const float*)p.ws;
    bf16_t* HX1 = (bf16_t*)(p.ws + 2 * PLANE);
    f32x4 vn[4];
    { const int r = blockIdx.x * 8 + wid; if (r < NX) {
#pragma unroll
        for (int i = 0; i < 4; ++i) vn[i] = *(const f32x4*)(X1 + (size_t)r * 1024 + lane * 4 + 256 * i); } }
    for (int r = blockIdx.x * 8 + wid; r < NX; r += gridDim.x * 8) {
        const float* md = MOD + (size_t)(r >> 12) * 3072;
        f32x4 v[4]; float ss = 0.f;
#pragma unroll
        for (int i = 0; i < 4; ++i) { v[i] = vn[i]; ss += v[i][0] * v[i][0] + v[i][1] * v[i][1] + v[i][2] * v[i][2] + v[i][3] * v[i][3]; }
        { const int r2 = r + gridDim.x * 8; if (r2 < NX) {
#pragma unroll
            for (int i = 0; i < 4; ++i) vn[i] = *(const f32x4*)(X1 + (size_t)r2 * 1024 + lane * 4 + 256 * i); } }
        ss = wave_sum(ss);
        const float rstd = rsqrtf(ss * (1.0f / 1024.0f) + 1e-6f);
#pragma unroll
        for (int i = 0; i < 4; ++i) {
            if (mode) { *(f32x4*)(p.out + (size_t)r * 1024 + lane * 4 + 256 * i) = v[i] * rstd * g[i]; }
            else { const f32x4 sh = *(const f32x4*)(md + lane * 4 + 256 * i), sc = *(const f32x4*)(md + 1024 + lane * 4 + 256 * i);
                const f32x4 h = v[i] * rstd * g[i] * (sc + 1.0f) + sh;
                u32x2 w; w.x = pk2(h[0], h[1]); w.y = pk2(h[2], h[3]);
                *(u32x2*)(HX1 + (size_t)r * 1024 + lane * 4 + 256 * i) = w; } }
    }
}

DI void ph_conv(const Params& p) {
    const bf16_t* QRAW = (const bf16_t*)p.ws; const bf16_t* KRAW = (const bf16_t*)(p.ws + PLANE);
    const bf16_t* CQ = (const bf16_t*)(p.ws + WS_CRAW); const bf16_t* CK = CQ + (size_t)NCX * 1024;
    bf16_t* QC = (bf16_t*)p.out; bf16_t* KC = QC + (size_t)NX * 1024;
    bf16_t* CQC = (bf16_t*)(p.ws + WS_CQC); bf16_t* CKC = (bf16_t*)(p.ws + WS_CKC);
    const int tid = opaque_tid();
    const bool scanner = (blockIdx.x < 64) && (tid < 64) && (gridDim.x >= 64);
    const int nscan = gridDim.x >= 64 ? 64 : 0;
    const int active_id = (int)blockIdx.x < nscan ? (int)blockIdx.x * 448 + (tid - 64) : nscan * 448 + ((int)blockIdx.x - nscan) * 512 + tid;
    const int active_n = nscan * 448 + ((int)gridDim.x - nscan) * 512;
    if (!scanner)
    for (int idx = active_id; idx < (NR / 8) * 256; idx += active_n) {
        const int oct = idx & 127, which = (idx >> 7) & 1, r0 = (idx >> 8) * 8, ch = oct * 8;
        const bf16_t* src; bf16_t* dst; int t0, T;
        if (r0 < NX) { src = (which ? KRAW : QRAW) + (size_t)r0 * 1024 + ch; dst = (which ? KC : QC) + (size_t)r0 * 1024 + ch; t0 = r0 & 4095; T = 4096; }
        else { const int rr = r0 - NX; src = (which ? CK : CQ) + (size_t)rr * 1024 + ch; dst = (which ? CKC : CQC) + (size_t)rr * 1024 + ch; t0 = rr & 255; T = 256; }
        const u32x4 z = {0u, 0u, 0u, 0u};
        u32x4 v[10];
        v[0] = (t0 > 0) ? *(const u32x4*)(src - 1024) : z;
#pragma unroll
        for (int i = 0; i < 8; ++i) v[i + 1] = *(const u32x4*)(src + (size_t)i * 1024);
        v[9] = (t0 + 8 < T) ? *(const u32x4*)(src + (size_t)8 * 1024) : z;
        const float* w = p.conv_qk + which * 1024 + ch;
        float wt[3][8];
#pragma unroll
        for (int j = 0; j < 3; ++j) { const f32x4 wa = *(const f32x4*)(w + j * 2048), wb = *(const f32x4*)(w + j * 2048 + 4);
#pragma unroll
            for (int e = 0; e < 4; ++e) { wt[j][e] = wa[e]; wt[j][4 + e] = wb[e]; } }
        const float qs = which ? 1.0f : 0.0625f;
#pragma unroll
        for (int i = 0; i < 8; ++i) {
            float o[8];
#pragma unroll
            for (int e = 0; e < 4; ++e) {
                float lo = wt[0][2 * e] * lo_f(v[i][e]) + wt[1][2 * e] * lo_f(v[i + 1][e]) + wt[2][2 * e] * lo_f(v[i + 2][e]);
                float hi = wt[0][2 * e + 1] * hi_f(v[i][e]) + wt[1][2 * e + 1] * hi_f(v[i + 1][e]) + wt[2][2 * e + 1] * hi_f(v[i + 2][e]);
                o[2 * e] = silu_f(lo) * qs; o[2 * e + 1] = silu_f(hi) * qs;
            }
            u32x4 wv; wv.x = pk2(o[0], o[1]); wv.y = pk2(o[2], o[3]); wv.z = pk2(o[4], o[5]); wv.w = pk2(o[6], o[7]);
            *(u32x4*)(dst + (size_t)i * 1024) = wv;
        }
    }
    const int lane = tid & 63;
    const int n_sc = nscan ? 1 : 64;
    if (scanner || (nscan == 0 && blockIdx.x == 0 && tid < 64))
    for (int sc = 0; sc < n_sc; ++sc) {
        const int gw = nscan ? (int)blockIdx.x : sc;
        const int b = gw >> 3, h = (gw >> 1) & 3, dir = gw & 1;
        const float* GATES = (const float*)(p.ws + WS_GATES);
        float* GP = (float*)(p.ws + WS_GPRE) + (size_t)gw * 68 * 384;
        float m_prev = 0.f;
        auto grow_of = [&](int st) -> size_t { if (st < 4) { const int cc = dir ? 3 - st : st; return (size_t)NX + (size_t)b * 256 + cc * 64; } const int xc = st - 4, cc = dir ? 63 - xc : xc; return (size_t)b * 4096 + cc * 64; };
        const int oi = (dir ? 8 : 0) + h, of = (dir ? 12 : 4) + h;
        float nig = GATES[(grow_of(0) + lane) * 16 + oi], nlf = GATES[(grow_of(0) + lane) * 16 + of];
        for (int st = 0; st < 68; ++st) {
            const float ig = nig, lf = nlf;
            if (st + 1 < 68) { const size_t g2 = grow_of(st + 1); nig = GATES[(g2 + lane) * 16 + oi]; nlf = GATES[(g2 + lane) * 16 + of]; }
            float bs = lf;
#pragma unroll
            for (int o = 1; o < 64; o <<= 1) { const float ov = dir ? __shfl_down(bs, o) : __shfl_up(bs, o); const bool ok = dir ? (lane + o < 64) : (lane >= o); if (ok) bs += ov; }
            const float a = ig - bs;
            float mx = a;
#pragma unroll
            for (int o = 1; o < 64; o <<= 1) { const float ov = dir ? __shfl_down(mx, o) : __shfl_up(mx, o); const bool ok = dir ? (lane + o < 64) : (lane >= o); if (ok) mx = fmaxf(mx, ov); }
            const float total = __shfl(bs, dir ? 0 : 63);
            const float m_inter = bs + m_prev, m_t = fmaxf(bs + mx, m_inter);
            const float wsl = total - bs + ig;
            const float m_new = fmaxf(total + m_prev, wave_max(wsl));
            float* o = GP + (size_t)st * 384;
            o[lane] = bs - m_t; o[64 + lane] = a; o[128 + lane] = __expf(m_inter - m_t); o[192 + lane] = __expf(wsl - m_new); o[256 + lane] = __expf(-m_t);
            if (lane == 0) o[320] = __expf(total + m_prev - m_new);
            m_prev = m_new;
        }
    }
}

DI void ph_mlstm(const Params& p, LAS unsigned char* lds) {
    constexpr int QP = 528, VP = 176, SP = 144;
    LAS unsigned char* Qi = lds; LAS unsigned char* Ki = lds + 33792; LAS unsigned char* Vi0 = lds + 67584; LAS unsigned char* Vwi = Vi0 + 2 * 11264;
    LAS unsigned char* Sgi = Vwi + 11264; LAS unsigned char* Ci = Sgi + 9216; LAS float* fl0 = (LAS float*)(Ci + 42240);
    const int tid = opaque_tid(), wid = tid >> 6, lane = tid & 63, fr = lane & 15, fq = lane >> 4;
    const bf16_t* QC = (const bf16_t*)p.out; const bf16_t* KC = QC + (size_t)NX * 1024; const bf16_t* VPL = (const bf16_t*)(p.ws + 2 * PLANE);
    const bf16_t* CQC = (const bf16_t*)(p.ws + WS_CQC); const bf16_t* CKC = (const bf16_t*)(p.ws + WS_CKC); const bf16_t* CV = (const bf16_t*)(p.ws + WS_CRAW) + (size_t)2 * NCX * 1024;
    for (int wi = blockIdx.x; wi < 256; wi += gridDim.x) {
        const int b = wi >> 5, h = (wi >> 3) & 3, dir = (wi >> 2) & 1, es = wi & 3;
        bf16_t* Hout = (bf16_t*)(p.ws + (dir ? PLANE : 0));
        const float* GP = (const float*)(p.ws + WS_GPRE) + (size_t)((b * 4 + h) * 2 + dir) * 68 * 384;
        f32x4 Cst[2][5];
#pragma unroll
        for (int i = 0; i < 2; ++i)
#pragma unroll
            for (int n = 0; n < 5; ++n) Cst[i][n] = (f32x4){0.f, 0.f, 0.f, 0.f};
        __syncthreads();
        for (int i = tid; i < 64 * 8; i += 512) { const int row = i >> 3, c = i & 7;
            *(LAS unsigned*)(Vi0 + row * VP + 128 + c * 4) = 0x3F803F80u; *(LAS unsigned*)(Vi0 + 11264 + row * VP + 128 + c * 4) = 0x3F803F80u; *(LAS unsigned*)(Vwi + row * VP + 128 + c * 4) = 0u; }
        u32x4 rq[4], rk[4], rv; float pg = 0.f, pws = 0.f, pdecay = 0.f, decay = 0.f;
        const int mt = wid >> 1, nt0 = 2 * (wid & 1);
#define ML_LOAD(ST) do { const int _st = (ST); const bf16_t *_q, *_k, *_v; \
            if (_st < 4) { const int cc = dir ? 3 - _st : _st; const size_t row0 = (size_t)b * 256 + cc * 64; _q = CQC + row0 * 1024 + h * 256; _k = CKC + row0 * 1024 + h * 256; _v = CV + row0 * 1024 + h * 256 + es * 64; } \
            else { const int xc = _st - 4, cc = dir ? 63 - xc : xc; const size_t row0 = (size_t)b * 4096 + cc * 64; _q = QC + row0 * 1024 + h * 256; _k = KC + row0 * 1024 + h * 256; _v = VPL + row0 * 1024 + h * 256 + es * 64; } \
            _Pragma("unroll") for (int i = 0; i < 4; ++i) { const int id = tid + 512 * i, row = id >> 5, chk = id & 31; rq[i] = *(const u32x4*)(_q + (size_t)row * 1024 + chk * 8); rk[i] = *(const u32x4*)(_k + (size_t)row * 1024 + chk * 8); } \
            rv = *(const u32x4*)(_v + (size_t)(tid >> 3) * 1024 + (tid & 7) * 8); \
            const float* _g = GP + (size_t)_st * 384; pg = _g[tid < 320 ? tid : 0]; pws = _g[192 + (tid >> 3)]; pdecay = _g[320]; } while (0)
#define ML_WRITE(ST) do { LAS unsigned char* _Vi = Vi0 + ((ST) & 1) * 11264; LAS float* _fl = fl0 + ((ST) & 1) * 320; \
            _Pragma("unroll") for (int i = 0; i < 4; ++i) { const int id = tid + 512 * i, row = id >> 5, chk = id & 31; \
                *(LAS u32x4*)(Qi + row * QP + chk * 16) = rq[i]; *(LAS u32x4*)(Ki + row * QP + chk * 16) = rk[i]; } \
            *(LAS u32x4*)(_Vi + (tid >> 3) * VP + (tid & 7) * 16) = rv; \
            { const float w = pws; u32x4 o; \
              o.x = pk2(w * lo_f(rv.x), w * hi_f(rv.x)); o.y = pk2(w * lo_f(rv.y), w * hi_f(rv.y)); o.z = pk2(w * lo_f(rv.z), w * hi_f(rv.z)); o.w = pk2(w * lo_f(rv.w), w * hi_f(rv.w)); \
              *(LAS u32x4*)(Vwi + (tid >> 3) * VP + (tid & 7) * 16) = o; \
              if ((tid & 7) == 0) *(LAS unsigned*)(Vwi + (tid >> 3) * VP + 128) = pk2(w, 0.f); } \
            if (tid < 320) _fl[tid] = pg; \
            _Pragma("unroll") for (int i = 0; i < 2; ++i) _Pragma("unroll") for (int n = 0; n < 5; ++n) { u32x2 w; w.x = pk2(Cst[i][n][0], Cst[i][n][1]); w.y = pk2(Cst[i][n][2], Cst[i][n][3]); \
                *(LAS u32x2*)(Ci + (16 * n + fr) * QP + (16 * (2 * wid + i) + 4 * fq) * 2) = w; } \
            decay = pdecay; } while (0)
        ML_LOAD(0);
        __syncthreads();
        ML_WRITE(0);
        ML_LOAD(1);
        for (int st = 0; st < 68; ++st) {
            const bool isx = st >= 4;
            LAS unsigned char* Vi = Vi0 + (st & 1) * 11264; LAS float* fl = fl0 + (st & 1) * 320;
            LAS float* f_bt = fl; LAS float* f_aa = fl + 64; LAS float* f_inter = fl + 128; LAS float* f_enm = fl + 256;
            __syncthreads();
            const float dcy = decay;
            const int t = 16 * mt + fr;
            f32x4 accC[3];
#pragma unroll
            for (int n = 0; n < 3; ++n) accC[n] = (f32x4){0.f, 0.f, 0.f, 0.f};
            if (isx) {
                f32x4 sacc[2] = {(f32x4){0.f, 0.f, 0.f, 0.f}, (f32x4){0.f, 0.f, 0.f, 0.f}};
#pragma unroll
                for (int ks = 0; ks < 8; ++ks) { const bf16x8 qf = *(const LAS bf16x8*)(Qi + t * QP + (32 * ks + 8 * fq) * 2);
#pragma unroll
                    for (int n = 0; n < 2; ++n) { const bf16x8 kf = *(const LAS bf16x8*)(Ki + (16 * (nt0 + n) + fr) * QP + (32 * ks + 8 * fq) * 2); sacc[n] = mfma16(kf, qf, sacc[n]); }
#pragma unroll
                    for (int n = 0; n < 3; ++n) { const int et = (n < 2) ? nt0 + n : 4; const bf16x8 cf = *(const LAS bf16x8*)(Ci + (16 * et + fr) * QP + (32 * ks + 8 * fq) * 2); accC[n] = mfma16(cf, qf, accC[n]); } }
                const float btm = f_bt[t];
#pragma unroll
                for (int n = 0; n < 2; ++n) { const int s0 = 16 * (nt0 + n) + 4 * fq; const f32x4 a4 = *(const LAS f32x4*)(f_aa + s0); float vv[4];
#pragma unroll
                    for (int j = 0; j < 4; ++j) { const int s = s0 + j; const bool ok = dir ? (s >= t) : (s <= t); const float e = __expf(btm + a4[j]); vv[j] = ok ? sacc[n][j] * e : 0.f; }
                    u32x2 w; w.x = pk2(vv[0], vv[1]); w.y = pk2(vv[2], vv[3]); *(LAS u32x2*)(Sgi + t * SP + s0 * 2) = w; }
            }
#pragma unroll
            for (int i = 0; i < 2; ++i)
#pragma unroll
                for (int n = 0; n < 5; ++n) Cst[i][n] = Cst[i][n] * dcy;
#pragma unroll
            for (int ks = 0; ks < 2; ++ks) { bf16x8 kf[2];
#pragma unroll
                for (int i = 0; i < 2; ++i) kf[i] = tr_frag(Ki, QP, 32 * ks, 16 * (2 * wid + i), lane);
#pragma unroll
                for (int n = 0; n < 5; ++n) { const bf16x8 vw = tr_frag(Vwi, VP, 32 * ks, 16 * n, lane);
#pragma unroll
                    for (int i = 0; i < 2; ++i) Cst[i][n] = mfma16(kf[i], vw, Cst[i][n]); } }
            __syncthreads();
            if (isx) {
                f32x4 accD[3];
#pragma unroll
                for (int n = 0; n < 3; ++n) accD[n] = (f32x4){0.f, 0.f, 0.f, 0.f};
#pragma unroll
                for (int ks = 0; ks < 2; ++ks) { const bf16x8 sgf = *(const LAS bf16x8*)(Sgi + t * SP + (32 * ks + 8 * fq) * 2);
#pragma unroll
                    for (int n = 0; n < 3; ++n) { const int et = (n < 2) ? nt0 + n : 4; const bf16x8 vf = tr_frag(Vi, VP, 32 * ks, 16 * et, lane); accD[n] = mfma16(vf, sgf, accD[n]); } }
                const float inter_t = f_inter[t];
                const float den0 = accD[2][0] + inter_t * accC[2][0];
                const float den = __shfl(den0, fr);
                const float rden = 1.0f / fmaxf(fabsf(den), f_enm[t]);
                const int xc = st - 4, cc = dir ? 63 - xc : xc;
                bf16_t* hp = Hout + ((size_t)b * 4096 + cc * 64 + t) * 1024 + h * 256 + es * 64 + 4 * fq;
#pragma unroll
                for (int n = 0; n < 2; ++n) { const f32x4 hv = (accD[n] + accC[n] * inter_t) * rden;
                    u32x2 w; w.x = pk2(hv[0], hv[1]); w.y = pk2(hv[2], hv[3]); *(u32x2*)(hp + 16 * (nt0 + n)) = w; }
            }
            if (st + 1 < 68) { ML_WRITE(st + 1); if (st + 2 < 68) ML_LOAD(st + 2); }
        }
#undef ML_LOAD
#undef ML_WRITE
    }
}

template <int KK, int NN, class Cfg>
DI void axis_mix(const Cfg& cfg, LAS unsigned char* lds, int n_items) {
    constexpr int TP = 528, BP = KK * 2 + 16, NCH = KK / 16;
    LAS unsigned char* Ti = lds; LAS unsigned char* Bi = lds + 128 * TP;
    const int tid = opaque_tid(), wid = tid >> 6, lane = tid & 63, fr = lane & 15, fq = lane >> 4;
    __syncthreads();
    cfg.fill_tables(Bi, tid);
    u32x4 ra[NCH], rb[NCH];
    const int G = gridDim.x;
#define AX_LOAD(R, IT) do { if ((IT) < n_items) { _Pragma("unroll") for (int i = 0; i < NCH; ++i) { const int id = tid + 512 * i; R[i] = *(const u32x4*)(cfg.row_ptr((IT), id >> 5) + (id & 31) * 8); } } } while (0)
#define AX_BODY(R, IT, PRE) do { \
        __syncthreads(); \
        _Pragma("unroll") for (int i = 0; i < NCH; ++i) { const int id = tid + 512 * i; *(LAS u32x4*)(Ti + (id >> 5) * TP + (id & 31) * 16) = R[i]; } \
        __syncthreads(); \
        AX_LOAD(R, PRE); \
        f32x4 acc[2][NN / 16]; \
        _Pragma("unroll") for (int i = 0; i < 2; ++i) _Pragma("unroll") for (int n = 0; n < NN / 16; ++n) acc[i][n] = (f32x4){0.f, 0.f, 0.f, 0.f}; \
        LAS unsigned char* tb = Bi + cfg.table_off(IT); \
        _Pragma("unroll") for (int ks = 0; ks < KK / 32; ++ks) { bf16x8 af[2]; \
            _Pragma("unroll") for (int i = 0; i < 2; ++i) af[i] = tr_frag(Ti, TP, 32 * ks, 32 * wid + 16 * i, lane); \
            _Pragma("unroll") for (int n = 0; n < NN / 16; ++n) { const bf16x8 bfr = *(const LAS bf16x8*)(tb + (16 * n + fr) * BP + (32 * ks + 8 * fq) * 2); \
                _Pragma("unroll") for (int i = 0; i < 2; ++i) acc[i][n] = mfma16(af[i], bfr, acc[i][n]); } } \
        cfg.epilogue(acc, (IT), wid, fr, fq, Bi); } while (0)
    int item = blockIdx.x;
    AX_LOAD(ra, item); AX_LOAD(rb, item + G);
    for (; item < n_items; item += 2 * G) {
        AX_BODY(ra, item, item + 2 * G);
        if (item + G < n_items) AX_BODY(rb, item + G, item + 3 * G);
    }
#undef AX_LOAD
#undef AX_BODY
}
DI void fill_dft_table(LAS unsigned char* Bi, int tid, int nrows) {
    for (int idx = tid; idx < nrows * 128; idx += 512) { const int n = idx >> 7, k = idx & 127, ap = n & 63, kk = k & 63; float s, c; sincospif((float)((kk * ap) & 63) / 32.0f, &s, &c);
        float v; if (n < 64) v = (k < 64) ? c : s; else v = (k < 64) ? -s : c;
        *(LAS unsigned short*)(Bi + n * 272 + k * 2) = (unsigned short)(pk2(v * 0.125f, 0.f) & 0xffffu); }
}
struct CfgDft1 {
    const bf16_t* Z; bf16_t* S1re; bf16_t* S1im;
    DI void fill_tables(LAS unsigned char* Bi, int tid) const { fill_dft_table(Bi, tid, 128); }
    DI int table_off(int) const { return 0; }
    DI const bf16_t* row_ptr(int item, int k) const { const int g = item & 3, b = (item >> 2) & 63, batch = item >> 8;
        return Z + ((size_t)batch * 4096 + 64 * (k & 63) + b) * 2048 + g * 512 + (k >> 6) * 256; }
    DI void epilogue(const f32x4 (&acc)[2][8], int item, int wid, int fr, int fq, LAS unsigned char* Bi) const {
        const int g = item & 3, b = (item >> 2) & 63, batch = item >> 8;
#pragma unroll
        for (int ni = 0; ni < 4; ++ni) { const int ap = 16 * ni + fr; float s, c; sincospif((float)(b * ap) * (1.0f / 2048.0f), &s, &c);
            const size_t tok = (size_t)batch * 4096 + 64 * ap + b;
#pragma unroll
            for (int i = 0; i < 2; ++i) { const f32x4 re = acc[i][ni], im = acc[i][ni + 4]; const f32x4 r2 = re * c + im * s, i2 = im * c - re * s;
                const size_t o = tok * 1024 + g * 256 + 32 * wid + 16 * i + 4 * fq;
                u32x2 w; w.x = pk2(r2[0], r2[1]); w.y = pk2(r2[2], r2[3]); *(u32x2*)(S1re + o) = w;
                w.x = pk2(i2[0], i2[1]); w.y = pk2(i2[2], i2[3]); *(u32x2*)(S1im + o) = w; } }
    }
};
struct CfgDft2 {
    const bf16_t* S1re; const bf16_t* S1im; const bf16_t* ZB; bf16_t* Y;
    DI void fill_tables(LAS unsigned char* Bi, int tid) const { fill_dft_table(Bi, tid, 64); }
    DI int table_off(int) const { return 0; }
    DI const bf16_t* row_ptr(int item, int k) const { const int g = item & 3, ap = (item >> 2) & 63, batch = item >> 8;
        return ((k >> 6) ? S1im : S1re) + ((size_t)batch * 4096 + 64 * ap + (k & 63)) * 1024 + g * 256; }
    DI void epilogue(const f32x4 (&acc)[2][4], int item, int wid, int fr, int fq, LAS unsigned char*) const {
        const int g = item & 3, ap = (item >> 2) & 63, batch = item >> 8;
#pragma unroll
        for (int ni = 0; ni < 4; ++ni) { const size_t tok = (size_t)batch * 4096 + ap + 64 * (16 * ni + fr);
#pragma unroll
            for (int i = 0; i < 2; ++i) { const int ch = g * 256 + 32 * wid + 16 * i + 4 * fq; const u32x2 z = *(const u32x2*)(ZB + tok * 1024 + ch); const f32x4 a = acc[i][ni];
                u32x2 w; w.x = pk2(a[0] * silu_f(lo_f(z.x)), a[1] * silu_f(hi_f(z.x))); w.y = pk2(a[2] * silu_f(lo_f(z.y)), a[3] * silu_f(hi_f(z.y)));
                *(u32x2*)(Y + tok * 2048 + 1024 + ch) = w; } }
    }
};
DI void fill_pool_tables(LAS unsigned char* Bi, int tid) {
    for (int idx = tid; idx < 4 * 4096; idx += 512) { const int g = idx >> 12, n = (idx >> 6) & 63, k = idx & 63, w = 2 << g, lo = n - w / 2, hi = n + w - w / 2;
        *(LAS unsigned short*)(Bi + g * 9216 + n * 144 + k * 2) = (k >= lo && k < hi) ? (unsigned short)0x3F80 : (unsigned short)0; }
}
DI float pool_rcnt(int g, int n) { const int w = 2 << g; int lo = n - w / 2, hi = n + w - w / 2; lo = lo < 0 ? 0 : lo; hi = hi > 64 ? 64 : hi; return 1.0f / (float)(hi - lo); }
struct CfgPoolA {
    const bf16_t* UC; bf16_t* PA;
    DI void fill_tables(LAS unsigned char* Bi, int tid) const { fill_pool_tables(Bi, tid); }
    DI int table_off(int item) const { return ((item & 7) >> 1) * 9216; }
    DI const bf16_t* row_ptr(int item, int k) const { const int ct = item & 7, c = (item >> 3) & 63, batch = item >> 9; return UC + ((size_t)batch * 4096 + 64 * k + c) * 2048 + ct * 256; }
    DI void epilogue(const f32x4 (&acc)[2][4], int item, int wid, int fr, int fq, LAS unsigned char*) const {
        const int ct = item & 7, c = (item >> 3) & 63, batch = item >> 9, g = ct >> 1;
#pragma unroll
        for (int ni = 0; ni < 4; ++ni) { const int n = 16 * ni + fr; const float rc = pool_rcnt(g, n); const size_t tok = (size_t)batch * 4096 + 64 * n + c;
#pragma unroll
            for (int i = 0; i < 2; ++i) { const f32x4 a = acc[i][ni] * rc; u32x2 w; w.x = pk2(a[0], a[1]); w.y = pk2(a[2], a[3]);
                *(u32x2*)(PA + tok * 2048 + ct * 256 + 32 * wid + 16 * i + 4 * fq) = w; } }
    }
};
struct CfgPoolB {
    const bf16_t* PA; bf16_t* UC;
    DI void fill_tables(LAS unsigned char* Bi, int tid) const { fill_pool_tables(Bi, tid); }
    DI int table_off(int item) const { return ((item & 7) >> 1) * 9216; }
    DI const bf16_t* row_ptr(int item, int k) const { const int ct = item & 7, rp = (item >> 3) & 63, batch = item >> 9; return PA + ((size_t)batch * 4096 + 64 * rp + k) * 2048 + ct * 256; }
    DI void epilogue(const f32x4 (&acc)[2][4], int item, int wid, int fr, int fq, LAS unsigned char*) const {
        const int ct = item & 7, rp = (item >> 3) & 63, batch = item >> 9, g = ct >> 1;
#pragma unroll
        for (int ni = 0; ni < 4; ++ni) { const int n = 16 * ni + fr; const float rc = pool_rcnt(g, n); const size_t tok = (size_t)batch * 4096 + 64 * rp + n;
#pragma unroll
            for (int i = 0; i < 2; ++i) { bf16_t* up = UC + tok * 2048 + ct * 256 + 32 * wid + 16 * i + 4 * fq; const u32x2 u = *(const u32x2*)up; const f32x4 a = acc[i][ni] * rc;
                u32x2 w; w.x = pk2(a[0] - lo_f(u.x), a[1] - hi_f(u.x)); w.y = pk2(a[2] - lo_f(u.y), a[3] - hi_f(u.y)); *(u32x2*)up = w; } }
    }
};

DI void ph_ya(const Params& p) {
    const int tid = opaque_tid(), wid = tid >> 6, lane = tid & 63;
    const bf16_t* HF = (const bf16_t*)p.ws; const bf16_t* HB = (const bf16_t*)(p.ws + PLANE); const bf16_t* O = (const bf16_t*)(p.ws + 3 * PLANE); const bf16_t* ZA = (const bf16_t*)(p.ws + 4 * PLANE);
    bf16_t* Y = (bf16_t*)p.out;
    f32x4 hg[4];
#pragma unroll
    for (int i = 0; i < 4; ++i) hg[i] = *(const f32x4*)(p.head_norm + lane * 16 + 4 * i);
    for (int r = blockIdx.x * 8 + wid; r < NX; r += gridDim.x * 8) {
        const size_t o = (size_t)r * 1024 + lane * 16;
        float gv[16], za[16]; float ss = 0.f;
#pragma unroll
        for (int hh = 0; hh < 2; ++hh) { const u32x4 a = *(const u32x4*)(HF + o + 8 * hh), bq = *(const u32x4*)(HB + o + 8 * hh), oo = *(const u32x4*)(O + o + 8 * hh), zz = *(const u32x4*)(ZA + o + 8 * hh);
#pragma unroll
            for (int e = 0; e < 4; ++e) { const float h0 = lo_f(a[e]) + lo_f(bq[e]), h1 = hi_f(a[e]) + hi_f(bq[e]);
                const float g0 = sigmoid_f(lo_f(oo[e])) * h0, g1 = sigmoid_f(hi_f(oo[e])) * h1;
                gv[8 * hh + 2 * e] = g0; gv[8 * hh + 2 * e + 1] = g1; ss += g0 * g0 + g1 * g1; za[8 * hh + 2 * e] = lo_f(zz[e]); za[8 * hh + 2 * e + 1] = hi_f(zz[e]); } }
        ss += __shfl_xor(ss, 1); ss += __shfl_xor(ss, 2); ss += __shfl_xor(ss, 4); ss += __shfl_xor(ss, 8);
        const float rstd = rsqrtf(ss * (1.0f / 256.0f) + 1e-6f);
        u32x4 w[2];
#pragma unroll
        for (int q = 0; q < 8; ++q) { const float y0 = gv[2 * q] * rstd * hg[q >> 1][(2 * q) & 3] * silu_f(za[2 * q]), y1 = gv[2 * q + 1] * rstd * hg[q >> 1][(2 * q + 1) & 3] * silu_f(za[2 * q + 1]);
            w[q >> 2][q & 3] = pk2(y0, y1); }
        *(u32x4*)(Y + (size_t)r * 2048 + lane * 16) = w[0]; *(u32x4*)(Y + (size_t)r * 2048 + lane * 16 + 8) = w[1];
    }
}


#define XB_TMO      128
#define XB_XCNT(j)  (256  + 64 * (j))
#define XB_XSUB(j)  (1280 + 64 * (j))
#define XB_XGEN(j)  (2304 + 64 * (j))
#define XB_TOP      3328
#define XB_TOPGEN   3392
#define XCD_BAR_WORDS 3456
#define XB_SPIN_CAP (1u << 18)
DI unsigned xb_ld(unsigned* p)              { return __hip_atomic_load(p, __ATOMIC_RELAXED, __HIP_MEMORY_SCOPE_AGENT); }
DI unsigned xb_add(unsigned* p, unsigned v) { return __hip_atomic_fetch_add(p, v, __ATOMIC_RELAXED, __HIP_MEMORY_SCOPE_AGENT); }
DI unsigned xb_xcc_id() { return (unsigned)__builtin_amdgcn_s_getreg((3 << 11) | 20) & 0xFu; }
#define XB_SPIN(cond, bar) do { unsigned _sp = 0; while (cond) { __builtin_amdgcn_s_sleep(1); \
    if ((++_sp & 255u) == 0u) { if (xb_ld(&(bar)[XB_TMO])) break; if (_sp > XB_SPIN_CAP) { atomicAdd(&(bar)[XB_TMO], 1u); break; } } } } while (0)
struct XcdBarrier { unsigned* bar; unsigned x; volatile LAS unsigned* st; };
DI XcdBarrier xcd_barrier_post(unsigned* bar, volatile LAS unsigned* st) {
    XcdBarrier b; b.bar = bar; b.x = xb_xcc_id(); b.st = st;
    if (threadIdx.x == 0) (void)xb_add(&bar[XB_XCNT(b.x)], 1u);
    return b;
}
DI void xcd_barrier_complete(unsigned* bar, unsigned x, unsigned& nloc, unsigned& nx) {
    const unsigned G = gridDim.x * gridDim.y * gridDim.z;
    unsigned sum, cnt, mine, sp = 0u;
    for (;;) {
        sum = 0u; cnt = 0u; mine = 0u;
#pragma unroll
        for (unsigned j = 0; j < 16; ++j) { const unsigned c = xb_ld(&bar[XB_XCNT(j)]); sum += c; cnt += (c > 0u) ? 1u : 0u; mine = (j == x) ? c : mine; }
        if (sum == G) break;
        __builtin_amdgcn_s_sleep(1);
        if ((++sp & 255u) == 0u) { if (xb_ld(&bar[XB_TMO])) break; if (sp > XB_SPIN_CAP) { atomicAdd(&bar[XB_TMO], 1u); break; } }
    }
    nloc = mine > 0u ? mine : 1u; nx = cnt > 0u ? cnt : 1u;
}
DI void xcd_barrier(const XcdBarrier& b) {
    asm volatile("s_waitcnt vmcnt(0)" ::: "memory");
    __syncthreads();
    if (threadIdx.x == 0) {
        unsigned* bar = b.bar;
        __builtin_amdgcn_s_waitcnt(0);
        unsigned nloc = b.st[0], nx = b.st[1];
        if (nloc == 0u) { xcd_barrier_complete(bar, b.x, nloc, nx); b.st[0] = nloc; b.st[1] = nx; }
        const unsigned old = xb_add(&bar[XB_XSUB(b.x)], 1u);
        const unsigned gen = old / nloc;
        if (old + 1u == (gen + 1u) * nloc) {
            __builtin_amdgcn_fence(__ATOMIC_RELEASE, "agent");
            asm volatile("s_waitcnt vmcnt(0)" ::: "memory");
            const unsigned og = xb_add(&bar[XB_TOP], 1u);
            const unsigned tg = og / nx;
            if (og + 1u == (tg + 1u) * nx) xb_add(&bar[XB_TOPGEN], 1u);
            else XB_SPIN(xb_ld(&bar[XB_TOPGEN]) == tg, bar);
            __builtin_amdgcn_fence(__ATOMIC_ACQUIRE, "agent");
            xb_add(&bar[XB_XGEN(b.x)], 1u);
            asm volatile("s_waitcnt vmcnt(0)" ::: "memory");
        } else {
            XB_SPIN(xb_ld(&bar[XB_XGEN(b.x)]) == gen, bar);
            __builtin_amdgcn_fence(__ATOMIC_ACQUIRE, "agent");
            asm volatile("s_waitcnt vmcnt(0)" ::: "memory");
        }
    }
    __syncthreads();
}

__global__ void __launch_bounds__(512, 2) mk_fwd(Params p, int ph_lo, int ph_hi) {
    extern __shared__ __attribute__((aligned(16))) unsigned char shm[];
    LAS unsigned char* lds = (LAS unsigned char*)shm;
    cg::grid_group grid = cg::this_grid();
    unsigned char* ws = p.ws;
    const int G = gridDim.x, c = blockIdx.x;
    volatile LAS unsigned* xst = (volatile LAS unsigned*)(lds + LDS_BYTES - 16);
    if (threadIdx.x == 0) { xst[0] = 0u; xst[1] = 0u; }
    __syncthreads();
    XcdBarrier xbar; xbar.bar = (unsigned*)(ws + WS_BAR); xbar.x = 0u; xbar.st = xst;
    if (ph_hi - ph_lo > 1) xbar = xcd_barrier_post((unsigned*)(ws + WS_BAR), xst);
    if (ph_lo > 1000) grid.sync();
#ifndef PHMASK
#define PHMASK 0xFFFF
#endif
#define GSYNC() xcd_barrier(xbar)
#ifndef REP_MASK
#define REP_MASK 0
#endif
#define PHASE(i, ...) if constexpr ((PHMASK >> (i)) & 1) if (ph_lo <= (i) && (i) < ph_hi) { __VA_ARGS__; if constexpr ((REP_MASK >> (i)) & 1) { __syncthreads(); __VA_ARGS__; } if ((i) + 1 < ph_hi) GSYNC(); }
    PHASE(0, ph_prep(p, lds));
    PHASE(1, ph_norm0(p, lds));
    PHASE(2, { GemmD g{(const bf16_t*)p.out, (const bf16_t*)(ws + WS_WINE), 1024, 1024, 0, 0, 1024}; Sched S{128, 28, 1, 8, 12, 128, G, c};
               EpiPlanes E{(bf16_t*)ws, (bf16_t*)(ws + WS_CRAW)}; gemm_phase(lds, g, S, E);
               if (G > 96 && c >= 96) transpose_jobs(p, lds, opaque_tid(), 2304, 4096, c - 96, G - 96); else if (G <= 96) transpose_jobs(p, lds, opaque_tid(), 2304, 4096, c, G); });
    PHASE(3, ph_conv(p));
    PHASE(4, ph_mlstm(p, lds));
    PHASE(5, { GemmD g{(const bf16_t*)(ws + 5 * PLANE), (const bf16_t*)(ws + WS_WF), 1024, 256, 256, 512 * 256, 256}; Sched S{128, 2, 4, 0, 0, 0, G, c};
               EpiBf E{(bf16_t*)p.out, nullptr, 2048, 512, 0, nullptr, nullptr}; gemm_phase(lds, g, S, E); });
    PHASE(6, { CfgDft1 cf{(const bf16_t*)p.out, (bf16_t*)(ws + 2 * PLANE), (bf16_t*)(ws + 5 * PLANE)}; axis_mix<128, 128>(cf, lds, 2048); });
    PHASE(7, { CfgDft2 cf{(const bf16_t*)(ws + 2 * PLANE), (const bf16_t*)(ws + 5 * PLANE), (const bf16_t*)(ws + 6 * PLANE), (bf16_t*)p.out}; axis_mix<128, 64>(cf, lds, 2048); ph_ya(p); });
    PHASE(8, { GemmD g{(const bf16_t*)p.out, (const bf16_t*)(ws + WS_WOUTE), 2048, 2048, 0, 0, 2048}; Sched S{128, 4, 1, 0, 0, 0, G, c};
               EpiRes E{(float*)ws, p.x, (const float*)(ws + WS_MOD) + 2048}; gemm_phase(lds, g, S, E); });
    PHASE(9, ph_norm1(p, 0));
    PHASE(10, { GemmD g{(const bf16_t*)(ws + 2 * PLANE), (const bf16_t*)(ws + WS_WINO), 1024, 1024, 0, 0, 1024}; Sched S{128, 16, 1, 0, 0, 0, G, c};
                EpiBf E{(bf16_t*)(ws + 3 * PLANE), (bf16_t*)(ws + 5 * PLANE), 2048, 0, 1, nullptr, nullptr}; gemm_phase(lds, g, S, E); });
    PHASE(11, { CfgPoolA cf{(const bf16_t*)(ws + 3 * PLANE), (bf16_t*)p.out}; axis_mix<64, 64>(cf, lds, 4096); });
    PHASE(12, { CfgPoolB cf{(const bf16_t*)p.out, (bf16_t*)(ws + 3 * PLANE)}; axis_mix<64, 64>(cf, lds, 4096); });
    PHASE(13, { GemmD g{(const bf16_t*)(ws + 3 * PLANE), (const bf16_t*)(ws + WS_WPOOL), 2048, 512, 512, 512 * 512, 512}; Sched S{128, 2, 4, 0, 0, 0, G, c};
                EpiBf E{(bf16_t*)p.out, nullptr, 2048, 512, 2, p.pool_scale, (const bf16_t*)(ws + 5 * PLANE)}; gemm_phase(lds, g, S, E); });
    PHASE(14, { GemmD g{(const bf16_t*)p.out, (const bf16_t*)(ws + WS_WOUTO), 2048, 2048, 0, 0, 2048}; Sched S{128, 4, 1, 0, 0, 0, G, c};
                EpiRes E{(float*)ws, (const float*)ws, (const float*)(ws + WS_MOD) + 9 * 3072 + 2048}; gemm_phase(lds, g, S, E); });
    PHASE(15, ph_norm1(p, 1));
#undef PHASE
#ifdef XSYNC
    for (int k = 0; k < XSYNC; ++k) GSYNC();
#endif
#ifdef DBG_STOP
    GSYNC();
    {   const size_t n = (size_t)NX * 1024; unsigned* o32 = (unsigned*)p.out;
        for (size_t i = (size_t)blockIdx.x * 512 + threadIdx.x; i < n; i += (size_t)gridDim.x * 512) {
            float v = 0.f;
            if (DBG_PLANES == -1) { const unsigned u = o32[i]; v = lo_f(u) + hi_f(u); }
            else if (DBG_PLANES == -2) { v = ((const float*)p.ws)[i]; }
            else { for (int pl = 0; pl < 7; ++pl) if ((DBG_PLANES >> pl) & 1) v += bf2f(((const bf16_t*)(p.ws + pl * PLANE))[i]); }
            if (!(fabsf(v) < 1e30f)) v = 12345.f;
            p.out[i] = v; } }
#endif
}

extern "C" void kernel_launch(void* const* d_in, const int* in_sizes, int n_in, void* d_out, int out_size, void* d_ws, size_t ws_size, hipStream_t stream) {
    static int grid = 0;
    if (grid == 0) {
        int dev = 0, cus = 0, per_cu = 0;
        hipGetDevice(&dev);
        hipDeviceGetAttribute(&cus, hipDeviceAttributeMultiprocessorCount, dev);
        if (hipFuncSetAttribute((const void*)mk_fwd, hipFuncAttributeMaxDynamicSharedMemorySize, LDS_BYTES) != hipSuccess) fprintf(stderr, "hipFuncSetAttribute failed\n");
        if (hipOccupancyMaxActiveBlocksPerMultiprocessor(&per_cu, (const void*)mk_fwd, 512, LDS_BYTES) != hipSuccess || per_cu < 1) { fprintf(stderr, "occupancy query: %d\n", per_cu); per_cu = 1; }
        (void)hipGetLastError();
        grid = cus * per_cu; if (grid > 256) grid = 256; if (grid < 1) grid = 1;
        if (ws_size < WS_END) fprintf(stderr, "workspace too small: %zu < %zu\n", ws_size, (size_t)WS_END);
    }
    Params p{};
    p.x = (const float*)d_in[0]; p.c = (const float*)d_in[1]; p.ctx = (const float*)d_in[2]; p.c_ctx = (const float*)d_in[3]; p.ada_w = (const float*)d_in[4]; p.ada_b = (const float*)d_in[5];
    p.norm_g = (const float*)d_in[6]; p.win_even = (const float*)d_in[7]; p.gate_b = (const float*)d_in[8]; p.conv_qk = (const float*)d_in[9]; p.head_norm = (const float*)d_in[10];
    p.fourier_w = (const float*)d_in[11]; p.wout_even = (const float*)d_in[12]; p.win_odd = (const float*)d_in[13]; p.pool_w = (const float*)d_in[14]; p.pool_scale = (const float*)d_in[15];
    p.wout_odd = (const float*)d_in[16]; p.final_g = (const float*)d_in[17]; p.out = (float*)d_out; p.ws = (unsigned char*)d_ws;
    (void)hipMemsetAsync((unsigned char*)d_ws + WS_BAR, 0, XCD_BAR_WORDS * 4, stream);
#if MK_MULTI
    for (int ph = 0; ph < 16; ++ph) { hipLaunchKernelGGL(mk_fwd, dim3(grid), dim3(512), LDS_BYTES, stream, p, ph, ph + 1); }
#else
#ifdef DBG_STOP
    int lo = 0, hi = DBG_STOP;
#else
    int lo = 0, hi = 16;
#endif
    void* args[] = {&p, &lo, &hi};
    hipError_t e = hipLaunchCooperativeKernel((void*)mk_fwd, dim3(grid), dim3(512), args, LDS_BYTES, stream);
    if (e != hipSuccess) fprintf(stderr, "cooperative launch failed: %s (grid %d)\n", hipGetErrorString(e), grid);
#endif
}
```

```cpp
#include <hip/hip_runtime.h>
#include <hip/hip_cooperative_groups.h>
#include <cstdio>
namespace cg = cooperative_groups;

#ifndef MK_MULTI
#define MK_MULTI 0
#endif

#define LAS __attribute__((address_space(3)))
typedef unsigned short bf16_t;
typedef short bf16x8 __attribute__((ext_vector_type(8)));
typedef short s16x4 __attribute__((ext_vector_type(4)));
typedef float f32x4 __attribute__((ext_vector_type(4)));
typedef unsigned u32x4 __attribute__((ext_vector_type(4)));
typedef unsigned u32x2 __attribute__((ext_vector_type(2)));

constexpr int NX = 32768, NCX = 2048, NR = NX + NCX;
constexpr size_t PLANE = (size_t)NX * 1024 * 2;
constexpr size_t WS_EXTRA = 7 * PLANE;
constexpr size_t WS_WINE  = WS_EXTRA;
constexpr size_t WS_WOUTE = WS_WINE  + (size_t)7168 * 1024 * 2;
constexpr size_t WS_WINO  = WS_WOUTE + (size_t)1024 * 2048 * 2;
constexpr size_t WS_WPOOL = WS_WINO  + (size_t)4096 * 1024 * 2;
constexpr size_t WS_WOUTO = WS_WPOOL + (size_t)4 * 512 * 512 * 2;
constexpr size_t WS_WF    = WS_WOUTO + (size_t)1024 * 2048 * 2;
constexpr size_t WS_MOD   = WS_WF    + (size_t)4 * 512 * 256 * 2;
constexpr size_t WS_GATES = WS_MOD   + 262144;
constexpr size_t WS_CRAW  = WS_GATES + (size_t)NR * 16 * 4;
constexpr size_t WS_CQC   = WS_CRAW  + (size_t)3 * NCX * 1024 * 2;
constexpr size_t WS_CKC   = WS_CQC   + (size_t)NCX * 1024 * 2;
constexpr size_t WS_END   = WS_CKC   + (size_t)NCX * 1024 * 2;
constexpr size_t WS_GPRE  = WS_END + 16384;
constexpr size_t WS_GPRE_END = WS_GPRE + (size_t)64 * 68 * 384 * 4;
static_assert(WS_GPRE_END <= (size_t)512 * 1024 * 1024, "gate tables exceed the workspace");
constexpr size_t WS_BAR   = WS_END;
static_assert(WS_BAR + 16384 <= (size_t)512 * 1024 * 1024, "workspace map exceeds 512 MiB");

constexpr int LDS_BYTES = 155648;

struct Params {
    const float* x; const float* c; const float* ctx; const float* c_ctx; const float* ada_w; const float* ada_b; const float* norm_g;
    const float* win_even; const float* gate_b; const float* conv_qk; const float* head_norm; const float* fourier_w; const float* wout_even;
    const float* win_odd; const float* pool_w; const float* pool_scale; const float* wout_odd; const float* final_g;
    float* out; unsigned char* ws;
};

#define DI __device__ __forceinline__
DI float bf2f(unsigned short b) { return __uint_as_float(((unsigned)b) << 16); }
DI float lo_f(unsigned u) { return __uint_as_float(u << 16); }
DI float hi_f(unsigned u) { return __uint_as_float(u & 0xffff0000u); }
typedef __bf16 bf16v2_t __attribute__((ext_vector_type(2)));
typedef float f32v2_t __attribute__((ext_vector_type(2)));
DI unsigned pk2(float lo, float hi) { const f32v2_t v = {lo, hi}; const bf16v2_t b = __builtin_convertvector(v, bf16v2_t); return __builtin_bit_cast(unsigned, b); }
DI float silu_f(float x) { return x / (1.0f + __expf(-x)); }
DI float sigmoid_f(float x) { return 1.0f / (1.0f + __expf(-x)); }
DI int opaque_tid() { int t = threadIdx.x; asm volatile("" : "+v"(t)); return t; }
DI float wave_sum(float v) { for (int o = 32; o > 0; o >>= 1) v += __shfl_xor(v, o); return v; }
DI float wave_max(float v) { for (int o = 32; o > 0; o >>= 1) v = fmaxf(v, __shfl_xor(v, o)); return v; }
DI f32x4 mfma16(bf16x8 a, bf16x8 b, f32x4 c) { return __builtin_amdgcn_mfma_f32_16x16x32_bf16(a, b, c, 0, 0, 0); }
DI bf16x8 tr_frag(LAS unsigned char* img, int pitch, int krow0, int col0, int lane) {
    const int g = lane >> 4, q = (lane & 15) >> 2, pp = lane & 3;
    LAS unsigned char* a0 = img + (krow0 + 8 * g + q) * pitch + col0 * 2 + 8 * pp;
    s16x4 lo = __builtin_amdgcn_ds_read_tr16_b64_v4i16((LAS s16x4*)a0);
    s16x4 hi = __builtin_amdgcn_ds_read_tr16_b64_v4i16((LAS s16x4*)(a0 + 4 * pitch));
    return __builtin_shufflevector(lo, hi, 0, 1, 2, 3, 4, 5, 6, 7);
}

constexpr int HTB = 128 * 64 * 2;
DI int lds_byte(int r, int c) { const int st = (r >> 4) * 2 + (c >> 5), rr = r & 15, cc = c & 31, ob = rr * 64 + cc * 2; return st * 1024 + (ob ^ (((ob >> 9) & 1) << 5)); }
DI void stage_rc(int b, int& R, int& C) { const int st = b / 1024, sb = b % 1024, swz = sb ^ (((sb >> 9) & 1) << 5); R = (st >> 1) * 16 + swz / 64; C = (st & 1) * 32 + (swz % 64) / 2; }
DI int perm32(int rho) { const int n = rho >> 4, i = rho & 15; return 8 * (i >> 2) + 4 * n + (i & 3); }

struct Unit { int pm, pn, g; };
struct GemmD { const bf16_t* A; const bf16_t* Bt; int lda, ldb; long a_gs, b_gs; int K; };
struct Sched {
    int nM, nN, nG, nM2, nN2, pm2off, G, c;
    DI bool next(int i, Unit& u) const {
        const int L = i * G + c; const int nwg = nM * nN, tot1 = nwg * nG;
        const bool first = L < tot1;
        const int L1 = first ? L : 0;
        const int g = L1 / nwg; int wgid = L1 - g * nwg;
        { const int q = nwg / 8, r = nwg % 8, xcd = wgid % 8, off = wgid / 8; wgid = (xcd < r ? xcd * (q + 1) : r * (q + 1) + (xcd - r) * q) + off; }
        const int nig = 8 * nN, gid = wgid / nig, fm = gid * 8, gsz = (nM - fm) < 8 ? (nM - fm) : 8;
        const int pm1 = fm + ((wgid % nig) % gsz), pn1 = (wgid % nig) / gsz;
        const int L2 = first ? 0 : L - tot1, d2 = nM2 > 0 ? nM2 : 1;
        const int pm2 = pm2off + L2 % d2, pn2 = L2 / d2;
        u.pm = first ? pm1 : pm2; u.pn = first ? pn1 : pn2; u.g = first ? g : 0;
        return first || (L2 < nM2 * nN2);
    }
};

template <class Epi>
DI void gemm_phase(LAS unsigned char* lds, const GemmD g, const Sched& S, const Epi& E) {
    const int tid = opaque_tid(), wid = __builtin_amdgcn_readfirstlane(tid >> 6), lane = tid & 63, wr = wid >> 2, wc = wid & 3, fr = lane & 15, fq = lane >> 4;
    const int K = g.K, nt = K / 64;
    unsigned voffA[2], voffB[2];
#pragma unroll
    for (int i = 0; i < 2; ++i) { int R, C; stage_rc(tid * 16 + i * 8192, R, C); const int Rb = Epi::PERM ? ((R & ~31) + perm32(R & 31)) : R;
        voffA[i] = (unsigned)(R * g.lda + C) * 2u; voffB[i] = (unsigned)(Rb * g.ldb + C) * 2u; }
    const size_t kstep = 128;
    const size_t hstepA = (size_t)128 * g.lda * 2, hstepB = (size_t)128 * g.ldb * 2;
    const unsigned ldsw = (unsigned)wid * 1024u;
    const int aoff = lds_byte(wr * 64 + fr, fq * 8), boff = lds_byte(wc * 32 + fr, fq * 8);
#define G_SA(b, h) (((b) * 2 + (h)) * HTB)
#define G_SB(b, h) ((4 + (b) * 2 + (h)) * HTB)
#define G_STAGE(bufoff, gbase, voff) do { _Pragma("unroll") for (int _i = 0; _i < 2; ++_i) \
        __builtin_amdgcn_global_load_lds((const unsigned*)((const char*)(gbase) + (voff)[_i]), (LAS unsigned*)(lds + (bufoff) + ldsw + _i * 8192), 16, 0, 0); } while (0)
#define G_LDA(dst, b, h) do { _Pragma("unroll") for (int m = 0; m < 4; ++m) _Pragma("unroll") for (int k = 0; k < 2; ++k) dst[m][k] = *(const LAS bf16x8*)(lds + G_SA(b, h) + aoff + m * 2048 + k * 1024); } while (0)
#define G_LDB(dst, b, h) do { _Pragma("unroll") for (int n = 0; n < 2; ++n) _Pragma("unroll") for (int k = 0; k < 2; ++k) dst[n][k] = *(const LAS bf16x8*)(lds + G_SB(b, h) + boff + n * 2048 + k * 1024); } while (0)
#define G_MMA(ai, bj, At, Bt) do { __builtin_amdgcn_s_setprio(1); _Pragma("unroll") for (int m = 0; m < 4; ++m) _Pragma("unroll") for (int n = 0; n < 2; ++n) _Pragma("unroll") for (int k = 0; k < 2; ++k) \
        acc[ai][bj][m][n] = __builtin_amdgcn_mfma_f32_16x16x32_bf16(Bt[n][k], At[m][k], acc[ai][bj][m][n], 0, 0, 0); __builtin_amdgcn_s_setprio(0); } while (0)
#define G_WAIT_V(n) asm volatile("s_waitcnt vmcnt(" #n ")" ::: "memory")
#define G_WAIT_L(n) asm volatile("s_waitcnt lgkmcnt(" #n ")" ::: "memory")
#define G_BAR __builtin_amdgcn_s_barrier()
#define G_SCHED __builtin_amdgcn_sched_barrier(0)
    Unit cur, nxt; int ui = 0;
    if (!S.next(0, cur)) return;
    f32x4 acc[2][2][4][2];
#pragma unroll
    for (int a = 0; a < 2; ++a)
#pragma unroll
        for (int b = 0; b < 2; ++b)
#pragma unroll
            for (int m = 0; m < 4; ++m)
#pragma unroll
                for (int n = 0; n < 2; ++n) acc[a][b][m][n] = (f32x4){0.f, 0.f, 0.f, 0.f};
    bf16x8 At[4][2], B0[2][2], B1[2][2];
    const char* cA = (const char*)(g.A + (long)cur.g * g.a_gs) + (size_t)cur.pm * 2 * hstepA;
    const char* cB = (const char*)(g.Bt + (long)cur.g * g.b_gs) + (size_t)cur.pn * 2 * hstepB;
    G_STAGE(G_SB(0, 0), cB, voffB); G_STAGE(G_SA(0, 0), cA, voffA); G_STAGE(G_SB(0, 1), cB + hstepB, voffB); G_STAGE(G_SA(0, 1), cA + hstepA, voffA);
    if (wr == 1) G_BAR;
    G_WAIT_V(4); G_BAR;
    G_STAGE(G_SB(1, 0), cB + kstep, voffB); G_STAGE(G_SA(1, 0), cA + kstep, voffA); G_STAGE(G_SB(1, 1), cB + hstepB + kstep, voffB);
    G_WAIT_V(6); G_BAR;
    for (;;) {
        const bool has_next = S.next(ui + 1, nxt);
        const char* nA = has_next ? (const char*)(g.A + (long)nxt.g * g.a_gs) + (size_t)nxt.pm * 2 * hstepA : cA;
        const char* nB = has_next ? (const char*)(g.Bt + (long)nxt.g * g.b_gs) + (size_t)nxt.pn * 2 * hstepB : cB;
        for (int t = 0; t < nt; t += 2) {
            const bool last = (t == nt - 2);
            const char* a1 = cA + (size_t)(t + 1) * kstep;
            const char* a2 = last ? nA : cA + (size_t)(t + 2) * kstep; const char* b2 = last ? nB : cB + (size_t)(t + 2) * kstep;
            const char* a3 = a2 + kstep; const char* b3 = b2 + kstep;
            G_LDB(B0, 0, 0); G_SCHED; G_LDA(At, 0, 0); G_STAGE(G_SA(1, 1), a1 + hstepA, voffA);
            G_WAIT_L(8); G_BAR; G_WAIT_L(0); G_MMA(0, 0, At, B0); G_BAR; G_SCHED;
            G_LDB(B1, 0, 1); G_STAGE(G_SB(0, 0), b2, voffB);
            G_BAR; G_WAIT_L(0); G_MMA(0, 1, At, B1); G_BAR;
            G_LDA(At, 0, 1); G_STAGE(G_SA(0, 0), a2, voffA);
            G_BAR; G_WAIT_L(0); G_MMA(1, 0, At, B0); G_BAR; G_SCHED;
            G_STAGE(G_SB(0, 1), b2 + hstepB, voffB);
            G_WAIT_V(6); G_BAR; G_MMA(1, 1, At, B1); G_BAR;
            G_LDB(B0, 1, 0); G_SCHED; G_LDA(At, 1, 0); G_STAGE(G_SA(0, 1), a2 + hstepA, voffA);
            G_WAIT_L(8); G_BAR; G_WAIT_L(0); G_MMA(0, 0, At, B0); G_BAR; G_SCHED;
            G_LDB(B1, 1, 1); G_STAGE(G_SB(1, 0), b3, voffB);
            G_BAR; G_WAIT_L(0); G_MMA(0, 1, At, B1); G_BAR;
            G_LDA(At, 1, 1); G_STAGE(G_SA(1, 0), a3, voffA);
            G_BAR; G_WAIT_L(0); G_MMA(1, 0, At, B0); G_BAR; G_SCHED;
            G_STAGE(G_SB(1, 1), b3 + hstepB, voffB);
            G_WAIT_V(6); G_BAR; G_MMA(1, 1, At, B1); G_BAR;
        }
        E(acc, cur, wr, wc, fr, fq);
        if (!has_next) break;
#pragma unroll
        for (int a = 0; a < 2; ++a)
#pragma unroll
            for (int b = 0; b < 2; ++b)
#pragma unroll
                for (int m = 0; m < 4; ++m)
#pragma unroll
                    for (int n = 0; n < 2; ++n) acc[a][b][m][n] = (f32x4){0.f, 0.f, 0.f, 0.f};
        cur = nxt; cA = nA; cB = nB; ++ui;
    }
    G_WAIT_V(0);
    if (wr == 0) G_BAR;
    G_BAR;
}

struct EpiPlanes {
    static constexpr bool PERM = true;
    bf16_t* xbase; bf16_t* cbase;
    DI void operator()(const f32x4 (&acc)[2][2][4][2], const Unit& u, int wr, int wc, int fr, int fq) const {
        const int plane = u.pn >> 2, colt = (u.pn & 3) * 256;
        bf16_t* base; int row0;
        if (u.pm < 128) { base = xbase + (size_t)plane * NX * 1024; row0 = u.pm * 256 + wr * 64 + fr; }
        else { base = cbase + (size_t)plane * NCX * 1024; row0 = (u.pm - 128) * 256 + wr * 64 + fr; }
        const int col0 = colt + wc * 32 + 8 * fq;
#pragma unroll
        for (int ai = 0; ai < 2; ++ai)
#pragma unroll
            for (int m = 0; m < 4; ++m) { bf16_t* rowp = base + (size_t)(row0 + ai * 128 + m * 16) * 1024 + col0;
#pragma unroll
                for (int bj = 0; bj < 2; ++bj) { const f32x4 v0 = acc[ai][bj][m][0], v1 = acc[ai][bj][m][1];
                    u32x4 w; w.x = pk2(v0[0], v0[1]); w.y = pk2(v0[2], v0[3]); w.z = pk2(v1[0], v1[1]); w.w = pk2(v1[2], v1[3]);
                    *(u32x4*)(rowp + bj * 128) = w; } }
    }
};
struct EpiBf {
    static constexpr bool PERM = true;
    bf16_t* O; bf16_t* O2; int ldc; int gcol; int mode; const float* scale; const bf16_t* zc;
    DI void operator()(const f32x4 (&acc)[2][2][4][2], const Unit& u, int wr, int wc, int fr, int fq) const {
        const int row0 = u.pm * 256 + wr * 64 + fr;
        bf16_t* base = O; int pn = u.pn; bool act = false;
        if (mode == 1 && pn >= 8) { base = O2; pn -= 8; act = true; }
        const int col0 = u.g * gcol + pn * 256 + wc * 32 + 8 * fq;
        f32x4 sc[2][2];
#pragma unroll
        for (int bj = 0; bj < 2; ++bj) { sc[bj][0] = (mode == 2) ? *(const f32x4*)(scale + col0 + bj * 128) : (f32x4){1.f, 1.f, 1.f, 1.f}; sc[bj][1] = (mode == 2) ? *(const f32x4*)(scale + col0 + bj * 128 + 4) : (f32x4){1.f, 1.f, 1.f, 1.f}; }
#pragma unroll
        for (int ai = 0; ai < 2; ++ai) {
            u32x4 zz[4][2];
            if (mode == 2) {
#pragma unroll
                for (int m = 0; m < 4; ++m)
#pragma unroll
                    for (int bj = 0; bj < 2; ++bj) zz[m][bj] = *(const volatile u32x4*)(zc + (size_t)(row0 + ai * 128 + m * 16) * ldc + col0 + bj * 128); }
#pragma unroll
            for (int m = 0; m < 4; ++m) { const size_t ro = (size_t)(row0 + ai * 128 + m * 16) * ldc + col0;
#pragma unroll
                for (int bj = 0; bj < 2; ++bj) { f32x4 v0 = acc[ai][bj][m][0], v1 = acc[ai][bj][m][1];
                    if (act) {
#pragma unroll
                        for (int j = 0; j < 4; ++j) { v0[j] = silu_f(v0[j]); v1[j] = silu_f(v1[j]); } }
                    if (mode == 2) {
                        const u32x4 z = zz[m][bj]; const f32x4 s0 = sc[bj][0], s1 = sc[bj][1];
                        v0[0] *= s0[0] * lo_f(z.x); v0[1] *= s0[1] * hi_f(z.x); v0[2] *= s0[2] * lo_f(z.y); v0[3] *= s0[3] * hi_f(z.y);
                        v1[0] *= s1[0] * lo_f(z.z); v1[1] *= s1[1] * hi_f(z.z); v1[2] *= s1[2] * lo_f(z.w); v1[3] *= s1[3] * hi_f(z.w);
                    }
                    u32x4 w; w.x = pk2(v0[0], v0[1]); w.y = pk2(v0[2], v0[3]); w.z = pk2(v1[0], v1[1]); w.w = pk2(v1[2], v1[3]);
                    *(u32x4*)(base + ro + bj * 128) = w; } } }
    }
};
struct EpiGate {
    static constexpr bool PERM = true;
    bf16_t* O; const float* gate;
    DI void operator()(const f32x4 (&acc)[2][2][4][2], const Unit& u, int wr, int wc, int fr, int fq) const {
        const int row0 = u.pm * 256 + wr * 64 + fr, col0 = u.pn * 256 + wc * 32 + 8 * fq;
        const float* gp = gate + (size_t)(u.pm >> 4) * 3072 + col0;
        f32x4 gv[2][2];
#pragma unroll
        for (int bj = 0; bj < 2; ++bj) { gv[bj][0] = *(const f32x4*)(gp + bj * 128); gv[bj][1] = *(const f32x4*)(gp + bj * 128 + 4); }
#pragma unroll
        for (int ai = 0; ai < 2; ++ai)
#pragma unroll
            for (int m = 0; m < 4; ++m) { bf16_t* rowp = O + (size_t)(row0 + ai * 128 + m * 16) * 1024 + col0;
#pragma unroll
                for (int bj = 0; bj < 2; ++bj) { const f32x4 v0 = acc[ai][bj][m][0] * gv[bj][0], v1 = acc[ai][bj][m][1] * gv[bj][1];
                    u32x4 w; w.x = pk2(v0[0], v0[1]); w.y = pk2(v0[2], v0[3]); w.z = pk2(v1[0], v1[1]); w.w = pk2(v1[2], v1[3]);
                    *(u32x4*)(rowp + bj * 128) = w; } }
    }
};
struct EpiRes {
    static constexpr bool PERM = false;
    float* O; const float* res; const float* gate;
    DI void operator()(const f32x4 (&acc)[2][2][4][2], const Unit& u, int wr, int wc, int fr, int fq) const {
        const int row0 = u.pm * 256 + wr * 64 + fr, col0 = u.pn * 256 + wc * 32 + 4 * fq;
        const float* gp = gate + (size_t)(u.pm >> 4) * 3072 + col0;
        f32x4 gv[2][2];
#pragma unroll
        for (int bj = 0; bj < 2; ++bj)
#pragma unroll
            for (int n = 0; n < 2; ++n) gv[bj][n] = *(const f32x4*)(gp + bj * 128 + n * 16);
#pragma unroll
        for (int ai = 0; ai < 2; ++ai)
#pragma unroll
            for (int mp = 0; mp < 2; ++mp) {
                f32x4 r[2][2][2];
#pragma unroll
                for (int mm = 0; mm < 2; ++mm) { const size_t ro = (size_t)(row0 + ai * 128 + (2 * mp + mm) * 16) * 1024 + col0;
#pragma unroll
                    for (int bj = 0; bj < 2; ++bj)
#pragma unroll
                        for (int n = 0; n < 2; ++n) r[mm][bj][n] = *(const volatile f32x4*)(res + ro + bj * 128 + n * 16); }
#pragma unroll
                for (int mm = 0; mm < 2; ++mm) { const size_t ro = (size_t)(row0 + ai * 128 + (2 * mp + mm) * 16) * 1024 + col0;
#pragma unroll
                    for (int bj = 0; bj < 2; ++bj)
#pragma unroll
                        for (int n = 0; n < 2; ++n) *(f32x4*)(O + ro + bj * 128 + n * 16) = r[mm][bj][n] + gv[bj][n] * acc[ai][bj][2 * mp + mm][n]; }
            }
    }
};

DI void transpose_jobs(const Params& p, LAS unsigned char* lds, int tid, int j_lo, int j_hi, int w, int nw) {
    LAS float* tile = (LAS float*)lds;
    {
        auto job_desc = [&](int job, const float*& src, bf16_t*& dst, int& K, int& Nt, int& k0, int& n0) {
            int j = job, tk, tn;
            if (j < 1792) { src = p.win_even; dst = (bf16_t*)(p.ws + WS_WINE); K = 1024; Nt = 7184; tk = j & 15; tn = j >> 4; }
            else if ((j -= 1792) < 512) { src = p.wout_even; dst = (bf16_t*)(p.ws + WS_WOUTE); K = 2048; Nt = 1024; tk = j & 31; tn = j >> 5; }
            else if ((j -= 512) < 1024) { src = p.win_odd; dst = (bf16_t*)(p.ws + WS_WINO); K = 1024; Nt = 4096; tk = j & 15; tn = j >> 4; }
            else if ((j -= 1024) < 256) { const int g = j >> 6, jj = j & 63; src = p.pool_w + (size_t)g * 512 * 512; dst = (bf16_t*)(p.ws + WS_WPOOL) + (size_t)g * 512 * 512; K = 512; Nt = 512; tk = jj & 7; tn = jj >> 3; }
            else { j -= 256; src = p.wout_odd; dst = (bf16_t*)(p.ws + WS_WOUTO); K = 2048; Nt = 1024; tk = j & 31; tn = j >> 5; }
            k0 = tk * 64; n0 = tn * 64; };
        float rg[8];
        int job = j_lo + w;
        if (job < j_hi) { const float* src; bf16_t* dst; int K, Nt, k0, n0; job_desc(job, src, dst, K, Nt, k0, n0);
#pragma unroll
            for (int i = 0; i < 8; ++i) { const int idx = tid + 512 * i, k = idx >> 6, n = idx & 63; rg[i] = src[(size_t)(k0 + k) * Nt + n0 + n]; } }
        for (; job < j_hi; job += nw) {
            const float* src; bf16_t* dst; int K, Nt, k0, n0; job_desc(job, src, dst, K, Nt, k0, n0);
            __syncthreads();
#pragma unroll
            for (int i = 0; i < 8; ++i) { const int idx = tid + 512 * i, k = idx >> 6, n = idx & 63; tile[k * 65 + n] = rg[i]; }
            __syncthreads();
            const int nj = job + nw;
            if (nj < j_hi) { const float* s2; bf16_t* d2; int K2, Nt2, k2, n2; job_desc(nj, s2, d2, K2, Nt2, k2, n2);
#pragma unroll
                for (int i = 0; i < 8; ++i) { const int idx = tid + 512 * i, k = idx >> 6, n = idx & 63; rg[i] = s2[(size_t)(k2 + k) * Nt2 + n2 + n]; } }
#pragma unroll
            for (int i = 0; i < 4; ++i) { const int idx = tid + 512 * i, n = idx >> 5, k = (idx & 31) * 2;
                *(unsigned*)(dst + (size_t)(n0 + n) * K + k0 + k) = pk2(tile[k * 65 + n], tile[(k + 1) * 65 + n]); }
        }
        __syncthreads();
    }
}
DI void ph_prep(const Params& p, LAS unsigned char* lds) {
    const int tid = opaque_tid();
    transpose_jobs(p, lds, tid, 0, 2304, blockIdx.x, gridDim.x);
    LAS float* sv = (LAS float*)(lds + 32768);
    LAS float* red = (LAS float*)(lds + 32768 + 36864);
    LAS float* ct = (LAS float*)(lds + 90112); LAS float* st = ct + 256;
    for (int idx = tid; idx < 9216; idx += 512) { const int v = idx >> 10, k = idx & 1023; const float cv = (v < 8) ? p.c[v * 1024 + k] : p.c_ctx[k]; sv[idx] = silu_f(cv); }
    if (tid < 256) { float s, c; sincospif((float)tid / 128.0f, &s, &c); ct[tid] = c; st[tid] = s; }
    __syncthreads();
    float* MOD = (float*)(p.ws + WS_MOD);
    for (int item = blockIdx.x; item < 192; item += gridDim.x) {
        const int l = item / 96, c0 = (item % 96) * 32, kg = tid >> 5, col = tid & 31;
        float a[9];
#pragma unroll
        for (int v = 0; v < 9; ++v) a[v] = 0.f;
        const float* w = p.ada_w + (size_t)l * 1024 * 3072 + c0 + col;
#pragma unroll 16
        for (int k = kg; k < 1024; k += 16) { const float wv = w[(size_t)k * 3072];
#pragma unroll
            for (int v = 0; v < 9; ++v) a[v] += sv[v * 1024 + k] * wv; }
#pragma unroll
        for (int v = 0; v < 9; ++v) red[(kg * 32 + col) * 9 + v] = a[v];
        __syncthreads();
        if (tid < 288) { const int v = tid >> 5, cc = tid & 31; float s = 0.f; for (int q = 0; q < 16; ++q) s += red[(q * 32 + cc) * 9 + v];
            MOD[(size_t)(l * 9 + v) * 3072 + c0 + cc] = s + p.ada_b[l * 3072 + c0 + cc]; }
        __syncthreads();
    }
    bf16_t* WF = (bf16_t*)(p.ws + WS_WF);
    for (int it = blockIdx.x; it < 512; it += gridDim.x) {
        const int idx = it * 512 + tid, d = idx & 255, c = (idx >> 8) & 255, g = idx >> 16;
        const float* f = p.fourier_w + (size_t)g * 65536 + d;
        float aP = 0.f, aQ = 0.f;
#pragma unroll 16
        for (int cp = 0; cp < 256; ++cp) { const float fv = f[cp * 256]; const int a = (c * cp) & 255; aP += ct[a] * fv; aQ += st[a] * fv; }
        WF[(size_t)(g * 512 + d) * 256 + c] = (bf16_t)(pk2(aP * 0.0625f, 0.f) & 0xffffu);
        WF[(size_t)(g * 512 + 256 + d) * 256 + c] = (bf16_t)(pk2(-aQ * 0.0625f, 0.f) & 0xffffu);
    }
}

DI void ph_norm0(const Params& p, LAS unsigned char* lds) {
    const int tid = opaque_tid(), wid = tid >> 6, lane = tid & 63;
    LAS float* wg = (LAS float*)lds;
#pragma unroll 4
    for (int i = 0; i < 32; ++i) { const int idx = tid + 512 * i, k = idx >> 4, j = idx & 15; wg[j * 1024 + k] = p.win_even[(size_t)k * 7184 + 7168 + j]; }
    __syncthreads();
    f32x4 g[4];
#pragma unroll
    for (int i = 0; i < 4; ++i) g[i] = *(const f32x4*)(p.norm_g + lane * 4 + 256 * i);
    const float* MOD = (const float*)(p.ws + WS_MOD);
    bf16_t* HX = (bf16_t*)p.out;
    float* GATES = (float*)(p.ws + WS_GATES);
    f32x4 vn[4];
    { const int r = blockIdx.x * 8 + wid; if (r < NR) { const float* src = (r < NX) ? p.x + (size_t)r * 1024 : p.ctx + (size_t)(r - NX) * 1024;
#pragma unroll
        for (int i = 0; i < 4; ++i) vn[i] = *(const f32x4*)(src + lane * 4 + 256 * i); } }
    for (int r = blockIdx.x * 8 + wid; r < NR; r += gridDim.x * 8) {
        const float* md;
        if (r < NX) { md = MOD + (size_t)(r >> 12) * 3072; } else { md = MOD + (size_t)8 * 3072; }
        f32x4 v[4]; float ss = 0.f;
#pragma unroll
        for (int i = 0; i < 4; ++i) { v[i] = vn[i]; ss += v[i][0] * v[i][0] + v[i][1] * v[i][1] + v[i][2] * v[i][2] + v[i][3] * v[i][3]; }
        { const int r2 = r + gridDim.x * 8; if (r2 < NR) { const float* s2 = (r2 < NX) ? p.x + (size_t)r2 * 1024 : p.ctx + (size_t)(r2 - NX) * 1024;
#pragma unroll
            for (int i = 0; i < 4; ++i) vn[i] = *(const f32x4*)(s2 + lane * 4 + 256 * i); } }
        ss = wave_sum(ss);
        const float rstd = rsqrtf(ss * (1.0f / 1024.0f) + 1e-6f);
#pragma unroll
        for (int i = 0; i < 4; ++i) { const f32x4 sh = *(const f32x4*)(md + lane * 4 + 256 * i), sc = *(const f32x4*)(md + 1024 + lane * 4 + 256 * i);
            v[i] = v[i] * rstd * g[i] * (sc + 1.0f) + sh;
            u32x2 w; w.x = pk2(v[i][0], v[i][1]); w.y = pk2(v[i][2], v[i][3]);
            *(u32x2*)(HX + (size_t)r * 1024 + lane * 4 + 256 * i) = w; }
        float pt[16];
#pragma unroll
        for (int j = 0; j < 16; ++j) { float a = 0.f;
#pragma unroll
            for (int i = 0; i < 4; ++i) { const f32x4 w4 = *(const LAS f32x4*)(wg + j * 1024 + lane * 4 + 256 * i); a += v[i][0] * w4[0] + v[i][1] * w4[1] + v[i][2] * w4[2] + v[i][3] * w4[3]; }
            pt[j] = a; if ((j & 3) == 3) __builtin_amdgcn_sched_barrier(0); }
        { const bool b5 = lane & 32;
#pragma unroll
          for (int j = 0; j < 8; ++j) { const float snd = b5 ? pt[j] : pt[j + 8], kp = b5 ? pt[j + 8] : pt[j]; pt[j] = kp + __shfl_xor(snd, 32); } }
        { const bool b4 = lane & 16;
#pragma unroll
          for (int j = 0; j < 4; ++j) { const float snd = b4 ? pt[j] : pt[j + 4], kp = b4 ? pt[j + 4] : pt[j]; pt[j] = kp + __shfl_xor(snd, 16); } }
        { const bool b3 = lane & 8;
#pragma unroll
          for (int j = 0; j < 2; ++j) { const float snd = b3 ? pt[j] : pt[j + 2], kp = b3 ? pt[j + 2] : pt[j]; pt[j] = kp + __shfl_xor(snd, 8); } }
        { const bool b2 = lane & 4; const float snd = b2 ? pt[0] : pt[1], kp = b2 ? pt[1] : pt[0]; pt[0] = kp + __shfl_xor(snd, 4); }
        pt[0] += __shfl_xor(pt[0], 2); pt[0] += __shfl_xor(pt[0], 1);
        if ((lane & 3) == 0) { const int j = ((lane >> 5) & 1) * 8 + ((lane >> 4) & 1) * 4 + ((lane >> 3) & 1) * 2 + ((lane >> 2) & 1);
            float val = pt[0] + p.gate_b[j];
            if ((j >> 2) & 1) val = fminf(val, 0.f) - log1pf(__expf(-fabsf(val)));
            GATES[(size_t)r * 16 + j] = val; }
    }
}
DI void ph_norm1(const Params& p, int mode) {
    const int tid = opaque_tid(), wid = tid >> 6, lane = tid & 63;
    const float* gsrc = mode ? p.final_g : p.norm_g + 1024;
    f32x4 g[4];
#pragma unroll
    for (int i = 0; i < 4; ++i) g[i] = *(const f32x4*)(gsrc + lane * 4 + 256 * i);
    const float* MOD = (const float*)(p.ws + WS_MOD) + (size_t)9 * 3072;
    const bf16_t* D0 = (const bf16_t*)p.ws; const bf16_t* D1 = (const bf16_t*)(p.ws + PLANE);
    bf16_t* HX1 = (bf16_t*)(p.ws + 2 * PLANE);
    f32x4 vn[4];
#define N1_LOAD(RR) do { _Pragma("unroll") for (int i = 0; i < 4; ++i) { const size_t o = (size_t)(RR) * 1024 + lane * 4 + 256 * i; \
        f32x4 xv = *(const f32x4*)(p.x + o); const u32x2 q = *(const u32x2*)(D0 + o); xv += (f32x4){lo_f(q.x), hi_f(q.x), lo_f(q.y), hi_f(q.y)}; \
        if (mode) { const u32x2 q1 = *(const u32x2*)(D1 + o); xv += (f32x4){lo_f(q1.x), hi_f(q1.x), lo_f(q1.y), hi_f(q1.y)}; } \
        vn[i] = xv; } } while (0)
    { const int r = blockIdx.x * 8 + wid; if (r < NX) N1_LOAD(r); }
    for (int r = blockIdx.x * 8 + wid; r < NX; r += gridDim.x * 8) {
        const float* md = MOD + (size_t)(r >> 12) * 3072;
        f32x4 v[4]; float ss = 0.f;
#pragma unroll
        for (int i = 0; i < 4; ++i) { v[i] = vn[i]; ss += v[i][0] * v[i][0] + v[i][1] * v[i][1] + v[i][2] * v[i][2] + v[i][3] * v[i][3]; }
        { const int r2 = r + gridDim.x * 8; if (r2 < NX) N1_LOAD(r2); }
        ss = wave_sum(ss);
        const float rstd = rsqrtf(ss * (1.0f / 1024.0f) + 1e-6f);
#pragma unroll
        for (int i = 0; i < 4; ++i) {
            if (mode) { *(f32x4*)(p.out + (size_t)r * 1024 + lane * 4 + 256 * i) = v[i] * rstd * g[i]; }
            else { const f32x4 sh = *(const f32x4*)(md + lane * 4 + 256 * i), sc = *(const f32x4*)(md + 1024 + lane * 4 + 256 * i);
                const f32x4 h = v[i] * rstd * g[i] * (sc + 1.0f) + sh;
                u32x2 w; w.x = pk2(h[0], h[1]); w.y = pk2(h[2], h[3]);
                *(u32x2*)(HX1 + (size_t)r * 1024 + lane * 4 + 256 * i) = w; } }
    }
#undef N1_LOAD
}

DI void ph_conv(const Params& p) {
    const bf16_t* QRAW = (const bf16_t*)p.ws; const bf16_t* KRAW = (const bf16_t*)(p.ws + PLANE);
    const bf16_t* CQ = (const bf16_t*)(p.ws + WS_CRAW); const bf16_t* CK = CQ + (size_t)NCX * 1024;
    bf16_t* QC = (bf16_t*)p.out; bf16_t* KC = QC + (size_t)NX * 1024;
    bf16_t* CQC = (bf16_t*)(p.ws + WS_CQC); bf16_t* CKC = (bf16_t*)(p.ws + WS_CKC);
    const int tid = opaque_tid();
    const bool scanner = (blockIdx.x < 64) && (tid < 64) && (gridDim.x >= 64);
    const int nscan = gridDim.x >= 64 ? 64 : 0;
    const int active_id = (int)blockIdx.x < nscan ? (int)blockIdx.x * 448 + (tid - 64) : nscan * 448 + ((int)blockIdx.x - nscan) * 512 + tid;
    const int active_n = nscan * 448 + ((int)gridDim.x - nscan) * 512;
    if (!scanner)
    for (int idx = active_id; idx < (NR / 8) * 256; idx += active_n) {
        const int oct = idx & 127, which = (idx >> 7) & 1, r0 = (idx >> 8) * 8, ch = oct * 8;
        const bf16_t* src; bf16_t* dst; int t0, T;
        if (r0 < NX) { src = (which ? KRAW : QRAW) + (size_t)r0 * 1024 + ch; dst = (which ? KC : QC) + (size_t)r0 * 1024 + ch; t0 = r0 & 4095; T = 4096; }
        else { const int rr = r0 - NX; src = (which ? CK : CQ) + (size_t)rr * 1024 + ch; dst = (which ? CKC : CQC) + (size_t)rr * 1024 + ch; t0 = rr & 255; T = 256; }
        const u32x4 z = {0u, 0u, 0u, 0u};
        u32x4 v[10];
        v[0] = (t0 > 0) ? *(const u32x4*)(src - 1024) : z;
#pragma unroll
        for (int i = 0; i < 8; ++i) v[i + 1] = *(const u32x4*)(src + (size_t)i * 1024);
        v[9] = (t0 + 8 < T) ? *(const u32x4*)(src + (size_t)8 * 1024) : z;
        const float* w = p.conv_qk + which * 1024 + ch;
        float wt[3][8];
#pragma unroll
        for (int j = 0; j < 3; ++j) { const f32x4 wa = *(const f32x4*)(w + j * 2048), wb = *(const f32x4*)(w + j * 2048 + 4);
#pragma unroll
            for (int e = 0; e < 4; ++e) { wt[j][e] = wa[e]; wt[j][4 + e] = wb[e]; } }
        const float qs = which ? 1.0f : 0.0625f;
#pragma unroll
        for (int i = 0; i < 8; ++i) {
            float o[8];
#pragma unroll
            for (int e = 0; e < 4; ++e) {
                float lo = wt[0][2 * e] * lo_f(v[i][e]) + wt[1][2 * e] * lo_f(v[i + 1][e]) + wt[2][2 * e] * lo_f(v[i + 2][e]);
                float hi = wt[0][2 * e + 1] * hi_f(v[i][e]) + wt[1][2 * e + 1] * hi_f(v[i + 1][e]) + wt[2][2 * e + 1] * hi_f(v[i + 2][e]);
                o[2 * e] = silu_f(lo) * qs; o[2 * e + 1] = silu_f(hi) * qs;
            }
            u32x4 wv; wv.x = pk2(o[0], o[1]); wv.y = pk2(o[2], o[3]); wv.z = pk2(o[4], o[5]); wv.w = pk2(o[6], o[7]);
            *(u32x4*)(dst + (size_t)i * 1024) = wv;
        }
    }
    const int lane = tid & 63;
    const int n_sc = nscan ? 1 : 64;
    if (scanner || (nscan == 0 && blockIdx.x == 0 && tid < 64))
    for (int sc = 0; sc < n_sc; ++sc) {
        const int gw = nscan ? (int)blockIdx.x : sc;
        const int b = gw >> 3, h = (gw >> 1) & 3, dir = gw & 1;
        const float* GATES = (const float*)(p.ws + WS_GATES);
        float* GP = (float*)(p.ws + WS_GPRE) + (size_t)gw * 68 * 384;
        float m_prev = 0.f;
        auto grow_of = [&](int st) -> size_t { if (st < 4) { const int cc = dir ? 3 - st : st; return (size_t)NX + (size_t)b * 256 + cc * 64; } const int xc = st - 4, cc = dir ? 63 - xc : xc; return (size_t)b * 4096 + cc * 64; };
        const int oi = (dir ? 8 : 0) + h, of = (dir ? 12 : 4) + h;
        float nig = GATES[(grow_of(0) + lane) * 16 + oi], nlf = GATES[(grow_of(0) + lane) * 16 + of];
        for (int st = 0; st < 68; ++st) {
            const float ig = nig, lf = nlf;
            if (st + 1 < 68) { const size_t g2 = grow_of(st + 1); nig = GATES[(g2 + lane) * 16 + oi]; nlf = GATES[(g2 + lane) * 16 + of]; }
            float bs = lf;
#pragma unroll
            for (int o = 1; o < 64; o <<= 1) { const float ov = dir ? __shfl_down(bs, o) : __shfl_up(bs, o); const bool ok = dir ? (lane + o < 64) : (lane >= o); if (ok) bs += ov; }
            const float a = ig - bs;
            float mx = a;
#pragma unroll
            for (int o = 1; o < 64; o <<= 1) { const float ov = dir ? __shfl_down(mx, o) : __shfl_up(mx, o); const bool ok = dir ? (lane + o < 64) : (lane >= o); if (ok) mx = fmaxf(mx, ov); }
            const float total = __shfl(bs, dir ? 0 : 63);
            const float m_inter = bs + m_prev, m_t = fmaxf(bs + mx, m_inter);
            const float wsl = total - bs + ig;
            const float m_new = fmaxf(total + m_prev, wave_max(wsl));
            float* o = GP + (size_t)st * 384;
            o[lane] = bs - m_t; o[64 + lane] = a; o[128 + lane] = __expf(m_inter - m_t); o[192 + lane] = __expf(wsl - m_new); o[256 + lane] = __expf(-m_t);
            if (lane == 0) o[320] = __expf(total + m_prev - m_new);
            m_prev = m_new;
        }
    }
}

DI void ph_mlstm(const Params& p, LAS unsigned char* lds) {
    constexpr int QP = 528, VP = 176, SP = 144;
    LAS unsigned char* Qi = lds; LAS unsigned char* Ki = lds + 33792; LAS unsigned char* Vi0 = lds + 67584; LAS unsigned char* Vwi = Vi0 + 2 * 11264;
    LAS unsigned char* Sgi = Vwi + 11264; LAS unsigned char* Ci = Sgi + 9216; LAS float* fl0 = (LAS float*)(Ci + 42240);
    const int tid = opaque_tid(), wid = tid >> 6, lane = tid & 63, fr = lane & 15, fq = lane >> 4;
    const bf16_t* QC = (const bf16_t*)p.out; const bf16_t* KC = QC + (size_t)NX * 1024; const bf16_t* VPL = (const bf16_t*)(p.ws + 2 * PLANE);
    const bf16_t* CQC = (const bf16_t*)(p.ws + WS_CQC); const bf16_t* CKC = (const bf16_t*)(p.ws + WS_CKC); const bf16_t* CV = (const bf16_t*)(p.ws + WS_CRAW) + (size_t)2 * NCX * 1024;
    for (int wi = blockIdx.x; wi < 256; wi += gridDim.x) {
        const int b = wi >> 5, h = (wi >> 3) & 3, dir = (wi >> 2) & 1, es = wi & 3;
        bf16_t* Hout = (bf16_t*)(p.ws + (dir ? PLANE : 0));
        const float* GP = (const float*)(p.ws + WS_GPRE) + (size_t)((b * 4 + h) * 2 + dir) * 68 * 384;
        f32x4 Cst[2][5];
#pragma unroll
        for (int i = 0; i < 2; ++i)
#pragma unroll
            for (int n = 0; n < 5; ++n) Cst[i][n] = (f32x4){0.f, 0.f, 0.f, 0.f};
        __syncthreads();
        for (int i = tid; i < 64 * 8; i += 512) { const int row = i >> 3, c = i & 7;
            *(LAS unsigned*)(Vi0 + row * VP + 128 + c * 4) = 0x3F803F80u; *(LAS unsigned*)(Vi0 + 11264 + row * VP + 128 + c * 4) = 0x3F803F80u; *(LAS unsigned*)(Vwi + row * VP + 128 + c * 4) = 0u; }
        u32x4 rq[4], rk[4], rv; float pg = 0.f, pws = 0.f, pdecay = 0.f, decay = 0.f;
        const int mt = wid >> 1, nt0 = 2 * (wid & 1);
#define ML_LOAD(ST) do { const int _st = (ST); const bf16_t *_q, *_k, *_v; \
            if (_st < 4) { const int cc = dir ? 3 - _st : _st; const size_t row0 = (size_t)b * 256 + cc * 64; _q = CQC + row0 * 1024 + h * 256; _k = CKC + row0 * 1024 + h * 256; _v = CV + row0 * 1024 + h * 256 + es * 64; } \
            else { const int xc = _st - 4, cc = dir ? 63 - xc : xc; const size_t row0 = (size_t)b * 4096 + cc * 64; _q = QC + row0 * 1024 + h * 256; _k = KC + row0 * 1024 + h * 256; _v = VPL + row0 * 1024 + h * 256 + es * 64; } \
            _Pragma("unroll") for (int i = 0; i < 4; ++i) { const int id = tid + 512 * i, row = id >> 5, chk = id & 31; rq[i] = *(const u32x4*)(_q + (size_t)row * 1024 + chk * 8); rk[i] = *(const u32x4*)(_k + (size_t)row * 1024 + chk * 8); } \
            rv = *(const u32x4*)(_v + (size_t)(tid >> 3) * 1024 + (tid & 7) * 8); \
            const float* _g = GP + (size_t)_st * 384; pg = _g[tid < 320 ? tid : 0]; pws = _g[192 + (tid >> 3)]; pdecay = _g[320]; } while (0)
#define ML_WRITE(ST) do { LAS unsigned char* _Vi = Vi0 + ((ST) & 1) * 11264; LAS float* _fl = fl0 + ((ST) & 1) * 320; \
            _Pragma("unroll") for (int i = 0; i < 4; ++i) { const int id = tid + 512 * i, row = id >> 5, chk = id & 31; \
                *(LAS u32x4*)(Qi + row * QP + chk * 16) = rq[i]; *(LAS u32x4*)(Ki + row * QP + chk * 16) = rk[i]; } \
            *(LAS u32x4*)(_Vi + (tid >> 3) * VP + (tid & 7) * 16) = rv; \
            { const float w = pws; u32x4 o; \
              o.x = pk2(w * lo_f(rv.x), w * hi_f(rv.x)); o.y = pk2(w * lo_f(rv.y), w * hi_f(rv.y)); o.z = pk2(w * lo_f(rv.z), w * hi_f(rv.z)); o.w = pk2(w * lo_f(rv.w), w * hi_f(rv.w)); \
              *(LAS u32x4*)(Vwi + (tid >> 3) * VP + (tid & 7) * 16) = o; \
              if ((tid & 7) == 0) *(LAS unsigned*)(Vwi + (tid >> 3) * VP + 128) = pk2(w, 0.f); } \
            if (tid < 320) _fl[tid] = pg; \
            _Pragma("unroll") for (int i = 0; i < 2; ++i) _Pragma("unroll") for (int n = 0; n < 5; ++n) { u32x2 w; w.x = pk2(Cst[i][n][0], Cst[i][n][1]); w.y = pk2(Cst[i][n][2], Cst[i][n][3]); \
                *(LAS u32x2*)(Ci + (16 * n + fr) * QP + (16 * (2 * wid + i) + 4 * fq) * 2) = w; } \
            decay = pdecay; } while (0)
        ML_LOAD(0);
        __syncthreads();
        ML_WRITE(0);
        ML_LOAD(1);
        for (int st = 0; st < 68; ++st) {
            const bool isx = st >= 4;
            LAS unsigned char* Vi = Vi0 + (st & 1) * 11264; LAS float* fl = fl0 + (st & 1) * 320;
            LAS float* f_bt = fl; LAS float* f_aa = fl + 64; LAS float* f_inter = fl + 128; LAS float* f_enm = fl + 256;
            __syncthreads();
            const float dcy = decay;
            const int t = 16 * mt + fr;
            f32x4 accC[3];
#pragma unroll
            for (int n = 0; n < 3; ++n) accC[n] = (f32x4){0.f, 0.f, 0.f, 0.f};
            if (isx) {
                f32x4 sacc[2] = {(f32x4){0.f, 0.f, 0.f, 0.f}, (f32x4){0.f, 0.f, 0.f, 0.f}};
#pragma unroll
                for (int ks = 0; ks < 8; ++ks) { const bf16x8 qf = *(const LAS bf16x8*)(Qi + t * QP + (32 * ks + 8 * fq) * 2);
#pragma unroll
                    for (int n = 0; n < 2; ++n) { const bf16x8 kf = *(const LAS bf16x8*)(Ki + (16 * (nt0 + n) + fr) * QP + (32 * ks + 8 * fq) * 2); sacc[n] = mfma16(kf, qf, sacc[n]); }
#pragma unroll
                    for (int n = 0; n < 3; ++n) { const int et = (n < 2) ? nt0 + n : 4; const bf16x8 cf = *(const LAS bf16x8*)(Ci + (16 * et + fr) * QP + (32 * ks + 8 * fq) * 2); accC[n] = mfma16(cf, qf, accC[n]); } }
                const float btm = f_bt[t];
#pragma unroll
                for (int n = 0; n < 2; ++n) { const int s0 = 16 * (nt0 + n) + 4 * fq; const f32x4 a4 = *(const LAS f32x4*)(f_aa + s0); float vv[4];
#pragma unroll
                    for (int j = 0; j < 4; ++j) { const int s = s0 + j; const bool ok = dir ? (s >= t) : (s <= t); const float e = __expf(btm + a4[j]); vv[j] = ok ? sacc[n][j] * e : 0.f; }
                    u32x2 w; w.x = pk2(vv[0], vv[1]); w.y = pk2(vv[2], vv[3]); *(LAS u32x2*)(Sgi + t * SP + s0 * 2) = w; }
            }
#pragma unroll
            for (int i = 0; i < 2; ++i)
#pragma unroll
                for (int n = 0; n < 5; ++n) Cst[i][n] = Cst[i][n] * dcy;
#pragma unroll
            for (int ks = 0; ks < 2; ++ks) { bf16x8 kf[2];
#pragma unroll
                for (int i = 0; i < 2; ++i) kf[i] = tr_frag(Ki, QP, 32 * ks, 16 * (2 * wid + i), lane);
#pragma unroll
                for (int n = 0; n < 5; ++n) { const bf16x8 vw = tr_frag(Vwi, VP, 32 * ks, 16 * n, lane);
#pragma unroll
                    for (int i = 0; i < 2; ++i) Cst[i][n] = mfma16(kf[i], vw, Cst[i][n]); } }
            __syncthreads();
            if (isx) {
                f32x4 accD[3];
#pragma unroll
                for (int n = 0; n < 3; ++n) accD[n] = (f32x4){0.f, 0.f, 0.f, 0.f};
#pragma unroll
                for (int ks = 0; ks < 2; ++ks) { const bf16x8 sgf = *(const LAS bf16x8*)(Sgi + t * SP + (32 * ks + 8 * fq) * 2);
#pragma unroll
                    for (int n = 0; n < 3; ++n) { const int et = (n < 2) ? nt0 + n : 4; const bf16x8 vf = tr_frag(Vi, VP, 32 * ks, 16 * et, lane); accD[n] = mfma16(vf, sgf, accD[n]); } }
                const float inter_t = f_inter[t];
                const float den0 = accD[2][0] + inter_t * accC[2][0];
                const float den = __shfl(den0, fr);
                const float rden = 1.0f / fmaxf(fabsf(den), f_enm[t]);
                const int xc = st - 4, cc = dir ? 63 - xc : xc;
                bf16_t* hp = Hout + ((size_t)b * 4096 + cc * 64 + t) * 1024 + h * 256 + es * 64 + 4 * fq;
#pragma unroll
                for (int n = 0; n < 2; ++n) { const f32x4 hv = (accD[n] + accC[n] * inter_t) * rden;
                    u32x2 w; w.x = pk2(hv[0], hv[1]); w.y = pk2(hv[2], hv[3]); *(u32x2*)(hp + 16 * (nt0 + n)) = w; }
            }
            if (st + 1 < 68) { ML_WRITE(st + 1); if (st + 2 < 68) ML_LOAD(st + 2); }
        }
#undef ML_LOAD
#undef ML_WRITE
    }
}

template <int KK, int NN, class Cfg>
DI void axis_mix(const Cfg& cfg, LAS unsigned char* lds, int n_items) {
    constexpr int TP = 528, BP = KK * 2 + 16, NCH = KK / 16;
    LAS unsigned char* Ti = lds; LAS unsigned char* Bi = lds + 128 * TP;
    const int tid = opaque_tid(), wid = tid >> 6, lane = tid & 63, fr = lane & 15, fq = lane >> 4;
    __syncthreads();
    cfg.fill_tables(Bi, tid);
    u32x4 ra[NCH], rb[NCH];
    const int G = gridDim.x;
#define AX_LOAD(R, IT) do { if ((IT) < n_items) { _Pragma("unroll") for (int i = 0; i < NCH; ++i) { const int id = tid + 512 * i; R[i] = *(const u32x4*)(cfg.row_ptr((IT), id >> 5) + (id & 31) * 8); } } } while (0)
#define AX_BODY(R, IT, PRE) do { \
        __syncthreads(); \
        _Pragma("unroll") for (int i = 0; i < NCH; ++i) { const int id = tid + 512 * i; *(LAS u32x4*)(Ti + (id >> 5) * TP + (id & 31) * 16) = R[i]; } \
        __syncthreads(); \
        AX_LOAD(R, PRE); \
        f32x4 acc[2][NN / 16]; \
        _Pragma("unroll") for (int i = 0; i < 2; ++i) _Pragma("unroll") for (int n = 0; n < NN / 16; ++n) acc[i][n] = (f32x4){0.f, 0.f, 0.f, 0.f}; \
        LAS unsigned char* tb = Bi + cfg.table_off(IT); \
        _Pragma("unroll") for (int ks = 0; ks < KK / 32; ++ks) { bf16x8 af[2]; \
            _Pragma("unroll") for (int i = 0; i < 2; ++i) af[i] = tr_frag(Ti, TP, 32 * ks, 32 * wid + 16 * i, lane); \
            _Pragma("unroll") for (int n = 0; n < NN / 16; ++n) { const bf16x8 bfr = *(const LAS bf16x8*)(tb + (16 * n + fr) * BP + (32 * ks + 8 * fq) * 2); \
                _Pragma("unroll") for (int i = 0; i < 2; ++i) acc[i][n] = mfma16(af[i], bfr, acc[i][n]); } } \
        cfg.epilogue(acc, (IT), wid, fr, fq, Bi); } while (0)
    int item = blockIdx.x;
    AX_LOAD(ra, item); AX_LOAD(rb, item + G);
    for (; item < n_items; item += 2 * G) {
        AX_BODY(ra, item, item + 2 * G);
        if (item + G < n_items) AX_BODY(rb, item + G, item + 3 * G);
    }
#undef AX_LOAD
#undef AX_BODY
}
DI void fill_dft_table(LAS unsigned char* Bi, int tid, int nrows) {
    for (int idx = tid; idx < nrows * 128; idx += 512) { const int n = idx >> 7, k = idx & 127, ap = n & 63, kk = k & 63; float s, c; sincospif((float)((kk * ap) & 63) / 32.0f, &s, &c);
        float v; if (n < 64) v = (k < 64) ? c : s; else v = (k < 64) ? -s : c;
        *(LAS unsigned short*)(Bi + n * 272 + k * 2) = (unsigned short)(pk2(v * 0.125f, 0.f) & 0xffffu); }
}
struct CfgDft1 {
    const bf16_t* Z; bf16_t* S1re; bf16_t* S1im;
    DI void fill_tables(LAS unsigned char* Bi, int tid) const { fill_dft_table(Bi, tid, 128); }
    DI int table_off(int) const { return 0; }
    DI const bf16_t* row_ptr(int item, int k) const { const int g = item & 3, b = (item >> 2) & 63, batch = item >> 8;
        return Z + ((size_t)batch * 4096 + 64 * (k & 63) + b) * 2048 + g * 512 + (k >> 6) * 256; }
    DI void epilogue(const f32x4 (&acc)[2][8], int item, int wid, int fr, int fq, LAS unsigned char* Bi) const {
        const int g = item & 3, b = (item >> 2) & 63, batch = item >> 8;
#pragma unroll
        for (int ni = 0; ni < 4; ++ni) { const int ap = 16 * ni + fr; float s, c; sincospif((float)(b * ap) * (1.0f / 2048.0f), &s, &c);
            const size_t tok = (size_t)batch * 4096 + 64 * ap + b;
#pragma unroll
            for (int i = 0; i < 2; ++i) { const f32x4 re = acc[i][ni], im = acc[i][ni + 4]; const f32x4 r2 = re * c + im * s, i2 = im * c - re * s;
                const size_t o = tok * 1024 + g * 256 + 32 * wid + 16 * i + 4 * fq;
                u32x2 w; w.x = pk2(r2[0], r2[1]); w.y = pk2(r2[2], r2[3]); *(u32x2*)(S1re + o) = w;
                w.x = pk2(i2[0], i2[1]); w.y = pk2(i2[2], i2[3]); *(u32x2*)(S1im + o) = w; } }
    }
};
struct CfgDft2 {
    const bf16_t* S1re; const bf16_t* S1im; const bf16_t* ZB; bf16_t* Y;
    DI void fill_tables(LAS unsigned char* Bi, int tid) const { fill_dft_table(Bi, tid, 64); }
    DI int table_off(int) const { return 0; }
    DI const bf16_t* row_ptr(int item, int k) const { const int g = item & 3, ap = (item >> 2) & 63, batch = item >> 8;
        return ((k >> 6) ? S1im : S1re) + ((size_t)batch * 4096 + 64 * ap + (k & 63)) * 1024 + g * 256; }
    DI void epilogue(const f32x4 (&acc)[2][4], int item, int wid, int fr, int fq, LAS unsigned char*) const {
        const int g = item & 3, ap = (item >> 2) & 63, batch = item >> 8;
#pragma unroll
        for (int ni = 0; ni < 4; ++ni) { const size_t tok = (size_t)batch * 4096 + ap + 64 * (16 * ni + fr);
#pragma unroll
            for (int i = 0; i < 2; ++i) { const int ch = g * 256 + 32 * wid + 16 * i + 4 * fq; const u32x2 z = *(const u32x2*)(ZB + tok * 1024 + ch); const f32x4 a = acc[i][ni];
                u32x2 w; w.x = pk2(a[0] * silu_f(lo_f(z.x)), a[1] * silu_f(hi_f(z.x))); w.y = pk2(a[2] * silu_f(lo_f(z.y)), a[3] * silu_f(hi_f(z.y)));
                *(u32x2*)(Y + tok * 2048 + 1024 + ch) = w; } }
    }
};
DI void fill_pool_tables(LAS unsigned char* Bi, int tid) {
    for (int idx = tid; idx < 4 * 4096; idx += 512) { const int g = idx >> 12, n = (idx >> 6) & 63, k = idx & 63, w = 2 << g, lo = n - w / 2, hi = n + w - w / 2;
        *(LAS unsigned short*)(Bi + g * 9216 + n * 144 + k * 2) = (k >= lo && k < hi) ? (unsigned short)0x3F80 : (unsigned short)0; }
}
DI float pool_rcnt(int g, int n) { const int w = 2 << g; int lo = n - w / 2, hi = n + w - w / 2; lo = lo < 0 ? 0 : lo; hi = hi > 64 ? 64 : hi; return 1.0f / (float)(hi - lo); }
struct CfgPoolA {
    const bf16_t* UC; bf16_t* PA;
    DI void fill_tables(LAS unsigned char* Bi, int tid) const { fill_pool_tables(Bi, tid); }
    DI int table_off(int item) const { return ((item & 7) >> 1) * 9216; }
    DI const bf16_t* row_ptr(int item, int k) const { const int ct = item & 7, c = (item >> 3) & 63, batch = item >> 9; return UC + ((size_t)batch * 4096 + 64 * k + c) * 2048 + ct * 256; }
    DI void epilogue(const f32x4 (&acc)[2][4], int item, int wid, int fr, int fq, LAS unsigned char*) const {
        const int ct = item & 7, c = (item >> 3) & 63, batch = item >> 9, g = ct >> 1;
#pragma unroll
        for (int ni = 0; ni < 4; ++ni) { const int n = 16 * ni + fr; const float rc = pool_rcnt(g, n); const size_t tok = (size_t)batch * 4096 + 64 * n + c;
#pragma unroll
            for (int i = 0; i < 2; ++i) { const f32x4 a = acc[i][ni] * rc; u32x2 w; w.x = pk2(a[0], a[1]); w.y = pk2(a[2], a[3]);
                *(u32x2*)(PA + tok * 2048 + ct * 256 + 32 * wid + 16 * i + 4 * fq) = w; } }
    }
};
struct CfgPoolB {
    const bf16_t* PA; bf16_t* UC;
    DI void fill_tables(LAS unsigned char* Bi, int tid) const { fill_pool_tables(Bi, tid); }
    DI int table_off(int item) const { return ((item & 7) >> 1) * 9216; }
    DI const bf16_t* row_ptr(int item, int k) const { const int ct = item & 7, rp = (item >> 3) & 63, batch = item >> 9; return PA + ((size_t)batch * 4096 + 64 * rp + k) * 2048 + ct * 256; }
    DI void epilogue(const f32x4 (&acc)[2][4], int item, int wid, int fr, int fq, LAS unsigned char*) const {
        const int ct = item & 7, rp = (item >> 3) & 63, batch = item >> 9, g = ct >> 1;
#pragma unroll
        for (int ni = 0; ni < 4; ++ni) { const int n = 16 * ni + fr; const float rc = pool_rcnt(g, n); const size_t tok = (size_t)batch * 4096 + 64 * rp + n;
#pragma unroll
            for (int i = 0; i < 2; ++i) { bf16_t* up = UC + tok * 2048 + ct * 256 + 32 * wid + 16 * i + 4 * fq; const u32x2 u = *(const u32x2*)up; const f32x4 a = acc[i][ni] * rc;
                u32x2 w; w.x = pk2(a[0] - lo_f(u.x), a[1] - hi_f(u.x)); w.y = pk2(a[2] - lo_f(u.y), a[3] - hi_f(u.y)); *(u32x2*)up = w; } }
    }
};

DI void ph_ya(const Params& p) {
    const int tid = opaque_tid(), wid = tid >> 6, lane = tid & 63;
    const bf16_t* HF = (const bf16_t*)p.ws; const bf16_t* HB = (const bf16_t*)(p.ws + PLANE); const bf16_t* O = (const bf16_t*)(p.ws + 3 * PLANE); const bf16_t* ZA = (const bf16_t*)(p.ws + 4 * PLANE);
    bf16_t* Y = (bf16_t*)p.out;
    f32x4 hg[4];
#pragma unroll
    for (int i = 0; i < 4; ++i) hg[i] = *(const f32x4*)(p.head_norm + lane * 16 + 4 * i);
    for (int r = blockIdx.x * 8 + wid; r < NX; r += gridDim.x * 8) {
        const size_t o = (size_t)r * 1024 + lane * 16;
        float gv[16], za[16]; float ss = 0.f;
#pragma unroll
        for (int hh = 0; hh < 2; ++hh) { const u32x4 a = *(const u32x4*)(HF + o + 8 * hh), bq = *(const u32x4*)(HB + o + 8 * hh), oo = *(const u32x4*)(O + o + 8 * hh), zz = *(const u32x4*)(ZA + o + 8 * hh);
#pragma unroll
            for (int e = 0; e < 4; ++e) { const float h0 = lo_f(a[e]) + lo_f(bq[e]), h1 = hi_f(a[e]) + hi_f(bq[e]);
                const float g0 = sigmoid_f(lo_f(oo[e])) * h0, g1 = sigmoid_f(hi_f(oo[e])) * h1;
                gv[8 * hh + 2 * e] = g0; gv[8 * hh + 2 * e + 1] = g1; ss += g0 * g0 + g1 * g1; za[8 * hh + 2 * e] = lo_f(zz[e]); za[8 * hh + 2 * e + 1] = hi_f(zz[e]); } }
        ss += __shfl_xor(ss, 1); ss += __shfl_xor(ss, 2); ss += __shfl_xor(ss, 4); ss += __shfl_xor(ss, 8);
        const float rstd = rsqrtf(ss * (1.0f / 256.0f) + 1e-6f);
        u32x4 w[2];
#pragma unroll
        for (int q = 0; q < 8; ++q) { const float y0 = gv[2 * q] * rstd * hg[q >> 1][(2 * q) & 3] * silu_f(za[2 * q]), y1 = gv[2 * q + 1] * rstd * hg[q >> 1][(2 * q + 1) & 3] * silu_f(za[2 * q + 1]);
            w[q >> 2][q & 3] = pk2(y0, y1); }
        *(u32x4*)(Y + (size_t)r * 2048 + lane * 16) = w[0]; *(u32x4*)(Y + (size_t)r * 2048 + lane * 16 + 8) = w[1];
    }
}


#define XB_TMO      128
#define XB_XCNT(j)  (256  + 64 * (j))
#define XB_XSUB(j)  (1280 + 64 * (j))
#define XB_XGEN(j)  (2304 + 64 * (j))
#define XB_TOP      3328
#define XB_TOPGEN   3392
#define XCD_BAR_WORDS 3456
#define XB_SPIN_CAP (1u << 18)
DI unsigned xb_ld(unsigned* p)              { return __hip_atomic_load(p, __ATOMIC_RELAXED, __HIP_MEMORY_SCOPE_AGENT); }
DI unsigned xb_add(unsigned* p, unsigned v) { return __hip_atomic_fetch_add(p, v, __ATOMIC_RELAXED, __HIP_MEMORY_SCOPE_AGENT); }
DI unsigned xb_xcc_id() { return (unsigned)__builtin_amdgcn_s_getreg((3 << 11) | 20) & 0xFu; }
#define XB_SPIN(cond, bar) do { unsigned _sp = 0; while (cond) { __builtin_amdgcn_s_sleep(1); \
    if ((++_sp & 255u) == 0u) { if (xb_ld(&(bar)[XB_TMO])) break; if (_sp > XB_SPIN_CAP) { atomicAdd(&(bar)[XB_TMO], 1u); break; } } } } while (0)
struct XcdBarrier { unsigned* bar; unsigned x; volatile LAS unsigned* st; };
DI XcdBarrier xcd_barrier_post(unsigned* bar, volatile LAS unsigned* st) {
    XcdBarrier b; b.bar = bar; b.x = xb_xcc_id(); b.st = st;
    if (threadIdx.x == 0) (void)xb_add(&bar[XB_XCNT(b.x)], 1u);
    return b;
}
DI void xcd_barrier_complete(unsigned* bar, unsigned x, unsigned& nloc, unsigned& nx) {
    const unsigned G = gridDim.x * gridDim.y * gridDim.z;
    unsigned sum, cnt, mine, sp = 0u;
    for (;;) {
        sum = 0u; cnt = 0u; mine = 0u;
#pragma unroll
        for (unsigned j = 0; j < 16; ++j) { const unsigned c = xb_ld(&bar[XB_XCNT(j)]); sum += c; cnt += (c > 0u) ? 1u : 0u; mine = (j == x) ? c : mine; }
        if (sum == G) break;
        __builtin_amdgcn_s_sleep(1);
        if ((++sp & 255u) == 0u) { if (xb_ld(&bar[XB_TMO])) break; if (sp > XB_SPIN_CAP) { atomicAdd(&bar[XB_TMO], 1u); break; } }
    }
    nloc = mine > 0u ? mine : 1u; nx = cnt > 0u ? cnt : 1u;
}
DI void xcd_barrier(const XcdBarrier& b) {
    asm volatile("s_waitcnt vmcnt(0)" ::: "memory");
    __syncthreads();
    if (threadIdx.x == 0) {
        unsigned* bar = b.bar;
        __builtin_amdgcn_s_waitcnt(0);
        unsigned nloc = b.st[0], nx = b.st[1];
        if (nloc == 0u) { xcd_barrier_complete(bar, b.x, nloc, nx); b.st[0] = nloc; b.st[1] = nx; }
        const unsigned old = xb_add(&bar[XB_XSUB(b.x)], 1u);
        const unsigned gen = old / nloc;
        if (old + 1u == (gen + 1u) * nloc) {
            __builtin_amdgcn_fence(__ATOMIC_RELEASE, "agent");
            asm volatile("s_waitcnt vmcnt(0)" ::: "memory");
            const unsigned og = xb_add(&bar[XB_TOP], 1u);
            const unsigned tg = og / nx;
            if (og + 1u == (tg + 1u) * nx) xb_add(&bar[XB_TOPGEN], 1u);
            else XB_SPIN(xb_ld(&bar[XB_TOPGEN]) == tg, bar);
            __builtin_amdgcn_fence(__ATOMIC_ACQUIRE, "agent");
            xb_add(&bar[XB_XGEN(b.x)], 1u);
            asm volatile("s_waitcnt vmcnt(0)" ::: "memory");
        } else {
            XB_SPIN(xb_ld(&bar[XB_XGEN(b.x)]) == gen, bar);
            __builtin_amdgcn_fence(__ATOMIC_ACQUIRE, "agent");
            asm volatile("s_waitcnt vmcnt(0)" ::: "memory");
        }
    }
    __syncthreads();
}

__global__ void __launch_bounds__(512, 2) mk_fwd(Params p, int ph_lo, int ph_hi) {
    extern __shared__ __attribute__((aligned(16))) unsigned char shm[];
    LAS unsigned char* lds = (LAS unsigned char*)shm;
    cg::grid_group grid = cg::this_grid();
    unsigned char* ws = p.ws;
    const int G = gridDim.x, c = blockIdx.x;
    volatile LAS unsigned* xst = (volatile LAS unsigned*)(lds + LDS_BYTES - 16);
    if (threadIdx.x == 0) { xst[0] = 0u; xst[1] = 0u; }
    __syncthreads();
    XcdBarrier xbar; xbar.bar = (unsigned*)(ws + WS_BAR); xbar.x = 0u; xbar.st = xst;
    if (ph_hi - ph_lo > 1) xbar = xcd_barrier_post((unsigned*)(ws + WS_BAR), xst);
    if (ph_lo > 1000) grid.sync();
#ifndef PHMASK
#define PHMASK 0xFFFF
#endif
#define GSYNC() xcd_barrier(xbar)
#ifndef REP_MASK
#define REP_MASK 0
#endif
#define PHASE(i, ...) if constexpr ((PHMASK >> (i)) & 1) if (ph_lo <= (i) && (i) < ph_hi) { __VA_ARGS__; if constexpr ((REP_MASK >> (i)) & 1) { __syncthreads(); __VA_ARGS__; } if ((i) + 1 < ph_hi) GSYNC(); }
    PHASE(0, ph_prep(p, lds));
    PHASE(1, ph_norm0(p, lds));
    PHASE(2, { GemmD g{(const bf16_t*)p.out, (const bf16_t*)(ws + WS_WINE), 1024, 1024, 0, 0, 1024}; Sched S{128, 28, 1, 8, 12, 128, G, c};
               EpiPlanes E{(bf16_t*)ws, (bf16_t*)(ws + WS_CRAW)}; gemm_phase(lds, g, S, E);
               if (G > 96 && c >= 96) transpose_jobs(p, lds, opaque_tid(), 2304, 4096, c - 96, G - 96); else if (G <= 96) transpose_jobs(p, lds, opaque_tid(), 2304, 4096, c, G); });
    PHASE(3, ph_conv(p));
    PHASE(4, ph_mlstm(p, lds));
    PHASE(5, { GemmD g{(const bf16_t*)(ws + 5 * PLANE), (const bf16_t*)(ws + WS_WF), 1024, 256, 256, 512 * 256, 256}; Sched S{128, 2, 4, 0, 0, 0, G, c};
               EpiBf E{(bf16_t*)p.out, nullptr, 2048, 512, 0, nullptr, nullptr}; gemm_phase(lds, g, S, E); });
    PHASE(6, { CfgDft1 cf{(const bf16_t*)p.out, (bf16_t*)(ws + 2 * PLANE), (bf16_t*)(ws + 5 * PLANE)}; axis_mix<128, 128>(cf, lds, 2048); });
    PHASE(7, { CfgDft2 cf{(const bf16_t*)(ws + 2 * PLANE), (const bf16_t*)(ws + 5 * PLANE), (const bf16_t*)(ws + 6 * PLANE), (bf16_t*)p.out}; axis_mix<128, 64>(cf, lds, 2048); ph_ya(p); });
    PHASE(8, { GemmD g{(const bf16_t*)p.out, (const bf16_t*)(ws + WS_WOUTE), 2048, 2048, 0, 0, 2048}; Sched S{128, 4, 1, 0, 0, 0, G, c};
               EpiGate E{(bf16_t*)ws, (const float*)(ws + WS_MOD) + 2048}; gemm_phase(lds, g, S, E); });
    PHASE(9, ph_norm1(p, 0));
    PHASE(10, { GemmD g{(const bf16_t*)(ws + 2 * PLANE), (const bf16_t*)(ws + WS_WINO), 1024, 1024, 0, 0, 1024}; Sched S{128, 16, 1, 0, 0, 0, G, c};
                EpiBf E{(bf16_t*)(ws + 3 * PLANE), (bf16_t*)(ws + 5 * PLANE), 2048, 0, 1, nullptr, nullptr}; gemm_phase(lds, g, S, E); });
    PHASE(11, { CfgPoolA cf{(const bf16_t*)(ws + 3 * PLANE), (bf16_t*)p.out}; axis_mix<64, 64>(cf, lds, 4096); });
    PHASE(12, { CfgPoolB cf{(const bf16_t*)p.out, (bf16_t*)(ws + 3 * PLANE)}; axis_mix<64, 64>(cf, lds, 4096); });
    PHASE(13, { GemmD g{(const bf16_t*)(ws + 3 * PLANE), (const bf16_t*)(ws + WS_WPOOL), 2048, 512, 512, 512 * 512, 512}; Sched S{128, 2, 4, 0, 0, 0, G, c};
                EpiBf E{(bf16_t*)p.out, nullptr, 2048, 512, 2, p.pool_scale, (const bf16_t*)(ws + 5 * PLANE)}; gemm_phase(lds, g, S, E); });
    PHASE(14, { GemmD g{(const bf16_t*)p.out, (const bf16_t*)(ws + WS_WOUTO), 2048, 2048, 0, 0, 2048}; Sched S{128, 4, 1, 0, 0, 0, G, c};
                EpiGate E{(bf16_t*)(ws + PLANE), (const float*)(ws + WS_MOD) + 9 * 3072 + 2048}; gemm_phase(lds, g, S, E); });
    PHASE(15, ph_norm1(p, 1));
#undef PHASE
#ifdef XSYNC
    for (int k = 0; k < XSYNC; ++k) GSYNC();
#endif
#ifdef DBG_STOP
    GSYNC();
    {   const size_t n = (size_t)NX * 1024; unsigned* o32 = (unsigned*)p.out;
        for (size_t i = (size_t)blockIdx.x * 512 + threadIdx.x; i < n; i += (size_t)gridDim.x * 512) {
            float v = 0.f;
            if (DBG_PLANES == -1) { const unsigned u = o32[i]; v = lo_f(u) + hi_f(u); }
            else if (DBG_PLANES == -2) { v = ((const float*)p.ws)[i]; }
            else { for (int pl = 0; pl < 7; ++pl) if ((DBG_PLANES >> pl) & 1) v += bf2f(((const bf16_t*)(p.ws + pl * PLANE))[i]); }
            if (!(fabsf(v) < 1e30f)) v = 12345.f;
            p.out[i] = v; } }
#endif
}

extern "C" void kernel_launch(void* const* d_in, const int* in_sizes, int n_in, void* d_out, int out_size, void* d_ws, size_t ws_size, hipStream_t stream) {
    static int grid = 0;
    if (grid == 0) {
        int dev = 0, cus = 0, per_cu = 0;
        hipGetDevice(&dev);
        hipDeviceGetAttribute(&cus, hipDeviceAttributeMultiprocessorCount, dev);
        if (hipFuncSetAttribute((const void*)mk_fwd, hipFuncAttributeMaxDynamicSharedMemorySize, LDS_BYTES) != hipSuccess) fprintf(stderr, "hipFuncSetAttribute failed\n");
        if (hipOccupancyMaxActiveBlocksPerMultiprocessor(&per_cu, (const void*)mk_fwd, 512, LDS_BYTES) != hipSuccess || per_cu < 1) { fprintf(stderr, "occupancy query: %d\n", per_cu); per_cu = 1; }
        (void)hipGetLastError();
        grid = cus * per_cu; if (grid > 256) grid = 256; if (grid < 1) grid = 1;
        if (ws_size < WS_END) fprintf(stderr, "workspace too small: %zu < %zu\n", ws_size, (size_t)WS_END);
    }
    Params p{};
    p.x = (const float*)d_in[0]; p.c = (const float*)d_in[1]; p.ctx = (const float*)d_in[2]; p.c_ctx = (const float*)d_in[3]; p.ada_w = (const float*)d_in[4]; p.ada_b = (const float*)d_in[5];
    p.norm_g = (const float*)d_in[6]; p.win_even = (const float*)d_in[7]; p.gate_b = (const float*)d_in[8]; p.conv_qk = (const float*)d_in[9]; p.head_norm = (const float*)d_in[10];
    p.fourier_w = (const float*)d_in[11]; p.wout_even = (const float*)d_in[12]; p.win_odd = (const float*)d_in[13]; p.pool_w = (const float*)d_in[14]; p.pool_scale = (const float*)d_in[15];
    p.wout_odd = (const float*)d_in[16]; p.final_g = (const float*)d_in[17]; p.out = (float*)d_out; p.ws = (unsigned char*)d_ws;
    (void)hipMemsetAsync((unsigned char*)d_ws + WS_BAR, 0, XCD_BAR_WORDS * 4, stream);
#if MK_MULTI
    for (int ph = 0; ph < 16; ++ph) { hipLaunchKernelGGL(mk_fwd, dim3(grid), dim3(512), LDS_BYTES, stream, p, ph, ph + 1); }
#else
#ifdef DBG_STOP
    int lo = 0, hi = DBG_STOP;
#else
    int lo = 0, hi = 16;
#endif
    void* args[] = {&p, &lo, &hi};
    hipError_t e = hipLaunchCooperativeKernel((void*)mk_fwd, dim3(grid), dim3(512), args, LDS_BYTES, stream);
    if (e != hipSuccess) fprintf(stderr, "cooperative launch failed: %s (grid %d)\n", hipGetErrorString(e), grid);
#endif
}
```

```cpp
#include <hip/hip_runtime.h>
#include <hip/hip_cooperative_groups.h>
#include <cstdio>
namespace cg = cooperative_groups;

#ifndef MK_MULTI
#define MK_MULTI 0
#endif

#define LAS __attribute__((address_space(3)))
typedef unsigned short bf16_t;
typedef short bf16x8 __attribute__((ext_vector_type(8)));
typedef short s16x4 __attribute__((ext_vector_type(4)));
typedef float f32x4 __attribute__((ext_vector_type(4)));
typedef unsigned u32x4 __attribute__((ext_vector_type(4)));
typedef unsigned u32x2 __attribute__((ext_vector_type(2)));

constexpr int NX = 32768, NCX = 2048, NR = NX + NCX;
constexpr size_t PLANE = (size_t)NX * 1024 * 2;
constexpr size_t WS_EXTRA = 7 * PLANE;
constexpr size_t WS_WINE  = WS_EXTRA;
constexpr size_t WS_WOUTE = WS_WINE  + (size_t)7168 * 1024 * 2;
constexpr size_t WS_WINO  = WS_WOUTE + (size_t)1024 * 2048 * 2;
constexpr size_t WS_WPOOL = WS_WINO  + (size_t)4096 * 1024 * 2;
constexpr size_t WS_WOUTO = WS_WPOOL + (size_t)4 * 512 * 512 * 2;
constexpr size_t WS_WF    = WS_WOUTO + (size_t)1024 * 2048 * 2;
constexpr size_t WS_MOD   = WS_WF    + (size_t)4 * 512 * 256 * 2;
constexpr size_t WS_GATES = WS_MOD   + 262144;
constexpr size_t WS_CRAW  = WS_GATES + (size_t)NR * 16 * 4;
constexpr size_t WS_CQC   = WS_CRAW  + (size_t)3 * NCX * 1024 * 2;
constexpr size_t WS_CKC   = WS_CQC   + (size_t)NCX * 1024 * 2;
constexpr size_t WS_END   = WS_CKC   + (size_t)NCX * 1024 * 2;
constexpr size_t WS_GPRE  = WS_END + 16384;
constexpr size_t WS_GPRE_END = WS_GPRE + (size_t)64 * 68 * 384 * 4;
static_assert(WS_GPRE_END <= (size_t)512 * 1024 * 1024, "gate tables exceed the workspace");
constexpr size_t WS_BAR   = WS_END;
static_assert(WS_BAR + 16384 <= (size_t)512 * 1024 * 1024, "workspace map exceeds 512 MiB");

constexpr int LDS_BYTES = 155648;

struct Params {
    const float* x; const float* c; const float* ctx; const float* c_ctx; const float* ada_w; const float* ada_b; const float* norm_g;
    const float* win_even; const float* gate_b; const float* conv_qk; const float* head_norm; const float* fourier_w; const float* wout_even;
    const float* win_odd; const float* pool_w; const float* pool_scale; const float* wout_odd; const float* final_g;
    float* out; unsigned char* ws;
};

#define DI __device__ __forceinline__
DI float bf2f(unsigned short b) { return __uint_as_float(((unsigned)b) << 16); }
DI float lo_f(unsigned u) { return __uint_as_float(u << 16); }
DI float hi_f(unsigned u) { return __uint_as_float(u & 0xffff0000u); }
typedef __bf16 bf16v2_t __attribute__((ext_vector_type(2)));
typedef float f32v2_t __attribute__((ext_vector_type(2)));
DI unsigned pk2(float lo, float hi) { const f32v2_t v = {lo, hi}; const bf16v2_t b = __builtin_convertvector(v, bf16v2_t); return __builtin_bit_cast(unsigned, b); }
DI float silu_f(float x) { return x / (1.0f + __expf(-x)); }
DI float sigmoid_f(float x) { return 1.0f / (1.0f + __expf(-x)); }
DI int opaque_tid() { int t = threadIdx.x; asm volatile("" : "+v"(t)); return t; }
DI float wave_sum(float v) { for (int o = 32; o > 0; o >>= 1) v += __shfl_xor(v, o); return v; }
DI float wave_max(float v) { for (int o = 32; o > 0; o >>= 1) v = fmaxf(v, __shfl_xor(v, o)); return v; }
DI f32x4 mfma16(bf16x8 a, bf16x8 b, f32x4 c) { return __builtin_amdgcn_mfma_f32_16x16x32_bf16(a, b, c, 0, 0, 0); }
DI bf16x8 tr_frag(LAS unsigned char* img, int pitch, int krow0, int col0, int lane) {
    const int g = lane >> 4, q = (lane & 15) >> 2, pp = lane & 3;
    LAS unsigned char* a0 = img + (krow0 + 8 * g + q) * pitch + col0 * 2 + 8 * pp;
    s16x4 lo = __builtin_amdgcn_ds_read_tr16_b64_v4i16((LAS s16x4*)a0);
    s16x4 hi = __builtin_amdgcn_ds_read_tr16_b64_v4i16((LAS s16x4*)(a0 + 4 * pitch));
    return __builtin_shufflevector(lo, hi, 0, 1, 2, 3, 4, 5, 6, 7);
}

constexpr int HTB = 128 * 64 * 2;
DI int lds_byte(int r, int c) { const int st = (r >> 4) * 2 + (c >> 5), rr = r & 15, cc = c & 31, ob = rr * 64 + cc * 2; return st * 1024 + (ob ^ (((ob >> 9) & 1) << 5)); }
DI void stage_rc(int b, int& R, int& C) { const int st = b / 1024, sb = b % 1024, swz = sb ^ (((sb >> 9) & 1) << 5); R = (st >> 1) * 16 + swz / 64; C = (st & 1) * 32 + (swz % 64) / 2; }
DI int perm32(int rho) { const int n = rho >> 4, i = rho & 15; return 8 * (i >> 2) + 4 * n + (i & 3); }

struct Unit { int pm, pn, g; };
struct GemmD { const bf16_t* A; const bf16_t* Bt; int lda, ldb; long a_gs, b_gs; int K; };
struct Sched {
    int nM, nN, nG, nM2, nN2, pm2off, G, c;
    DI bool next(int i, Unit& u) const {
        const int L = i * G + c; const int nwg = nM * nN, tot1 = nwg * nG;
        const bool first = L < tot1;
        const int L1 = first ? L : 0;
        const int g = L1 / nwg; int wgid = L1 - g * nwg;
        { const int q = nwg / 8, r = nwg % 8, xcd = wgid % 8, off = wgid / 8; wgid = (xcd < r ? xcd * (q + 1) : r * (q + 1) + (xcd - r) * q) + off; }
        const int nig = 8 * nN, gid = wgid / nig, fm = gid * 8, gsz = (nM - fm) < 8 ? (nM - fm) : 8;
        const int pm1 = fm + ((wgid % nig) % gsz), pn1 = (wgid % nig) / gsz;
        const int L2 = first ? 0 : L - tot1, d2 = nM2 > 0 ? nM2 : 1;
        const int pm2 = pm2off + L2 % d2, pn2 = L2 / d2;
        u.pm = first ? pm1 : pm2; u.pn = first ? pn1 : pn2; u.g = first ? g : 0;
        return first || (L2 < nM2 * nN2);
    }
};

template <class Epi>
DI void gemm_phase(LAS unsigned char* lds, const GemmD g, const Sched& S, const Epi& E) {
    const int tid = opaque_tid(), wid = __builtin_amdgcn_readfirstlane(tid >> 6), lane = tid & 63, wr = wid >> 2, wc = wid & 3, fr = lane & 15, fq = lane >> 4;
    const int K = g.K, nt = K / 64;
    unsigned voffA[2], voffB[2];
#pragma unroll
    for (int i = 0; i < 2; ++i) { int R, C; stage_rc(tid * 16 + i * 8192, R, C); const int Rb = Epi::PERM ? ((R & ~31) + perm32(R & 31)) : R;
        voffA[i] = (unsigned)(R * g.lda + C) * 2u; voffB[i] = (unsigned)(Rb * g.ldb + C) * 2u; }
    const size_t kstep = 128;
    const size_t hstepA = (size_t)128 * g.lda * 2, hstepB = (size_t)128 * g.ldb * 2;
    const unsigned ldsw = (unsigned)wid * 1024u;
    const int aoff = lds_byte(wr * 64 + fr, fq * 8), boff = lds_byte(wc * 32 + fr, fq * 8);
#define G_SA(b, h) (((b) * 2 + (h)) * HTB)
#define G_SB(b, h) ((4 + (b) * 2 + (h)) * HTB)
#define G_STAGE(bufoff, gbase, voff) do { _Pragma("unroll") for (int _i = 0; _i < 2; ++_i) \
        __builtin_amdgcn_global_load_lds((const unsigned*)((const char*)(gbase) + (voff)[_i]), (LAS unsigned*)(lds + (bufoff) + ldsw + _i * 8192), 16, 0, 0); } while (0)
#define G_LDA(dst, b, h) do { _Pragma("unroll") for (int m = 0; m < 4; ++m) _Pragma("unroll") for (int k = 0; k < 2; ++k) dst[m][k] = *(const LAS bf16x8*)(lds + G_SA(b, h) + aoff + m * 2048 + k * 1024); } while (0)
#define G_LDB(dst, b, h) do { _Pragma("unroll") for (int n = 0; n < 2; ++n) _Pragma("unroll") for (int k = 0; k < 2; ++k) dst[n][k] = *(const LAS bf16x8*)(lds + G_SB(b, h) + boff + n * 2048 + k * 1024); } while (0)
#define G_MMA(ai, bj, At, Bt) do { __builtin_amdgcn_s_setprio(1); _Pragma("unroll") for (int m = 0; m < 4; ++m) _Pragma("unroll") for (int n = 0; n < 2; ++n) _Pragma("unroll") for (int k = 0; k < 2; ++k) \
        acc[ai][bj][m][n] = __builtin_amdgcn_mfma_f32_16x16x32_bf16(Bt[n][k], At[m][k], acc[ai][bj][m][n], 0, 0, 0); __builtin_amdgcn_s_setprio(0); } while (0)
#define G_WAIT_V(n) asm volatile("s_waitcnt vmcnt(" #n ")" ::: "memory")
#define G_WAIT_L(n) asm volatile("s_waitcnt lgkmcnt(" #n ")" ::: "memory")
#define G_BAR __builtin_amdgcn_s_barrier()
#define G_SCHED __builtin_amdgcn_sched_barrier(0)
    Unit cur, nxt; int ui = 0;
    if (!S.next(0, cur)) return;
    f32x4 acc[2][2][4][2];
#pragma unroll
    for (int a = 0; a < 2; ++a)
#pragma unroll
        for (int b = 0; b < 2; ++b)
#pragma unroll
            for (int m = 0; m < 4; ++m)
#pragma unroll
                for (int n = 0; n < 2; ++n) acc[a][b][m][n] = (f32x4){0.f, 0.f, 0.f, 0.f};
    bf16x8 At[4][2], B0[2][2], B1[2][2];
    const char* cA = (const char*)(g.A + (long)cur.g * g.a_gs) + (size_t)cur.pm * 2 * hstepA;
    const char* cB = (const char*)(g.Bt + (long)cur.g * g.b_gs) + (size_t)cur.pn * 2 * hstepB;
    G_STAGE(G_SB(0, 0), cB, voffB); G_STAGE(G_SA(0, 0), cA, voffA); G_STAGE(G_SB(0, 1), cB + hstepB, voffB); G_STAGE(G_SA(0, 1), cA + hstepA, voffA);
    if (wr == 1) G_BAR;
    G_WAIT_V(4); G_BAR;
    G_STAGE(G_SB(1, 0), cB + kstep, voffB); G_STAGE(G_SA(1, 0), cA + kstep, voffA); G_STAGE(G_SB(1, 1), cB + hstepB + kstep, voffB);
    G_WAIT_V(6); G_BAR;
    for (;;) {
        const bool has_next = S.next(ui + 1, nxt);
        const char* nA = has_next ? (const char*)(g.A + (long)nxt.g * g.a_gs) + (size_t)nxt.pm * 2 * hstepA : cA;
        const char* nB = has_next ? (const char*)(g.Bt + (long)nxt.g * g.b_gs) + (size_t)nxt.pn * 2 * hstepB : cB;
        for (int t = 0; t < nt; t += 2) {
            const bool last = (t == nt - 2);
            const char* a1 = cA + (size_t)(t + 1) * kstep;
            const char* a2 = last ? nA : cA + (size_t)(t + 2) * kstep; const char* b2 = last ? nB : cB + (size_t)(t + 2) * kstep;
            const char* a3 = a2 + kstep; const char* b3 = b2 + kstep;
            G_LDB(B0, 0, 0); G_SCHED; G_LDA(At, 0, 0); G_STAGE(G_SA(1, 1), a1 + hstepA, voffA);
            G_WAIT_L(8); G_BAR; G_WAIT_L(0); G_MMA(0, 0, At, B0); G_BAR; G_SCHED;
            G_LDB(B1, 0, 1); G_STAGE(G_SB(0, 0), b2, voffB);
            G_BAR; G_WAIT_L(0); G_MMA(0, 1, At, B1); G_BAR;
            G_LDA(At, 0, 1); G_STAGE(G_SA(0, 0), a2, voffA);
            G_BAR; G_WAIT_L(0); G_MMA(1, 0, At, B0); G_BAR; G_SCHED;
            G_STAGE(G_SB(0, 1), b2 + hstepB, voffB);
            G_WAIT_V(6); G_BAR; G_MMA(1, 1, At, B1); G_BAR;
            G_LDB(B0, 1, 0); G_SCHED; G_LDA(At, 1, 0); G_STAGE(G_SA(0, 1), a2 + hstepA, voffA);
            G_WAIT_L(8); G_BAR; G_WAIT_L(0); G_MMA(0, 0, At, B0); G_BAR; G_SCHED;
            G_LDB(B1, 1, 1); G_STAGE(G_SB(1, 0), b3, voffB);
            G_BAR; G_WAIT_L(0); G_MMA(0, 1, At, B1); G_BAR;
            G_LDA(At, 1, 1); G_STAGE(G_SA(1, 0), a3, voffA);
            G_BAR; G_WAIT_L(0); G_MMA(1, 0, At, B0); G_BAR; G_SCHED;
            G_STAGE(G_SB(1, 1), b3 + hstepB, voffB);
            G_WAIT_V(6); G_BAR; G_MMA(1, 1, At, B1); G_BAR;
        }
        E(acc, cur, wr, wc, fr, fq);
        if (!has_next) break;
#pragma unroll
        for (int a = 0; a < 2; ++a)
#pragma unroll
            for (int b = 0; b < 2; ++b)
#pragma unroll
                for (int m = 0; m < 4; ++m)
#pragma unroll
                    for (int n = 0; n < 2; ++n) acc[a][b][m][n] = (f32x4){0.f, 0.f, 0.f, 0.f};
        cur = nxt; cA = nA; cB = nB; ++ui;
    }
    G_WAIT_V(0);
    if (wr == 0) G_BAR;
    G_BAR;
}

struct EpiPlanes {
    static constexpr bool PERM = true;
    bf16_t* xbase; bf16_t* cbase;
    DI void operator()(const f32x4 (&acc)[2][2][4][2], const Unit& u, int wr, int wc, int fr, int fq) const {
        const int plane = u.pn >> 2, colt = (u.pn & 3) * 256;
        bf16_t* base; int row0;
        if (u.pm < 128) { base = xbase + (size_t)plane * NX * 1024; row0 = u.pm * 256 + wr * 64 + fr; }
        else { base = cbase + (size_t)plane * NCX * 1024; row0 = (u.pm - 128) * 256 + wr * 64 + fr; }
        const int col0 = colt + wc * 32 + 8 * fq;
#pragma unroll
        for (int ai = 0; ai < 2; ++ai)
#pragma unroll
            for (int m = 0; m < 4; ++m) { bf16_t* rowp = base + (size_t)(row0 + ai * 128 + m * 16) * 1024 + col0;
#pragma unroll
                for (int bj = 0; bj < 2; ++bj) { const f32x4 v0 = acc[ai][bj][m][0], v1 = acc[ai][bj][m][1];
                    u32x4 w; w.x = pk2(v0[0], v0[1]); w.y = pk2(v0[2], v0[3]); w.z = pk2(v1[0], v1[1]); w.w = pk2(v1[2], v1[3]);
                    *(u32x4*)(rowp + bj * 128) = w; } }
    }
};
struct EpiBf {
    static constexpr bool PERM = true;
    bf16_t* O; bf16_t* O2; int ldc; int gcol; int mode; const float* scale; const bf16_t* zc;
    DI void operator()(const f32x4 (&acc)[2][2][4][2], const Unit& u, int wr, int wc, int fr, int fq) const {
        const int row0 = u.pm * 256 + wr * 64 + fr;
        bf16_t* base = O; int pn = u.pn; bool act = false;
        if (mode == 1 && pn >= 8) { base = O2; pn -= 8; act = true; }
        const int col0 = u.g * gcol + pn * 256 + wc * 32 + 8 * fq;
        f32x4 sc[2][2];
#pragma unroll
        for (int bj = 0; bj < 2; ++bj) { sc[bj][0] = (mode == 2) ? *(const f32x4*)(scale + col0 + bj * 128) : (f32x4){1.f, 1.f, 1.f, 1.f}; sc[bj][1] = (mode == 2) ? *(const f32x4*)(scale + col0 + bj * 128 + 4) : (f32x4){1.f, 1.f, 1.f, 1.f}; }
        u32x4 zq[2][4][2];
        if (mode == 2) {
#pragma unroll
            for (int ai = 0; ai < 2; ++ai)
#pragma unroll
                for (int m = 0; m < 4; ++m)
#pragma unroll
                    for (int bj = 0; bj < 2; ++bj) zq[ai][m][bj] = *(const volatile u32x4*)(zc + (size_t)(row0 + ai * 128 + m * 16) * ldc + col0 + bj * 128); }
#pragma unroll
        for (int ai = 0; ai < 2; ++ai) {
            u32x4 (&zz)[4][2] = zq[ai];
#pragma unroll
            for (int m = 0; m < 4; ++m) { const size_t ro = (size_t)(row0 + ai * 128 + m * 16) * ldc + col0;
#pragma unroll
                for (int bj = 0; bj < 2; ++bj) { f32x4 v0 = acc[ai][bj][m][0], v1 = acc[ai][bj][m][1];
                    if (act) {
#pragma unroll
                        for (int j = 0; j < 4; ++j) { v0[j] = silu_f(v0[j]); v1[j] = silu_f(v1[j]); } }
                    if (mode == 2) {
                        const u32x4 z = zz[m][bj]; const f32x4 s0 = sc[bj][0], s1 = sc[bj][1];
                        v0[0] *= s0[0] * lo_f(z.x); v0[1] *= s0[1] * hi_f(z.x); v0[2] *= s0[2] * lo_f(z.y); v0[3] *= s0[3] * hi_f(z.y);
                        v1[0] *= s1[0] * lo_f(z.z); v1[1] *= s1[1] * hi_f(z.z); v1[2] *= s1[2] * lo_f(z.w); v1[3] *= s1[3] * hi_f(z.w);
                    }
                    u32x4 w; w.x = pk2(v0[0], v0[1]); w.y = pk2(v0[2], v0[3]); w.z = pk2(v1[0], v1[1]); w.w = pk2(v1[2], v1[3]);
                    *(u32x4*)(base + ro + bj * 128) = w; } } }
    }
};
struct EpiGate {
    static constexpr bool PERM = true;
    bf16_t* O; const float* gate;
    DI void operator()(const f32x4 (&acc)[2][2][4][2], const Unit& u, int wr, int wc, int fr, int fq) const {
        const int row0 = u.pm * 256 + wr * 64 + fr, col0 = u.pn * 256 + wc * 32 + 8 * fq;
        const float* gp = gate + (size_t)(u.pm >> 4) * 3072 + col0;
        f32x4 gv[2][2];
#pragma unroll
        for (int bj = 0; bj < 2; ++bj) { gv[bj][0] = *(const f32x4*)(gp + bj * 128); gv[bj][1] = *(const f32x4*)(gp + bj * 128 + 4); }
#pragma unroll
        for (int ai = 0; ai < 2; ++ai)
#pragma unroll
            for (int m = 0; m < 4; ++m) { bf16_t* rowp = O + (size_t)(row0 + ai * 128 + m * 16) * 1024 + col0;
#pragma unroll
                for (int bj = 0; bj < 2; ++bj) { const f32x4 v0 = acc[ai][bj][m][0] * gv[bj][0], v1 = acc[ai][bj][m][1] * gv[bj][1];
                    u32x4 w; w.x = pk2(v0[0], v0[1]); w.y = pk2(v0[2], v0[3]); w.z = pk2(v1[0], v1[1]); w.w = pk2(v1[2], v1[3]);
                    *(u32x4*)(rowp + bj * 128) = w; } }
    }
};
struct EpiRes {
    static constexpr bool PERM = false;
    float* O; const float* res; const float* gate;
    DI void operator()(const f32x4 (&acc)[2][2][4][2], const Unit& u, int wr, int wc, int fr, int fq) const {
        const int row0 = u.pm * 256 + wr * 64 + fr, col0 = u.pn * 256 + wc * 32 + 4 * fq;
        const float* gp = gate + (size_t)(u.pm >> 4) * 3072 + col0;
        f32x4 gv[2][2];
#pragma unroll
        for (int bj = 0; bj < 2; ++bj)
#pragma unroll
            for (int n = 0; n < 2; ++n) gv[bj][n] = *(const f32x4*)(gp + bj * 128 + n * 16);
#pragma unroll
        for (int ai = 0; ai < 2; ++ai)
#pragma unroll
            for (int mp = 0; mp < 2; ++mp) {
                f32x4 r[2][2][2];
#pragma unroll
                for (int mm = 0; mm < 2; ++mm) { const size_t ro = (size_t)(row0 + ai * 128 + (2 * mp + mm) * 16) * 1024 + col0;
#pragma unroll
                    for (int bj = 0; bj < 2; ++bj)
#pragma unroll
                        for (int n = 0; n < 2; ++n) r[mm][bj][n] = *(const volatile f32x4*)(res + ro + bj * 128 + n * 16); }
#pragma unroll
                for (int mm = 0; mm < 2; ++mm) { const size_t ro = (size_t)(row0 + ai * 128 + (2 * mp + mm) * 16) * 1024 + col0;
#pragma unroll
                    for (int bj = 0; bj < 2; ++bj)
#pragma unroll
                        for (int n = 0; n < 2; ++n) *(f32x4*)(O + ro + bj * 128 + n * 16) = r[mm][bj][n] + gv[bj][n] * acc[ai][bj][2 * mp + mm][n]; }
            }
    }
};

DI void transpose_jobs(const Params& p, LAS unsigned char* lds, int tid, int j_lo, int j_hi, int w, int nw) {
    LAS float* tile = (LAS float*)lds;
    {
        auto job_desc = [&](int job, const float*& src, bf16_t*& dst, int& K, int& Nt, int& k0, int& n0) {
            int j = job, tk, tn;
            if (j < 1792) { src = p.win_even; dst = (bf16_t*)(p.ws + WS_WINE); K = 1024; Nt = 7184; tk = j & 15; tn = j >> 4; }
            else if ((j -= 1792) < 512) { src = p.wout_even; dst = (bf16_t*)(p.ws + WS_WOUTE); K = 2048; Nt = 1024; tk = j & 31; tn = j >> 5; }
            else if ((j -= 512) < 1024) { src = p.win_odd; dst = (bf16_t*)(p.ws + WS_WINO); K = 1024; Nt = 4096; tk = j & 15; tn = j >> 4; }
            else if ((j -= 1024) < 256) { const int g = j >> 6, jj = j & 63; src = p.pool_w + (size_t)g * 512 * 512; dst = (bf16_t*)(p.ws + WS_WPOOL) + (size_t)g * 512 * 512; K = 512; Nt = 512; tk = jj & 7; tn = jj >> 3; }
            else { j -= 256; src = p.wout_odd; dst = (bf16_t*)(p.ws + WS_WOUTO); K = 2048; Nt = 1024; tk = j & 31; tn = j >> 5; }
            k0 = tk * 64; n0 = tn * 64; };
        float rg[8];
        int job = j_lo + w;
        if (job < j_hi) { const float* src; bf16_t* dst; int K, Nt, k0, n0; job_desc(job, src, dst, K, Nt, k0, n0);
#pragma unroll
            for (int i = 0; i < 8; ++i) { const int idx = tid + 512 * i, k = idx >> 6, n = idx & 63; rg[i] = src[(size_t)(k0 + k) * Nt + n0 + n]; } }
        for (; job < j_hi; job += nw) {
            const float* src; bf16_t* dst; int K, Nt, k0, n0; job_desc(job, src, dst, K, Nt, k0, n0);
            __syncthreads();
#pragma unroll
            for (int i = 0; i < 8; ++i) { const int idx = tid + 512 * i, k = idx >> 6, n = idx & 63; tile[k * 65 + n] = rg[i]; }
            __syncthreads();
            const int nj = job + nw;
            if (nj < j_hi) { const float* s2; bf16_t* d2; int K2, Nt2, k2, n2; job_desc(nj, s2, d2, K2, Nt2, k2, n2);
#pragma unroll
                for (int i = 0; i < 8; ++i) { const int idx = tid + 512 * i, k = idx >> 6, n = idx & 63; rg[i] = s2[(size_t)(k2 + k) * Nt2 + n2 + n]; } }
#pragma unroll
            for (int i = 0; i < 4; ++i) { const int idx = tid + 512 * i, n = idx >> 5, k = (idx & 31) * 2;
                *(unsigned*)(dst + (size_t)(n0 + n) * K + k0 + k) = pk2(tile[k * 65 + n], tile[(k + 1) * 65 + n]); }
        }
        __syncthreads();
    }
}
DI void ph_prep(const Params& p, LAS unsigned char* lds) {
    const int tid = opaque_tid();
    transpose_jobs(p, lds, tid, 0, 2304, blockIdx.x, gridDim.x);
    LAS float* sv = (LAS float*)(lds + 32768);
    LAS float* red = (LAS float*)(lds + 32768 + 36864);
    LAS float* ct = (LAS float*)(lds + 90112); LAS float* st = ct + 256;
    for (int idx = tid; idx < 9216; idx += 512) { const int v = idx >> 10, k = idx & 1023; const float cv = (v < 8) ? p.c[v * 1024 + k] : p.c_ctx[k]; sv[idx] = silu_f(cv); }
    if (tid < 256) { float s, c; sincospif((float)tid / 128.0f, &s, &c); ct[tid] = c; st[tid] = s; }
    __syncthreads();
    float* MOD = (float*)(p.ws + WS_MOD);
    for (int item = blockIdx.x; item < 192; item += gridDim.x) {
        const int l = item / 96, c0 = (item % 96) * 32, kg = tid >> 5, col = tid & 31;
        float a[9];
#pragma unroll
        for (int v = 0; v < 9; ++v) a[v] = 0.f;
        const float* w = p.ada_w + (size_t)l * 1024 * 3072 + c0 + col;
#pragma unroll 16
        for (int k = kg; k < 1024; k += 16) { const float wv = w[(size_t)k * 3072];
#pragma unroll
            for (int v = 0; v < 9; ++v) a[v] += sv[v * 1024 + k] * wv; }
#pragma unroll
        for (int v = 0; v < 9; ++v) red[(kg * 32 + col) * 9 + v] = a[v];
        __syncthreads();
        if (tid < 288) { const int v = tid >> 5, cc = tid & 31; float s = 0.f; for (int q = 0; q < 16; ++q) s += red[(q * 32 + cc) * 9 + v];
            MOD[(size_t)(l * 9 + v) * 3072 + c0 + cc] = s + p.ada_b[l * 3072 + c0 + cc]; }
        __syncthreads();
    }
    bf16_t* WF = (bf16_t*)(p.ws + WS_WF);
    for (int it = blockIdx.x; it < 512; it += gridDim.x) {
        const int idx = it * 512 + tid, d = idx & 255, c = (idx >> 8) & 255, g = idx >> 16;
        const float* f = p.fourier_w + (size_t)g * 65536 + d;
        float aP = 0.f, aQ = 0.f;
#pragma unroll 16
        for (int cp = 0; cp < 256; ++cp) { const float fv = f[cp * 256]; const int a = (c * cp) & 255; aP += ct[a] * fv; aQ += st[a] * fv; }
        WF[(size_t)(g * 512 + d) * 256 + c] = (bf16_t)(pk2(aP * 0.0625f, 0.f) & 0xffffu);
        WF[(size_t)(g * 512 + 256 + d) * 256 + c] = (bf16_t)(pk2(-aQ * 0.0625f, 0.f) & 0xffffu);
    }
}

DI void ph_norm0(const Params& p, LAS unsigned char* lds) {
    const int tid = opaque_tid(), wid = tid >> 6, lane = tid & 63;
    LAS float* wg = (LAS float*)lds;
#pragma unroll 4
    for (int i = 0; i < 32; ++i) { const int idx = tid + 512 * i, k = idx >> 4, j = idx & 15; wg[j * 1024 + k] = p.win_even[(size_t)k * 7184 + 7168 + j]; }
    __syncthreads();
    f32x4 g[4];
#pragma unroll
    for (int i = 0; i < 4; ++i) g[i] = *(const f32x4*)(p.norm_g + lane * 4 + 256 * i);
    const float* MOD = (const float*)(p.ws + WS_MOD);
    bf16_t* HX = (bf16_t*)p.out;
    float* GATES = (float*)(p.ws + WS_GATES);
    f32x4 vn[4];
    { const int r = blockIdx.x * 8 + wid; if (r < NR) { const float* src = (r < NX) ? p.x + (size_t)r * 1024 : p.ctx + (size_t)(r - NX) * 1024;
#pragma unroll
        for (int i = 0; i < 4; ++i) vn[i] = *(const f32x4*)(src + lane * 4 + 256 * i); } }
    for (int r = blockIdx.x * 8 + wid; r < NR; r += gridDim.x * 8) {
        const float* md;
        if (r < NX) { md = MOD + (size_t)(r >> 12) * 3072; } else { md = MOD + (size_t)8 * 3072; }
        f32x4 v[4]; float ss = 0.f;
#pragma unroll
        for (int i = 0; i < 4; ++i) { v[i] = vn[i]; ss += v[i][0] * v[i][0] + v[i][1] * v[i][1] + v[i][2] * v[i][2] + v[i][3] * v[i][3]; }
        { const int r2 = r + gridDim.x * 8; if (r2 < NR) { const float* s2 = (r2 < NX) ? p.x + (size_t)r2 * 1024 : p.ctx + (size_t)(r2 - NX) * 1024;
#pragma unroll
            for (int i = 0; i < 4; ++i) vn[i] = *(const f32x4*)(s2 + lane * 4 + 256 * i); } }
        ss = wave_sum(ss);
        const float rstd = rsqrtf(ss * (1.0f / 1024.0f) + 1e-6f);
#pragma unroll
        for (int i = 0; i < 4; ++i) { const f32x4 sh = *(const f32x4*)(md + lane * 4 + 256 * i), sc = *(const f32x4*)(md + 1024 + lane * 4 + 256 * i);
            v[i] = v[i] * rstd * g[i] * (sc + 1.0f) + sh;
            u32x2 w; w.x = pk2(v[i][0], v[i][1]); w.y = pk2(v[i][2], v[i][3]);
            *(u32x2*)(HX + (size_t)r * 1024 + lane * 4 + 256 * i) = w; }
        float pt[16];
#pragma unroll
        for (int j = 0; j < 16; ++j) { float a = 0.f;
#pragma unroll
            for (int i = 0; i < 4; ++i) { const f32x4 w4 = *(const LAS f32x4*)(wg + j * 1024 + lane * 4 + 256 * i); a += v[i][0] * w4[0] + v[i][1] * w4[1] + v[i][2] * w4[2] + v[i][3] * w4[3]; }
            pt[j] = a; if ((j & 3) == 3) __builtin_amdgcn_sched_barrier(0); }
        { const bool b5 = lane & 32;
#pragma unroll
          for (int j = 0; j < 8; ++j) { const float snd = b5 ? pt[j] : pt[j + 8], kp = b5 ? pt[j + 8] : pt[j]; pt[j] = kp + __shfl_xor(snd, 32); } }
        { const bool b4 = lane & 16;
#pragma unroll
          for (int j = 0; j < 4; ++j) { const float snd = b4 ? pt[j] : pt[j + 4], kp = b4 ? pt[j + 4] : pt[j]; pt[j] = kp + __shfl_xor(snd, 16); } }
        { const bool b3 = lane & 8;
#pragma unroll
          for (int j = 0; j < 2; ++j) { const float snd = b3 ? pt[j] : pt[j + 2], kp = b3 ? pt[j + 2] : pt[j]; pt[j] = kp + __shfl_xor(snd, 8); } }
        { const bool b2 = lane & 4; const float snd = b2 ? pt[0] : pt[1], kp = b2 ? pt[1] : pt[0]; pt[0] = kp + __shfl_xor(snd, 4); }
        pt[0] += __shfl_xor(pt[0], 2); pt[0] += __shfl_xor(pt[0], 1);
        if ((lane & 3) == 0) { const int j = ((lane >> 5) & 1) * 8 + ((lane >> 4) & 1) * 4 + ((lane >> 3) & 1) * 2 + ((lane >> 2) & 1);
            float val = pt[0] + p.gate_b[j];
            if ((j >> 2) & 1) val = fminf(val, 0.f) - log1pf(__expf(-fabsf(val)));
            GATES[(size_t)r * 16 + j] = val; }
    }
}
DI void ph_norm1(const Params& p, int mode) {
    const int tid = opaque_tid(), wid = tid >> 6, lane = tid & 63;
    const float* gsrc = mode ? p.final_g : p.norm_g + 1024;
    f32x4 g[4];
#pragma unroll
    for (int i = 0; i < 4; ++i) g[i] = *(const f32x4*)(gsrc + lane * 4 + 256 * i);
    const float* MOD = (const float*)(p.ws + WS_MOD) + (size_t)9 * 3072;
    const bf16_t* D0 = (const bf16_t*)p.ws; const bf16_t* D1 = (const bf16_t*)(p.ws + PLANE);
    bf16_t* HX1 = (bf16_t*)(p.ws + 2 * PLANE);
    f32x4 vn[4];
#define N1_LOAD(RR) do { _Pragma("unroll") for (int i = 0; i < 4; ++i) { const size_t o = (size_t)(RR) * 1024 + lane * 4 + 256 * i; \
        f32x4 xv = *(const f32x4*)(p.x + o); const u32x2 q = *(const u32x2*)(D0 + o); xv += (f32x4){lo_f(q.x), hi_f(q.x), lo_f(q.y), hi_f(q.y)}; \
        if (mode) { const u32x2 q1 = *(const u32x2*)(D1 + o); xv += (f32x4){lo_f(q1.x), hi_f(q1.x), lo_f(q1.y), hi_f(q1.y)}; } \
        vn[i] = xv; } } while (0)
    { const int r = blockIdx.x * 8 + wid; if (r < NX) N1_LOAD(r); }
    for (int r = blockIdx.x * 8 + wid; r < NX; r += gridDim.x * 8) {
        const float* md = MOD + (size_t)(r >> 12) * 3072;
        f32x4 v[4]; float ss = 0.f;
#pragma unroll
        for (int i = 0; i < 4; ++i) { v[i] = vn[i]; ss += v[i][0] * v[i][0] + v[i][1] * v[i][1] + v[i][2] * v[i][2] + v[i][3] * v[i][3]; }
        { const int r2 = r + gridDim.x * 8; if (r2 < NX) N1_LOAD(r2); }
        ss = wave_sum(ss);
        const float rstd = rsqrtf(ss * (1.0f / 1024.0f) + 1e-6f);
#pragma unroll
        for (int i = 0; i < 4; ++i) {
            if (mode) { *(f32x4*)(p.out + (size_t)r * 1024 + lane * 4 + 256 * i) = v[i] * rstd * g[i]; }
            else { const f32x4 sh = *(const f32x4*)(md + lane * 4 + 256 * i), sc = *(const f32x4*)(md + 1024 + lane * 4 + 256 * i);
                const f32x4 h = v[i] * rstd * g[i] * (sc + 1.0f) + sh;
                u32x2 w; w.x = pk2(h[0], h[1]); w.y = pk2(h[2], h[3]);
                *(u32x2*)(HX1 + (size_t)r * 1024 + lane * 4 + 256 * i) = w; } }
    }
#undef N1_LOAD
}

DI void ph_conv(const Params& p) {
    const bf16_t* QRAW = (const bf16_t*)p.ws; const bf16_t* KRAW = (const bf16_t*)(p.ws + PLANE);
    const bf16_t* CQ = (const bf16_t*)(p.ws + WS_CRAW); const bf16_t* CK = CQ + (size_t)NCX * 1024;
    bf16_t* QC = (bf16_t*)p.out; bf16_t* KC = QC + (size_t)NX * 1024;
    bf16_t* CQC = (bf16_t*)(p.ws + WS_CQC); bf16_t* CKC = (bf16_t*)(p.ws + WS_CKC);
    const int tid = opaque_tid();
    const bool scanner = (blockIdx.x < 64) && (tid < 64) && (gridDim.x >= 64);
    const int nscan = gridDim.x >= 64 ? 64 : 0;
    const int active_id = (int)blockIdx.x < nscan ? (int)blockIdx.x * 448 + (tid - 64) : nscan * 448 + ((int)blockIdx.x - nscan) * 512 + tid;
    const int active_n = nscan * 448 + ((int)gridDim.x - nscan) * 512;
    if (!scanner)
    for (int idx = active_id; idx < (NR / 8) * 256; idx += active_n) {
        const int oct = idx & 127, which = (idx >> 7) & 1, r0 = (idx >> 8) * 8, ch = oct * 8;
        const bf16_t* src; bf16_t* dst; int t0, T;
        if (r0 < NX) { src = (which ? KRAW : QRAW) + (size_t)r0 * 1024 + ch; dst = (which ? KC : QC) + (size_t)r0 * 1024 + ch; t0 = r0 & 4095; T = 4096; }
        else { const int rr = r0 - NX; src = (which ? CK : CQ) + (size_t)rr * 1024 + ch; dst = (which ? CKC : CQC) + (size_t)rr * 1024 + ch; t0 = rr & 255; T = 256; }
        const u32x4 z = {0u, 0u, 0u, 0u};
        u32x4 v[10];
        v[0] = (t0 > 0) ? *(const u32x4*)(src - 1024) : z;
#pragma unroll
        for (int i = 0; i < 8; ++i) v[i + 1] = *(const u32x4*)(src + (size_t)i * 1024);
        v[9] = (t0 + 8 < T) ? *(const u32x4*)(src + (size_t)8 * 1024) : z;
        const float* w = p.conv_qk + which * 1024 + ch;
        float wt[3][8];
#pragma unroll
        for (int j = 0; j < 3; ++j) { const f32x4 wa = *(const f32x4*)(w + j * 2048), wb = *(const f32x4*)(w + j * 2048 + 4);
#pragma unroll
            for (int e = 0; e < 4; ++e) { wt[j][e] = wa[e]; wt[j][4 + e] = wb[e]; } }
        const float qs = which ? 1.0f : 0.0625f;
#pragma unroll
        for (int i = 0; i < 8; ++i) {
            float o[8];
#pragma unroll
            for (int e = 0; e < 4; ++e) {
                float lo = wt[0][2 * e] * lo_f(v[i][e]) + wt[1][2 * e] * lo_f(v[i + 1][e]) + wt[2][2 * e] * lo_f(v[i + 2][e]);
                float hi = wt[0][2 * e + 1] * hi_f(v[i][e]) + wt[1][2 * e + 1] * hi_f(v[i + 1][e]) + wt[2][2 * e + 1] * hi_f(v[i + 2][e]);
                o[2 * e] = silu_f(lo) * qs; o[2 * e + 1] = silu_f(hi) * qs;
            }
            u32x4 wv; wv.x = pk2(o[0], o[1]); wv.y = pk2(o[2], o[3]); wv.z = pk2(o[4], o[5]); wv.w = pk2(o[6], o[7]);
            *(u32x4*)(dst + (size_t)i * 1024) = wv;
        }
    }
    const int lane = tid & 63;
    const int n_sc = nscan ? 1 : 64;
    if (scanner || (nscan == 0 && blockIdx.x == 0 && tid < 64))
    for (int sc = 0; sc < n_sc; ++sc) {
        const int gw = nscan ? (int)blockIdx.x : sc;
        const int b = gw >> 3, h = (gw >> 1) & 3, dir = gw & 1;
        const float* GATES = (const float*)(p.ws + WS_GATES);
        float* GP = (float*)(p.ws + WS_GPRE) + (size_t)gw * 68 * 384;
        float m_prev = 0.f;
        auto grow_of = [&](int st) -> size_t { if (st < 4) { const int cc = dir ? 3 - st : st; return (size_t)NX + (size_t)b * 256 + cc * 64; } const int xc = st - 4, cc = dir ? 63 - xc : xc; return (size_t)b * 4096 + cc * 64; };
        const int oi = (dir ? 8 : 0) + h, of = (dir ? 12 : 4) + h;
        float nig = GATES[(grow_of(0) + lane) * 16 + oi], nlf = GATES[(grow_of(0) + lane) * 16 + of];
        for (int st = 0; st < 68; ++st) {
            const float ig = nig, lf = nlf;
            if (st + 1 < 68) { const size_t g2 = grow_of(st + 1); nig = GATES[(g2 + lane) * 16 + oi]; nlf = GATES[(g2 + lane) * 16 + of]; }
            float bs = lf;
#pragma unroll
            for (int o = 1; o < 64; o <<= 1) { const float ov = dir ? __shfl_down(bs, o) : __shfl_up(bs, o); const bool ok = dir ? (lane + o < 64) : (lane >= o); if (ok) bs += ov; }
            const float a = ig - bs;
            float mx = a;
#pragma unroll
            for (int o = 1; o < 64; o <<= 1) { const float ov = dir ? __shfl_down(mx, o) : __shfl_up(mx, o); const bool ok = dir ? (lane + o < 64) : (lane >= o); if (ok) mx = fmaxf(mx, ov); }
            const float total = __shfl(bs, dir ? 0 : 63);
            const float m_inter = bs + m_prev, m_t = fmaxf(bs + mx, m_inter);
            const float wsl = total - bs + ig;
            const float m_new = fmaxf(total + m_prev, wave_max(wsl));
            float* o = GP + (size_t)st * 384;
            o[lane] = bs - m_t; o[64 + lane] = a; o[128 + lane] = __expf(m_inter - m_t); o[192 + lane] = __expf(wsl - m_new); o[256 + lane] = __expf(-m_t);
            if (lane == 0) o[320] = __expf(total + m_prev - m_new);
            m_prev = m_new;
        }
    }
}

DI void ph_mlstm(const Params& p, LAS unsigned char* lds) {
    constexpr int QP = 528, VP = 176, SP = 144;
    LAS unsigned char* Qi = lds; LAS unsigned char* Ki = lds + 33792; LAS unsigned char* Vi0 = lds + 67584; LAS unsigned char* Vwi = Vi0 + 2 * 11264;
    LAS unsigned char* Sgi = Vwi + 11264; LAS unsigned char* Ci = Sgi + 9216; LAS float* fl0 = (LAS float*)(Ci + 42240);
    const int tid = opaque_tid(), wid = tid >> 6, lane = tid & 63, fr = lane & 15, fq = lane >> 4;
    const bf16_t* QC = (const bf16_t*)p.out; const bf16_t* KC = QC + (size_t)NX * 1024; const bf16_t* VPL = (const bf16_t*)(p.ws + 2 * PLANE);
    const bf16_t* CQC = (const bf16_t*)(p.ws + WS_CQC); const bf16_t* CKC = (const bf16_t*)(p.ws + WS_CKC); const bf16_t* CV = (const bf16_t*)(p.ws + WS_CRAW) + (size_t)2 * NCX * 1024;
    for (int wi = blockIdx.x; wi < 256; wi += gridDim.x) {
        const int b = wi >> 5, h = (wi >> 3) & 3, dir = (wi >> 2) & 1, es = wi & 3;
        bf16_t* Hout = (bf16_t*)(p.ws + (dir ? PLANE : 0));
        const float* GP = (const float*)(p.ws + WS_GPRE) + (size_t)((b * 4 + h) * 2 + dir) * 68 * 384;
        f32x4 Cst[2][5];
#pragma unroll
        for (int i = 0; i < 2; ++i)
#pragma unroll
            for (int n = 0; n < 5; ++n) Cst[i][n] = (f32x4){0.f, 0.f, 0.f, 0.f};
        __syncthreads();
        for (int i = tid; i < 64 * 8; i += 512) { const int row = i >> 3, c = i & 7;
            *(LAS unsigned*)(Vi0 + row * VP + 128 + c * 4) = 0x3F803F80u; *(LAS unsigned*)(Vi0 + 11264 + row * VP + 128 + c * 4) = 0x3F803F80u; *(LAS unsigned*)(Vwi + row * VP + 128 + c * 4) = 0u; }
        u32x4 rq[4], rk[4], rv; float pg = 0.f, pws = 0.f, pdecay = 0.f, decay = 0.f;
        const int mt = wid >> 1, nt0 = 2 * (wid & 1);
#define ML_LOAD(ST) do { const int _st = (ST); const bf16_t *_q, *_k, *_v; \
            if (_st < 4) { const int cc = dir ? 3 - _st : _st; const size_t row0 = (size_t)b * 256 + cc * 64; _q = CQC + row0 * 1024 + h * 256; _k = CKC + row0 * 1024 + h * 256; _v = CV + row0 * 1024 + h * 256 + es * 64; } \
            else { const int xc = _st - 4, cc = dir ? 63 - xc : xc; const size_t row0 = (size_t)b * 4096 + cc * 64; _q = QC + row0 * 1024 + h * 256; _k = KC + row0 * 1024 + h * 256; _v = VPL + row0 * 1024 + h * 256 + es * 64; } \
            _Pragma("unroll") for (int i = 0; i < 4; ++i) { const int id = tid + 512 * i, row = id >> 5, chk = id & 31; rq[i] = *(const u32x4*)(_q + (size_t)row * 1024 + chk * 8); rk[i] = *(const u32x4*)(_k + (size_t)row * 1024 + chk * 8); } \
            rv = *(const u32x4*)(_v + (size_t)(tid >> 3) * 1024 + (tid & 7) * 8); \
            const float* _g = GP + (size_t)_st * 384; pg = _g[tid < 320 ? tid : 0]; pws = _g[192 + (tid >> 3)]; pdecay = _g[320]; } while (0)
#define ML_WRITE(ST) do { LAS unsigned char* _Vi = Vi0 + ((ST) & 1) * 11264; LAS float* _fl = fl0 + ((ST) & 1) * 320; \
            _Pragma("unroll") for (int i = 0; i < 4; ++i) { const int id = tid + 512 * i, row = id >> 5, chk = id & 31; \
                *(LAS u32x4*)(Qi + row * QP + chk * 16) = rq[i]; *(LAS u32x4*)(Ki + row * QP + chk * 16) = rk[i]; } \
            *(LAS u32x4*)(_Vi + (tid >> 3) * VP + (tid & 7) * 16) = rv; \
            { const float w = pws; u32x4 o; \
              o.x = pk2(w * lo_f(rv.x), w * hi_f(rv.x)); o.y = pk2(w * lo_f(rv.y), w * hi_f(rv.y)); o.z = pk2(w * lo_f(rv.z), w * hi_f(rv.z)); o.w = pk2(w * lo_f(rv.w), w * hi_f(rv.w)); \
              *(LAS u32x4*)(Vwi + (tid >> 3) * VP + (tid & 7) * 16) = o; \
              if ((tid & 7) == 0) *(LAS unsigned*)(Vwi + (tid >> 3) * VP + 128) = pk2(w, 0.f); } \
            if (tid < 320) _fl[tid] = pg; \
            _Pragma("unroll") for (int i = 0; i < 2; ++i) _Pragma("unroll") for (int n = 0; n < 5; ++n) { u32x2 w; w.x = pk2(Cst[i][n][0], Cst[i][n][1]); w.y = pk2(Cst[i][n][2], Cst[i][n][3]); \
                *(LAS u32x2*)(Ci + (16 * n + fr) * QP + (16 * (2 * wid + i) + 4 * fq) * 2) = w; } \
            decay = pdecay; } while (0)
        ML_LOAD(0);
        __syncthreads();
        ML_WRITE(0);
        ML_LOAD(1);
        for (int st = 0; st < 68; ++st) {
            const bool isx = st >= 4;
            LAS unsigned char* Vi = Vi0 + (st & 1) * 11264; LAS float* fl = fl0 + (st & 1) * 320;
            LAS float* f_bt = fl; LAS float* f_aa = fl + 64; LAS float* f_inter = fl + 128; LAS float* f_enm = fl + 256;
            __syncthreads();
            const float dcy = decay;
            const int t = 16 * mt + fr;
            f32x4 accC[3];
#pragma unroll
            for (int n = 0; n < 3; ++n) accC[n] = (f32x4){0.f, 0.f, 0.f, 0.f};
            if (isx) {
                f32x4 sacc[2] = {(f32x4){0.f, 0.f, 0.f, 0.f}, (f32x4){0.f, 0.f, 0.f, 0.f}};
#pragma unroll
                for (int ks = 0; ks < 8; ++ks) { const bf16x8 qf = *(const LAS bf16x8*)(Qi + t * QP + (32 * ks + 8 * fq) * 2);
#pragma unroll
                    for (int n = 0; n < 2; ++n) { const bf16x8 kf = *(const LAS bf16x8*)(Ki + (16 * (nt0 + n) + fr) * QP + (32 * ks + 8 * fq) * 2); sacc[n] = mfma16(kf, qf, sacc[n]); }
#pragma unroll
                    for (int n = 0; n < 3; ++n) { const int et = (n < 2) ? nt0 + n : 4; const bf16x8 cf = *(const LAS bf16x8*)(Ci + (16 * et + fr) * QP + (32 * ks + 8 * fq) * 2); accC[n] = mfma16(cf, qf, accC[n]); } }
                const float btm = f_bt[t];
#pragma unroll
                for (int n = 0; n < 2; ++n) { const int s0 = 16 * (nt0 + n) + 4 * fq; const f32x4 a4 = *(const LAS f32x4*)(f_aa + s0); float vv[4];
#pragma unroll
                    for (int j = 0; j < 4; ++j) { const int s = s0 + j; const bool ok = dir ? (s >= t) : (s <= t); const float e = __expf(btm + a4[j]); vv[j] = ok ? sacc[n][j] * e : 0.f; }
                    u32x2 w; w.x = pk2(vv[0], vv[1]); w.y = pk2(vv[2], vv[3]); *(LAS u32x2*)(Sgi + t * SP + s0 * 2) = w; }
            }
#pragma unroll
            for (int i = 0; i < 2; ++i)
#pragma unroll
                for (int n = 0; n < 5; ++n) Cst[i][n] = Cst[i][n] * dcy;
#pragma unroll
            for (int ks = 0; ks < 2; ++ks) { bf16x8 kf[2];
#pragma unroll
                for (int i = 0; i < 2; ++i) kf[i] = tr_frag(Ki, QP, 32 * ks, 16 * (2 * wid + i), lane);
#pragma unroll
                for (int n = 0; n < 5; ++n) { const bf16x8 vw = tr_frag(Vwi, VP, 32 * ks, 16 * n, lane);
#pragma unroll
                    for (int i = 0; i < 2; ++i) Cst[i][n] = mfma16(kf[i], vw, Cst[i][n]); } }
            __syncthreads();
            if (isx) {
                f32x4 accD[3];
#pragma unroll
                for (int n = 0; n < 3; ++n) accD[n] = (f32x4){0.f, 0.f, 0.f, 0.f};
#pragma unroll
                for (int ks = 0; ks < 2; ++ks) { const bf16x8 sgf = *(const LAS bf16x8*)(Sgi + t * SP + (32 * ks + 8 * fq) * 2);
#pragma unroll
                    for (int n = 0; n < 3; ++n) { const int et = (n < 2) ? nt0 + n : 4; const bf16x8 vf = tr_frag(Vi, VP, 32 * ks, 16 * et, lane); accD[n] = mfma16(vf, sgf, accD[n]); } }
                const float inter_t = f_inter[t];
                const float den0 = accD[2][0] + inter_t * accC[2][0];
                const float den = __shfl(den0, fr);
                const float rden = 1.0f / fmaxf(fabsf(den), f_enm[t]);
                const int xc = st - 4, cc = dir ? 63 - xc : xc;
                bf16_t* hp = Hout + ((size_t)b * 4096 + cc * 64 + t) * 1024 + h * 256 + es * 64 + 4 * fq;
#pragma unroll
                for (int n = 0; n < 2; ++n) { const f32x4 hv = (accD[n] + accC[n] * inter_t) * rden;
                    u32x2 w; w.x = pk2(hv[0], hv[1]); w.y = pk2(hv[2], hv[3]); *(u32x2*)(hp + 16 * (nt0 + n)) = w; }
            }
            if (st + 1 < 68) { ML_WRITE(st + 1); if (st + 2 < 68) ML_LOAD(st + 2); }
        }
#undef ML_LOAD
#undef ML_WRITE
    }
}

template <int KK, int NN, class Cfg>
DI void axis_mix(const Cfg& cfg, LAS unsigned char* lds, int n_items) {
    constexpr int TP = 528, BP = KK * 2 + 16, NCH = KK / 16;
    LAS unsigned char* Ti = lds; LAS unsigned char* Bi = lds + 128 * TP;
    const int tid = opaque_tid(), wid = tid >> 6, lane = tid & 63, fr = lane & 15, fq = lane >> 4;
    __syncthreads();
    cfg.fill_tables(Bi, tid);
    u32x4 ra[NCH], rb[NCH];
    const int G = gridDim.x;
#define AX_LOAD(R, IT) do { if ((IT) < n_items) { _Pragma("unroll") for (int i = 0; i < NCH; ++i) { const int id = tid + 512 * i; R[i] = *(const u32x4*)(cfg.row_ptr((IT), id >> 5) + (id & 31) * 8); } } } while (0)
#define AX_BODY(R, IT, PRE) do { \
        __syncthreads(); \
        _Pragma("unroll") for (int i = 0; i < NCH; ++i) { const int id = tid + 512 * i; *(LAS u32x4*)(Ti + (id >> 5) * TP + (id & 31) * 16) = R[i]; } \
        __syncthreads(); \
        AX_LOAD(R, PRE); \
        f32x4 acc[2][NN / 16]; \
        _Pragma("unroll") for (int i = 0; i < 2; ++i) _Pragma("unroll") for (int n = 0; n < NN / 16; ++n) acc[i][n] = (f32x4){0.f, 0.f, 0.f, 0.f}; \
        LAS unsigned char* tb = Bi + cfg.table_off(IT); \
        _Pragma("unroll") for (int ks = 0; ks < KK / 32; ++ks) { bf16x8 af[2]; \
            _Pragma("unroll") for (int i = 0; i < 2; ++i) af[i] = tr_frag(Ti, TP, 32 * ks, 32 * wid + 16 * i, lane); \
            _Pragma("unroll") for (int n = 0; n < NN / 16; ++n) { const bf16x8 bfr = *(const LAS bf16x8*)(tb + (16 * n + fr) * BP + (32 * ks + 8 * fq) * 2); \
                _Pragma("unroll") for (int i = 0; i < 2; ++i) acc[i][n] = mfma16(af[i], bfr, acc[i][n]); } } \
        cfg.epilogue(acc, (IT), wid, fr, fq, Bi); } while (0)
    int item = blockIdx.x;
    AX_LOAD(ra, item); AX_LOAD(rb, item + G);
    for (; item < n_items; item += 2 * G) {
        AX_BODY(ra, item, item + 2 * G);
        if (item + G < n_items) AX_BODY(rb, item + G, item + 3 * G);
    }
#undef AX_LOAD
#undef AX_BODY
}
DI void fill_dft_table(LAS unsigned char* Bi, int tid, int nrows) {
    for (int idx = tid; idx < nrows * 128; idx += 512) { const int n = idx >> 7, k = idx & 127, ap = n & 63, kk = k & 63; float s, c; sincospif((float)((kk * ap) & 63) / 32.0f, &s, &c);
        float v; if (n < 64) v = (k < 64) ? c : s; else v = (k < 64) ? -s : c;
        *(LAS unsigned short*)(Bi + n * 272 + k * 2) = (unsigned short)(pk2(v * 0.125f, 0.f) & 0xffffu); }
}
struct CfgDft1 {
    const bf16_t* Z; bf16_t* S1re; bf16_t* S1im;
    DI void fill_tables(LAS unsigned char* Bi, int tid) const { fill_dft_table(Bi, tid, 128); }
    DI int table_off(int) const { return 0; }
    DI const bf16_t* row_ptr(int item, int k) const { const int g = item & 3, b = (item >> 2) & 63, batch = item >> 8;
        return Z + ((size_t)batch * 4096 + 64 * (k & 63) + b) * 2048 + g * 512 + (k >> 6) * 256; }
    DI void epilogue(const f32x4 (&acc)[2][8], int item, int wid, int fr, int fq, LAS unsigned char* Bi) const {
        const int g = item & 3, b = (item >> 2) & 63, batch = item >> 8;
#pragma unroll
        for (int ni = 0; ni < 4; ++ni) { const int ap = 16 * ni + fr; float s, c; sincospif((float)(b * ap) * (1.0f / 2048.0f), &s, &c);
            const size_t tok = (size_t)batch * 4096 + 64 * ap + b;
#pragma unroll
            for (int i = 0; i < 2; ++i) { const f32x4 re = acc[i][ni], im = acc[i][ni + 4]; const f32x4 r2 = re * c + im * s, i2 = im * c - re * s;
                const size_t o = tok * 1024 + g * 256 + 32 * wid + 16 * i + 4 * fq;
                u32x2 w; w.x = pk2(r2[0], r2[1]); w.y = pk2(r2[2], r2[3]); *(u32x2*)(S1re + o) = w;
                w.x = pk2(i2[0], i2[1]); w.y = pk2(i2[2], i2[3]); *(u32x2*)(S1im + o) = w; } }
    }
};
struct CfgDft2 {
    const bf16_t* S1re; const bf16_t* S1im; const bf16_t* ZB; bf16_t* Y;
    DI void fill_tables(LAS unsigned char* Bi, int tid) const { fill_dft_table(Bi, tid, 64); }
    DI int table_off(int) const { return 0; }
    DI const bf16_t* row_ptr(int item, int k) const { const int g = item & 3, ap = (item >> 2) & 63, batch = item >> 8;
        return ((k >> 6) ? S1im : S1re) + ((size_t)batch * 4096 + 64 * ap + (k & 63)) * 1024 + g * 256; }
    DI void epilogue(const f32x4 (&acc)[2][4], int item, int wid, int fr, int fq, LAS unsigned char*) const {
        const int g = item & 3, ap = (item >> 2) & 63, batch = item >> 8;
#pragma unroll
        for (int ni = 0; ni < 4; ++ni) { const size_t tok = (size_t)batch * 4096 + ap + 64 * (16 * ni + fr);
#pragma unroll
            for (int i = 0; i < 2; ++i) { const int ch = g * 256 + 32 * wid + 16 * i + 4 * fq; const u32x2 z = *(const u32x2*)(ZB + tok * 1024 + ch); const f32x4 a = acc[i][ni];
                u32x2 w; w.x = pk2(a[0] * silu_f(lo_f(z.x)), a[1] * silu_f(hi_f(z.x))); w.y = pk2(a[2] * silu_f(lo_f(z.y)), a[3] * silu_f(hi_f(z.y)));
                *(u32x2*)(Y + tok * 2048 + 1024 + ch) = w; } }
    }
};
DI void fill_pool_tables(LAS unsigned char* Bi, int tid) {
    for (int idx = tid; idx < 4 * 4096; idx += 512) { const int g = idx >> 12, n = (idx >> 6) & 63, k = idx & 63, w = 2 << g, lo = n - w / 2, hi = n + w - w / 2;
        *(LAS unsigned short*)(Bi + g * 9216 + n * 144 + k * 2) = (k >= lo && k < hi) ? (unsigned short)0x3F80 : (unsigned short)0; }
}
DI float pool_rcnt(int g, int n) { const int w = 2 << g; int lo = n - w / 2, hi = n + w - w / 2; lo = lo < 0 ? 0 : lo; hi = hi > 64 ? 64 : hi; return 1.0f / (float)(hi - lo); }
struct CfgPoolA {
    const bf16_t* UC; bf16_t* PA;
    DI void fill_tables(LAS unsigned char* Bi, int tid) const { fill_pool_tables(Bi, tid); }
    DI int table_off(int item) const { return ((item & 7) >> 1) * 9216; }
    DI const bf16_t* row_ptr(int item, int k) const { const int ct = item & 7, c = (item >> 3) & 63, batch = item >> 9; return UC + ((size_t)batch * 4096 + 64 * k + c) * 2048 + ct * 256; }
    DI void epilogue(const f32x4 (&acc)[2][4], int item, int wid, int fr, int fq, LAS unsigned char*) const {
        const int ct = item & 7, c = (item >> 3) & 63, batch = item >> 9, g = ct >> 1;
#pragma unroll
        for (int ni = 0; ni < 4; ++ni) { const int n = 16 * ni + fr; const float rc = pool_rcnt(g, n); const size_t tok = (size_t)batch * 4096 + 64 * n + c;
#pragma unroll
            for (int i = 0; i < 2; ++i) { const f32x4 a = acc[i][ni] * rc; u32x2 w; w.x = pk2(a[0], a[1]); w.y = pk2(a[2], a[3]);
                *(u32x2*)(PA + tok * 2048 + ct * 256 + 32 * wid + 16 * i + 4 * fq) = w; } }
    }
};
struct CfgPoolB {
    const bf16_t* PA; bf16_t* UC;
    DI void fill_tables(LAS unsigned char* Bi, int tid) const { fill_pool_tables(Bi, tid); }
    DI int table_off(int item) const { return ((item & 7) >> 1) * 9216; }
    DI const bf16_t* row_ptr(int item, int k) const { const int ct = item & 7, rp = (item >> 3) & 63, batch = item >> 9; return PA + ((size_t)batch * 4096 + 64 * rp + k) * 2048 + ct * 256; }
    DI void epilogue(const f32x4 (&acc)[2][4], int item, int wid, int fr, int fq, LAS unsigned char*) const {
        const int ct = item & 7, rp = (item >> 3) & 63, batch = item >> 9, g = ct >> 1;
#pragma unroll
        for (int ni = 0; ni < 4; ++ni) { const int n = 16 * ni + fr; const float rc = pool_rcnt(g, n); const size_t tok = (size_t)batch * 4096 + 64 * rp + n;
#pragma unroll
            for (int i = 0; i < 2; ++i) { bf16_t* up = UC + tok * 2048 + ct * 256 + 32 * wid + 16 * i + 4 * fq; const u32x2 u = *(const u32x2*)up; const f32x4 a = acc[i][ni] * rc;
                u32x2 w; w.x = pk2(a[0] - lo_f(u.x), a[1] - hi_f(u.x)); w.y = pk2(a[2] - lo_f(u.y), a[3] - hi_f(u.y)); *(u32x2*)up = w; } }
    }
};

DI void ph_ya(const Params& p) {
    const int tid = opaque_tid(), wid = tid >> 6, lane = tid & 63;
    const bf16_t* HF = (const bf16_t*)p.ws; const bf16_t* HB = (const bf16_t*)(p.ws + PLANE); const bf16_t* O = (const bf16_t*)(p.ws + 3 * PLANE); const bf16_t* ZA = (const bf16_t*)(p.ws + 4 * PLANE);
    bf16_t* Y = (bf16_t*)p.out;
    f32x4 hg[4];
#pragma unroll
    for (int i = 0; i < 4; ++i) hg[i] = *(const f32x4*)(p.head_norm + lane * 16 + 4 * i);
    for (int r = blockIdx.x * 8 + wid; r < NX; r += gridDim.x * 8) {
        const size_t o = (size_t)r * 1024 + lane * 16;
        float gv[16], za[16]; float ss = 0.f;
#pragma unroll
        for (int hh = 0; hh < 2; ++hh) { const u32x4 a = *(const u32x4*)(HF + o + 8 * hh), bq = *(const u32x4*)(HB + o + 8 * hh), oo = *(const u32x4*)(O + o + 8 * hh), zz = *(const u32x4*)(ZA + o + 8 * hh);
#pragma unroll
            for (int e = 0; e < 4; ++e) { const float h0 = lo_f(a[e]) + lo_f(bq[e]), h1 = hi_f(a[e]) + hi_f(bq[e]);
                const float g0 = sigmoid_f(lo_f(oo[e])) * h0, g1 = sigmoid_f(hi_f(oo[e])) * h1;
                gv[8 * hh + 2 * e] = g0; gv[8 * hh + 2 * e + 1] = g1; ss += g0 * g0 + g1 * g1; za[8 * hh + 2 * e] = lo_f(zz[e]); za[8 * hh + 2 * e + 1] = hi_f(zz[e]); } }
        ss += __shfl_xor(ss, 1); ss += __shfl_xor(ss, 2); ss += __shfl_xor(ss, 4); ss += __shfl_xor(ss, 8);
        const float rstd = rsqrtf(ss * (1.0f / 256.0f) + 1e-6f);
        u32x4 w[2];
#pragma unroll
        for (int q = 0; q < 8; ++q) { const float y0 = gv[2 * q] * rstd * hg[q >> 1][(2 * q) & 3] * silu_f(za[2 * q]), y1 = gv[2 * q + 1] * rstd * hg[q >> 1][(2 * q + 1) & 3] * silu_f(za[2 * q + 1]);
            w[q >> 2][q & 3] = pk2(y0, y1); }
        *(u32x4*)(Y + (size_t)r * 2048 + lane * 16) = w[0]; *(u32x4*)(Y + (size_t)r * 2048 + lane * 16 + 8) = w[1];
    }
}


#define XB_TMO      128
#define XB_XCNT(j)  (256  + 64 * (j))
#define XB_XSUB(j)  (1280 + 64 * (j))
#define XB_XGEN(j)  (2304 + 64 * (j))
#define XB_TOP      3328
#define XB_TOPGEN   3392
#define XCD_BAR_WORDS 3456
#define XB_SPIN_CAP (1u << 18)
DI unsigned xb_ld(unsigned* p)              { return __hip_atomic_load(p, __ATOMIC_RELAXED, __HIP_MEMORY_SCOPE_AGENT); }
DI unsigned xb_add(unsigned* p, unsigned v) { return __hip_atomic_fetch_add(p, v, __ATOMIC_RELAXED, __HIP_MEMORY_SCOPE_AGENT); }
DI unsigned xb_xcc_id() { return (unsigned)__builtin_amdgcn_s_getreg((3 << 11) | 20) & 0xFu; }
#define XB_SPIN(cond, bar) do { unsigned _sp = 0; while (cond) { __builtin_amdgcn_s_sleep(1); \
    if ((++_sp & 255u) == 0u) { if (xb_ld(&(bar)[XB_TMO])) break; if (_sp > XB_SPIN_CAP) { atomicAdd(&(bar)[XB_TMO], 1u); break; } } } } while (0)
struct XcdBarrier { unsigned* bar; unsigned x; volatile LAS unsigned* st; };
DI XcdBarrier xcd_barrier_post(unsigned* bar, volatile LAS unsigned* st) {
    XcdBarrier b; b.bar = bar; b.x = xb_xcc_id(); b.st = st;
    if (threadIdx.x == 0) (void)xb_add(&bar[XB_XCNT(b.x)], 1u);
    return b;
}
DI void xcd_barrier_complete(unsigned* bar, unsigned x, unsigned& nloc, unsigned& nx) {
    const unsigned G = gridDim.x * gridDim.y * gridDim.z;
    unsigned sum, cnt, mine, sp = 0u;
    for (;;) {
        sum = 0u; cnt = 0u; mine = 0u;
#pragma unroll
        for (unsigned j = 0; j < 16; ++j) { const unsigned c = xb_ld(&bar[XB_XCNT(j)]); sum += c; cnt += (c > 0u) ? 1u : 0u; mine = (j == x) ? c : mine; }
        if (sum == G) break;
        __builtin_amdgcn_s_sleep(1);
        if ((++sp & 255u) == 0u) { if (xb_ld(&bar[XB_TMO])) break; if (sp > XB_SPIN_CAP) { atomicAdd(&bar[XB_TMO], 1u); break; } }
    }
    nloc = mine > 0u ? mine : 1u; nx = cnt > 0u ? cnt : 1u;
}
DI void xcd_barrier(const XcdBarrier& b) {
    asm volatile("s_waitcnt vmcnt(0)" ::: "memory");
    __syncthreads();
    if (threadIdx.x == 0) {
        unsigned* bar = b.bar;
        __builtin_amdgcn_s_waitcnt(0);
        unsigned nloc = b.st[0], nx = b.st[1];
        if (nloc == 0u) { xcd_barrier_complete(bar, b.x, nloc, nx); b.st[0] = nloc; b.st[1] = nx; }
        const unsigned old = xb_add(&bar[XB_XSUB(b.x)], 1u);
        const unsigned gen = old / nloc;
        if (old + 1u == (gen + 1u) * nloc) {
            __builtin_amdgcn_fence(__ATOMIC_RELEASE, "agent");
            asm volatile("s_waitcnt vmcnt(0)" ::: "memory");
            const unsigned og = xb_add(&bar[XB_TOP], 1u);
            const unsigned tg = og / nx;
            if (og + 1u == (tg + 1u) * nx) xb_add(&bar[XB_TOPGEN], 1u);
            else XB_SPIN(xb_ld(&bar[XB_TOPGEN]) == tg, bar);
            __builtin_amdgcn_fence(__ATOMIC_ACQUIRE, "agent");
            xb_add(&bar[XB_XGEN(b.x)], 1u);
            asm volatile("s_waitcnt vmcnt(0)" ::: "memory");
        } else {
            XB_SPIN(xb_ld(&bar[XB_XGEN(b.x)]) == gen, bar);
            __builtin_amdgcn_fence(__ATOMIC_ACQUIRE, "agent");
            asm volatile("s_waitcnt vmcnt(0)" ::: "memory");
        }
    }
    __syncthreads();
}

__global__ void __launch_bounds__(512, 2) mk_fwd(Params p, int ph_lo, int ph_hi) {
    extern __shared__ __attribute__((aligned(16))) unsigned char shm[];
    LAS unsigned char* lds = (LAS unsigned char*)shm;
    cg::grid_group grid = cg::this_grid();
    unsigned char* ws = p.ws;
    const int G = gridDim.x, c = blockIdx.x;
    volatile LAS unsigned* xst = (volatile LAS unsigned*)(lds + LDS_BYTES - 16);
    if (threadIdx.x == 0) { xst[0] = 0u; xst[1] = 0u; }
    __syncthreads();
    XcdBarrier xbar; xbar.bar = (unsigned*)(ws + WS_BAR); xbar.x = 0u; xbar.st = xst;
    if (ph_hi - ph_lo > 1) xbar = xcd_barrier_post((unsigned*)(ws + WS_BAR), xst);
    if (ph_lo > 1000) grid.sync();
#ifndef PHMASK
#define PHMASK 0xFFFF
#endif
#define GSYNC() xcd_barrier(xbar)
#ifndef REP_MASK
#define REP_MASK 0
#endif
#define PHASE(i, ...) if constexpr ((PHMASK >> (i)) & 1) if (ph_lo <= (i) && (i) < ph_hi) { __VA_ARGS__; if constexpr ((REP_MASK >> (i)) & 1) { __syncthreads(); __VA_ARGS__; } if ((i) + 1 < ph_hi) GSYNC(); }
    PHASE(0, ph_prep(p, lds));
    PHASE(1, ph_norm0(p, lds));
    PHASE(2, { GemmD g{(const bf16_t*)p.out, (const bf16_t*)(ws + WS_WINE), 1024, 1024, 0, 0, 1024}; Sched S{128, 28, 1, 8, 12, 128, G, c};
               EpiPlanes E{(bf16_t*)ws, (bf16_t*)(ws + WS_CRAW)}; gemm_phase(lds, g, S, E);
               if (G > 96 && c >= 96) transpose_jobs(p, lds, opaque_tid(), 2304, 4096, c - 96, G - 96); else if (G <= 96) transpose_jobs(p, lds, opaque_tid(), 2304, 4096, c, G); });
    PHASE(3, ph_conv(p));
    PHASE(4, ph_mlstm(p, lds));
    PHASE(5, { GemmD g{(const bf16_t*)(ws + 5 * PLANE), (const bf16_t*)(ws + WS_WF), 1024, 256, 256, 512 * 256, 256}; Sched S{128, 2, 4, 0, 0, 0, G, c};
               EpiBf E{(bf16_t*)p.out, nullptr, 2048, 512, 0, nullptr, nullptr}; gemm_phase(lds, g, S, E); });
    PHASE(6, { CfgDft1 cf{(const bf16_t*)p.out, (bf16_t*)(ws + 2 * PLANE), (bf16_t*)(ws + 5 * PLANE)}; axis_mix<128, 128>(cf, lds, 2048); });
    PHASE(7, { CfgDft2 cf{(const bf16_t*)(ws + 2 * PLANE), (const bf16_t*)(ws + 5 * PLANE), (const bf16_t*)(ws + 6 * PLANE), (bf16_t*)p.out}; axis_mix<128, 64>(cf, lds, 2048); ph_ya(p); });
    PHASE(8, { GemmD g{(const bf16_t*)p.out, (const bf16_t*)(ws + WS_WOUTE), 2048, 2048, 0, 0, 2048}; Sched S{128, 4, 1, 0, 0, 0, G, c};
               EpiGate E{(bf16_t*)ws, (const float*)(ws + WS_MOD) + 2048}; gemm_phase(lds, g, S, E); });
    PHASE(9, ph_norm1(p, 0));
    PHASE(10, { GemmD g{(const bf16_t*)(ws + 2 * PLANE), (const bf16_t*)(ws + WS_WINO), 1024, 1024, 0, 0, 1024}; Sched S{128, 16, 1, 0, 0, 0, G, c};
                EpiBf E{(bf16_t*)(ws + 3 * PLANE), (bf16_t*)(ws + 5 * PLANE), 2048, 0, 1, nullptr, nullptr}; gemm_phase(lds, g, S, E); });
    PHASE(11, { CfgPoolA cf{(const bf16_t*)(ws + 3 * PLANE), (bf16_t*)p.out}; axis_mix<64, 64>(cf, lds, 4096); });
    PHASE(12, { CfgPoolB cf{(const bf16_t*)p.out, (bf16_t*)(ws + 3 * PLANE)}; axis_mix<64, 64>(cf, lds, 4096); });
    PHASE(13, { GemmD g{(const bf16_t*)(ws + 3 * PLANE), (const bf16_t*)(ws + WS_WPOOL), 2048, 512, 512, 512 * 512, 512}; Sched S{128, 2, 4, 0, 0, 0, G, c};
                EpiBf E{(bf16_t*)p.out, nullptr, 2048, 512, 2, p.pool_scale, (const bf16_t*)(ws + 5 * PLANE)}; gemm_phase(lds, g, S, E); });
    PHASE(14, { GemmD g{(const bf16_t*)p.out, (const bf16_t*)(ws + WS_WOUTO), 2048, 2048, 0, 0, 2048}; Sched S{128, 4, 1, 0, 0, 0, G, c};
                EpiGate E{(bf16_t*)(ws + PLANE), (const float*)(ws + WS_MOD) + 9 * 3072 + 2048}; gemm_phase(lds, g, S, E); });
    PHASE(15, ph_norm1(p, 1));
#undef PHASE
#ifdef XSYNC
    for (int k = 0; k < XSYNC; ++k) GSYNC();
#endif
#ifdef DBG_STOP
    GSYNC();
    {   const size_t n = (size_t)NX * 1024; unsigned* o32 = (unsigned*)p.out;
        for (size_t i = (size_t)blockIdx.x * 512 + threadIdx.x; i < n; i += (size_t)gridDim.x * 512) {
            float v = 0.f;
            if (DBG_PLANES == -1) { const unsigned u = o32[i]; v = lo_f(u) + hi_f(u); }
            else if (DBG_PLANES == -2) { v = ((const float*)p.ws)[i]; }
            else { for (int pl = 0; pl < 7; ++pl) if ((DBG_PLANES >> pl) & 1) v += bf2f(((const bf16_t*)(p.ws + pl * PLANE))[i]); }
            if (!(fabsf(v) < 1e30f)) v = 12345.f;
            p.out[i] = v; } }
#endif
}

extern "C" void kernel_launch(void* const* d_in, const int* in_sizes, int n_in, void* d_out, int out_size, void* d_ws, size_t ws_size, hipStream_t stream) {
    static int grid = 0;
    if (grid == 0) {
        int dev = 0, cus = 0, per_cu = 0;
        hipGetDevice(&dev);
        hipDeviceGetAttribute(&cus, hipDeviceAttributeMultiprocessorCount, dev);
        if (hipFuncSetAttribute((const void*)mk_fwd, hipFuncAttributeMaxDynamicSharedMemorySize, LDS_BYTES) != hipSuccess) fprintf(stderr, "hipFuncSetAttribute failed\n");
        if (hipOccupancyMaxActiveBlocksPerMultiprocessor(&per_cu, (const void*)mk_fwd, 512, LDS_BYTES) != hipSuccess || per_cu < 1) { fprintf(stderr, "occupancy query: %d\n", per_cu); per_cu = 1; }
        (void)hipGetLastError();
        grid = cus * per_cu; if (grid > 256) grid = 256; if (grid < 1) grid = 1;
        if (ws_size < WS_END) fprintf(stderr, "workspace too small: %zu < %zu\n", ws_size, (size_t)WS_END);
    }
    Params p{};
    p.x = (const float*)d_in[0]; p.c = (const float*)d_in[1]; p.ctx = (const float*)d_in[2]; p.c_ctx = (const float*)d_in[3]; p.ada_w = (const float*)d_in[4]; p.ada_b = (const float*)d_in[5];
    p.norm_g = (const float*)d_in[6]; p.win_even = (const float*)d_in[7]; p.gate_b = (const float*)d_in[8]; p.conv_qk = (const float*)d_in[9]; p.head_norm = (const float*)d_in[10];
    p.fourier_w = (const float*)d_in[11]; p.wout_even = (const float*)d_in[12]; p.win_odd = (const float*)d_in[13]; p.pool_w = (const float*)d_in[14]; p.pool_scale = (const float*)d_in[15];
    p.wout_odd = (const float*)d_in[16]; p.final_g = (const float*)d_in[17]; p.out = (float*)d_out; p.ws = (unsigned char*)d_ws;
    (void)hipMemsetAsync((unsigned char*)d_ws + WS_BAR, 0, XCD_BAR_WORDS * 4, stream);
#if MK_MULTI
    for (int ph = 0; ph < 16; ++ph) { hipLaunchKernelGGL(mk_fwd, dim3(grid), dim3(512), LDS_BYTES, stream, p, ph, ph + 1); }
#else
#ifdef DBG_STOP
    int lo = 0, hi = DBG_STOP;
#else
    int lo = 0, hi = 16;
#endif
    void* args[] = {&p, &lo, &hi};
    hipError_t e = hipLaunchCooperativeKernel((void*)mk_fwd, dim3(grid), dim3(512), args, LDS_BYTES, stream);
    if (e != hipSuccess) fprintf(stderr, "cooperative launch failed: %s (grid %d)\n", hipGetErrorString(e), grid);
#endif
}
```

```cpp
#include <hip/hip_runtime.h>
#include <hip/hip_cooperative_groups.h>
#include <cstdio>
namespace cg = cooperative_groups;

#ifndef MK_MULTI
#define MK_MULTI 0
#endif

#define LAS __attribute__((address_space(3)))
typedef unsigned short bf16_t;
typedef short bf16x8 __attribute__((ext_vector_type(8)));
typedef short s16x4 __attribute__((ext_vector_type(4)));
typedef float f32x4 __attribute__((ext_vector_type(4)));
typedef unsigned u32x4 __attribute__((ext_vector_type(4)));
typedef unsigned u32x2 __attribute__((ext_vector_type(2)));

constexpr int NX = 32768, NCX = 2048, NR = NX + NCX;
constexpr size_t PLANE = (size_t)NX * 1024 * 2;
constexpr size_t WS_EXTRA = 7 * PLANE;
constexpr size_t WS_WINE  = WS_EXTRA;
constexpr size_t WS_WOUTE = WS_WINE  + (size_t)7168 * 1024 * 2;
constexpr size_t WS_WINO  = WS_WOUTE + (size_t)1024 * 2048 * 2;
constexpr size_t WS_WPOOL = WS_WINO  + (size_t)4096 * 1024 * 2;
constexpr size_t WS_WOUTO = WS_WPOOL + (size_t)4 * 512 * 512 * 2;
constexpr size_t WS_WF    = WS_WOUTO + (size_t)1024 * 2048 * 2;
constexpr size_t WS_MOD   = WS_WF    + (size_t)4 * 512 * 256 * 2;
constexpr size_t WS_GATES = WS_MOD   + 262144;
constexpr size_t WS_CRAW  = WS_GATES + (size_t)NR * 16 * 4;
constexpr size_t WS_CQC   = WS_CRAW  + (size_t)3 * NCX * 1024 * 2;
constexpr size_t WS_CKC   = WS_CQC   + (size_t)NCX * 1024 * 2;
constexpr size_t WS_END   = WS_CKC   + (size_t)NCX * 1024 * 2;
constexpr size_t WS_GPRE  = WS_END + 16384;
constexpr size_t WS_GPRE_END = WS_GPRE + (size_t)64 * 68 * 384 * 4;
static_assert(WS_GPRE_END <= (size_t)512 * 1024 * 1024, "gate tables exceed the workspace");
constexpr size_t WS_BAR   = WS_END;
static_assert(WS_BAR + 16384 <= (size_t)512 * 1024 * 1024, "workspace map exceeds 512 MiB");

constexpr int LDS_BYTES = 155648;

struct Params {
    const float* x; const float* c; const float* ctx; const float* c_ctx; const float* ada_w; const float* ada_b; const float* norm_g;
    const float* win_even; const float* gate_b; const float* conv_qk; const float* head_norm; const float* fourier_w; const float* wout_even;
    const float* win_odd; const float* pool_w; const float* pool_scale; const float* wout_odd; const float* final_g;
    float* out; unsigned char* ws;
};

#define DI __device__ __forceinline__
DI float bf2f(unsigned short b) { return __uint_as_float(((unsigned)b) << 16); }
DI float lo_f(unsigned u) { return __uint_as_float(u << 16); }
DI float hi_f(unsigned u) { return __uint_as_float(u & 0xffff0000u); }
typedef __bf16 bf16v2_t __attribute__((ext_vector_type(2)));
typedef float f32v2_t __attribute__((ext_vector_type(2)));
DI unsigned pk2(float lo, float hi) { const f32v2_t v = {lo, hi}; const bf16v2_t b = __builtin_convertvector(v, bf16v2_t); return __builtin_bit_cast(unsigned, b); }
DI float silu_f(float x) { return x / (1.0f + __expf(-x)); }
DI float sigmoid_f(float x) { return 1.0f / (1.0f + __expf(-x)); }
DI int opaque_tid() { int t = threadIdx.x; asm volatile("" : "+v"(t)); return t; }
DI float wave_sum(float v) { for (int o = 32; o > 0; o >>= 1) v += __shfl_xor(v, o); return v; }
DI float wave_max(float v) { for (int o = 32; o > 0; o >>= 1) v = fmaxf(v, __shfl_xor(v, o)); return v; }
DI void st_pair16(bf16_t* base0, u32x2 w0, u32x2 w1, int fq) {
    const auto rx = __builtin_amdgcn_permlane16_swap(w0.x, w1.x, false, false);
    const auto ry = __builtin_amdgcn_permlane16_swap(w0.y, w1.y, false, false);
    u32x4 v; v.x = rx[0]; v.y = ry[0]; v.z = rx[1]; v.w = ry[1];
    *(u32x4*)((fq & 1) ? base0 + 12 : base0) = v;
}
DI f32x4 mfma16(bf16x8 a, bf16x8 b, f32x4 c) { return __builtin_amdgcn_mfma_f32_16x16x32_bf16(a, b, c, 0, 0, 0); }
DI bf16x8 tr_frag(LAS unsigned char* img, int pitch, int krow0, int col0, int lane) {
    const int g = lane >> 4, q = (lane & 15) >> 2, pp = lane & 3;
    LAS unsigned char* a0 = img + (krow0 + 8 * g + q) * pitch + col0 * 2 + 8 * pp;
    s16x4 lo = __builtin_amdgcn_ds_read_tr16_b64_v4i16((LAS s16x4*)a0);
    s16x4 hi = __builtin_amdgcn_ds_read_tr16_b64_v4i16((LAS s16x4*)(a0 + 4 * pitch));
    return __builtin_shufflevector(lo, hi, 0, 1, 2, 3, 4, 5, 6, 7);
}

constexpr int HTB = 128 * 64 * 2;
DI int lds_byte(int r, int c) { const int st = (r >> 4) * 2 + (c >> 5), rr = r & 15, cc = c & 31, ob = rr * 64 + cc * 2; return st * 1024 + (ob ^ (((ob >> 9) & 1) << 5)); }
DI void stage_rc(int b, int& R, int& C) { const int st = b / 1024, sb = b % 1024, swz = sb ^ (((sb >> 9) & 1) << 5); R = (st >> 1) * 16 + swz / 64; C = (st & 1) * 32 + (swz % 64) / 2; }
DI int perm32(int rho) { const int n = rho >> 4, i = rho & 15; return 8 * (i >> 2) + 4 * n + (i & 3); }

struct Unit { int pm, pn, g; };
struct GemmD { const bf16_t* A; const bf16_t* Bt; int lda, ldb; long a_gs, b_gs; int K; };
struct Sched {
    int nM, nN, nG, nM2, nN2, pm2off, G, c;
    DI bool next(int i, Unit& u) const {
        const int L = i * G + c; const int nwg = nM * nN, tot1 = nwg * nG;
        const bool first = L < tot1;
        const int L1 = first ? L : 0;
        const int g = L1 / nwg; int wgid = L1 - g * nwg;
        { const int q = nwg / 8, r = nwg % 8, xcd = wgid % 8, off = wgid / 8; wgid = (xcd < r ? xcd * (q + 1) : r * (q + 1) + (xcd - r) * q) + off; }
        const int nig = 8 * nN, gid = wgid / nig, fm = gid * 8, gsz = (nM - fm) < 8 ? (nM - fm) : 8;
        const int pm1 = fm + ((wgid % nig) % gsz), pn1 = (wgid % nig) / gsz;
        const int L2 = first ? 0 : L - tot1, d2 = nM2 > 0 ? nM2 : 1;
        const int pm2 = pm2off + L2 % d2, pn2 = L2 / d2;
        u.pm = first ? pm1 : pm2; u.pn = first ? pn1 : pn2; u.g = first ? g : 0;
        return first || (L2 < nM2 * nN2);
    }
};

template <class Epi>
DI void gemm_phase(LAS unsigned char* lds, const GemmD g, const Sched& S, const Epi& E) {
    const int tid = opaque_tid(), wid = __builtin_amdgcn_readfirstlane(tid >> 6), lane = tid & 63, wr = wid >> 2, wc = wid & 3, fr = lane & 15, fq = lane >> 4;
    const int K = g.K, nt = K / 64;
    unsigned voffA[2], voffB[2];
#pragma unroll
    for (int i = 0; i < 2; ++i) { int R, C; stage_rc(tid * 16 + i * 8192, R, C); const int Rb = Epi::PERM ? ((R & ~31) + perm32(R & 31)) : R;
        voffA[i] = (unsigned)(R * g.lda + C) * 2u; voffB[i] = (unsigned)(Rb * g.ldb + C) * 2u; }
    const size_t kstep = 128;
    const size_t hstepA = (size_t)128 * g.lda * 2, hstepB = (size_t)128 * g.ldb * 2;
    const unsigned ldsw = (unsigned)wid * 1024u;
    const int aoff = lds_byte(wr * 64 + fr, fq * 8), boff = lds_byte(wc * 32 + fr, fq * 8);
#define G_SA(b, h) (((b) * 2 + (h)) * HTB)
#define G_SB(b, h) ((4 + (b) * 2 + (h)) * HTB)
#define G_STAGE(bufoff, gbase, voff) do { _Pragma("unroll") for (int _i = 0; _i < 2; ++_i) \
        __builtin_amdgcn_global_load_lds((const unsigned*)((const char*)(gbase) + (voff)[_i]), (LAS unsigned*)(lds + (bufoff) + ldsw + _i * 8192), 16, 0, 0); } while (0)
#define G_LDA(dst, b, h) do { _Pragma("unroll") for (int m = 0; m < 4; ++m) _Pragma("unroll") for (int k = 0; k < 2; ++k) dst[m][k] = *(const LAS bf16x8*)(lds + G_SA(b, h) + aoff + m * 2048 + k * 1024); } while (0)
#define G_LDB(dst, b, h) do { _Pragma("unroll") for (int n = 0; n < 2; ++n) _Pragma("unroll") for (int k = 0; k < 2; ++k) dst[n][k] = *(const LAS bf16x8*)(lds + G_SB(b, h) + boff + n * 2048 + k * 1024); } while (0)
#define G_MMA(ai, bj, At, Bt) do { __builtin_amdgcn_s_setprio(1); _Pragma("unroll") for (int m = 0; m < 4; ++m) _Pragma("unroll") for (int n = 0; n < 2; ++n) _Pragma("unroll") for (int k = 0; k < 2; ++k) \
        acc[ai][bj][m][n] = __builtin_amdgcn_mfma_f32_16x16x32_bf16(Bt[n][k], At[m][k], acc[ai][bj][m][n], 0, 0, 0); __builtin_amdgcn_s_setprio(0); } while (0)
#define G_WAIT_V(n) asm volatile("s_waitcnt vmcnt(" #n ")" ::: "memory")
#define G_WAIT_L(n) asm volatile("s_waitcnt lgkmcnt(" #n ")" ::: "memory")
#define G_BAR __builtin_amdgcn_s_barrier()
#define G_SCHED __builtin_amdgcn_sched_barrier(0)
    Unit cur, nxt; int ui = 0;
    if (!S.next(0, cur)) return;
    f32x4 acc[2][2][4][2];
#pragma unroll
    for (int a = 0; a < 2; ++a)
#pragma unroll
        for (int b = 0; b < 2; ++b)
#pragma unroll
            for (int m = 0; m < 4; ++m)
#pragma unroll
                for (int n = 0; n < 2; ++n) acc[a][b][m][n] = (f32x4){0.f, 0.f, 0.f, 0.f};
    bf16x8 At[4][2], B0[2][2], B1[2][2];
    const char* cA = (const char*)(g.A + (long)cur.g * g.a_gs) + (size_t)cur.pm * 2 * hstepA;
    const char* cB = (const char*)(g.Bt + (long)cur.g * g.b_gs) + (size_t)cur.pn * 2 * hstepB;
    G_STAGE(G_SB(0, 0), cB, voffB); G_STAGE(G_SA(0, 0), cA, voffA); G_STAGE(G_SB(0, 1), cB + hstepB, voffB); G_STAGE(G_SA(0, 1), cA + hstepA, voffA);
    if (wr == 1) G_BAR;
    G_WAIT_V(4); G_BAR;
    G_STAGE(G_SB(1, 0), cB + kstep, voffB); G_STAGE(G_SA(1, 0), cA + kstep, voffA); G_STAGE(G_SB(1, 1), cB + hstepB + kstep, voffB);
    G_WAIT_V(6); G_BAR;
    for (;;) {
        const bool has_next = S.next(ui + 1, nxt);
        const char* nA = has_next ? (const char*)(g.A + (long)nxt.g * g.a_gs) + (size_t)nxt.pm * 2 * hstepA : cA;
        const char* nB = has_next ? (const char*)(g.Bt + (long)nxt.g * g.b_gs) + (size_t)nxt.pn * 2 * hstepB : cB;
        for (int t = 0; t < nt; t += 2) {
            const bool last = (t == nt - 2);
            const char* a1 = cA + (size_t)(t + 1) * kstep;
            const char* a2 = last ? nA : cA + (size_t)(t + 2) * kstep; const char* b2 = last ? nB : cB + (size_t)(t + 2) * kstep;
            const char* a3 = a2 + kstep; const char* b3 = b2 + kstep;
            G_LDB(B0, 0, 0); G_SCHED; G_LDA(At, 0, 0); G_STAGE(G_SA(1, 1), a1 + hstepA, voffA);
            G_WAIT_L(8); G_BAR; G_WAIT_L(0); G_MMA(0, 0, At, B0); G_BAR; G_SCHED;
            G_LDB(B1, 0, 1); G_STAGE(G_SB(0, 0), b2, voffB);
            G_BAR; G_WAIT_L(0); G_MMA(0, 1, At, B1); G_BAR;
            G_LDA(At, 0, 1); G_STAGE(G_SA(0, 0), a2, voffA);
            G_BAR; G_WAIT_L(0); G_MMA(1, 0, At, B0); G_BAR; G_SCHED;
            G_STAGE(G_SB(0, 1), b2 + hstepB, voffB);
            G_WAIT_V(6); G_BAR; G_MMA(1, 1, At, B1); G_BAR;
            G_LDB(B0, 1, 0); G_SCHED; G_LDA(At, 1, 0); G_STAGE(G_SA(0, 1), a2 + hstepA, voffA);
            G_WAIT_L(8); G_BAR; G_WAIT_L(0); G_MMA(0, 0, At, B0); G_BAR; G_SCHED;
            G_LDB(B1, 1, 1); G_STAGE(G_SB(1, 0), b3, voffB);
            G_BAR; G_WAIT_L(0); G_MMA(0, 1, At, B1); G_BAR;
            G_LDA(At, 1, 1); G_STAGE(G_SA(1, 0), a3, voffA);
            G_BAR; G_WAIT_L(0); G_MMA(1, 0, At, B0); G_BAR; G_SCHED;
            G_STAGE(G_SB(1, 1), b3 + hstepB, voffB);
            G_WAIT_V(6); G_BAR; G_MMA(1, 1, At, B1); G_BAR;
        }
        E(acc, cur, wr, wc, fr, fq);
        if (!has_next) break;
#pragma unroll
        for (int a = 0; a < 2; ++a)
#pragma unroll
            for (int b = 0; b < 2; ++b)
#pragma unroll
                for (int m = 0; m < 4; ++m)
#pragma unroll
                    for (int n = 0; n < 2; ++n) acc[a][b][m][n] = (f32x4){0.f, 0.f, 0.f, 0.f};
        cur = nxt; cA = nA; cB = nB; ++ui;
    }
    G_WAIT_V(0);
    if (wr == 0) G_BAR;
    G_BAR;
}

struct EpiPlanes {
    static constexpr bool PERM = true;
    bf16_t* xbase; bf16_t* cbase;
    DI void operator()(const f32x4 (&acc)[2][2][4][2], const Unit& u, int wr, int wc, int fr, int fq) const {
        const int plane = u.pn >> 2, colt = (u.pn & 3) * 256;
        bf16_t* base; int row0;
        if (u.pm < 128) { base = xbase + (size_t)plane * NX * 1024; row0 = u.pm * 256 + wr * 64 + fr; }
        else { base = cbase + (size_t)plane * NCX * 1024; row0 = (u.pm - 128) * 256 + wr * 64 + fr; }
        const int col0 = colt + wc * 32 + 8 * fq;
#pragma unroll
        for (int ai = 0; ai < 2; ++ai)
#pragma unroll
            for (int m = 0; m < 4; ++m) { bf16_t* rowp = base + (size_t)(row0 + ai * 128 + m * 16) * 1024 + col0;
#pragma unroll
                for (int bj = 0; bj < 2; ++bj) { const f32x4 v0 = acc[ai][bj][m][0], v1 = acc[ai][bj][m][1];
                    u32x4 w; w.x = pk2(v0[0], v0[1]); w.y = pk2(v0[2], v0[3]); w.z = pk2(v1[0], v1[1]); w.w = pk2(v1[2], v1[3]);
                    *(u32x4*)(rowp + bj * 128) = w; } }
    }
};
struct EpiBf {
    static constexpr bool PERM = true;
    bf16_t* O; bf16_t* O2; int ldc; int gcol; int mode; const float* scale; const bf16_t* zc;
    DI void operator()(const f32x4 (&acc)[2][2][4][2], const Unit& u, int wr, int wc, int fr, int fq) const {
        const int row0 = u.pm * 256 + wr * 64 + fr;
        bf16_t* base = O; int pn = u.pn; bool act = false;
        if (mode == 1 && pn >= 8) { base = O2; pn -= 8; act = true; }
        const int col0 = u.g * gcol + pn * 256 + wc * 32 + 8 * fq;
        f32x4 sc[2][2];
#pragma unroll
        for (int bj = 0; bj < 2; ++bj) { sc[bj][0] = (mode == 2) ? *(const f32x4*)(scale + col0 + bj * 128) : (f32x4){1.f, 1.f, 1.f, 1.f}; sc[bj][1] = (mode == 2) ? *(const f32x4*)(scale + col0 + bj * 128 + 4) : (f32x4){1.f, 1.f, 1.f, 1.f}; }
        u32x4 zq[2][4][2];
        if (mode == 2) {
#pragma unroll
            for (int ai = 0; ai < 2; ++ai)
#pragma unroll
                for (int m = 0; m < 4; ++m)
#pragma unroll
                    for (int bj = 0; bj < 2; ++bj) zq[ai][m][bj] = *(const volatile u32x4*)(zc + (size_t)(row0 + ai * 128 + m * 16) * ldc + col0 + bj * 128); }
#pragma unroll
        for (int ai = 0; ai < 2; ++ai) {
            u32x4 (&zz)[4][2] = zq[ai];
#pragma unroll
            for (int m = 0; m < 4; ++m) { const size_t ro = (size_t)(row0 + ai * 128 + m * 16) * ldc + col0;
#pragma unroll
                for (int bj = 0; bj < 2; ++bj) { f32x4 v0 = acc[ai][bj][m][0], v1 = acc[ai][bj][m][1];
                    if (act) {
#pragma unroll
                        for (int j = 0; j < 4; ++j) { v0[j] = silu_f(v0[j]); v1[j] = silu_f(v1[j]); } }
                    if (mode == 2) {
                        const u32x4 z = zz[m][bj]; const f32x4 s0 = sc[bj][0], s1 = sc[bj][1];
                        v0[0] *= s0[0] * lo_f(z.x); v0[1] *= s0[1] * hi_f(z.x); v0[2] *= s0[2] * lo_f(z.y); v0[3] *= s0[3] * hi_f(z.y);
                        v1[0] *= s1[0] * lo_f(z.z); v1[1] *= s1[1] * hi_f(z.z); v1[2] *= s1[2] * lo_f(z.w); v1[3] *= s1[3] * hi_f(z.w);
                    }
                    u32x4 w; w.x = pk2(v0[0], v0[1]); w.y = pk2(v0[2], v0[3]); w.z = pk2(v1[0], v1[1]); w.w = pk2(v1[2], v1[3]);
                    *(u32x4*)(base + ro + bj * 128) = w; } } }
    }
};
struct EpiGate {
    static constexpr bool PERM = true;
    bf16_t* O; const float* gate;
    DI void operator()(const f32x4 (&acc)[2][2][4][2], const Unit& u, int wr, int wc, int fr, int fq) const {
        const int row0 = u.pm * 256 + wr * 64 + fr, col0 = u.pn * 256 + wc * 32 + 8 * fq;
        const float* gp = gate + (size_t)(u.pm >> 4) * 3072 + col0;
        f32x4 gv[2][2];
#pragma unroll
        for (int bj = 0; bj < 2; ++bj) { gv[bj][0] = *(const f32x4*)(gp + bj * 128); gv[bj][1] = *(const f32x4*)(gp + bj * 128 + 4); }
#pragma unroll
        for (int ai = 0; ai < 2; ++ai)
#pragma unroll
            for (int m = 0; m < 4; ++m) { bf16_t* rowp = O + (size_t)(row0 + ai * 128 + m * 16) * 1024 + col0;
#pragma unroll
                for (int bj = 0; bj < 2; ++bj) { const f32x4 v0 = acc[ai][bj][m][0] * gv[bj][0], v1 = acc[ai][bj][m][1] * gv[bj][1];
                    u32x4 w; w.x = pk2(v0[0], v0[1]); w.y = pk2(v0[2], v0[3]); w.z = pk2(v1[0], v1[1]); w.w = pk2(v1[2], v1[3]);
                    *(u32x4*)(rowp + bj * 128) = w; } }
    }
};
struct EpiRes {
    static constexpr bool PERM = false;
    float* O; const float* res; const float* gate;
    DI void operator()(const f32x4 (&acc)[2][2][4][2], const Unit& u, int wr, int wc, int fr, int fq) const {
        const int row0 = u.pm * 256 + wr * 64 + fr, col0 = u.pn * 256 + wc * 32 + 4 * fq;
        const float* gp = gate + (size_t)(u.pm >> 4) * 3072 + col0;
        f32x4 gv[2][2];
#pragma unroll
        for (int bj = 0; bj < 2; ++bj)
#pragma unroll
            for (int n = 0; n < 2; ++n) gv[bj][n] = *(const f32x4*)(gp + bj * 128 + n * 16);
#pragma unroll
        for (int ai = 0; ai < 2; ++ai)
#pragma unroll
            for (int mp = 0; mp < 2; ++mp) {
                f32x4 r[2][2][2];
#pragma unroll
                for (int mm = 0; mm < 2; ++mm) { const size_t ro = (size_t)(row0 + ai * 128 + (2 * mp + mm) * 16) * 1024 + col0;
#pragma unroll
                    for (int bj = 0; bj < 2; ++bj)
#pragma unroll
                        for (int n = 0; n < 2; ++n) r[mm][bj][n] = *(const volatile f32x4*)(res + ro + bj * 128 + n * 16); }
#pragma unroll
                for (int mm = 0; mm < 2; ++mm) { const size_t ro = (size_t)(row0 + ai * 128 + (2 * mp + mm) * 16) * 1024 + col0;
#pragma unroll
                    for (int bj = 0; bj < 2; ++bj)
#pragma unroll
                        for (int n = 0; n < 2; ++n) *(f32x4*)(O + ro + bj * 128 + n * 16) = r[mm][bj][n] + gv[bj][n] * acc[ai][bj][2 * mp + mm][n]; }
            }
    }
};

DI void transpose_jobs(const Params& p, LAS unsigned char* lds, int tid, int j_lo, int j_hi, int w, int nw) {
    LAS float* tile = (LAS float*)lds;
    {
        auto job_desc = [&](int job, const float*& src, bf16_t*& dst, int& K, int& Nt, int& k0, int& n0) {
            int j = job, tk, tn;
            if (j < 1792) { src = p.win_even; dst = (bf16_t*)(p.ws + WS_WINE); K = 1024; Nt = 7184; tk = j & 15; tn = j >> 4; }
            else if ((j -= 1792) < 512) { src = p.wout_even; dst = (bf16_t*)(p.ws + WS_WOUTE); K = 2048; Nt = 1024; tk = j & 31; tn = j >> 5; }
            else if ((j -= 512) < 1024) { src = p.win_odd; dst = (bf16_t*)(p.ws + WS_WINO); K = 1024; Nt = 4096; tk = j & 15; tn = j >> 4; }
            else if ((j -= 1024) < 256) { const int g = j >> 6, jj = j & 63; src = p.pool_w + (size_t)g * 512 * 512; dst = (bf16_t*)(p.ws + WS_WPOOL) + (size_t)g * 512 * 512; K = 512; Nt = 512; tk = jj & 7; tn = jj >> 3; }
            else { j -= 256; src = p.wout_odd; dst = (bf16_t*)(p.ws + WS_WOUTO); K = 2048; Nt = 1024; tk = j & 31; tn = j >> 5; }
            k0 = tk * 64; n0 = tn * 64; };
        float rg[8];
        int job = j_lo + w;
        if (job < j_hi) { const float* src; bf16_t* dst; int K, Nt, k0, n0; job_desc(job, src, dst, K, Nt, k0, n0);
#pragma unroll
            for (int i = 0; i < 8; ++i) { const int idx = tid + 512 * i, k = idx >> 6, n = idx & 63; rg[i] = src[(size_t)(k0 + k) * Nt + n0 + n]; } }
        for (; job < j_hi; job += nw) {
            const float* src; bf16_t* dst; int K, Nt, k0, n0; job_desc(job, src, dst, K, Nt, k0, n0);
            __syncthreads();
#pragma unroll
            for (int i = 0; i < 8; ++i) { const int idx = tid + 512 * i, k = idx >> 6, n = idx & 63; tile[k * 65 + n] = rg[i]; }
            __syncthreads();
            const int nj = job + nw;
            if (nj < j_hi) { const float* s2; bf16_t* d2; int K2, Nt2, k2, n2; job_desc(nj, s2, d2, K2, Nt2, k2, n2);
#pragma unroll
                for (int i = 0; i < 8; ++i) { const int idx = tid + 512 * i, k = idx >> 6, n = idx & 63; rg[i] = s2[(size_t)(k2 + k) * Nt2 + n2 + n]; } }
#pragma unroll
            for (int i = 0; i < 4; ++i) { const int idx = tid + 512 * i, n = idx >> 5, k = (idx & 31) * 2;
                *(unsigned*)(dst + (size_t)(n0 + n) * K + k0 + k) = pk2(tile[k * 65 + n], tile[(k + 1) * 65 + n]); }
        }
        __syncthreads();
    }
}
DI void ph_prep(const Params& p, LAS unsigned char* lds) {
    const int tid = opaque_tid();
    transpose_jobs(p, lds, tid, 0, 2304, blockIdx.x, gridDim.x);
    LAS float* sv = (LAS float*)(lds + 32768);
    LAS float* red = (LAS float*)(lds + 32768 + 36864);
    LAS float* ct = (LAS float*)(lds + 90112); LAS float* st = ct + 256;
    for (int idx = tid; idx < 9216; idx += 512) { const int v = idx >> 10, k = idx & 1023; const float cv = (v < 8) ? p.c[v * 1024 + k] : p.c_ctx[k]; sv[idx] = silu_f(cv); }
    if (tid < 256) { float s, c; sincospif((float)tid / 128.0f, &s, &c); ct[tid] = c; st[tid] = s; }
    __syncthreads();
    float* MOD = (float*)(p.ws + WS_MOD);
    for (int item = blockIdx.x; item < 192; item += gridDim.x) {
        const int l = item / 96, c0 = (item % 96) * 32, kg = tid >> 5, col = tid & 31;
        float a[9];
#pragma unroll
        for (int v = 0; v < 9; ++v) a[v] = 0.f;
        const float* w = p.ada_w + (size_t)l * 1024 * 3072 + c0 + col;
#pragma unroll 16
        for (int k = kg; k < 1024; k += 16) { const float wv = w[(size_t)k * 3072];
#pragma unroll
            for (int v = 0; v < 9; ++v) a[v] += sv[v * 1024 + k] * wv; }
#pragma unroll
        for (int v = 0; v < 9; ++v) red[(kg * 32 + col) * 9 + v] = a[v];
        __syncthreads();
        if (tid < 288) { const int v = tid >> 5, cc = tid & 31; float s = 0.f; for (int q = 0; q < 16; ++q) s += red[(q * 32 + cc) * 9 + v];
            MOD[(size_t)(l * 9 + v) * 3072 + c0 + cc] = s + p.ada_b[l * 3072 + c0 + cc]; }
        __syncthreads();
    }
    bf16_t* WF = (bf16_t*)(p.ws + WS_WF);
    for (int it = blockIdx.x; it < 512; it += gridDim.x) {
        const int idx = it * 512 + tid, d = idx & 255, c = (idx >> 8) & 255, g = idx >> 16;
        const float* f = p.fourier_w + (size_t)g * 65536 + d;
        float aP = 0.f, aQ = 0.f;
#pragma unroll 16
        for (int cp = 0; cp < 256; ++cp) { const float fv = f[cp * 256]; const int a = (c * cp) & 255; aP += ct[a] * fv; aQ += st[a] * fv; }
        WF[(size_t)(g * 512 + d) * 256 + c] = (bf16_t)(pk2(aP * 0.0625f, 0.f) & 0xffffu);
        WF[(size_t)(g * 512 + 256 + d) * 256 + c] = (bf16_t)(pk2(-aQ * 0.0625f, 0.f) & 0xffffu);
    }
}

DI void ph_norm0(const Params& p, LAS unsigned char* lds) {
    const int tid = opaque_tid(), wid = tid >> 6, lane = tid & 63;
    LAS float* wg = (LAS float*)lds;
#pragma unroll 4
    for (int i = 0; i < 32; ++i) { const int idx = tid + 512 * i, k = idx >> 4, j = idx & 15; wg[j * 1024 + k] = p.win_even[(size_t)k * 7184 + 7168 + j]; }
    __syncthreads();
    f32x4 g[4];
#pragma unroll
    for (int i = 0; i < 4; ++i) g[i] = *(const f32x4*)(p.norm_g + lane * 4 + 256 * i);
    const float* MOD = (const float*)(p.ws + WS_MOD);
    bf16_t* HX = (bf16_t*)p.out;
    float* GATES = (float*)(p.ws + WS_GATES);
    f32x4 vn[4];
    { const int r = blockIdx.x * 8 + wid; if (r < NR) { const float* src = (r < NX) ? p.x + (size_t)r * 1024 : p.ctx + (size_t)(r - NX) * 1024;
#pragma unroll
        for (int i = 0; i < 4; ++i) vn[i] = *(const f32x4*)(src + lane * 4 + 256 * i); } }
    for (int r = blockIdx.x * 8 + wid; r < NR; r += gridDim.x * 8) {
        const float* md;
        if (r < NX) { md = MOD + (size_t)(r >> 12) * 3072; } else { md = MOD + (size_t)8 * 3072; }
        f32x4 v[4]; float ss = 0.f;
#pragma unroll
        for (int i = 0; i < 4; ++i) { v[i] = vn[i]; ss += v[i][0] * v[i][0] + v[i][1] * v[i][1] + v[i][2] * v[i][2] + v[i][3] * v[i][3]; }
        { const int r2 = r + gridDim.x * 8; if (r2 < NR) { const float* s2 = (r2 < NX) ? p.x + (size_t)r2 * 1024 : p.ctx + (size_t)(r2 - NX) * 1024;
#pragma unroll
            for (int i = 0; i < 4; ++i) vn[i] = *(const f32x4*)(s2 + lane * 4 + 256 * i); } }
        ss = wave_sum(ss);
        const float rstd = rsqrtf(ss * (1.0f / 1024.0f) + 1e-6f);
#pragma unroll
        for (int i = 0; i < 4; ++i) { const f32x4 sh = *(const f32x4*)(md + lane * 4 + 256 * i), sc = *(const f32x4*)(md + 1024 + lane * 4 + 256 * i);
            v[i] = v[i] * rstd * g[i] * (sc + 1.0f) + sh;
            u32x2 w; w.x = pk2(v[i][0], v[i][1]); w.y = pk2(v[i][2], v[i][3]);
            *(u32x2*)(HX + (size_t)r * 1024 + lane * 4 + 256 * i) = w; }
        float pt[16];
#pragma unroll
        for (int j = 0; j < 16; ++j) { float a = 0.f;
#pragma unroll
            for (int i = 0; i < 4; ++i) { const f32x4 w4 = *(const LAS f32x4*)(wg + j * 1024 + lane * 4 + 256 * i); a += v[i][0] * w4[0] + v[i][1] * w4[1] + v[i][2] * w4[2] + v[i][3] * w4[3]; }
            pt[j] = a; if ((j & 3) == 3) __builtin_amdgcn_sched_barrier(0); }
        { const bool b5 = lane & 32;
#pragma unroll
          for (int j = 0; j < 8; ++j) { const float snd = b5 ? pt[j] : pt[j + 8], kp = b5 ? pt[j + 8] : pt[j]; pt[j] = kp + __shfl_xor(snd, 32); } }
        { const bool b4 = lane & 16;
#pragma unroll
          for (int j = 0; j < 4; ++j) { const float snd = b4 ? pt[j] : pt[j + 4], kp = b4 ? pt[j + 4] : pt[j]; pt[j] = kp + __shfl_xor(snd, 16); } }
        { const bool b3 = lane & 8;
#pragma unroll
          for (int j = 0; j < 2; ++j) { const float snd = b3 ? pt[j] : pt[j + 2], kp = b3 ? pt[j + 2] : pt[j]; pt[j] = kp + __shfl_xor(snd, 8); } }
        { const bool b2 = lane & 4; const float snd = b2 ? pt[0] : pt[1], kp = b2 ? pt[1] : pt[0]; pt[0] = kp + __shfl_xor(snd, 4); }
        pt[0] += __shfl_xor(pt[0], 2); pt[0] += __shfl_xor(pt[0], 1);
        if ((lane & 3) == 0) { const int j = ((lane >> 5) & 1) * 8 + ((lane >> 4) & 1) * 4 + ((lane >> 3) & 1) * 2 + ((lane >> 2) & 1);
            float val = pt[0] + p.gate_b[j];
            if ((j >> 2) & 1) val = fminf(val, 0.f) - log1pf(__expf(-fabsf(val)));
            GATES[(size_t)r * 16 + j] = val; }
    }
}
DI void ph_norm1(const Params& p, int mode) {
    const int tid = opaque_tid(), wid = tid >> 6, lane = tid & 63;
    const float* gsrc = mode ? p.final_g : p.norm_g + 1024;
    f32x4 g[4];
#pragma unroll
    for (int i = 0; i < 4; ++i) g[i] = *(const f32x4*)(gsrc + lane * 4 + 256 * i);
    const float* MOD = (const float*)(p.ws + WS_MOD) + (size_t)9 * 3072;
    const bf16_t* D0 = (const bf16_t*)p.ws; const bf16_t* D1 = (const bf16_t*)(p.ws + PLANE);
    bf16_t* HX1 = (bf16_t*)(p.ws + 2 * PLANE);
    f32x4 vn[4];
#define N1_LOAD(RR) do { _Pragma("unroll") for (int i = 0; i < 4; ++i) { const size_t o = (size_t)(RR) * 1024 + lane * 4 + 256 * i; \
        f32x4 xv = *(const f32x4*)(p.x + o); const u32x2 q = *(const u32x2*)(D0 + o); xv += (f32x4){lo_f(q.x), hi_f(q.x), lo_f(q.y), hi_f(q.y)}; \
        if (mode) { const u32x2 q1 = *(const u32x2*)(D1 + o); xv += (f32x4){lo_f(q1.x), hi_f(q1.x), lo_f(q1.y), hi_f(q1.y)}; } \
        vn[i] = xv; } } while (0)
    { const int r = blockIdx.x * 8 + wid; if (r < NX) N1_LOAD(r); }
    for (int r = blockIdx.x * 8 + wid; r < NX; r += gridDim.x * 8) {
        const float* md = MOD + (size_t)(r >> 12) * 3072;
        f32x4 v[4]; float ss = 0.f;
#pragma unroll
        for (int i = 0; i < 4; ++i) { v[i] = vn[i]; ss += v[i][0] * v[i][0] + v[i][1] * v[i][1] + v[i][2] * v[i][2] + v[i][3] * v[i][3]; }
        { const int r2 = r + gridDim.x * 8; if (r2 < NX) N1_LOAD(r2); }
        ss = wave_sum(ss);
        const float rstd = rsqrtf(ss * (1.0f / 1024.0f) + 1e-6f);
#pragma unroll
        for (int i = 0; i < 4; ++i) {
            if (mode) { *(f32x4*)(p.out + (size_t)r * 1024 + lane * 4 + 256 * i) = v[i] * rstd * g[i]; }
            else { const f32x4 sh = *(const f32x4*)(md + lane * 4 + 256 * i), sc = *(const f32x4*)(md + 1024 + lane * 4 + 256 * i);
                const f32x4 h = v[i] * rstd * g[i] * (sc + 1.0f) + sh;
                u32x2 w; w.x = pk2(h[0], h[1]); w.y = pk2(h[2], h[3]);
                *(u32x2*)(HX1 + (size_t)r * 1024 + lane * 4 + 256 * i) = w; } }
    }
#undef N1_LOAD
}

DI void ph_conv(const Params& p) {
    const bf16_t* QRAW = (const bf16_t*)p.ws; const bf16_t* KRAW = (const bf16_t*)(p.ws + PLANE);
    const bf16_t* CQ = (const bf16_t*)(p.ws + WS_CRAW); const bf16_t* CK = CQ + (size_t)NCX * 1024;
    bf16_t* QC = (bf16_t*)p.out; bf16_t* KC = QC + (size_t)NX * 1024;
    bf16_t* CQC = (bf16_t*)(p.ws + WS_CQC); bf16_t* CKC = (bf16_t*)(p.ws + WS_CKC);
    const int tid = opaque_tid();
    const bool scanner = (blockIdx.x < 64) && (tid < 64) && (gridDim.x >= 64);
    const int nscan = gridDim.x >= 64 ? 64 : 0;
    const int active_id = (int)blockIdx.x < nscan ? (int)blockIdx.x * 448 + (tid - 64) : nscan * 448 + ((int)blockIdx.x - nscan) * 512 + tid;
    const int active_n = nscan * 448 + ((int)gridDim.x - nscan) * 512;
    if (!scanner)
    for (int idx = active_id; idx < (NR / 8) * 256; idx += active_n) {
        const int oct = idx & 127, which = (idx >> 7) & 1, r0 = (idx >> 8) * 8, ch = oct * 8;
        const bf16_t* src; bf16_t* dst; int t0, T;
        if (r0 < NX) { src = (which ? KRAW : QRAW) + (size_t)r0 * 1024 + ch; dst = (which ? KC : QC) + (size_t)r0 * 1024 + ch; t0 = r0 & 4095; T = 4096; }
        else { const int rr = r0 - NX; src = (which ? CK : CQ) + (size_t)rr * 1024 + ch; dst = (which ? CKC : CQC) + (size_t)rr * 1024 + ch; t0 = rr & 255; T = 256; }
        const u32x4 z = {0u, 0u, 0u, 0u};
        u32x4 v[10];
        v[0] = (t0 > 0) ? *(const u32x4*)(src - 1024) : z;
#pragma unroll
        for (int i = 0; i < 8; ++i) v[i + 1] = *(const u32x4*)(src + (size_t)i * 1024);
        v[9] = (t0 + 8 < T) ? *(const u32x4*)(src + (size_t)8 * 1024) : z;
        const float* w = p.conv_qk + which * 1024 + ch;
        float wt[3][8];
#pragma unroll
        for (int j = 0; j < 3; ++j) { const f32x4 wa = *(const f32x4*)(w + j * 2048), wb = *(const f32x4*)(w + j * 2048 + 4);
#pragma unroll
            for (int e = 0; e < 4; ++e) { wt[j][e] = wa[e]; wt[j][4 + e] = wb[e]; } }
        const float qs = which ? 1.0f : 0.0625f;
#pragma unroll
        for (int i = 0; i < 8; ++i) {
            float o[8];
#pragma unroll
            for (int e = 0; e < 4; ++e) {
                float lo = wt[0][2 * e] * lo_f(v[i][e]) + wt[1][2 * e] * lo_f(v[i + 1][e]) + wt[2][2 * e] * lo_f(v[i + 2][e]);
                float hi = wt[0][2 * e + 1] * hi_f(v[i][e]) + wt[1][2 * e + 1] * hi_f(v[i + 1][e]) + wt[2][2 * e + 1] * hi_f(v[i + 2][e]);
                o[2 * e] = silu_f(lo) * qs; o[2 * e + 1] = silu_f(hi) * qs;
            }
            u32x4 wv; wv.x = pk2(o[0], o[1]); wv.y = pk2(o[2], o[3]); wv.z = pk2(o[4], o[5]); wv.w = pk2(o[6], o[7]);
            *(u32x4*)(dst + (size_t)i * 1024) = wv;
        }
    }
    const int lane = tid & 63;
    const int n_sc = nscan ? 1 : 64;
    if (scanner || (nscan == 0 && blockIdx.x == 0 && tid < 64))
    for (int sc = 0; sc < n_sc; ++sc) {
        const int gw = nscan ? (int)blockIdx.x : sc;
        const int b = gw >> 3, h = (gw >> 1) & 3, dir = gw & 1;
        const float* GATES = (const float*)(p.ws + WS_GATES);
        float* GP = (float*)(p.ws + WS_GPRE) + (size_t)gw * 68 * 384;
        float m_prev = 0.f;
        auto grow_of = [&](int st) -> size_t { if (st < 4) { const int cc = dir ? 3 - st : st; return (size_t)NX + (size_t)b * 256 + cc * 64; } const int xc = st - 4, cc = dir ? 63 - xc : xc; return (size_t)b * 4096 + cc * 64; };
        const int oi = (dir ? 8 : 0) + h, of = (dir ? 12 : 4) + h;
        float nig = GATES[(grow_of(0) + lane) * 16 + oi], nlf = GATES[(grow_of(0) + lane) * 16 + of];
        for (int st = 0; st < 68; ++st) {
            const float ig = nig, lf = nlf;
            if (st + 1 < 68) { const size_t g2 = grow_of(st + 1); nig = GATES[(g2 + lane) * 16 + oi]; nlf = GATES[(g2 + lane) * 16 + of]; }
            float bs = lf;
#pragma unroll
            for (int o = 1; o < 64; o <<= 1) { const float ov = dir ? __shfl_down(bs, o) : __shfl_up(bs, o); const bool ok = dir ? (lane + o < 64) : (lane >= o); if (ok) bs += ov; }
            const float a = ig - bs;
            float mx = a;
#pragma unroll
            for (int o = 1; o < 64; o <<= 1) { const float ov = dir ? __shfl_down(mx, o) : __shfl_up(mx, o); const bool ok = dir ? (lane + o < 64) : (lane >= o); if (ok) mx = fmaxf(mx, ov); }
            const float total = __shfl(bs, dir ? 0 : 63);
            const float m_inter = bs + m_prev, m_t = fmaxf(bs + mx, m_inter);
            const float wsl = total - bs + ig;
            const float m_new = fmaxf(total + m_prev, wave_max(wsl));
            float* o = GP + (size_t)st * 384;
            o[lane] = bs - m_t; o[64 + lane] = a; o[128 + lane] = __expf(m_inter - m_t); o[192 + lane] = __expf(wsl - m_new); o[256 + lane] = __expf(-m_t);
            if (lane == 0) o[320] = __expf(total + m_prev - m_new);
            m_prev = m_new;
        }
    }
}

DI void ph_mlstm(const Params& p, LAS unsigned char* lds) {
    constexpr int QP = 528, VP = 176, SP = 144;
    LAS unsigned char* Qi = lds; LAS unsigned char* Ki = lds + 33792; LAS unsigned char* Vi0 = lds + 67584; LAS unsigned char* Vwi = Vi0 + 2 * 11264;
    LAS unsigned char* Sgi = Vwi + 11264; LAS unsigned char* Ci = Sgi + 9216; LAS float* fl0 = (LAS float*)(Ci + 42240);
    const int tid = opaque_tid(), wid = tid >> 6, lane = tid & 63, fr = lane & 15, fq = lane >> 4;
    const bf16_t* QC = (const bf16_t*)p.out; const bf16_t* KC = QC + (size_t)NX * 1024; const bf16_t* VPL = (const bf16_t*)(p.ws + 2 * PLANE);
    const bf16_t* CQC = (const bf16_t*)(p.ws + WS_CQC); const bf16_t* CKC = (const bf16_t*)(p.ws + WS_CKC); const bf16_t* CV = (const bf16_t*)(p.ws + WS_CRAW) + (size_t)2 * NCX * 1024;
    for (int wi = blockIdx.x; wi < 256; wi += gridDim.x) {
        const int b = wi >> 5, h = (wi >> 3) & 3, dir = (wi >> 2) & 1, es = wi & 3;
        bf16_t* Hout = (bf16_t*)(p.ws + (dir ? PLANE : 0));
        const float* GP = (const float*)(p.ws + WS_GPRE) + (size_t)((b * 4 + h) * 2 + dir) * 68 * 384;
        f32x4 Cst[2][5];
#pragma unroll
        for (int i = 0; i < 2; ++i)
#pragma unroll
            for (int n = 0; n < 5; ++n) Cst[i][n] = (f32x4){0.f, 0.f, 0.f, 0.f};
        __syncthreads();
        for (int i = tid; i < 64 * 8; i += 512) { const int row = i >> 3, c = i & 7;
            *(LAS unsigned*)(Vi0 + row * VP + 128 + c * 4) = 0x3F803F80u; *(LAS unsigned*)(Vi0 + 11264 + row * VP + 128 + c * 4) = 0x3F803F80u; *(LAS unsigned*)(Vwi + row * VP + 128 + c * 4) = 0u; }
        u32x4 rq[4], rk[4], rv; float pg = 0.f, pws = 0.f, pdecay = 0.f, decay = 0.f;
        const int mt = wid >> 1, nt0 = 2 * (wid & 1);
#define ML_LOAD(ST) do { const int _st = (ST); const bf16_t *_q, *_k, *_v; \
            if (_st < 4) { const int cc = dir ? 3 - _st : _st; const size_t row0 = (size_t)b * 256 + cc * 64; _q = CQC + row0 * 1024 + h * 256; _k = CKC + row0 * 1024 + h * 256; _v = CV + row0 * 1024 + h * 256 + es * 64; } \
            else { const int xc = _st - 4, cc = dir ? 63 - xc : xc; const size_t row0 = (size_t)b * 4096 + cc * 64; _q = QC + row0 * 1024 + h * 256; _k = KC + row0 * 1024 + h * 256; _v = VPL + row0 * 1024 + h * 256 + es * 64; } \
            _Pragma("unroll") for (int i = 0; i < 4; ++i) { const int id = tid + 512 * i, row = id >> 5, chk = id & 31; rq[i] = *(const u32x4*)(_q + (size_t)row * 1024 + chk * 8); rk[i] = *(const u32x4*)(_k + (size_t)row * 1024 + chk * 8); } \
            rv = *(const u32x4*)(_v + (size_t)(tid >> 3) * 1024 + (tid & 7) * 8); \
            const float* _g = GP + (size_t)_st * 384; pg = _g[tid < 320 ? tid : 0]; pws = _g[192 + (tid >> 3)]; pdecay = _g[320]; } while (0)
#define ML_WRITE(ST) do { LAS unsigned char* _Vi = Vi0 + ((ST) & 1) * 11264; LAS float* _fl = fl0 + ((ST) & 1) * 320; \
            _Pragma("unroll") for (int i = 0; i < 4; ++i) { const int id = tid + 512 * i, row = id >> 5, chk = id & 31; \
                *(LAS u32x4*)(Qi + row * QP + chk * 16) = rq[i]; *(LAS u32x4*)(Ki + row * QP + chk * 16) = rk[i]; } \
            *(LAS u32x4*)(_Vi + (tid >> 3) * VP + (tid & 7) * 16) = rv; \
            { const float w = pws; u32x4 o; \
              o.x = pk2(w * lo_f(rv.x), w * hi_f(rv.x)); o.y = pk2(w * lo_f(rv.y), w * hi_f(rv.y)); o.z = pk2(w * lo_f(rv.z), w * hi_f(rv.z)); o.w = pk2(w * lo_f(rv.w), w * hi_f(rv.w)); \
              *(LAS u32x4*)(Vwi + (tid >> 3) * VP + (tid & 7) * 16) = o; \
              if ((tid & 7) == 0) *(LAS unsigned*)(Vwi + (tid >> 3) * VP + 128) = pk2(w, 0.f); } \
            if (tid < 320) _fl[tid] = pg; \
            _Pragma("unroll") for (int i = 0; i < 2; ++i) _Pragma("unroll") for (int n = 0; n < 5; ++n) { u32x2 w; w.x = pk2(Cst[i][n][0], Cst[i][n][1]); w.y = pk2(Cst[i][n][2], Cst[i][n][3]); \
                *(LAS u32x2*)(Ci + (16 * n + fr) * QP + (16 * (2 * wid + i) + 4 * fq) * 2) = w; } \
            decay = pdecay; } while (0)
        ML_LOAD(0);
        __syncthreads();
        ML_WRITE(0);
        ML_LOAD(1);
        for (int st = 0; st < 68; ++st) {
            const bool isx = st >= 4;
            LAS unsigned char* Vi = Vi0 + (st & 1) * 11264; LAS float* fl = fl0 + (st & 1) * 320;
            LAS float* f_bt = fl; LAS float* f_aa = fl + 64; LAS float* f_inter = fl + 128; LAS float* f_enm = fl + 256;
            __syncthreads();
            const float dcy = decay;
            const int t = 16 * mt + fr;
            f32x4 accC[3];
#pragma unroll
            for (int n = 0; n < 3; ++n) accC[n] = (f32x4){0.f, 0.f, 0.f, 0.f};
            if (isx) {
                f32x4 sacc[2] = {(f32x4){0.f, 0.f, 0.f, 0.f}, (f32x4){0.f, 0.f, 0.f, 0.f}};
#pragma unroll
                for (int ks = 0; ks < 8; ++ks) { const bf16x8 qf = *(const LAS bf16x8*)(Qi + t * QP + (32 * ks + 8 * fq) * 2);
#pragma unroll
                    for (int n = 0; n < 2; ++n) { const bf16x8 kf = *(const LAS bf16x8*)(Ki + (16 * (nt0 + n) + fr) * QP + (32 * ks + 8 * fq) * 2); sacc[n] = mfma16(kf, qf, sacc[n]); }
#pragma unroll
                    for (int n = 0; n < 3; ++n) { const int et = (n < 2) ? nt0 + n : 4; const bf16x8 cf = *(const LAS bf16x8*)(Ci + (16 * et + fr) * QP + (32 * ks + 8 * fq) * 2); accC[n] = mfma16(cf, qf, accC[n]); } }
                const float btm = f_bt[t];
#pragma unroll
                for (int n = 0; n < 2; ++n) { const int s0 = 16 * (nt0 + n) + 4 * fq; const f32x4 a4 = *(const LAS f32x4*)(f_aa + s0); float vv[4];
#pragma unroll
                    for (int j = 0; j < 4; ++j) { const int s = s0 + j; const bool ok = dir ? (s >= t) : (s <= t); const float e = __expf(btm + a4[j]); vv[j] = ok ? sacc[n][j] * e : 0.f; }
                    u32x2 w; w.x = pk2(vv[0], vv[1]); w.y = pk2(vv[2], vv[3]); *(LAS u32x2*)(Sgi + t * SP + s0 * 2) = w; }
            }
#pragma unroll
            for (int i = 0; i < 2; ++i)
#pragma unroll
                for (int n = 0; n < 5; ++n) Cst[i][n] = Cst[i][n] * dcy;
#pragma unroll
            for (int ks = 0; ks < 2; ++ks) { bf16x8 kf[2];
#pragma unroll
                for (int i = 0; i < 2; ++i) kf[i] = tr_frag(Ki, QP, 32 * ks, 16 * (2 * wid + i), lane);
#pragma unroll
                for (int n = 0; n < 5; ++n) { const bf16x8 vw = tr_frag(Vwi, VP, 32 * ks, 16 * n, lane);
#pragma unroll
                    for (int i = 0; i < 2; ++i) Cst[i][n] = mfma16(kf[i], vw, Cst[i][n]); } }
            __syncthreads();
            if (isx) {
                f32x4 accD[3];
#pragma unroll
                for (int n = 0; n < 3; ++n) accD[n] = (f32x4){0.f, 0.f, 0.f, 0.f};
#pragma unroll
                for (int ks = 0; ks < 2; ++ks) { const bf16x8 sgf = *(const LAS bf16x8*)(Sgi + t * SP + (32 * ks + 8 * fq) * 2);
#pragma unroll
                    for (int n = 0; n < 3; ++n) { const int et = (n < 2) ? nt0 + n : 4; const bf16x8 vf = tr_frag(Vi, VP, 32 * ks, 16 * et, lane); accD[n] = mfma16(vf, sgf, accD[n]); } }
                const float inter_t = f_inter[t];
                const float den0 = accD[2][0] + inter_t * accC[2][0];
                const float den = __shfl(den0, fr);
                const float rden = 1.0f / fmaxf(fabsf(den), f_enm[t]);
                const int xc = st - 4, cc = dir ? 63 - xc : xc;
                bf16_t* hp = Hout + ((size_t)b * 4096 + cc * 64 + t) * 1024 + h * 256 + es * 64 + 4 * fq;
                u32x2 hw[2];
#pragma unroll
                for (int n = 0; n < 2; ++n) { const f32x4 hv = (accD[n] + accC[n] * inter_t) * rden; hw[n].x = pk2(hv[0], hv[1]); hw[n].y = pk2(hv[2], hv[3]); }
                st_pair16(hp + 16 * nt0, hw[0], hw[1], fq);
            }
            if (st + 1 < 68) { ML_WRITE(st + 1); if (st + 2 < 68) ML_LOAD(st + 2); }
        }
#undef ML_LOAD
#undef ML_WRITE
    }
}

template <int KK, int NN, class Cfg>
DI void axis_mix(const Cfg& cfg, LAS unsigned char* lds, int n_items) {
    constexpr int TP = 528, BP = KK * 2 + 16, NCH = KK / 16;
    LAS unsigned char* Ti = lds; LAS unsigned char* Bi = lds + 128 * TP;
    const int tid = opaque_tid(), wid = tid >> 6, lane = tid & 63, fr = lane & 15, fq = lane >> 4;
    __syncthreads();
    cfg.fill_tables(Bi, tid);
    u32x4 ra[NCH], rb[NCH];
    const int G = gridDim.x;
#define AX_LOAD(R, IT) do { if ((IT) < n_items) { _Pragma("unroll") for (int i = 0; i < NCH; ++i) { const int id = tid + 512 * i; R[i] = *(const u32x4*)(cfg.row_ptr((IT), id >> 5) + (id & 31) * 8); } } } while (0)
#define AX_BODY(R, IT, PRE) do { \
        __syncthreads(); \
        _Pragma("unroll") for (int i = 0; i < NCH; ++i) { const int id = tid + 512 * i; *(LAS u32x4*)(Ti + (id >> 5) * TP + (id & 31) * 16) = R[i]; } \
        __syncthreads(); \
        AX_LOAD(R, PRE); \
        f32x4 acc[2][NN / 16]; \
        _Pragma("unroll") for (int i = 0; i < 2; ++i) _Pragma("unroll") for (int n = 0; n < NN / 16; ++n) acc[i][n] = (f32x4){0.f, 0.f, 0.f, 0.f}; \
        LAS unsigned char* tb = Bi + cfg.table_off(IT); \
        _Pragma("unroll") for (int ks = 0; ks < KK / 32; ++ks) { bf16x8 af[2]; \
            _Pragma("unroll") for (int i = 0; i < 2; ++i) af[i] = tr_frag(Ti, TP, 32 * ks, 32 * wid + 16 * i, lane); \
            _Pragma("unroll") for (int n = 0; n < NN / 16; ++n) { const bf16x8 bfr = *(const LAS bf16x8*)(tb + (16 * n + fr) * BP + (32 * ks + 8 * fq) * 2); \
                _Pragma("unroll") for (int i = 0; i < 2; ++i) acc[i][n] = mfma16(af[i], bfr, acc[i][n]); } } \
        cfg.epilogue(acc, (IT), wid, fr, fq, Bi); } while (0)
    int item = blockIdx.x;
    AX_LOAD(ra, item); AX_LOAD(rb, item + G);
    for (; item < n_items; item += 2 * G) {
        AX_BODY(ra, item, item + 2 * G);
        if (item + G < n_items) AX_BODY(rb, item + G, item + 3 * G);
    }
#undef AX_LOAD
#undef AX_BODY
}
DI void fill_dft_table(LAS unsigned char* Bi, int tid, int nrows) {
    for (int idx = tid; idx < nrows * 128; idx += 512) { const int n = idx >> 7, k = idx & 127, ap = n & 63, kk = k & 63; float s, c; sincospif((float)((kk * ap) & 63) / 32.0f, &s, &c);
        float v; if (n < 64) v = (k < 64) ? c : s; else v = (k < 64) ? -s : c;
        *(LAS unsigned short*)(Bi + n * 272 + k * 2) = (unsigned short)(pk2(v * 0.125f, 0.f) & 0xffffu); }
}
struct CfgDft1 {
    const bf16_t* Z; bf16_t* S1re; bf16_t* S1im;
    DI void fill_tables(LAS unsigned char* Bi, int tid) const { fill_dft_table(Bi, tid, 128); }
    DI int table_off(int) const { return 0; }
    DI const bf16_t* row_ptr(int item, int k) const { const int g = item & 3, b = (item >> 2) & 63, batch = item >> 8;
        return Z + ((size_t)batch * 4096 + 64 * (k & 63) + b) * 2048 + g * 512 + (k >> 6) * 256; }
    DI void epilogue(const f32x4 (&acc)[2][8], int item, int wid, int fr, int fq, LAS unsigned char* Bi) const {
        const int g = item & 3, b = (item >> 2) & 63, batch = item >> 8;
#pragma unroll
        for (int ni = 0; ni < 4; ++ni) { const int ap = 16 * ni + fr; float s, c; sincospif((float)(b * ap) * (1.0f / 2048.0f), &s, &c);
            const size_t tok = (size_t)batch * 4096 + 64 * ap + b;
            u32x2 wr[2], wi[2];
#pragma unroll
            for (int i = 0; i < 2; ++i) { const f32x4 re = acc[i][ni], im = acc[i][ni + 4]; const f32x4 r2 = re * c + im * s, i2 = im * c - re * s;
                wr[i].x = pk2(r2[0], r2[1]); wr[i].y = pk2(r2[2], r2[3]); wi[i].x = pk2(i2[0], i2[1]); wi[i].y = pk2(i2[2], i2[3]); }
            { const size_t o = tok * 1024 + g * 256 + 32 * wid + 4 * fq; st_pair16(S1re + o, wr[0], wr[1], fq); st_pair16(S1im + o, wi[0], wi[1], fq); } }
    }
};
struct CfgDft2 {
    const bf16_t* S1re; const bf16_t* S1im; const bf16_t* ZB; bf16_t* Y;
    DI void fill_tables(LAS unsigned char* Bi, int tid) const { fill_dft_table(Bi, tid, 64); }
    DI int table_off(int) const { return 0; }
    DI const bf16_t* row_ptr(int item, int k) const { const int g = item & 3, ap = (item >> 2) & 63, batch = item >> 8;
        return ((k >> 6) ? S1im : S1re) + ((size_t)batch * 4096 + 64 * ap + (k & 63)) * 1024 + g * 256; }
    DI void epilogue(const f32x4 (&acc)[2][4], int item, int wid, int fr, int fq, LAS unsigned char*) const {
        const int g = item & 3, ap = (item >> 2) & 63, batch = item >> 8;
#pragma unroll
        for (int ni = 0; ni < 4; ++ni) { const size_t tok = (size_t)batch * 4096 + ap + 64 * (16 * ni + fr);
            u32x2 w[2];
#pragma unroll
            for (int i = 0; i < 2; ++i) { const int ch = g * 256 + 32 * wid + 16 * i + 4 * fq; const u32x2 z = *(const u32x2*)(ZB + tok * 1024 + ch); const f32x4 a = acc[i][ni];
                w[i].x = pk2(a[0] * silu_f(lo_f(z.x)), a[1] * silu_f(hi_f(z.x))); w[i].y = pk2(a[2] * silu_f(lo_f(z.y)), a[3] * silu_f(hi_f(z.y))); }
            st_pair16(Y + tok * 2048 + 1024 + g * 256 + 32 * wid + 4 * fq, w[0], w[1], fq); }
    }
};
DI void fill_pool_tables(LAS unsigned char* Bi, int tid) {
    for (int idx = tid; idx < 4 * 4096; idx += 512) { const int g = idx >> 12, n = (idx >> 6) & 63, k = idx & 63, w = 2 << g, lo = n - w / 2, hi = n + w - w / 2;
        *(LAS unsigned short*)(Bi + g * 9216 + n * 144 + k * 2) = (k >= lo && k < hi) ? (unsigned short)0x3F80 : (unsigned short)0; }
}
DI float pool_rcnt(int g, int n) { const int w = 2 << g; int lo = n - w / 2, hi = n + w - w / 2; lo = lo < 0 ? 0 : lo; hi = hi > 64 ? 64 : hi; return 1.0f / (float)(hi - lo); }
struct CfgPoolA {
    const bf16_t* UC; bf16_t* PA;
    DI void fill_tables(LAS unsigned char* Bi, int tid) const { fill_pool_tables(Bi, tid); }
    DI int table_off(int item) const { return ((item & 7) >> 1) * 9216; }
    DI const bf16_t* row_ptr(int item, int k) const { const int ct = item & 7, c = (item >> 3) & 63, batch = item >> 9; return UC + ((size_t)batch * 4096 + 64 * k + c) * 2048 + ct * 256; }
    DI void epilogue(const f32x4 (&acc)[2][4], int item, int wid, int fr, int fq, LAS unsigned char*) const {
        const int ct = item & 7, c = (item >> 3) & 63, batch = item >> 9, g = ct >> 1;
#pragma unroll
        for (int ni = 0; ni < 4; ++ni) { const int n = 16 * ni + fr; const float rc = pool_rcnt(g, n); const size_t tok = (size_t)batch * 4096 + 64 * n + c;
            u32x2 w[2];
#pragma unroll
            for (int i = 0; i < 2; ++i) { const f32x4 a = acc[i][ni] * rc; w[i].x = pk2(a[0], a[1]); w[i].y = pk2(a[2], a[3]); }
            st_pair16(PA + tok * 2048 + ct * 256 + 32 * wid + 4 * fq, w[0], w[1], fq); }
    }
};
struct CfgPoolB {
    const bf16_t* PA; bf16_t* UC;
    DI void fill_tables(LAS unsigned char* Bi, int tid) const { fill_pool_tables(Bi, tid); }
    DI int table_off(int item) const { return ((item & 7) >> 1) * 9216; }
    DI const bf16_t* row_ptr(int item, int k) const { const int ct = item & 7, rp = (item >> 3) & 63, batch = item >> 9; return PA + ((size_t)batch * 4096 + 64 * rp + k) * 2048 + ct * 256; }
    DI void epilogue(const f32x4 (&acc)[2][4], int item, int wid, int fr, int fq, LAS unsigned char*) const {
        const int ct = item & 7, rp = (item >> 3) & 63, batch = item >> 9, g = ct >> 1;
#pragma unroll
        for (int ni = 0; ni < 4; ++ni) { const int n = 16 * ni + fr; const float rc = pool_rcnt(g, n); const size_t tok = (size_t)batch * 4096 + 64 * rp + n;
            u32x2 w[2]; bf16_t* up0 = UC + tok * 2048 + ct * 256 + 32 * wid + 4 * fq;
#pragma unroll
            for (int i = 0; i < 2; ++i) { const u32x2 u = *(const u32x2*)(up0 + 16 * i); const f32x4 a = acc[i][ni] * rc;
                w[i].x = pk2(a[0] - lo_f(u.x), a[1] - hi_f(u.x)); w[i].y = pk2(a[2] - lo_f(u.y), a[3] - hi_f(u.y)); }
            st_pair16(up0, w[0], w[1], fq); }
    }
};

DI void ph_ya(const Params& p) {
    const int tid = opaque_tid(), wid = tid >> 6, lane = tid & 63;
    const bf16_t* HF = (const bf16_t*)p.ws; const bf16_t* HB = (const bf16_t*)(p.ws + PLANE); const bf16_t* O = (const bf16_t*)(p.ws + 3 * PLANE); const bf16_t* ZA = (const bf16_t*)(p.ws + 4 * PLANE);
    bf16_t* Y = (bf16_t*)p.out;
    f32x4 hg[4];
#pragma unroll
    for (int i = 0; i < 4; ++i) hg[i] = *(const f32x4*)(p.head_norm + lane * 16 + 4 * i);
    for (int r = blockIdx.x * 8 + wid; r < NX; r += gridDim.x * 8) {
        const size_t o = (size_t)r * 1024 + lane * 16;
        float gv[16], za[16]; float ss = 0.f;
#pragma unroll
        for (int hh = 0; hh < 2; ++hh) { const u32x4 a = *(const u32x4*)(HF + o + 8 * hh), bq = *(const u32x4*)(HB + o + 8 * hh), oo = *(const u32x4*)(O + o + 8 * hh), zz = *(const u32x4*)(ZA + o + 8 * hh);
#pragma unroll
            for (int e = 0; e < 4; ++e) { const float h0 = lo_f(a[e]) + lo_f(bq[e]), h1 = hi_f(a[e]) + hi_f(bq[e]);
                const float g0 = sigmoid_f(lo_f(oo[e])) * h0, g1 = sigmoid_f(hi_f(oo[e])) * h1;
                gv[8 * hh + 2 * e] = g0; gv[8 * hh + 2 * e + 1] = g1; ss += g0 * g0 + g1 * g1; za[8 * hh + 2 * e] = lo_f(zz[e]); za[8 * hh + 2 * e + 1] = hi_f(zz[e]); } }
        ss += __shfl_xor(ss, 1); ss += __shfl_xor(ss, 2); ss += __shfl_xor(ss, 4); ss += __shfl_xor(ss, 8);
        const float rstd = rsqrtf(ss * (1.0f / 256.0f) + 1e-6f);
        u32x4 w[2];
#pragma unroll
        for (int q = 0; q < 8; ++q) { const float y0 = gv[2 * q] * rstd * hg[q >> 1][(2 * q) & 3] * silu_f(za[2 * q]), y1 = gv[2 * q + 1] * rstd * hg[q >> 1][(2 * q + 1) & 3] * silu_f(za[2 * q + 1]);
            w[q >> 2][q & 3] = pk2(y0, y1); }
        *(u32x4*)(Y + (size_t)r * 2048 + lane * 16) = w[0]; *(u32x4*)(Y + (size_t)r * 2048 + lane * 16 + 8) = w[1];
    }
}


#define XB_TMO      128
#define XB_XCNT(j)  (256  + 64 * (j))
#define XB_XSUB(j)  (1280 + 64 * (j))
#define XB_XGEN(j)  (2304 + 64 * (j))
#define XB_TOP      3328
#define XB_TOPGEN   3392
#define XCD_BAR_WORDS 3456
#define XB_SPIN_CAP (1u << 18)
DI unsigned xb_ld(unsigned* p)              { return __hip_atomic_load(p, __ATOMIC_RELAXED, __HIP_MEMORY_SCOPE_AGENT); }
DI unsigned xb_add(unsigned* p, unsigned v) { return __hip_atomic_fetch_add(p, v, __ATOMIC_RELAXED, __HIP_MEMORY_SCOPE_AGENT); }
DI unsigned xb_xcc_id() { return (unsigned)__builtin_amdgcn_s_getreg((3 << 11) | 20) & 0xFu; }
#define XB_SPIN(cond, bar) do { unsigned _sp = 0; while (cond) { __builtin_amdgcn_s_sleep(1); \
    if ((++_sp & 255u) == 0u) { if (xb_ld(&(bar)[XB_TMO])) break; if (_sp > XB_SPIN_CAP) { atomicAdd(&(bar)[XB_TMO], 1u); break; } } } } while (0)
struct XcdBarrier { unsigned* bar; unsigned x; volatile LAS unsigned* st; };
DI XcdBarrier xcd_barrier_post(unsigned* bar, volatile LAS unsigned* st) {
    XcdBarrier b; b.bar = bar; b.x = xb_xcc_id(); b.st = st;
    if (threadIdx.x == 0) (void)xb_add(&bar[XB_XCNT(b.x)], 1u);
    return b;
}
DI void xcd_barrier_complete(unsigned* bar, unsigned x, unsigned& nloc, unsigned& nx) {
    const unsigned G = gridDim.x * gridDim.y * gridDim.z;
    unsigned sum, cnt, mine, sp = 0u;
    for (;;) {
        sum = 0u; cnt = 0u; mine = 0u;
#pragma unroll
        for (unsigned j = 0; j < 16; ++j) { const unsigned c = xb_ld(&bar[XB_XCNT(j)]); sum += c; cnt += (c > 0u) ? 1u : 0u; mine = (j == x) ? c : mine; }
        if (sum == G) break;
        __builtin_amdgcn_s_sleep(1);
        if ((++sp & 255u) == 0u) { if (xb_ld(&bar[XB_TMO])) break; if (sp > XB_SPIN_CAP) { atomicAdd(&bar[XB_TMO], 1u); break; } }
    }
    nloc = mine > 0u ? mine : 1u; nx = cnt > 0u ? cnt : 1u;
}
DI void xcd_barrier(const XcdBarrier& b) {
    asm volatile("s_waitcnt vmcnt(0)" ::: "memory");
    __syncthreads();
    if (threadIdx.x == 0) {
        unsigned* bar = b.bar;
        __builtin_amdgcn_s_waitcnt(0);
        unsigned nloc = b.st[0], nx = b.st[1];
        if (nloc == 0u) { xcd_barrier_complete(bar, b.x, nloc, nx); b.st[0] = nloc; b.st[1] = nx; }
        const unsigned old = xb_add(&bar[XB_XSUB(b.x)], 1u);
        const unsigned gen = old / nloc;
        if (old + 1u == (gen + 1u) * nloc) {
            __builtin_amdgcn_fence(__ATOMIC_RELEASE, "agent");
            asm volatile("s_waitcnt vmcnt(0)" ::: "memory");
            const unsigned og = xb_add(&bar[XB_TOP], 1u);
            const unsigned tg = og / nx;
            if (og + 1u == (tg + 1u) * nx) xb_add(&bar[XB_TOPGEN], 1u);
            else XB_SPIN(xb_ld(&bar[XB_TOPGEN]) == tg, bar);
            __builtin_amdgcn_fence(__ATOMIC_ACQUIRE, "agent");
            xb_add(&bar[XB_XGEN(b.x)], 1u);
            asm volatile("s_waitcnt vmcnt(0)" ::: "memory");
        } else {
            XB_SPIN(xb_ld(&bar[XB_XGEN(b.x)]) == gen, bar);
            __builtin_amdgcn_fence(__ATOMIC_ACQUIRE, "agent");
            asm volatile("s_waitcnt vmcnt(0)" ::: "memory");
        }
    }
    __syncthreads();
}

__global__ void __launch_bounds__(512, 2) mk_fwd(Params p, int ph_lo, int ph_hi) {
    extern __shared__ __attribute__((aligned(16))) unsigned char shm[];
    LAS unsigned char* lds = (LAS unsigned char*)shm;
    cg::grid_group grid = cg::this_grid();
    unsigned char* ws = p.ws;
    const int G = gridDim.x, c = blockIdx.x;
    volatile LAS unsigned* xst = (volatile LAS unsigned*)(lds + LDS_BYTES - 16);
    if (threadIdx.x == 0) { xst[0] = 0u; xst[1] = 0u; }
    __syncthreads();
    XcdBarrier xbar; xbar.bar = (unsigned*)(ws + WS_BAR); xbar.x = 0u; xbar.st = xst;
    if (ph_hi - ph_lo > 1) xbar = xcd_barrier_post((unsigned*)(ws + WS_BAR), xst);
    if (ph_lo > 1000) grid.sync();
#ifndef PHMASK
#define PHMASK 0xFFFF
#endif
#define GSYNC() xcd_barrier(xbar)
#ifndef REP_MASK
#define REP_MASK 0
#endif
#define PHASE(i, ...) if constexpr ((PHMASK >> (i)) & 1) if (ph_lo <= (i) && (i) < ph_hi) { __VA_ARGS__; if constexpr ((REP_MASK >> (i)) & 1) { __syncthreads(); __VA_ARGS__; } if ((i) + 1 < ph_hi) GSYNC(); }
    PHASE(0, ph_prep(p, lds));
    PHASE(1, ph_norm0(p, lds));
    PHASE(2, { GemmD g{(const bf16_t*)p.out, (const bf16_t*)(ws + WS_WINE), 1024, 1024, 0, 0, 1024}; Sched S{128, 28, 1, 8, 12, 128, G, c};
               EpiPlanes E{(bf16_t*)ws, (bf16_t*)(ws + WS_CRAW)}; gemm_phase(lds, g, S, E);
               if (G > 96 && c >= 96) transpose_jobs(p, lds, opaque_tid(), 2304, 4096, c - 96, G - 96); else if (G <= 96) transpose_jobs(p, lds, opaque_tid(), 2304, 4096, c, G); });
    PHASE(3, ph_conv(p));
    PHASE(4, ph_mlstm(p, lds));
    PHASE(5, { GemmD g{(const bf16_t*)(ws + 5 * PLANE), (const bf16_t*)(ws + WS_WF), 1024, 256, 256, 512 * 256, 256}; Sched S{128, 2, 4, 0, 0, 0, G, c};
               EpiBf E{(bf16_t*)p.out, nullptr, 2048, 512, 0, nullptr, nullptr}; gemm_phase(lds, g, S, E); });
    PHASE(6, { CfgDft1 cf{(const bf16_t*)p.out, (bf16_t*)(ws + 2 * PLANE), (bf16_t*)(ws + 5 * PLANE)}; axis_mix<128, 128>(cf, lds, 2048); });
    PHASE(7, { CfgDft2 cf{(const bf16_t*)(ws + 2 * PLANE), (const bf16_t*)(ws + 5 * PLANE), (const bf16_t*)(ws + 6 * PLANE), (bf16_t*)p.out}; axis_mix<128, 64>(cf, lds, 2048); ph_ya(p); });
    PHASE(8, { GemmD g{(const bf16_t*)p.out, (const bf16_t*)(ws + WS_WOUTE), 2048, 2048, 0, 0, 2048}; Sched S{128, 4, 1, 0, 0, 0, G, c};
               EpiGate E{(bf16_t*)ws, (const float*)(ws + WS_MOD) + 2048}; gemm_phase(lds, g, S, E); });
    PHASE(9, ph_norm1(p, 0));
    PHASE(10, { GemmD g{(const bf16_t*)(ws + 2 * PLANE), (const bf16_t*)(ws + WS_WINO), 1024, 1024, 0, 0, 1024}; Sched S{128, 16, 1, 0, 0, 0, G, c};
                EpiBf E{(bf16_t*)(ws + 3 * PLANE), (bf16_t*)(ws + 5 * PLANE), 2048, 0, 1, nullptr, nullptr}; gemm_phase(lds, g, S, E); });
    PHASE(11, { CfgPoolA cf{(const bf16_t*)(ws + 3 * PLANE), (bf16_t*)p.out}; axis_mix<64, 64>(cf, lds, 4096); });
    PHASE(12, { CfgPoolB cf{(const bf16_t*)p.out, (bf16_t*)(ws + 3 * PLANE)}; axis_mix<64, 64>(cf, lds, 4096); });
    PHASE(13, { GemmD g{(const bf16_t*)(ws + 3 * PLANE), (const bf16_t*)(ws + WS_WPOOL), 2048, 512, 512, 512 * 512, 512}; Sched S{128, 2, 4, 0, 0, 0, G, c};
                EpiBf E{(bf16_t*)p.out, nullptr, 2048, 512, 2, p.pool_scale, (const bf16_t*)(ws + 5 * PLANE)}; gemm_phase(lds, g, S, E); });
    PHASE(14, { GemmD g{(const bf16_t*)p.out, (const bf16_t*)(ws + WS_WOUTO), 2048, 2048, 0, 0, 2048}; Sched S{128, 4, 1, 0, 0, 0, G, c};
                EpiGate E{(bf16_t*)(ws + PLANE), (const float*)(ws + WS_MOD) + 9 * 3072 + 2048}; gemm_phase(lds, g, S, E); });
    PHASE(15, ph_norm1(p, 1));
#undef PHASE
#ifdef XSYNC
    for (int k = 0; k < XSYNC; ++k) GSYNC();
#endif
#ifdef DBG_STOP
    GSYNC();
    {   const size_t n = (size_t)NX * 1024; unsigned* o32 = (unsigned*)p.out;
        for (size_t i = (size_t)blockIdx.x * 512 + threadIdx.x; i < n; i += (size_t)gridDim.x * 512) {
            float v = 0.f;
            if (DBG_PLANES == -1) { const unsigned u = o32[i]; v = lo_f(u) + hi_f(u); }
            else if (DBG_PLANES == -2) { v = ((const float*)p.ws)[i]; }
            else { for (int pl = 0; pl < 7; ++pl) if ((DBG_PLANES >> pl) & 1) v += bf2f(((const bf16_t*)(p.ws + pl * PLANE))[i]); }
            if (!(fabsf(v) < 1e30f)) v = 12345.f;
            p.out[i] = v; } }
#endif
}

extern "C" void kernel_launch(void* const* d_in, const int* in_sizes, int n_in, void* d_out, int out_size, void* d_ws, size_t ws_size, hipStream_t stream) {
    static int grid = 0;
    if (grid == 0) {
        int dev = 0, cus = 0, per_cu = 0;
        hipGetDevice(&dev);
        hipDeviceGetAttribute(&cus, hipDeviceAttributeMultiprocessorCount, dev);
        if (hipFuncSetAttribute((const void*)mk_fwd, hipFuncAttributeMaxDynamicSharedMemorySize, LDS_BYTES) != hipSuccess) fprintf(stderr, "hipFuncSetAttribute failed\n");
        if (hipOccupancyMaxActiveBlocksPerMultiprocessor(&per_cu, (const void*)mk_fwd, 512, LDS_BYTES) != hipSuccess || per_cu < 1) { fprintf(stderr, "occupancy query: %d\n", per_cu); per_cu = 1; }
        (void)hipGetLastError();
        grid = cus * per_cu; if (grid > 256) grid = 256; if (grid < 1) grid = 1;
        if (ws_size < WS_END) fprintf(stderr, "workspace too small: %zu < %zu\n", ws_size, (size_t)WS_END);
    }
    Params p{};
    p.x = (const float*)d_in[0]; p.c = (const float*)d_in[1]; p.ctx = (const float*)d_in[2]; p.c_ctx = (const float*)d_in[3]; p.ada_w = (const float*)d_in[4]; p.ada_b = (const float*)d_in[5];
    p.norm_g = (const float*)d_in[6]; p.win_even = (const float*)d_in[7]; p.gate_b = (const float*)d_in[8]; p.conv_qk = (const float*)d_in[9]; p.head_norm = (const float*)d_in[10];
    p.fourier_w = (const float*)d_in[11]; p.wout_even = (const float*)d_in[12]; p.win_odd = (const float*)d_in[13]; p.pool_w = (const float*)d_in[14]; p.pool_scale = (const float*)d_in[15];
    p.wout_odd = (const float*)d_in[16]; p.final_g = (const float*)d_in[17]; p.out = (float*)d_out; p.ws = (unsigned char*)d_ws;
    (void)hipMemsetAsync((unsigned char*)d_ws + WS_BAR, 0, XCD_BAR_WORDS * 4, stream);
#if MK_MULTI
    for (int ph = 0; ph < 16; ++ph) { hipLaunchKernelGGL(mk_fwd, dim3(grid), dim3(512), LDS_BYTES, stream, p, ph, ph + 1); }
#else
#ifdef DBG_STOP
    int lo = 0, hi = DBG_STOP;
#else
    int lo = 0, hi = 16;
#endif
    void* args[] = {&p, &lo, &hi};
    hipError_t e = hipLaunchCooperativeKernel((void*)mk_fwd, dim3(grid), dim3(512), args, LDS_BYTES, stream);
    if (e != hipSuccess) fprintf(stderr, "cooperative launch failed: %s (grid %d)\n", hipGetErrorString(e), grid);
#endif
}
```

```cpp
#include <hip/hip_runtime.h>
#include <hip/hip_cooperative_groups.h>
#include <cstdio>
namespace cg = cooperative_groups;

#ifndef MK_MULTI
#define MK_MULTI 0
#endif

#define LAS __attribute__((address_space(3)))
typedef unsigned short bf16_t;
typedef short bf16x8 __attribute__((ext_vector_type(8)));
typedef short s16x4 __attribute__((ext_vector_type(4)));
typedef float f32x4 __attribute__((ext_vector_type(4)));
typedef unsigned u32x4 __attribute__((ext_vector_type(4)));
typedef unsigned u32x2 __attribute__((ext_vector_type(2)));

constexpr int NX = 32768, NCX = 2048, NR = NX + NCX;
constexpr size_t PLANE = (size_t)NX * 1024 * 2;
constexpr size_t WS_EXTRA = 7 * PLANE;
constexpr size_t WS_WINE  = WS_EXTRA;
constexpr size_t WS_WOUTE = WS_WINE  + (size_t)7168 * 1024 * 2;
constexpr size_t WS_WINO  = WS_WOUTE + (size_t)1024 * 2048 * 2;
constexpr size_t WS_WPOOL = WS_WINO  + (size_t)4096 * 1024 * 2;
constexpr size_t WS_WOUTO = WS_WPOOL + (size_t)4 * 512 * 512 * 2;
constexpr size_t WS_WF    = WS_WOUTO + (size_t)1024 * 2048 * 2;
constexpr size_t WS_MOD   = WS_WF    + (size_t)4 * 512 * 256 * 2;
constexpr size_t WS_GATES = WS_MOD   + 262144;
constexpr size_t WS_CRAW  = WS_GATES + (size_t)NR * 16 * 4;
constexpr size_t WS_CQC   = WS_CRAW  + (size_t)3 * NCX * 1024 * 2;
constexpr size_t WS_CKC   = WS_CQC   + (size_t)NCX * 1024 * 2;
constexpr size_t WS_END   = WS_CKC   + (size_t)NCX * 1024 * 2;
constexpr size_t WS_GPRE  = WS_END + 16384;
constexpr size_t WS_GPRE_END = WS_GPRE + (size_t)64 * 68 * 384 * 4;
static_assert(WS_GPRE_END <= (size_t)512 * 1024 * 1024, "gate tables exceed the workspace");
constexpr size_t WS_BAR   = WS_END;
static_assert(WS_BAR + 16384 <= (size_t)512 * 1024 * 1024, "workspace map exceeds 512 MiB");

constexpr int LDS_BYTES = 155648;

struct Params {
    const float* x; const float* c; const float* ctx; const float* c_ctx; const float* ada_w; const float* ada_b; const float* norm_g;
    const float* win_even; const float* gate_b; const float* conv_qk; const float* head_norm; const float* fourier_w; const float* wout_even;
    const float* win_odd; const float* pool_w; const float* pool_scale; const float* wout_odd; const float* final_g;
    float* out; unsigned char* ws;
};

#define DI __device__ __forceinline__
DI float bf2f(unsigned short b) { return __uint_as_float(((unsigned)b) << 16); }
DI float lo_f(unsigned u) { return __uint_as_float(u << 16); }
DI float hi_f(unsigned u) { return __uint_as_float(u & 0xffff0000u); }
typedef __bf16 bf16v2_t __attribute__((ext_vector_type(2)));
typedef float f32v2_t __attribute__((ext_vector_type(2)));
DI unsigned pk2(float lo, float hi) { const f32v2_t v = {lo, hi}; const bf16v2_t b = __builtin_convertvector(v, bf16v2_t); return __builtin_bit_cast(unsigned, b); }
DI float silu_f(float x) { return x / (1.0f + __expf(-x)); }
DI float sigmoid_f(float x) { return 1.0f / (1.0f + __expf(-x)); }
DI int opaque_tid() { int t = threadIdx.x; asm volatile("" : "+v"(t)); return t; }
DI float wave_sum(float v) { for (int o = 32; o > 0; o >>= 1) v += __shfl_xor(v, o); return v; }
DI float wave_max(float v) { for (int o = 32; o > 0; o >>= 1) v = fmaxf(v, __shfl_xor(v, o)); return v; }
DI void st_pair16(bf16_t* base0, u32x2 w0, u32x2 w1, int fq) {
    const auto rx = __builtin_amdgcn_permlane16_swap(w0.x, w1.x, false, false);
    const auto ry = __builtin_amdgcn_permlane16_swap(w0.y, w1.y, false, false);
    u32x4 v; v.x = rx[0]; v.y = ry[0]; v.z = rx[1]; v.w = ry[1];
    *(u32x4*)((fq & 1) ? base0 + 12 : base0) = v;
}
DI void ld_pair16(const bf16_t* base0, int fq, u32x2& w0, u32x2& w1) {
    const u32x4 v = *(const u32x4*)((fq & 1) ? base0 + 12 : base0);
    const auto rx = __builtin_amdgcn_permlane16_swap(v.x, v.z, false, false);
    const auto ry = __builtin_amdgcn_permlane16_swap(v.y, v.w, false, false);
    w0.x = rx[0]; w1.x = rx[1]; w0.y = ry[0]; w1.y = ry[1];
}
DI f32x4 mfma16(bf16x8 a, bf16x8 b, f32x4 c) { return __builtin_amdgcn_mfma_f32_16x16x32_bf16(a, b, c, 0, 0, 0); }
DI bf16x8 tr_frag(LAS unsigned char* img, int pitch, int krow0, int col0, int lane) {
    const int g = lane >> 4, q = (lane & 15) >> 2, pp = lane & 3;
    LAS unsigned char* a0 = img + (krow0 + 8 * g + q) * pitch + col0 * 2 + 8 * pp;
    s16x4 lo = __builtin_amdgcn_ds_read_tr16_b64_v4i16((LAS s16x4*)a0);
    s16x4 hi = __builtin_amdgcn_ds_read_tr16_b64_v4i16((LAS s16x4*)(a0 + 4 * pitch));
    return __builtin_shufflevector(lo, hi, 0, 1, 2, 3, 4, 5, 6, 7);
}

constexpr int HTB = 128 * 64 * 2;
DI int lds_byte(int r, int c) { const int st = (r >> 4) * 2 + (c >> 5), rr = r & 15, cc = c & 31, ob = rr * 64 + cc * 2; return st * 1024 + (ob ^ (((ob >> 9) & 1) << 5)); }
DI void stage_rc(int b, int& R, int& C) { const int st = b / 1024, sb = b % 1024, swz = sb ^ (((sb >> 9) & 1) << 5); R = (st >> 1) * 16 + swz / 64; C = (st & 1) * 32 + (swz % 64) / 2; }
DI int perm32(int rho) { const int n = rho >> 4, i = rho & 15; return 8 * (i >> 2) + 4 * n + (i & 3); }

struct Unit { int pm, pn, g; };
struct GemmD { const bf16_t* A; const bf16_t* Bt; int lda, ldb; long a_gs, b_gs; int K; };
struct Sched {
    int nM, nN, nG, nM2, nN2, pm2off, G, c;
    DI bool next(int i, Unit& u) const {
        const int L = i * G + c; const int nwg = nM * nN, tot1 = nwg * nG;
        const bool first = L < tot1;
        const int L1 = first ? L : 0;
        const int g = L1 / nwg; int wgid = L1 - g * nwg;
        { const int q = nwg / 8, r = nwg % 8, xcd = wgid % 8, off = wgid / 8; wgid = (xcd < r ? xcd * (q + 1) : r * (q + 1) + (xcd - r) * q) + off; }
        const int nig = 8 * nN, gid = wgid / nig, fm = gid * 8, gsz = (nM - fm) < 8 ? (nM - fm) : 8;
        const int pm1 = fm + ((wgid % nig) % gsz), pn1 = (wgid % nig) / gsz;
        const int L2 = first ? 0 : L - tot1, d2 = nM2 > 0 ? nM2 : 1;
        const int pm2 = pm2off + L2 % d2, pn2 = L2 / d2;
        u.pm = first ? pm1 : pm2; u.pn = first ? pn1 : pn2; u.g = first ? g : 0;
        return first || (L2 < nM2 * nN2);
    }
};

template <class Epi>
DI void gemm_phase(LAS unsigned char* lds, const GemmD g, const Sched& S, const Epi& E) {
    const int tid = opaque_tid(), wid = __builtin_amdgcn_readfirstlane(tid >> 6), lane = tid & 63, wr = wid >> 2, wc = wid & 3, fr = lane & 15, fq = lane >> 4;
    const int K = g.K, nt = K / 64;
    unsigned voffA[2], voffB[2];
#pragma unroll
    for (int i = 0; i < 2; ++i) { int R, C; stage_rc(tid * 16 + i * 8192, R, C); const int Rb = Epi::PERM ? ((R & ~31) + perm32(R & 31)) : R;
        voffA[i] = (unsigned)(R * g.lda + C) * 2u; voffB[i] = (unsigned)(Rb * g.ldb + C) * 2u; }
    const size_t kstep = 128;
    const size_t hstepA = (size_t)128 * g.lda * 2, hstepB = (size_t)128 * g.ldb * 2;
    const unsigned ldsw = (unsigned)wid * 1024u;
    const int aoff = lds_byte(wr * 64 + fr, fq * 8), boff = lds_byte(wc * 32 + fr, fq * 8);
#define G_SA(b, h) (((b) * 2 + (h)) * HTB)
#define G_SB(b, h) ((4 + (b) * 2 + (h)) * HTB)
#define G_STAGE(bufoff, gbase, voff) do { _Pragma("unroll") for (int _i = 0; _i < 2; ++_i) \
        __builtin_amdgcn_global_load_lds((const unsigned*)((const char*)(gbase) + (voff)[_i]), (LAS unsigned*)(lds + (bufoff) + ldsw + _i * 8192), 16, 0, 0); } while (0)
#define G_LDA(dst, b, h) do { _Pragma("unroll") for (int m = 0; m < 4; ++m) _Pragma("unroll") for (int k = 0; k < 2; ++k) dst[m][k] = *(const LAS bf16x8*)(lds + G_SA(b, h) + aoff + m * 2048 + k * 1024); } while (0)
#define G_LDB(dst, b, h) do { _Pragma("unroll") for (int n = 0; n < 2; ++n) _Pragma("unroll") for (int k = 0; k < 2; ++k) dst[n][k] = *(const LAS bf16x8*)(lds + G_SB(b, h) + boff + n * 2048 + k * 1024); } while (0)
#define G_MMA(ai, bj, At, Bt) do { __builtin_amdgcn_s_setprio(1); _Pragma("unroll") for (int m = 0; m < 4; ++m) _Pragma("unroll") for (int n = 0; n < 2; ++n) _Pragma("unroll") for (int k = 0; k < 2; ++k) \
        acc[ai][bj][m][n] = __builtin_amdgcn_mfma_f32_16x16x32_bf16(Bt[n][k], At[m][k], acc[ai][bj][m][n], 0, 0, 0); __builtin_amdgcn_s_setprio(0); } while (0)
#define G_WAIT_V(n) asm volatile("s_waitcnt vmcnt(" #n ")" ::: "memory")
#define G_WAIT_L(n) asm volatile("s_waitcnt lgkmcnt(" #n ")" ::: "memory")
#define G_BAR __builtin_amdgcn_s_barrier()
#define G_SCHED __builtin_amdgcn_sched_barrier(0)
    Unit cur, nxt; int ui = 0;
    if (!S.next(0, cur)) return;
    f32x4 acc[2][2][4][2];
#pragma unroll
    for (int a = 0; a < 2; ++a)
#pragma unroll
        for (int b = 0; b < 2; ++b)
#pragma unroll
            for (int m = 0; m < 4; ++m)
#pragma unroll
                for (int n = 0; n < 2; ++n) acc[a][b][m][n] = (f32x4){0.f, 0.f, 0.f, 0.f};
    bf16x8 At[4][2], B0[2][2], B1[2][2];
    const char* cA = (const char*)(g.A + (long)cur.g * g.a_gs) + (size_t)cur.pm * 2 * hstepA;
    const char* cB = (const char*)(g.Bt + (long)cur.g * g.b_gs) + (size_t)cur.pn * 2 * hstepB;
    G_STAGE(G_SB(0, 0), cB, voffB); G_STAGE(G_SA(0, 0), cA, voffA); G_STAGE(G_SB(0, 1), cB + hstepB, voffB); G_STAGE(G_SA(0, 1), cA + hstepA, voffA);
    if (wr == 1) G_BAR;
    G_WAIT_V(4); G_BAR;
    G_STAGE(G_SB(1, 0), cB + kstep, voffB); G_STAGE(G_SA(1, 0), cA + kstep, voffA); G_STAGE(G_SB(1, 1), cB + hstepB + kstep, voffB);
    G_WAIT_V(6); G_BAR;
    for (;;) {
        const bool has_next = S.next(ui + 1, nxt);
        const char* nA = has_next ? (const char*)(g.A + (long)nxt.g * g.a_gs) + (size_t)nxt.pm * 2 * hstepA : cA;
        const char* nB = has_next ? (const char*)(g.Bt + (long)nxt.g * g.b_gs) + (size_t)nxt.pn * 2 * hstepB : cB;
        for (int t = 0; t < nt; t += 2) {
            const bool last = (t == nt - 2);
            const char* a1 = cA + (size_t)(t + 1) * kstep;
            const char* a2 = last ? nA : cA + (size_t)(t + 2) * kstep; const char* b2 = last ? nB : cB + (size_t)(t + 2) * kstep;
            const char* a3 = a2 + kstep; const char* b3 = b2 + kstep;
            G_LDB(B0, 0, 0); G_SCHED; G_LDA(At, 0, 0); G_STAGE(G_SA(1, 1), a1 + hstepA, voffA);
            G_WAIT_L(8); G_BAR; G_WAIT_L(0); G_MMA(0, 0, At, B0); G_BAR; G_SCHED;
            G_LDB(B1, 0, 1); G_STAGE(G_SB(0, 0), b2, voffB);
            G_BAR; G_WAIT_L(0); G_MMA(0, 1, At, B1); G_BAR;
            G_LDA(At, 0, 1); G_STAGE(G_SA(0, 0), a2, voffA);
            G_BAR; G_WAIT_L(0); G_MMA(1, 0, At, B0); G_BAR; G_SCHED;
            G_STAGE(G_SB(0, 1), b2 + hstepB, voffB);
            G_WAIT_V(6); G_BAR; G_MMA(1, 1, At, B1); G_BAR;
            G_LDB(B0, 1, 0); G_SCHED; G_LDA(At, 1, 0); G_STAGE(G_SA(0, 1), a2 + hstepA, voffA);
            G_WAIT_L(8); G_BAR; G_WAIT_L(0); G_MMA(0, 0, At, B0); G_BAR; G_SCHED;
            G_LDB(B1, 1, 1); G_STAGE(G_SB(1, 0), b3, voffB);
            G_BAR; G_WAIT_L(0); G_MMA(0, 1, At, B1); G_BAR;
            G_LDA(At, 1, 1); G_STAGE(G_SA(1, 0), a3, voffA);
            G_BAR; G_WAIT_L(0); G_MMA(1, 0, At, B0); G_BAR; G_SCHED;
            G_STAGE(G_SB(1, 1), b3 + hstepB, voffB);
            G_WAIT_V(6); G_BAR; G_MMA(1, 1, At, B1); G_BAR;
        }
        E(acc, cur, wr, wc, fr, fq);
        if (!has_next) break;
#pragma unroll
        for (int a = 0; a < 2; ++a)
#pragma unroll
            for (int b = 0; b < 2; ++b)
#pragma unroll
                for (int m = 0; m < 4; ++m)
#pragma unroll
                    for (int n = 0; n < 2; ++n) acc[a][b][m][n] = (f32x4){0.f, 0.f, 0.f, 0.f};
        cur = nxt; cA = nA; cB = nB; ++ui;
    }
    G_WAIT_V(0);
    if (wr == 0) G_BAR;
    G_BAR;
}

struct EpiPlanes {
    static constexpr bool PERM = true;
    bf16_t* xbase; bf16_t* cbase;
    DI void operator()(const f32x4 (&acc)[2][2][4][2], const Unit& u, int wr, int wc, int fr, int fq) const {
        const int plane = u.pn >> 2, colt = (u.pn & 3) * 256;
        bf16_t* base; int row0;
        if (u.pm < 128) { base = xbase + (size_t)plane * NX * 1024; row0 = u.pm * 256 + wr * 64 + fr; }
        else { base = cbase + (size_t)plane * NCX * 1024; row0 = (u.pm - 128) * 256 + wr * 64 + fr; }
        const int col0 = colt + wc * 32 + 8 * fq;
#pragma unroll
        for (int ai = 0; ai < 2; ++ai)
#pragma unroll
            for (int m = 0; m < 4; ++m) { bf16_t* rowp = base + (size_t)(row0 + ai * 128 + m * 16) * 1024 + col0;
#pragma unroll
                for (int bj = 0; bj < 2; ++bj) { const f32x4 v0 = acc[ai][bj][m][0], v1 = acc[ai][bj][m][1];
                    u32x4 w; w.x = pk2(v0[0], v0[1]); w.y = pk2(v0[2], v0[3]); w.z = pk2(v1[0], v1[1]); w.w = pk2(v1[2], v1[3]);
                    *(u32x4*)(rowp + bj * 128) = w; } }
    }
};
struct EpiBf {
    static constexpr bool PERM = true;
    bf16_t* O; bf16_t* O2; int ldc; int gcol; int mode; const float* scale; const bf16_t* zc;
    DI void operator()(const f32x4 (&acc)[2][2][4][2], const Unit& u, int wr, int wc, int fr, int fq) const {
        const int row0 = u.pm * 256 + wr * 64 + fr;
        bf16_t* base = O; int pn = u.pn; bool act = false;
        if (mode == 1 && pn >= 8) { base = O2; pn -= 8; act = true; }
        const int col0 = u.g * gcol + pn * 256 + wc * 32 + 8 * fq;
        f32x4 sc[2][2];
#pragma unroll
        for (int bj = 0; bj < 2; ++bj) { sc[bj][0] = (mode == 2) ? *(const f32x4*)(scale + col0 + bj * 128) : (f32x4){1.f, 1.f, 1.f, 1.f}; sc[bj][1] = (mode == 2) ? *(const f32x4*)(scale + col0 + bj * 128 + 4) : (f32x4){1.f, 1.f, 1.f, 1.f}; }
        u32x4 zq[2][4][2];
        if (mode == 2) {
#pragma unroll
            for (int ai = 0; ai < 2; ++ai)
#pragma unroll
                for (int m = 0; m < 4; ++m)
#pragma unroll
                    for (int bj = 0; bj < 2; ++bj) zq[ai][m][bj] = *(const volatile u32x4*)(zc + (size_t)(row0 + ai * 128 + m * 16) * ldc + col0 + bj * 128); }
#pragma unroll
        for (int ai = 0; ai < 2; ++ai) {
            u32x4 (&zz)[4][2] = zq[ai];
#pragma unroll
            for (int m = 0; m < 4; ++m) { const size_t ro = (size_t)(row0 + ai * 128 + m * 16) * ldc + col0;
#pragma unroll
                for (int bj = 0; bj < 2; ++bj) { f32x4 v0 = acc[ai][bj][m][0], v1 = acc[ai][bj][m][1];
                    if (act) {
#pragma unroll
                        for (int j = 0; j < 4; ++j) { v0[j] = silu_f(v0[j]); v1[j] = silu_f(v1[j]); } }
                    if (mode == 2) {
                        const u32x4 z = zz[m][bj]; const f32x4 s0 = sc[bj][0], s1 = sc[bj][1];
                        v0[0] *= s0[0] * lo_f(z.x); v0[1] *= s0[1] * hi_f(z.x); v0[2] *= s0[2] * lo_f(z.y); v0[3] *= s0[3] * hi_f(z.y);
                        v1[0] *= s1[0] * lo_f(z.z); v1[1] *= s1[1] * hi_f(z.z); v1[2] *= s1[2] * lo_f(z.w); v1[3] *= s1[3] * hi_f(z.w);
                    }
                    u32x4 w; w.x = pk2(v0[0], v0[1]); w.y = pk2(v0[2], v0[3]); w.z = pk2(v1[0], v1[1]); w.w = pk2(v1[2], v1[3]);
                    *(u32x4*)(base + ro + bj * 128) = w; } } }
    }
};
struct EpiGate {
    static constexpr bool PERM = true;
    bf16_t* O; const float* gate;
    DI void operator()(const f32x4 (&acc)[2][2][4][2], const Unit& u, int wr, int wc, int fr, int fq) const {
        const int row0 = u.pm * 256 + wr * 64 + fr, col0 = u.pn * 256 + wc * 32 + 8 * fq;
        const float* gp = gate + (size_t)(u.pm >> 4) * 3072 + col0;
        f32x4 gv[2][2];
#pragma unroll
        for (int bj = 0; bj < 2; ++bj) { gv[bj][0] = *(const f32x4*)(gp + bj * 128); gv[bj][1] = *(const f32x4*)(gp + bj * 128 + 4); }
#pragma unroll
        for (int ai = 0; ai < 2; ++ai)
#pragma unroll
            for (int m = 0; m < 4; ++m) { bf16_t* rowp = O + (size_t)(row0 + ai * 128 + m * 16) * 1024 + col0;
#pragma unroll
                for (int bj = 0; bj < 2; ++bj) { const f32x4 v0 = acc[ai][bj][m][0] * gv[bj][0], v1 = acc[ai][bj][m][1] * gv[bj][1];
                    u32x4 w; w.x = pk2(v0[0], v0[1]); w.y = pk2(v0[2], v0[3]); w.z = pk2(v1[0], v1[1]); w.w = pk2(v1[2], v1[3]);
                    *(u32x4*)(rowp + bj * 128) = w; } }
    }
};
struct EpiRes {
    static constexpr bool PERM = false;
    float* O; const float* res; const float* gate;
    DI void operator()(const f32x4 (&acc)[2][2][4][2], const Unit& u, int wr, int wc, int fr, int fq) const {
        const int row0 = u.pm * 256 + wr * 64 + fr, col0 = u.pn * 256 + wc * 32 + 4 * fq;
        const float* gp = gate + (size_t)(u.pm >> 4) * 3072 + col0;
        f32x4 gv[2][2];
#pragma unroll
        for (int bj = 0; bj < 2; ++bj)
#pragma unroll
            for (int n = 0; n < 2; ++n) gv[bj][n] = *(const f32x4*)(gp + bj * 128 + n * 16);
#pragma unroll
        for (int ai = 0; ai < 2; ++ai)
#pragma unroll
            for (int mp = 0; mp < 2; ++mp) {
                f32x4 r[2][2][2];
#pragma unroll
                for (int mm = 0; mm < 2; ++mm) { const size_t ro = (size_t)(row0 + ai * 128 + (2 * mp + mm) * 16) * 1024 + col0;
#pragma unroll
                    for (int bj = 0; bj < 2; ++bj)
#pragma unroll
                        for (int n = 0; n < 2; ++n) r[mm][bj][n] = *(const volatile f32x4*)(res + ro + bj * 128 + n * 16); }
#pragma unroll
                for (int mm = 0; mm < 2; ++mm) { const size_t ro = (size_t)(row0 + ai * 128 + (2 * mp + mm) * 16) * 1024 + col0;
#pragma unroll
                    for (int bj = 0; bj < 2; ++bj)
#pragma unroll
                        for (int n = 0; n < 2; ++n) *(f32x4*)(O + ro + bj * 128 + n * 16) = r[mm][bj][n] + gv[bj][n] * acc[ai][bj][2 * mp + mm][n]; }
            }
    }
};

DI void transpose_jobs(const Params& p, LAS unsigned char* lds, int tid, int j_lo, int j_hi, int w, int nw) {
    LAS float* tile = (LAS float*)lds;
    {
        auto job_desc = [&](int job, const float*& src, bf16_t*& dst, int& K, int& Nt, int& k0, int& n0) {
            int j = job, tk, tn;
            if (j < 1792) { src = p.win_even; dst = (bf16_t*)(p.ws + WS_WINE); K = 1024; Nt = 7184; tk = j & 15; tn = j >> 4; }
            else if ((j -= 1792) < 512) { src = p.wout_even; dst = (bf16_t*)(p.ws + WS_WOUTE); K = 2048; Nt = 1024; tk = j & 31; tn = j >> 5; }
            else if ((j -= 512) < 1024) { src = p.win_odd; dst = (bf16_t*)(p.ws + WS_WINO); K = 1024; Nt = 4096; tk = j & 15; tn = j >> 4; }
            else if ((j -= 1024) < 256) { const int g = j >> 6, jj = j & 63; src = p.pool_w + (size_t)g * 512 * 512; dst = (bf16_t*)(p.ws + WS_WPOOL) + (size_t)g * 512 * 512; K = 512; Nt = 512; tk = jj & 7; tn = jj >> 3; }
            else { j -= 256; src = p.wout_odd; dst = (bf16_t*)(p.ws + WS_WOUTO); K = 2048; Nt = 1024; tk = j & 31; tn = j >> 5; }
            k0 = tk * 64; n0 = tn * 64; };
        float rg[8];
        int job = j_lo + w;
        if (job < j_hi) { const float* src; bf16_t* dst; int K, Nt, k0, n0; job_desc(job, src, dst, K, Nt, k0, n0);
#pragma unroll
            for (int i = 0; i < 8; ++i) { const int idx = tid + 512 * i, k = idx >> 6, n = idx & 63; rg[i] = src[(size_t)(k0 + k) * Nt + n0 + n]; } }
        for (; job < j_hi; job += nw) {
            const float* src; bf16_t* dst; int K, Nt, k0, n0; job_desc(job, src, dst, K, Nt, k0, n0);
            __syncthreads();
#pragma unroll
            for (int i = 0; i < 8; ++i) { const int idx = tid + 512 * i, k = idx >> 6, n = idx & 63; tile[k * 65 + n] = rg[i]; }
            __syncthreads();
            const int nj = job + nw;
            if (nj < j_hi) { const float* s2; bf16_t* d2; int K2, Nt2, k2, n2; job_desc(nj, s2, d2, K2, Nt2, k2, n2);
#pragma unroll
                for (int i = 0; i < 8; ++i) { const int idx = tid + 512 * i, k = idx >> 6, n = idx & 63; rg[i] = s2[(size_t)(k2 + k) * Nt2 + n2 + n]; } }
#pragma unroll
            for (int i = 0; i < 4; ++i) { const int idx = tid + 512 * i, n = idx >> 5, k = (idx & 31) * 2;
                *(unsigned*)(dst + (size_t)(n0 + n) * K + k0 + k) = pk2(tile[k * 65 + n], tile[(k + 1) * 65 + n]); }
        }
        __syncthreads();
    }
}
DI void ph_prep(const Params& p, LAS unsigned char* lds) {
    const int tid = opaque_tid();
    transpose_jobs(p, lds, tid, 0, 2304, blockIdx.x, gridDim.x);
    LAS float* sv = (LAS float*)(lds + 32768);
    LAS float* red = (LAS float*)(lds + 32768 + 36864);
    LAS float* ct = (LAS float*)(lds + 90112); LAS float* st = ct + 256;
    for (int idx = tid; idx < 9216; idx += 512) { const int v = idx >> 10, k = idx & 1023; const float cv = (v < 8) ? p.c[v * 1024 + k] : p.c_ctx[k]; sv[idx] = silu_f(cv); }
    if (tid < 256) { float s, c; sincospif((float)tid / 128.0f, &s, &c); ct[tid] = c; st[tid] = s; }
    __syncthreads();
    float* MOD = (float*)(p.ws + WS_MOD);
    for (int item = blockIdx.x; item < 192; item += gridDim.x) {
        const int l = item / 96, c0 = (item % 96) * 32, kg = tid >> 5, col = tid & 31;
        float a[9];
#pragma unroll
        for (int v = 0; v < 9; ++v) a[v] = 0.f;
        const float* w = p.ada_w + (size_t)l * 1024 * 3072 + c0 + col;
#pragma unroll 16
        for (int k = kg; k < 1024; k += 16) { const float wv = w[(size_t)k * 3072];
#pragma unroll
            for (int v = 0; v < 9; ++v) a[v] += sv[v * 1024 + k] * wv; }
#pragma unroll
        for (int v = 0; v < 9; ++v) red[(kg * 32 + col) * 9 + v] = a[v];
        __syncthreads();
        if (tid < 288) { const int v = tid >> 5, cc = tid & 31; float s = 0.f; for (int q = 0; q < 16; ++q) s += red[(q * 32 + cc) * 9 + v];
            MOD[(size_t)(l * 9 + v) * 3072 + c0 + cc] = s + p.ada_b[l * 3072 + c0 + cc]; }
        __syncthreads();
    }
    bf16_t* WF = (bf16_t*)(p.ws + WS_WF);
    for (int it = blockIdx.x; it < 512; it += gridDim.x) {
        const int idx = it * 512 + tid, d = idx & 255, c = (idx >> 8) & 255, g = idx >> 16;
        const float* f = p.fourier_w + (size_t)g * 65536 + d;
        float aP = 0.f, aQ = 0.f;
#pragma unroll 16
        for (int cp = 0; cp < 256; ++cp) { const float fv = f[cp * 256]; const int a = (c * cp) & 255; aP += ct[a] * fv; aQ += st[a] * fv; }
        WF[(size_t)(g * 512 + d) * 256 + c] = (bf16_t)(pk2(aP * 0.0625f, 0.f) & 0xffffu);
        WF[(size_t)(g * 512 + 256 + d) * 256 + c] = (bf16_t)(pk2(-aQ * 0.0625f, 0.f) & 0xffffu);
    }
}

DI void ph_norm0(const Params& p, LAS unsigned char* lds) {
    const int tid = opaque_tid(), wid = tid >> 6, lane = tid & 63;
    LAS float* wg = (LAS float*)lds;
#pragma unroll 4
    for (int i = 0; i < 32; ++i) { const int idx = tid + 512 * i, k = idx >> 4, j = idx & 15; wg[j * 1024 + k] = p.win_even[(size_t)k * 7184 + 7168 + j]; }
    __syncthreads();
    f32x4 g[4];
#pragma unroll
    for (int i = 0; i < 4; ++i) g[i] = *(const f32x4*)(p.norm_g + lane * 4 + 256 * i);
    const float* MOD = (const float*)(p.ws + WS_MOD);
    bf16_t* HX = (bf16_t*)p.out;
    float* GATES = (float*)(p.ws + WS_GATES);
    f32x4 vn[4];
    { const int r = blockIdx.x * 8 + wid; if (r < NR) { const float* src = (r < NX) ? p.x + (size_t)r * 1024 : p.ctx + (size_t)(r - NX) * 1024;
#pragma unroll
        for (int i = 0; i < 4; ++i) vn[i] = *(const f32x4*)(src + lane * 4 + 256 * i); } }
    for (int r = blockIdx.x * 8 + wid; r < NR; r += gridDim.x * 8) {
        const float* md;
        if (r < NX) { md = MOD + (size_t)(r >> 12) * 3072; } else { md = MOD + (size_t)8 * 3072; }
        f32x4 v[4]; float ss = 0.f;
#pragma unroll
        for (int i = 0; i < 4; ++i) { v[i] = vn[i]; ss += v[i][0] * v[i][0] + v[i][1] * v[i][1] + v[i][2] * v[i][2] + v[i][3] * v[i][3]; }
        { const int r2 = r + gridDim.x * 8; if (r2 < NR) { const float* s2 = (r2 < NX) ? p.x + (size_t)r2 * 1024 : p.ctx + (size_t)(r2 - NX) * 1024;
#pragma unroll
            for (int i = 0; i < 4; ++i) vn[i] = *(const f32x4*)(s2 + lane * 4 + 256 * i); } }
        ss = wave_sum(ss);
        const float rstd = rsqrtf(ss * (1.0f / 1024.0f) + 1e-6f);
#pragma unroll
        for (int i = 0; i < 4; ++i) { const f32x4 sh = *(const f32x4*)(md + lane * 4 + 256 * i), sc = *(const f32x4*)(md + 1024 + lane * 4 + 256 * i);
            v[i] = v[i] * rstd * g[i] * (sc + 1.0f) + sh;
            u32x2 w; w.x = pk2(v[i][0], v[i][1]); w.y = pk2(v[i][2], v[i][3]);
            *(u32x2*)(HX + (size_t)r * 1024 + lane * 4 + 256 * i) = w; }
        float pt[16];
#pragma unroll
        for (int j = 0; j < 16; ++j) { float a = 0.f;
#pragma unroll
            for (int i = 0; i < 4; ++i) { const f32x4 w4 = *(const LAS f32x4*)(wg + j * 1024 + lane * 4 + 256 * i); a += v[i][0] * w4[0] + v[i][1] * w4[1] + v[i][2] * w4[2] + v[i][3] * w4[3]; }
            pt[j] = a; if ((j & 3) == 3) __builtin_amdgcn_sched_barrier(0); }
        { const bool b5 = lane & 32;
#pragma unroll
          for (int j = 0; j < 8; ++j) { const float snd = b5 ? pt[j] : pt[j + 8], kp = b5 ? pt[j + 8] : pt[j]; pt[j] = kp + __shfl_xor(snd, 32); } }
        { const bool b4 = lane & 16;
#pragma unroll
          for (int j = 0; j < 4; ++j) { const float snd = b4 ? pt[j] : pt[j + 4], kp = b4 ? pt[j + 4] : pt[j]; pt[j] = kp + __shfl_xor(snd, 16); } }
        { const bool b3 = lane & 8;
#pragma unroll
          for (int j = 0; j < 2; ++j) { const float snd = b3 ? pt[j] : pt[j + 2], kp = b3 ? pt[j + 2] : pt[j]; pt[j] = kp + __shfl_xor(snd, 8); } }
        { const bool b2 = lane & 4; const float snd = b2 ? pt[0] : pt[1], kp = b2 ? pt[1] : pt[0]; pt[0] = kp + __shfl_xor(snd, 4); }
        pt[0] += __shfl_xor(pt[0], 2); pt[0] += __shfl_xor(pt[0], 1);
        if ((lane & 3) == 0) { const int j = ((lane >> 5) & 1) * 8 + ((lane >> 4) & 1) * 4 + ((lane >> 3) & 1) * 2 + ((lane >> 2) & 1);
            float val = pt[0] + p.gate_b[j];
            if ((j >> 2) & 1) val = fminf(val, 0.f) - log1pf(__expf(-fabsf(val)));
            GATES[(size_t)r * 16 + j] = val; }
    }
}
DI void ph_norm1(const Params& p, int mode) {
    const int tid = opaque_tid(), wid = tid >> 6, lane = tid & 63;
    const float* gsrc = mode ? p.final_g : p.norm_g + 1024;
    f32x4 g[4];
#pragma unroll
    for (int i = 0; i < 4; ++i) g[i] = *(const f32x4*)(gsrc + lane * 4 + 256 * i);
    const float* MOD = (const float*)(p.ws + WS_MOD) + (size_t)9 * 3072;
    const bf16_t* D0 = (const bf16_t*)p.ws; const bf16_t* D1 = (const bf16_t*)(p.ws + PLANE);
    bf16_t* HX1 = (bf16_t*)(p.ws + 2 * PLANE);
    f32x4 vn[4];
#define N1_LOAD(RR) do { _Pragma("unroll") for (int i = 0; i < 4; ++i) { const size_t o = (size_t)(RR) * 1024 + lane * 4 + 256 * i; \
        f32x4 xv = *(const f32x4*)(p.x + o); const u32x2 q = *(const u32x2*)(D0 + o); xv += (f32x4){lo_f(q.x), hi_f(q.x), lo_f(q.y), hi_f(q.y)}; \
        if (mode) { const u32x2 q1 = *(const u32x2*)(D1 + o); xv += (f32x4){lo_f(q1.x), hi_f(q1.x), lo_f(q1.y), hi_f(q1.y)}; } \
        vn[i] = xv; } } while (0)
    { const int r = blockIdx.x * 8 + wid; if (r < NX) N1_LOAD(r); }
    for (int r = blockIdx.x * 8 + wid; r < NX; r += gridDim.x * 8) {
        const float* md = MOD + (size_t)(r >> 12) * 3072;
        f32x4 v[4]; float ss = 0.f;
#pragma unroll
        for (int i = 0; i < 4; ++i) { v[i] = vn[i]; ss += v[i][0] * v[i][0] + v[i][1] * v[i][1] + v[i][2] * v[i][2] + v[i][3] * v[i][3]; }
        { const int r2 = r + gridDim.x * 8; if (r2 < NX) N1_LOAD(r2); }
        ss = wave_sum(ss);
        const float rstd = rsqrtf(ss * (1.0f / 1024.0f) + 1e-6f);
#pragma unroll
        for (int i = 0; i < 4; ++i) {
            if (mode) { *(f32x4*)(p.out + (size_t)r * 1024 + lane * 4 + 256 * i) = v[i] * rstd * g[i]; }
            else { const f32x4 sh = *(const f32x4*)(md + lane * 4 + 256 * i), sc = *(const f32x4*)(md + 1024 + lane * 4 + 256 * i);
                const f32x4 h = v[i] * rstd * g[i] * (sc + 1.0f) + sh;
                u32x2 w; w.x = pk2(h[0], h[1]); w.y = pk2(h[2], h[3]);
                *(u32x2*)(HX1 + (size_t)r * 1024 + lane * 4 + 256 * i) = w; } }
    }
#undef N1_LOAD
}

DI void ph_conv(const Params& p) {
    const bf16_t* QRAW = (const bf16_t*)p.ws; const bf16_t* KRAW = (const bf16_t*)(p.ws + PLANE);
    const bf16_t* CQ = (const bf16_t*)(p.ws + WS_CRAW); const bf16_t* CK = CQ + (size_t)NCX * 1024;
    bf16_t* QC = (bf16_t*)p.out; bf16_t* KC = QC + (size_t)NX * 1024;
    bf16_t* CQC = (bf16_t*)(p.ws + WS_CQC); bf16_t* CKC = (bf16_t*)(p.ws + WS_CKC);
    const int tid = opaque_tid();
    const bool scanner = (blockIdx.x < 64) && (tid < 64) && (gridDim.x >= 64);
    const int nscan = gridDim.x >= 64 ? 64 : 0;
    const int active_id = (int)blockIdx.x < nscan ? (int)blockIdx.x * 448 + (tid - 64) : nscan * 448 + ((int)blockIdx.x - nscan) * 512 + tid;
    const int active_n = nscan * 448 + ((int)gridDim.x - nscan) * 512;
    if (!scanner)
    for (int idx = active_id; idx < (NR / 8) * 256; idx += active_n) {
        const int oct = idx & 127, which = (idx >> 7) & 1, r0 = (idx >> 8) * 8, ch = oct * 8;
        const bf16_t* src; bf16_t* dst; int t0, T;
        if (r0 < NX) { src = (which ? KRAW : QRAW) + (size_t)r0 * 1024 + ch; dst = (which ? KC : QC) + (size_t)r0 * 1024 + ch; t0 = r0 & 4095; T = 4096; }
        else { const int rr = r0 - NX; src = (which ? CK : CQ) + (size_t)rr * 1024 + ch; dst = (which ? CKC : CQC) + (size_t)rr * 1024 + ch; t0 = rr & 255; T = 256; }
        const u32x4 z = {0u, 0u, 0u, 0u};
        u32x4 v[10];
        v[0] = (t0 > 0) ? *(const u32x4*)(src - 1024) : z;
#pragma unroll
        for (int i = 0; i < 8; ++i) v[i + 1] = *(const u32x4*)(src + (size_t)i * 1024);
        v[9] = (t0 + 8 < T) ? *(const u32x4*)(src + (size_t)8 * 1024) : z;
        const float* w = p.conv_qk + which * 1024 + ch;
        float wt[3][8];
#pragma unroll
        for (int j = 0; j < 3; ++j) { const f32x4 wa = *(const f32x4*)(w + j * 2048), wb = *(const f32x4*)(w + j * 2048 + 4);
#pragma unroll
            for (int e = 0; e < 4; ++e) { wt[j][e] = wa[e]; wt[j][4 + e] = wb[e]; } }
        const float qs = which ? 1.0f : 0.0625f;
#pragma unroll
        for (int i = 0; i < 8; ++i) {
            float o[8];
#pragma unroll
            for (int e = 0; e < 4; ++e) {
                float lo = wt[0][2 * e] * lo_f(v[i][e]) + wt[1][2 * e] * lo_f(v[i + 1][e]) + wt[2][2 * e] * lo_f(v[i + 2][e]);
                float hi = wt[0][2 * e + 1] * hi_f(v[i][e]) + wt[1][2 * e + 1] * hi_f(v[i + 1][e]) + wt[2][2 * e + 1] * hi_f(v[i + 2][e]);
                o[2 * e] = silu_f(lo) * qs; o[2 * e + 1] = silu_f(hi) * qs;
            }
            u32x4 wv; wv.x = pk2(o[0], o[1]); wv.y = pk2(o[2], o[3]); wv.z = pk2(o[4], o[5]); wv.w = pk2(o[6], o[7]);
            *(u32x4*)(dst + (size_t)i * 1024) = wv;
        }
    }
    const int lane = tid & 63;
    const int n_sc = nscan ? 1 : 64;
    if (scanner || (nscan == 0 && blockIdx.x == 0 && tid < 64))
    for (int sc = 0; sc < n_sc; ++sc) {
        const int gw = nscan ? (int)blockIdx.x : sc;
        const int b = gw >> 3, h = (gw >> 1) & 3, dir = gw & 1;
        const float* GATES = (const float*)(p.ws + WS_GATES);
        float* GP = (float*)(p.ws + WS_GPRE) + (size_t)gw * 68 * 384;
        float m_prev = 0.f;
        auto grow_of = [&](int st) -> size_t { if (st < 4) { const int cc = dir ? 3 - st : st; return (size_t)NX + (size_t)b * 256 + cc * 64; } const int xc = st - 4, cc = dir ? 63 - xc : xc; return (size_t)b * 4096 + cc * 64; };
        const int oi = (dir ? 8 : 0) + h, of = (dir ? 12 : 4) + h;
        float nig = GATES[(grow_of(0) + lane) * 16 + oi], nlf = GATES[(grow_of(0) + lane) * 16 + of];
        for (int st = 0; st < 68; ++st) {
            const float ig = nig, lf = nlf;
            if (st + 1 < 68) { const size_t g2 = grow_of(st + 1); nig = GATES[(g2 + lane) * 16 + oi]; nlf = GATES[(g2 + lane) * 16 + of]; }
            float bs = lf;
#pragma unroll
            for (int o = 1; o < 64; o <<= 1) { const float ov = dir ? __shfl_down(bs, o) : __shfl_up(bs, o); const bool ok = dir ? (lane + o < 64) : (lane >= o); if (ok) bs += ov; }
            const float a = ig - bs;
            float mx = a;
#pragma unroll
            for (int o = 1; o < 64; o <<= 1) { const float ov = dir ? __shfl_down(mx, o) : __shfl_up(mx, o); const bool ok = dir ? (lane + o < 64) : (lane >= o); if (ok) mx = fmaxf(mx, ov); }
            const float total = __shfl(bs, dir ? 0 : 63);
            const float m_inter = bs + m_prev, m_t = fmaxf(bs + mx, m_inter);
            const float wsl = total - bs + ig;
            const float m_new = fmaxf(total + m_prev, wave_max(wsl));
            float* o = GP + (size_t)st * 384;
            o[lane] = bs - m_t; o[64 + lane] = a; o[128 + lane] = __expf(m_inter - m_t); o[192 + lane] = __expf(wsl - m_new); o[256 + lane] = __expf(-m_t);
            if (lane == 0) o[320] = __expf(total + m_prev - m_new);
            m_prev = m_new;
        }
    }
}

DI void ph_mlstm(const Params& p, LAS unsigned char* lds) {
    constexpr int QP = 528, VP = 176, SP = 144;
    LAS unsigned char* Qi = lds; LAS unsigned char* Ki = lds + 33792; LAS unsigned char* Vi0 = lds + 67584; LAS unsigned char* Vwi = Vi0 + 2 * 11264;
    LAS unsigned char* Sgi = Vwi + 11264; LAS unsigned char* Ci = Sgi + 9216; LAS float* fl0 = (LAS float*)(Ci + 42240);
    const int tid = opaque_tid(), wid = tid >> 6, lane = tid & 63, fr = lane & 15, fq = lane >> 4;
    const bf16_t* QC = (const bf16_t*)p.out; const bf16_t* KC = QC + (size_t)NX * 1024; const bf16_t* VPL = (const bf16_t*)(p.ws + 2 * PLANE);
    const bf16_t* CQC = (const bf16_t*)(p.ws + WS_CQC); const bf16_t* CKC = (const bf16_t*)(p.ws + WS_CKC); const bf16_t* CV = (const bf16_t*)(p.ws + WS_CRAW) + (size_t)2 * NCX * 1024;
    for (int wi = blockIdx.x; wi < 256; wi += gridDim.x) {
        const int b = wi >> 5, h = (wi >> 3) & 3, dir = (wi >> 2) & 1, es = wi & 3;
        bf16_t* Hout = (bf16_t*)(p.ws + (dir ? PLANE : 0));
        const float* GP = (const float*)(p.ws + WS_GPRE) + (size_t)((b * 4 + h) * 2 + dir) * 68 * 384;
        f32x4 Cst[2][5];
#pragma unroll
        for (int i = 0; i < 2; ++i)
#pragma unroll
            for (int n = 0; n < 5; ++n) Cst[i][n] = (f32x4){0.f, 0.f, 0.f, 0.f};
        __syncthreads();
        for (int i = tid; i < 64 * 8; i += 512) { const int row = i >> 3, c = i & 7;
            *(LAS unsigned*)(Vi0 + row * VP + 128 + c * 4) = 0x3F803F80u; *(LAS unsigned*)(Vi0 + 11264 + row * VP + 128 + c * 4) = 0x3F803F80u; *(LAS unsigned*)(Vwi + row * VP + 128 + c * 4) = 0u; }
        u32x4 rq[4], rk[4], rv; float pg = 0.f, pws = 0.f, pdecay = 0.f, decay = 0.f;
        const int mt = wid >> 1, nt0 = 2 * (wid & 1);
#define ML_LOAD(ST) do { const int _st = (ST); const bf16_t *_q, *_k, *_v; \
            if (_st < 4) { const int cc = dir ? 3 - _st : _st; const size_t row0 = (size_t)b * 256 + cc * 64; _q = CQC + row0 * 1024 + h * 256; _k = CKC + row0 * 1024 + h * 256; _v = CV + row0 * 1024 + h * 256 + es * 64; } \
            else { const int xc = _st - 4, cc = dir ? 63 - xc : xc; const size_t row0 = (size_t)b * 4096 + cc * 64; _q = QC + row0 * 1024 + h * 256; _k = KC + row0 * 1024 + h * 256; _v = VPL + row0 * 1024 + h * 256 + es * 64; } \
            _Pragma("unroll") for (int i = 0; i < 4; ++i) { const int id = tid + 512 * i, row = id >> 5, chk = id & 31; rq[i] = *(const u32x4*)(_q + (size_t)row * 1024 + chk * 8); rk[i] = *(const u32x4*)(_k + (size_t)row * 1024 + chk * 8); } \
            rv = *(const u32x4*)(_v + (size_t)(tid >> 3) * 1024 + (tid & 7) * 8); \
            const float* _g = GP + (size_t)_st * 384; pg = _g[tid < 320 ? tid : 0]; pws = _g[192 + (tid >> 3)]; pdecay = _g[320]; } while (0)
#define ML_WRITE(ST) do { LAS unsigned char* _Vi = Vi0 + ((ST) & 1) * 11264; LAS float* _fl = fl0 + ((ST) & 1) * 320; \
            _Pragma("unroll") for (int i = 0; i < 4; ++i) { const int id = tid + 512 * i, row = id >> 5, chk = id & 31; \
                *(LAS u32x4*)(Qi + row * QP + chk * 16) = rq[i]; *(LAS u32x4*)(Ki + row * QP + chk * 16) = rk[i]; } \
            *(LAS u32x4*)(_Vi + (tid >> 3) * VP + (tid & 7) * 16) = rv; \
            { const float w = pws; u32x4 o; \
              o.x = pk2(w * lo_f(rv.x), w * hi_f(rv.x)); o.y = pk2(w * lo_f(rv.y), w * hi_f(rv.y)); o.z = pk2(w * lo_f(rv.z), w * hi_f(rv.z)); o.w = pk2(w * lo_f(rv.w), w * hi_f(rv.w)); \
              *(LAS u32x4*)(Vwi + (tid >> 3) * VP + (tid & 7) * 16) = o; \
              if ((tid & 7) == 0) *(LAS unsigned*)(Vwi + (tid >> 3) * VP + 128) = pk2(w, 0.f); } \
            if (tid < 320) _fl[tid] = pg; \
            _Pragma("unroll") for (int i = 0; i < 2; ++i) _Pragma("unroll") for (int n = 0; n < 5; ++n) { u32x2 w; w.x = pk2(Cst[i][n][0], Cst[i][n][1]); w.y = pk2(Cst[i][n][2], Cst[i][n][3]); \
                *(LAS u32x2*)(Ci + (16 * n + fr) * QP + (16 * (2 * wid + i) + 4 * fq) * 2) = w; } \
            decay = pdecay; } while (0)
        ML_LOAD(0);
        __syncthreads();
        ML_WRITE(0);
        ML_LOAD(1);
        for (int st = 0; st < 68; ++st) {
            const bool isx = st >= 4;
            LAS unsigned char* Vi = Vi0 + (st & 1) * 11264; LAS float* fl = fl0 + (st & 1) * 320;
            LAS float* f_bt = fl; LAS float* f_aa = fl + 64; LAS float* f_inter = fl + 128; LAS float* f_enm = fl + 256;
            __syncthreads();
            const float dcy = decay;
            const int t = 16 * mt + fr;
            f32x4 accC[3];
#pragma unroll
            for (int n = 0; n < 3; ++n) accC[n] = (f32x4){0.f, 0.f, 0.f, 0.f};
            if (isx) {
                f32x4 sacc[2] = {(f32x4){0.f, 0.f, 0.f, 0.f}, (f32x4){0.f, 0.f, 0.f, 0.f}};
#pragma unroll
                for (int ks = 0; ks < 8; ++ks) { const bf16x8 qf = *(const LAS bf16x8*)(Qi + t * QP + (32 * ks + 8 * fq) * 2);
#pragma unroll
                    for (int n = 0; n < 2; ++n) { const bf16x8 kf = *(const LAS bf16x8*)(Ki + (16 * (nt0 + n) + fr) * QP + (32 * ks + 8 * fq) * 2); sacc[n] = mfma16(kf, qf, sacc[n]); }
#pragma unroll
                    for (int n = 0; n < 3; ++n) { const int et = (n < 2) ? nt0 + n : 4; const bf16x8 cf = *(const LAS bf16x8*)(Ci + (16 * et + fr) * QP + (32 * ks + 8 * fq) * 2); accC[n] = mfma16(cf, qf, accC[n]); } }
                const float btm = f_bt[t];
#pragma unroll
                for (int n = 0; n < 2; ++n) { const int s0 = 16 * (nt0 + n) + 4 * fq; const f32x4 a4 = *(const LAS f32x4*)(f_aa + s0); float vv[4];
#pragma unroll
                    for (int j = 0; j < 4; ++j) { const int s = s0 + j; const bool ok = dir ? (s >= t) : (s <= t); const float e = __expf(btm + a4[j]); vv[j] = ok ? sacc[n][j] * e : 0.f; }
                    u32x2 w; w.x = pk2(vv[0], vv[1]); w.y = pk2(vv[2], vv[3]); *(LAS u32x2*)(Sgi + t * SP + s0 * 2) = w; }
            }
#pragma unroll
            for (int i = 0; i < 2; ++i)
#pragma unroll
                for (int n = 0; n < 5; ++n) Cst[i][n] = Cst[i][n] * dcy;
#pragma unroll
            for (int ks = 0; ks < 2; ++ks) { bf16x8 kf[2];
#pragma unroll
                for (int i = 0; i < 2; ++i) kf[i] = tr_frag(Ki, QP, 32 * ks, 16 * (2 * wid + i), lane);
#pragma unroll
                for (int n = 0; n < 5; ++n) { const bf16x8 vw = tr_frag(Vwi, VP, 32 * ks, 16 * n, lane);
#pragma unroll
                    for (int i = 0; i < 2; ++i) Cst[i][n] = mfma16(kf[i], vw, Cst[i][n]); } }
            __syncthreads();
            if (isx) {
                f32x4 accD[3];
#pragma unroll
                for (int n = 0; n < 3; ++n) accD[n] = (f32x4){0.f, 0.f, 0.f, 0.f};
#pragma unroll
                for (int ks = 0; ks < 2; ++ks) { const bf16x8 sgf = *(const LAS bf16x8*)(Sgi + t * SP + (32 * ks + 8 * fq) * 2);
#pragma unroll
                    for (int n = 0; n < 3; ++n) { const int et = (n < 2) ? nt0 + n : 4; const bf16x8 vf = tr_frag(Vi, VP, 32 * ks, 16 * et, lane); accD[n] = mfma16(vf, sgf, accD[n]); } }
                const float inter_t = f_inter[t];
                const float den0 = accD[2][0] + inter_t * accC[2][0];
                const float den = __shfl(den0, fr);
                const float rden = 1.0f / fmaxf(fabsf(den), f_enm[t]);
                const int xc = st - 4, cc = dir ? 63 - xc : xc;
                bf16_t* hp = Hout + ((size_t)b * 4096 + cc * 64 + t) * 1024 + h * 256 + es * 64 + 4 * fq;
                u32x2 hw[2];
#pragma unroll
                for (int n = 0; n < 2; ++n) { const f32x4 hv = (accD[n] + accC[n] * inter_t) * rden; hw[n].x = pk2(hv[0], hv[1]); hw[n].y = pk2(hv[2], hv[3]); }
                st_pair16(hp + 16 * nt0, hw[0], hw[1], fq);
            }
            if (st + 1 < 68) { ML_WRITE(st + 1); if (st + 2 < 68) ML_LOAD(st + 2); }
        }
#undef ML_LOAD
#undef ML_WRITE
    }
}

template <int KK, int NN, class Cfg>
DI void axis_mix(const Cfg& cfg, LAS unsigned char* lds, int n_items) {
    constexpr int TP = 528, BP = KK * 2 + 16, NCH = KK / 16;
    LAS unsigned char* Ti = lds; LAS unsigned char* Bi = lds + 128 * TP;
    const int tid = opaque_tid(), wid = tid >> 6, lane = tid & 63, fr = lane & 15, fq = lane >> 4;
    __syncthreads();
    cfg.fill_tables(Bi, tid);
    u32x4 ra[NCH], rb[NCH];
    const int G = gridDim.x;
#define AX_LOAD(R, IT) do { if ((IT) < n_items) { _Pragma("unroll") for (int i = 0; i < NCH; ++i) { const int id = tid + 512 * i; R[i] = *(const u32x4*)(cfg.row_ptr((IT), id >> 5) + (id & 31) * 8); } } } while (0)
#define AX_BODY(R, IT, PRE) do { \
        __syncthreads(); \
        _Pragma("unroll") for (int i = 0; i < NCH; ++i) { const int id = tid + 512 * i; *(LAS u32x4*)(Ti + (id >> 5) * TP + (id & 31) * 16) = R[i]; } \
        __syncthreads(); \
        AX_LOAD(R, PRE); \
        f32x4 acc[2][NN / 16]; \
        _Pragma("unroll") for (int i = 0; i < 2; ++i) _Pragma("unroll") for (int n = 0; n < NN / 16; ++n) acc[i][n] = (f32x4){0.f, 0.f, 0.f, 0.f}; \
        LAS unsigned char* tb = Bi + cfg.table_off(IT); \
        _Pragma("unroll") for (int ks = 0; ks < KK / 32; ++ks) { bf16x8 af[2]; \
            _Pragma("unroll") for (int i = 0; i < 2; ++i) af[i] = tr_frag(Ti, TP, 32 * ks, 32 * wid + 16 * i, lane); \
            _Pragma("unroll") for (int n = 0; n < NN / 16; ++n) { const bf16x8 bfr = *(const LAS bf16x8*)(tb + (16 * n + fr) * BP + (32 * ks + 8 * fq) * 2); \
                _Pragma("unroll") for (int i = 0; i < 2; ++i) acc[i][n] = mfma16(af[i], bfr, acc[i][n]); } } \
        cfg.epilogue(acc, (IT), wid, fr, fq, Bi); } while (0)
    int item = blockIdx.x;
    AX_LOAD(ra, item); AX_LOAD(rb, item + G);
    for (; item < n_items; item += 2 * G) {
        AX_BODY(ra, item, item + 2 * G);
        if (item + G < n_items) AX_BODY(rb, item + G, item + 3 * G);
    }
#undef AX_LOAD
#undef AX_BODY
}
DI void fill_dft_table(LAS unsigned char* Bi, int tid, int nrows) {
    for (int idx = tid; idx < nrows * 128; idx += 512) { const int n = idx >> 7, k = idx & 127, ap = n & 63, kk = k & 63; float s, c; sincospif((float)((kk * ap) & 63) / 32.0f, &s, &c);
        float v; if (n < 64) v = (k < 64) ? c : s; else v = (k < 64) ? -s : c;
        *(LAS unsigned short*)(Bi + n * 272 + k * 2) = (unsigned short)(pk2(v * 0.125f, 0.f) & 0xffffu); }
}
struct CfgDft1 {
    const bf16_t* Z; bf16_t* S1re; bf16_t* S1im;
    DI void fill_tables(LAS unsigned char* Bi, int tid) const { fill_dft_table(Bi, tid, 128); }
    DI int table_off(int) const { return 0; }
    DI const bf16_t* row_ptr(int item, int k) const { const int g = item & 3, b = (item >> 2) & 63, batch = item >> 8;
        return Z + ((size_t)batch * 4096 + 64 * (k & 63) + b) * 2048 + g * 512 + (k >> 6) * 256; }
    DI void epilogue(const f32x4 (&acc)[2][8], int item, int wid, int fr, int fq, LAS unsigned char* Bi) const {
        const int g = item & 3, b = (item >> 2) & 63, batch = item >> 8;
#pragma unroll
        for (int ni = 0; ni < 4; ++ni) { const int ap = 16 * ni + fr; float s, c; sincospif((float)(b * ap) * (1.0f / 2048.0f), &s, &c);
            const size_t tok = (size_t)batch * 4096 + 64 * ap + b;
            u32x2 wr[2], wi[2];
#pragma unroll
            for (int i = 0; i < 2; ++i) { const f32x4 re = acc[i][ni], im = acc[i][ni + 4]; const f32x4 r2 = re * c + im * s, i2 = im * c - re * s;
                wr[i].x = pk2(r2[0], r2[1]); wr[i].y = pk2(r2[2], r2[3]); wi[i].x = pk2(i2[0], i2[1]); wi[i].y = pk2(i2[2], i2[3]); }
            { const size_t o = tok * 1024 + g * 256 + 32 * wid + 4 * fq; st_pair16(S1re + o, wr[0], wr[1], fq); st_pair16(S1im + o, wi[0], wi[1], fq); } }
    }
};
struct CfgDft2 {
    const bf16_t* S1re; const bf16_t* S1im; const bf16_t* ZB; bf16_t* Y;
    DI void fill_tables(LAS unsigned char* Bi, int tid) const { fill_dft_table(Bi, tid, 64); }
    DI int table_off(int) const { return 0; }
    DI const bf16_t* row_ptr(int item, int k) const { const int g = item & 3, ap = (item >> 2) & 63, batch = item >> 8;
        return ((k >> 6) ? S1im : S1re) + ((size_t)batch * 4096 + 64 * ap + (k & 63)) * 1024 + g * 256; }
    DI void epilogue(const f32x4 (&acc)[2][4], int item, int wid, int fr, int fq, LAS unsigned char*) const {
        const int g = item & 3, ap = (item >> 2) & 63, batch = item >> 8;
#pragma unroll
        for (int ni = 0; ni < 4; ++ni) { const size_t tok = (size_t)batch * 4096 + ap + 64 * (16 * ni + fr);
            u32x2 w[2], zz[2]; ld_pair16(ZB + tok * 1024 + g * 256 + 32 * wid + 4 * fq, fq, zz[0], zz[1]);
#pragma unroll
            for (int i = 0; i < 2; ++i) { const u32x2 z = zz[i]; const f32x4 a = acc[i][ni];
                w[i].x = pk2(a[0] * silu_f(lo_f(z.x)), a[1] * silu_f(hi_f(z.x))); w[i].y = pk2(a[2] * silu_f(lo_f(z.y)), a[3] * silu_f(hi_f(z.y))); }
            st_pair16(Y + tok * 2048 + 1024 + g * 256 + 32 * wid + 4 * fq, w[0], w[1], fq); }
    }
};
DI void fill_pool_tables(LAS unsigned char* Bi, int tid) {
    for (int idx = tid; idx < 4 * 4096; idx += 512) { const int g = idx >> 12, n = (idx >> 6) & 63, k = idx & 63, w = 2 << g, lo = n - w / 2, hi = n + w - w / 2;
        *(LAS unsigned short*)(Bi + g * 9216 + n * 144 + k * 2) = (k >= lo && k < hi) ? (unsigned short)0x3F80 : (unsigned short)0; }
}
DI float pool_rcnt(int g, int n) { const int w = 2 << g; int lo = n - w / 2, hi = n + w - w / 2; lo = lo < 0 ? 0 : lo; hi = hi > 64 ? 64 : hi; return 1.0f / (float)(hi - lo); }
struct CfgPoolA {
    const bf16_t* UC; bf16_t* PA;
    DI void fill_tables(LAS unsigned char* Bi, int tid) const { fill_pool_tables(Bi, tid); }
    DI int table_off(int item) const { return ((item & 7) >> 1) * 9216; }
    DI const bf16_t* row_ptr(int item, int k) const { const int ct = item & 7, c = (item >> 3) & 63, batch = item >> 9; return UC + ((size_t)batch * 4096 + 64 * k + c) * 2048 + ct * 256; }
    DI void epilogue(const f32x4 (&acc)[2][4], int item, int wid, int fr, int fq, LAS unsigned char*) const {
        const int ct = item & 7, c = (item >> 3) & 63, batch = item >> 9, g = ct >> 1;
#pragma unroll
        for (int ni = 0; ni < 4; ++ni) { const int n = 16 * ni + fr; const float rc = pool_rcnt(g, n); const size_t tok = (size_t)batch * 4096 + 64 * n + c;
            u32x2 w[2];
#pragma unroll
            for (int i = 0; i < 2; ++i) { const f32x4 a = acc[i][ni] * rc; w[i].x = pk2(a[0], a[1]); w[i].y = pk2(a[2], a[3]); }
            st_pair16(PA + tok * 2048 + ct * 256 + 32 * wid + 4 * fq, w[0], w[1], fq); }
    }
};
struct CfgPoolB {
    const bf16_t* PA; bf16_t* UC;
    DI void fill_tables(LAS unsigned char* Bi, int tid) const { fill_pool_tables(Bi, tid); }
    DI int table_off(int item) const { return ((item & 7) >> 1) * 9216; }
    DI const bf16_t* row_ptr(int item, int k) const { const int ct = item & 7, rp = (item >> 3) & 63, batch = item >> 9; return PA + ((size_t)batch * 4096 + 64 * rp + k) * 2048 + ct * 256; }
    DI void epilogue(const f32x4 (&acc)[2][4], int item, int wid, int fr, int fq, LAS unsigned char*) const {
        const int ct = item & 7, rp = (item >> 3) & 63, batch = item >> 9, g = ct >> 1;
#pragma unroll
        for (int ni = 0; ni < 4; ++ni) { const int n = 16 * ni + fr; const float rc = pool_rcnt(g, n); const size_t tok = (size_t)batch * 4096 + 64 * rp + n;
            u32x2 w[2]; bf16_t* up0 = UC + tok * 2048 + ct * 256 + 32 * wid + 4 * fq;
            u32x2 uu[2]; ld_pair16(up0, fq, uu[0], uu[1]);
#pragma unroll
            for (int i = 0; i < 2; ++i) { const u32x2 u = uu[i]; const f32x4 a = acc[i][ni] * rc;
                w[i].x = pk2(a[0] - lo_f(u.x), a[1] - hi_f(u.x)); w[i].y = pk2(a[2] - lo_f(u.y), a[3] - hi_f(u.y)); }
            st_pair16(up0, w[0], w[1], fq); }
    }
};

DI void ph_ya(const Params& p) {
    const int tid = opaque_tid(), wid = tid >> 6, lane = tid & 63;
    const bf16_t* HF = (const bf16_t*)p.ws; const bf16_t* HB = (const bf16_t*)(p.ws + PLANE); const bf16_t* O = (const bf16_t*)(p.ws + 3 * PLANE); const bf16_t* ZA = (const bf16_t*)(p.ws + 4 * PLANE);
    bf16_t* Y = (bf16_t*)p.out;
    f32x4 hg[4];
#pragma unroll
    for (int i = 0; i < 4; ++i) hg[i] = *(const f32x4*)(p.head_norm + lane * 16 + 4 * i);
    for (int r = blockIdx.x * 8 + wid; r < NX; r += gridDim.x * 8) {
        const size_t o = (size_t)r * 1024 + lane * 16;
        float gv[16], za[16]; float ss = 0.f;
#pragma unroll
        for (int hh = 0; hh < 2; ++hh) { const u32x4 a = *(const u32x4*)(HF + o + 8 * hh), bq = *(const u32x4*)(HB + o + 8 * hh), oo = *(const u32x4*)(O + o + 8 * hh), zz = *(const u32x4*)(ZA + o + 8 * hh);
#pragma unroll
            for (int e = 0; e < 4; ++e) { const float h0 = lo_f(a[e]) + lo_f(bq[e]), h1 = hi_f(a[e]) + hi_f(bq[e]);
                const float g0 = sigmoid_f(lo_f(oo[e])) * h0, g1 = sigmoid_f(hi_f(oo[e])) * h1;
                gv[8 * hh + 2 * e] = g0; gv[8 * hh + 2 * e + 1] = g1; ss += g0 * g0 + g1 * g1; za[8 * hh + 2 * e] = lo_f(zz[e]); za[8 * hh + 2 * e + 1] = hi_f(zz[e]); } }
        ss += __shfl_xor(ss, 1); ss += __shfl_xor(ss, 2); ss += __shfl_xor(ss, 4); ss += __shfl_xor(ss, 8);
        const float rstd = rsqrtf(ss * (1.0f / 256.0f) + 1e-6f);
        u32x4 w[2];
#pragma unroll
        for (int q = 0; q < 8; ++q) { const float y0 = gv[2 * q] * rstd * hg[q >> 1][(2 * q) & 3] * silu_f(za[2 * q]), y1 = gv[2 * q + 1] * rstd * hg[q >> 1][(2 * q + 1) & 3] * silu_f(za[2 * q + 1]);
            w[q >> 2][q & 3] = pk2(y0, y1); }
        *(u32x4*)(Y + (size_t)r * 2048 + lane * 16) = w[0]; *(u32x4*)(Y + (size_t)r * 2048 + lane * 16 + 8) = w[1];
    }
}


#define XB_TMO      128
#define XB_XCNT(j)  (256  + 64 * (j))
#define XB_XSUB(j)  (1280 + 64 * (j))
#define XB_XGEN(j)  (2304 + 64 * (j))
#define XB_TOP      3328
#define XB_TOPGEN   3392
#define XCD_BAR_WORDS 3456
#define XB_SPIN_CAP (1u << 18)
DI unsigned xb_ld(unsigned* p)              { return __hip_atomic_load(p, __ATOMIC_RELAXED, __HIP_MEMORY_SCOPE_AGENT); }
DI unsigned xb_add(unsigned* p, unsigned v) { return __hip_atomic_fetch_add(p, v, __ATOMIC_RELAXED, __HIP_MEMORY_SCOPE_AGENT); }
DI unsigned xb_xcc_id() { return (unsigned)__builtin_amdgcn_s_getreg((3 << 11) | 20) & 0xFu; }
#define XB_SPIN(cond, bar) do { unsigned _sp = 0; while (cond) { __builtin_amdgcn_s_sleep(1); \
    if ((++_sp & 255u) == 0u) { if (xb_ld(&(bar)[XB_TMO])) break; if (_sp > XB_SPIN_CAP) { atomicAdd(&(bar)[XB_TMO], 1u); break; } } } } while (0)
struct XcdBarrier { unsigned* bar; unsigned x; volatile LAS unsigned* st; };
DI XcdBarrier xcd_barrier_post(unsigned* bar, volatile LAS unsigned* st) {
    XcdBarrier b; b.bar = bar; b.x = xb_xcc_id(); b.st = st;
    if (threadIdx.x == 0) (void)xb_add(&bar[XB_XCNT(b.x)], 1u);
    return b;
}
DI void xcd_barrier_complete(unsigned* bar, unsigned x, unsigned& nloc, unsigned& nx) {
    const unsigned G = gridDim.x * gridDim.y * gridDim.z;
    unsigned sum, cnt, mine, sp = 0u;
    for (;;) {
        sum = 0u; cnt = 0u; mine = 0u;
#pragma unroll
        for (unsigned j = 0; j < 16; ++j) { const unsigned c = xb_ld(&bar[XB_XCNT(j)]); sum += c; cnt += (c > 0u) ? 1u : 0u; mine = (j == x) ? c : mine; }
        if (sum == G) break;
        __builtin_amdgcn_s_sleep(1);
        if ((++sp & 255u) == 0u) { if (xb_ld(&bar[XB_TMO])) break; if (sp > XB_SPIN_CAP) { atomicAdd(&bar[XB_TMO], 1u); break; } }
    }
    nloc = mine > 0u ? mine : 1u; nx = cnt > 0u ? cnt : 1u;
}
DI void xcd_barrier(const XcdBarrier& b) {
    asm volatile("s_waitcnt vmcnt(0)" ::: "memory");
    __syncthreads();
    if (threadIdx.x == 0) {
        unsigned* bar = b.bar;
        __builtin_amdgcn_s_waitcnt(0);
        unsigned nloc = b.st[0], nx = b.st[1];
        if (nloc == 0u) { xcd_barrier_complete(bar, b.x, nloc, nx); b.st[0] = nloc; b.st[1] = nx; }
        const unsigned old = xb_add(&bar[XB_XSUB(b.x)], 1u);
        const unsigned gen = old / nloc;
        if (old + 1u == (gen + 1u) * nloc) {
            __builtin_amdgcn_fence(__ATOMIC_RELEASE, "agent");
            asm volatile("s_waitcnt vmcnt(0)" ::: "memory");
            const unsigned og = xb_add(&bar[XB_TOP], 1u);
            const unsigned tg = og / nx;
            if (og + 1u == (tg + 1u) * nx) xb_add(&bar[XB_TOPGEN], 1u);
            else XB_SPIN(xb_ld(&bar[XB_TOPGEN]) == tg, bar);
            __builtin_amdgcn_fence(__ATOMIC_ACQUIRE, "agent");
            xb_add(&bar[XB_XGEN(b.x)], 1u);
            asm volatile("s_waitcnt vmcnt(0)" ::: "memory");
        } else {
            XB_SPIN(xb_ld(&bar[XB_XGEN(b.x)]) == gen, bar);
            __builtin_amdgcn_fence(__ATOMIC_ACQUIRE, "agent");
            asm volatile("s_waitcnt vmcnt(0)" ::: "memory");
        }
    }
    __syncthreads();
}

__global__ void __launch_bounds__(512, 2) mk_fwd(Params p, int ph_lo, int ph_hi) {
    extern __shared__ __attribute__((aligned(16))) unsigned char shm[];
    LAS unsigned char* lds = (LAS unsigned char*)shm;
    cg::grid_group grid = cg::this_grid();
    unsigned char* ws = p.ws;
    const int G = gridDim.x, c = blockIdx.x;
    volatile LAS unsigned* xst = (volatile LAS unsigned*)(lds + LDS_BYTES - 16);
    if (threadIdx.x == 0) { xst[0] = 0u; xst[1] = 0u; }
    __syncthreads();
    XcdBarrier xbar; xbar.bar = (unsigned*)(ws + WS_BAR); xbar.x = 0u; xbar.st = xst;
    if (ph_hi - ph_lo > 1) xbar = xcd_barrier_post((unsigned*)(ws + WS_BAR), xst);
    if (ph_lo > 1000) grid.sync();
#ifndef PHMASK
#define PHMASK 0xFFFF
#endif
#define GSYNC() xcd_barrier(xbar)
#ifndef REP_MASK
#define REP_MASK 0
#endif
#define PHASE(i, ...) if constexpr ((PHMASK >> (i)) & 1) if (ph_lo <= (i) && (i) < ph_hi) { __VA_ARGS__; if constexpr ((REP_MASK >> (i)) & 1) { __syncthreads(); __VA_ARGS__; } if ((i) + 1 < ph_hi) GSYNC(); }
    PHASE(0, ph_prep(p, lds));
    PHASE(1, ph_norm0(p, lds));
    PHASE(2, { GemmD g{(const bf16_t*)p.out, (const bf16_t*)(ws + WS_WINE), 1024, 1024, 0, 0, 1024}; Sched S{128, 28, 1, 8, 12, 128, G, c};
               EpiPlanes E{(bf16_t*)ws, (bf16_t*)(ws + WS_CRAW)}; gemm_phase(lds, g, S, E);
               if (G > 96 && c >= 96) transpose_jobs(p, lds, opaque_tid(), 2304, 4096, c - 96, G - 96); else if (G <= 96) transpose_jobs(p, lds, opaque_tid(), 2304, 4096, c, G); });
    PHASE(3, ph_conv(p));
    PHASE(4, ph_mlstm(p, lds));
    PHASE(5, { GemmD g{(const bf16_t*)(ws + 5 * PLANE), (const bf16_t*)(ws + WS_WF), 1024, 256, 256, 512 * 256, 256}; Sched S{128, 2, 4, 0, 0, 0, G, c};
               EpiBf E{(bf16_t*)p.out, nullptr, 2048, 512, 0, nullptr, nullptr}; gemm_phase(lds, g, S, E); });
    PHASE(6, { CfgDft1 cf{(const bf16_t*)p.out, (bf16_t*)(ws + 2 * PLANE), (bf16_t*)(ws + 5 * PLANE)}; axis_mix<128, 128>(cf, lds, 2048); });
    PHASE(7, { CfgDft2 cf{(const bf16_t*)(ws + 2 * PLANE), (const bf16_t*)(ws + 5 * PLANE), (const bf16_t*)(ws + 6 * PLANE), (bf16_t*)p.out}; axis_mix<128, 64>(cf, lds, 2048); ph_ya(p); });
    PHASE(8, { GemmD g{(const bf16_t*)p.out, (const bf16_t*)(ws + WS_WOUTE), 2048, 2048, 0, 0, 2048}; Sched S{128, 4, 1, 0, 0, 0, G, c};
               EpiGate E{(bf16_t*)ws, (const float*)(ws + WS_MOD) + 2048}; gemm_phase(lds, g, S, E); });
    PHASE(9, ph_norm1(p, 0));
    PHASE(10, { GemmD g{(const bf16_t*)(ws + 2 * PLANE), (const bf16_t*)(ws + WS_WINO), 1024, 1024, 0, 0, 1024}; Sched S{128, 16, 1, 0, 0, 0, G, c};
                EpiBf E{(bf16_t*)(ws + 3 * PLANE), (bf16_t*)(ws + 5 * PLANE), 2048, 0, 1, nullptr, nullptr}; gemm_phase(lds, g, S, E); });
    PHASE(11, { CfgPoolA cf{(const bf16_t*)(ws + 3 * PLANE), (bf16_t*)p.out}; axis_mix<64, 64>(cf, lds, 4096); });
    PHASE(12, { CfgPoolB cf{(const bf16_t*)p.out, (bf16_t*)(ws + 3 * PLANE)}; axis_mix<64, 64>(cf, lds, 4096); });
    PHASE(13, { GemmD g{(const bf16_t*)(ws + 3 * PLANE), (const bf16_t*)(ws + WS_WPOOL), 2048, 512, 512, 512 * 512, 512}; Sched S{128, 2, 4, 0, 0, 0, G, c};
                EpiBf E{(bf16_t*)p.out, nullptr, 2048, 512, 2, p.pool_scale, (const bf16_t*)(ws + 5 * PLANE)}; gemm_phase(lds, g, S, E); });
    PHASE(14, { GemmD g{(const bf16_t*)p.out, (const bf16_t*)(ws + WS_WOUTO), 2048, 2048, 0, 0, 2048}; Sched S{128, 4, 1, 0, 0, 0, G, c};
                EpiGate E{(bf16_t*)(ws + PLANE), (const float*)(ws + WS_MOD) + 9 * 3072 + 2048}; gemm_phase(lds, g, S, E); });
    PHASE(15, ph_norm1(p, 1));
#undef PHASE
#ifdef XSYNC
    for (int k = 0; k < XSYNC; ++k) GSYNC();
#endif
#ifdef DBG_STOP
    GSYNC();
    {   const size_t n = (size_t)NX * 1024; unsigned* o32 = (unsigned*)p.out;
        for (size_t i = (size_t)blockIdx.x * 512 + threadIdx.x; i < n; i += (size_t)gridDim.x * 512) {
            float v = 0.f;
            if (DBG_PLANES == -1) { const unsigned u = o32[i]; v = lo_f(u) + hi_f(u); }
            else if (DBG_PLANES == -2) { v = ((const float*)p.ws)[i]; }
            else { for (int pl = 0; pl < 7; ++pl) if ((DBG_PLANES >> pl) & 1) v += bf2f(((const bf16_t*)(p.ws + pl * PLANE))[i]); }
            if (!(fabsf(v) < 1e30f)) v = 12345.f;
            p.out[i] = v; } }
#endif
}

extern "C" void kernel_launch(void* const* d_in, const int* in_sizes, int n_in, void* d_out, int out_size, void* d_ws, size_t ws_size, hipStream_t stream) {
    static int grid = 0;
    if (grid == 0) {
        int dev = 0, cus = 0, per_cu = 0;
        hipGetDevice(&dev);
        hipDeviceGetAttribute(&cus, hipDeviceAttributeMultiprocessorCount, dev);
        if (hipFuncSetAttribute((const void*)mk_fwd, hipFuncAttributeMaxDynamicSharedMemorySize, LDS_BYTES) != hipSuccess) fprintf(stderr, "hipFuncSetAttribute failed\n");
        if (hipOccupancyMaxActiveBlocksPerMultiprocessor(&per_cu, (const void*)mk_fwd, 512, LDS_BYTES) != hipSuccess || per_cu < 1) { fprintf(stderr, "occupancy query: %d\n", per_cu); per_cu = 1; }
        (void)hipGetLastError();
        grid = cus * per_cu; if (grid > 256) grid = 256; if (grid < 1) grid = 1;
        if (ws_size < WS_END) fprintf(stderr, "workspace too small: %zu < %zu\n", ws_size, (size_t)WS_END);
    }
    Params p{};
    p.x = (const float*)d_in[0]; p.c = (const float*)d_in[1]; p.ctx = (const float*)d_in[2]; p.c_ctx = (const float*)d_in[3]; p.ada_w = (const float*)d_in[4]; p.ada_b = (const float*)d_in[5];
    p.norm_g = (const float*)d_in[6]; p.win_even = (const float*)d_in[7]; p.gate_b = (const float*)d_in[8]; p.conv_qk = (const float*)d_in[9]; p.head_norm = (const float*)d_in[10];
    p.fourier_w = (const float*)d_in[11]; p.wout_even = (const float*)d_in[12]; p.win_odd = (const float*)d_in[13]; p.pool_w = (const float*)d_in[14]; p.pool_scale = (const float*)d_in[15];
    p.wout_odd = (const float*)d_in[16]; p.final_g = (const float*)d_in[17]; p.out = (float*)d_out; p.ws = (unsigned char*)d_ws;
    (void)hipMemsetAsync((unsigned char*)d_ws + WS_BAR, 0, XCD_BAR_WORDS * 4, stream);
#if MK_MULTI
    for (int ph = 0; ph < 16; ++ph) { hipLaunchKernelGGL(mk_fwd, dim3(grid), dim3(512), LDS_BYTES, stream, p, ph, ph + 1); }
#else
#ifdef DBG_STOP
    int lo = 0, hi = DBG_STOP;
#else
    int lo = 0, hi = 16;
#endif
    void* args[] = {&p, &lo, &hi};
    hipError_t e = hipLaunchCooperativeKernel((void*)mk_fwd, dim3(grid), dim3(512), args, LDS_BYTES, stream);
    if (e != hipSuccess) fprintf(stderr, "cooperative launch failed: %s (grid %d)\n", hipGetErrorString(e), grid);
#endif
}
```

```cpp
#include <hip/hip_runtime.h>
#include <hip/hip_cooperative_groups.h>
#include <cstdio>
namespace cg = cooperative_groups;

#ifndef MK_MULTI
#define MK_MULTI 0
#endif

#define LAS __attribute__((address_space(3)))
typedef unsigned short bf16_t;
typedef short bf16x8 __attribute__((ext_vector_type(8)));
typedef short s16x4 __attribute__((ext_vector_type(4)));
typedef float f32x4 __attribute__((ext_vector_type(4)));
typedef unsigned u32x4 __attribute__((ext_vector_type(4)));
typedef unsigned u32x2 __attribute__((ext_vector_type(2)));

constexpr int NX = 32768, NCX = 2048, NR = NX + NCX;
constexpr size_t PLANE = (size_t)NX * 1024 * 2;
constexpr size_t WS_EXTRA = 7 * PLANE;
constexpr size_t WS_WINE  = WS_EXTRA;
constexpr size_t WS_WOUTE = WS_WINE  + (size_t)7168 * 1024 * 2;
constexpr size_t WS_WINO  = WS_WOUTE + (size_t)1024 * 2048 * 2;
constexpr size_t WS_WPOOL = WS_WINO  + (size_t)4096 * 1024 * 2;
constexpr size_t WS_WOUTO = WS_WPOOL + (size_t)4 * 512 * 512 * 2;
constexpr size_t WS_WF    = WS_WOUTO + (size_t)1024 * 2048 * 2;
constexpr size_t WS_MOD   = WS_WF    + (size_t)4 * 512 * 256 * 2;
constexpr size_t WS_GATES = WS_MOD   + 262144;
constexpr size_t WS_CRAW  = WS_GATES + (size_t)NR * 16 * 4;
constexpr size_t WS_CQC   = WS_CRAW  + (size_t)3 * NCX * 1024 * 2;
constexpr size_t WS_CKC   = WS_CQC   + (size_t)NCX * 1024 * 2;
constexpr size_t WS_END   = WS_CKC   + (size_t)NCX * 1024 * 2;
constexpr size_t WS_GPRE  = WS_END + 16384;
constexpr size_t WS_GPRE_END = WS_GPRE + (size_t)64 * 68 * 384 * 4;
static_assert(WS_GPRE_END <= (size_t)512 * 1024 * 1024, "gate tables exceed the workspace");
constexpr size_t WS_BAR   = WS_END;
static_assert(WS_BAR + 16384 <= (size_t)512 * 1024 * 1024, "workspace map exceeds 512 MiB");

constexpr int LDS_BYTES = 155648;

struct Params {
    const float* x; const float* c; const float* ctx; const float* c_ctx; const float* ada_w; const float* ada_b; const float* norm_g;
    const float* win_even; const float* gate_b; const float* conv_qk; const float* head_norm; const float* fourier_w; const float* wout_even;
    const float* win_odd; const float* pool_w; const float* pool_scale; const float* wout_odd; const float* final_g;
    float* out; unsigned char* ws;
};

#define DI __device__ __forceinline__
DI float bf2f(unsigned short b) { return __uint_as_float(((unsigned)b) << 16); }
DI float lo_f(unsigned u) { return __uint_as_float(u << 16); }
DI float hi_f(unsigned u) { return __uint_as_float(u & 0xffff0000u); }
typedef __bf16 bf16v2_t __attribute__((ext_vector_type(2)));
typedef float f32v2_t __attribute__((ext_vector_type(2)));
DI unsigned pk2(float lo, float hi) { const f32v2_t v = {lo, hi}; const bf16v2_t b = __builtin_convertvector(v, bf16v2_t); return __builtin_bit_cast(unsigned, b); }
DI float silu_f(float x) { return x / (1.0f + __expf(-x)); }
DI float sigmoid_f(float x) { return 1.0f / (1.0f + __expf(-x)); }
DI int opaque_tid() { int t = threadIdx.x; asm volatile("" : "+v"(t)); return t; }
DI float wave_sum(float v) { for (int o = 32; o > 0; o >>= 1) v += __shfl_xor(v, o); return v; }
DI float wave_max(float v) { for (int o = 32; o > 0; o >>= 1) v = fmaxf(v, __shfl_xor(v, o)); return v; }
DI void st_pair16(bf16_t* base0, u32x2 w0, u32x2 w1, int fq) {
    const auto rx = __builtin_amdgcn_permlane16_swap(w0.x, w1.x, false, false);
    const auto ry = __builtin_amdgcn_permlane16_swap(w0.y, w1.y, false, false);
    u32x4 v; v.x = rx[0]; v.y = ry[0]; v.z = rx[1]; v.w = ry[1];
    *(u32x4*)((fq & 1) ? base0 + 12 : base0) = v;
}
DI unsigned swap1(unsigned x) { return (unsigned)__builtin_amdgcn_mov_dpp((int)x, 0xB1, 0xF, 0xF, true); }
DI void st_adj16(bf16_t* pa, bf16_t* pb, u32x2 a, u32x2 b, int lane) {
    const bool odd = lane & 1;
    const unsigned rx = swap1(odd ? a.x : b.x), ry = swap1(odd ? a.y : b.y);
    u32x4 v; v.x = odd ? rx : a.x; v.y = odd ? ry : a.y; v.z = odd ? b.x : rx; v.w = odd ? b.y : ry;
    *(u32x4*)(odd ? pb - 4 : pa) = v;
}
DI void ld_adj16(const bf16_t* pa, const bf16_t* pb, int lane, u32x2& a, u32x2& b) {
    const bool odd = lane & 1;
    const u32x4 v = *(const u32x4*)(odd ? pb - 4 : pa);
    const unsigned rx = swap1(odd ? v.x : v.z), ry = swap1(odd ? v.y : v.w);
    a.x = odd ? rx : v.x; a.y = odd ? ry : v.y; b.x = odd ? v.z : rx; b.y = odd ? v.w : ry;
}
DI void ld_pair16(const bf16_t* base0, int fq, u32x2& w0, u32x2& w1) {
    const u32x4 v = *(const u32x4*)((fq & 1) ? base0 + 12 : base0);
    const auto rx = __builtin_amdgcn_permlane16_swap(v.x, v.z, false, false);
    const auto ry = __builtin_amdgcn_permlane16_swap(v.y, v.w, false, false);
    w0.x = rx[0]; w1.x = rx[1]; w0.y = ry[0]; w1.y = ry[1];
}
DI f32x4 mfma16(bf16x8 a, bf16x8 b, f32x4 c) { return __builtin_amdgcn_mfma_f32_16x16x32_bf16(a, b, c, 0, 0, 0); }
DI bf16x8 tr_frag(LAS unsigned char* img, int pitch, int krow0, int col0, int lane) {
    const int g = lane >> 4, q = (lane & 15) >> 2, pp = lane & 3;
    LAS unsigned char* a0 = img + (krow0 + 8 * g + q) * pitch + col0 * 2 + 8 * pp;
    s16x4 lo = __builtin_amdgcn_ds_read_tr16_b64_v4i16((LAS s16x4*)a0);
    s16x4 hi = __builtin_amdgcn_ds_read_tr16_b64_v4i16((LAS s16x4*)(a0 + 4 * pitch));
    return __builtin_shufflevector(lo, hi, 0, 1, 2, 3, 4, 5, 6, 7);
}

constexpr int HTB = 128 * 64 * 2;
DI int lds_byte(int r, int c) { const int st = (r >> 4) * 2 + (c >> 5), rr = r & 15, cc = c & 31, ob = rr * 64 + cc * 2; return st * 1024 + (ob ^ (((ob >> 9) & 1) << 5)); }
DI void stage_rc(int b, int& R, int& C) { const int st = b / 1024, sb = b % 1024, swz = sb ^ (((sb >> 9) & 1) << 5); R = (st >> 1) * 16 + swz / 64; C = (st & 1) * 32 + (swz % 64) / 2; }
DI int perm32(int rho) { const int n = rho >> 4, i = rho & 15; return 8 * (i >> 2) + 4 * n + (i & 3); }

struct Unit { int pm, pn, g; };
struct GemmD { const bf16_t* A; const bf16_t* Bt; int lda, ldb; long a_gs, b_gs; int K; };
struct Sched {
    int nM, nN, nG, nM2, nN2, pm2off, G, c;
    DI bool next(int i, Unit& u) const {
        const int L = i * G + c; const int nwg = nM * nN, tot1 = nwg * nG;
        const bool first = L < tot1;
        const int L1 = first ? L : 0;
        const int g = L1 / nwg; int wgid = L1 - g * nwg;
        { const int q = nwg / 8, r = nwg % 8, xcd = wgid % 8, off = wgid / 8; wgid = (xcd < r ? xcd * (q + 1) : r * (q + 1) + (xcd - r) * q) + off; }
        const int nig = 8 * nN, gid = wgid / nig, fm = gid * 8, gsz = (nM - fm) < 8 ? (nM - fm) : 8;
        const int pm1 = fm + ((wgid % nig) % gsz), pn1 = (wgid % nig) / gsz;
        const int L2 = first ? 0 : L - tot1, d2 = nM2 > 0 ? nM2 : 1;
        const int pm2 = pm2off + L2 % d2, pn2 = L2 / d2;
        u.pm = first ? pm1 : pm2; u.pn = first ? pn1 : pn2; u.g = first ? g : 0;
        return first || (L2 < nM2 * nN2);
    }
};

template <class Epi>
DI void gemm_phase(LAS unsigned char* lds, const GemmD g, const Sched& S, const Epi& E) {
    const int tid = opaque_tid(), wid = __builtin_amdgcn_readfirstlane(tid >> 6), lane = tid & 63, wr = wid >> 2, wc = wid & 3, fr = lane & 15, fq = lane >> 4;
    const int K = g.K, nt = K / 64;
    unsigned voffA[2], voffB[2];
#pragma unroll
    for (int i = 0; i < 2; ++i) { int R, C; stage_rc(tid * 16 + i * 8192, R, C); const int Rb = Epi::PERM ? ((R & ~31) + perm32(R & 31)) : R;
        voffA[i] = (unsigned)(R * g.lda + C) * 2u; voffB[i] = (unsigned)(Rb * g.ldb + C) * 2u; }
    const size_t kstep = 128;
    const size_t hstepA = (size_t)128 * g.lda * 2, hstepB = (size_t)128 * g.ldb * 2;
    const unsigned ldsw = (unsigned)wid * 1024u;
    const int aoff = lds_byte(wr * 64 + fr, fq * 8), boff = lds_byte(wc * 32 + fr, fq * 8);
#define G_SA(b, h) (((b) * 2 + (h)) * HTB)
#define G_SB(b, h) ((4 + (b) * 2 + (h)) * HTB)
#define G_STAGE(bufoff, gbase, voff) do { _Pragma("unroll") for (int _i = 0; _i < 2; ++_i) \
        __builtin_amdgcn_global_load_lds((const unsigned*)((const char*)(gbase) + (voff)[_i]), (LAS unsigned*)(lds + (bufoff) + ldsw + _i * 8192), 16, 0, 0); } while (0)
#define G_LDA(dst, b, h) do { _Pragma("unroll") for (int m = 0; m < 4; ++m) _Pragma("unroll") for (int k = 0; k < 2; ++k) dst[m][k] = *(const LAS bf16x8*)(lds + G_SA(b, h) + aoff + m * 2048 + k * 1024); } while (0)
#define G_LDB(dst, b, h) do { _Pragma("unroll") for (int n = 0; n < 2; ++n) _Pragma("unroll") for (int k = 0; k < 2; ++k) dst[n][k] = *(const LAS bf16x8*)(lds + G_SB(b, h) + boff + n * 2048 + k * 1024); } while (0)
#define G_MMA(ai, bj, At, Bt) do { __builtin_amdgcn_s_setprio(1); _Pragma("unroll") for (int m = 0; m < 4; ++m) _Pragma("unroll") for (int n = 0; n < 2; ++n) _Pragma("unroll") for (int k = 0; k < 2; ++k) \
        acc[ai][bj][m][n] = __builtin_amdgcn_mfma_f32_16x16x32_bf16(Bt[n][k], At[m][k], acc[ai][bj][m][n], 0, 0, 0); __builtin_amdgcn_s_setprio(0); } while (0)
#define G_WAIT_V(n) asm volatile("s_waitcnt vmcnt(" #n ")" ::: "memory")
#define G_WAIT_L(n) asm volatile("s_waitcnt lgkmcnt(" #n ")" ::: "memory")
#define G_BAR __builtin_amdgcn_s_barrier()
#define G_SCHED __builtin_amdgcn_sched_barrier(0)
    Unit cur, nxt; int ui = 0;
    if (!S.next(0, cur)) return;
    f32x4 acc[2][2][4][2];
#pragma unroll
    for (int a = 0; a < 2; ++a)
#pragma unroll
        for (int b = 0; b < 2; ++b)
#pragma unroll
            for (int m = 0; m < 4; ++m)
#pragma unroll
                for (int n = 0; n < 2; ++n) acc[a][b][m][n] = (f32x4){0.f, 0.f, 0.f, 0.f};
    bf16x8 At[4][2], B0[2][2], B1[2][2];
    const char* cA = (const char*)(g.A + (long)cur.g * g.a_gs) + (size_t)cur.pm * 2 * hstepA;
    const char* cB = (const char*)(g.Bt + (long)cur.g * g.b_gs) + (size_t)cur.pn * 2 * hstepB;
    G_STAGE(G_SB(0, 0), cB, voffB); G_STAGE(G_SA(0, 0), cA, voffA); G_STAGE(G_SB(0, 1), cB + hstepB, voffB); G_STAGE(G_SA(0, 1), cA + hstepA, voffA);
    if (wr == 1) G_BAR;
    G_WAIT_V(4); G_BAR;
    G_STAGE(G_SB(1, 0), cB + kstep, voffB); G_STAGE(G_SA(1, 0), cA + kstep, voffA); G_STAGE(G_SB(1, 1), cB + hstepB + kstep, voffB);
    G_WAIT_V(6); G_BAR;
    for (;;) {
        const bool has_next = S.next(ui + 1, nxt);
        const char* nA = has_next ? (const char*)(g.A + (long)nxt.g * g.a_gs) + (size_t)nxt.pm * 2 * hstepA : cA;
        const char* nB = has_next ? (const char*)(g.Bt + (long)nxt.g * g.b_gs) + (size_t)nxt.pn * 2 * hstepB : cB;
        for (int t = 0; t < nt; t += 2) {
            const bool last = (t == nt - 2);
            const char* a1 = cA + (size_t)(t + 1) * kstep;
            const char* a2 = last ? nA : cA + (size_t)(t + 2) * kstep; const char* b2 = last ? nB : cB + (size_t)(t + 2) * kstep;
            const char* a3 = a2 + kstep; const char* b3 = b2 + kstep;
            G_LDB(B0, 0, 0); G_SCHED; G_LDA(At, 0, 0); G_STAGE(G_SA(1, 1), a1 + hstepA, voffA);
            G_WAIT_L(8); G_BAR; G_WAIT_L(0); G_MMA(0, 0, At, B0); G_BAR; G_SCHED;
            G_LDB(B1, 0, 1); G_STAGE(G_SB(0, 0), b2, voffB);
            G_BAR; G_WAIT_L(0); G_MMA(0, 1, At, B1); G_BAR;
            G_LDA(At, 0, 1); G_STAGE(G_SA(0, 0), a2, voffA);
            G_BAR; G_WAIT_L(0); G_MMA(1, 0, At, B0); G_BAR; G_SCHED;
            G_STAGE(G_SB(0, 1), b2 + hstepB, voffB);
            G_WAIT_V(6); G_BAR; G_MMA(1, 1, At, B1); G_BAR;
            G_LDB(B0, 1, 0); G_SCHED; G_LDA(At, 1, 0); G_STAGE(G_SA(0, 1), a2 + hstepA, voffA);
            G_WAIT_L(8); G_BAR; G_WAIT_L(0); G_MMA(0, 0, At, B0); G_BAR; G_SCHED;
            G_LDB(B1, 1, 1); G_STAGE(G_SB(1, 0), b3, voffB);
            G_BAR; G_WAIT_L(0); G_MMA(0, 1, At, B1); G_BAR;
            G_LDA(At, 1, 1); G_STAGE(G_SA(1, 0), a3, voffA);
            G_BAR; G_WAIT_L(0); G_MMA(1, 0, At, B0); G_BAR; G_SCHED;
            G_STAGE(G_SB(1, 1), b3 + hstepB, voffB);
            G_WAIT_V(6); G_BAR; G_MMA(1, 1, At, B1); G_BAR;
        }
        E(acc, cur, wr, wc, fr, fq);
        if (!has_next) break;
#pragma unroll
        for (int a = 0; a < 2; ++a)
#pragma unroll
            for (int b = 0; b < 2; ++b)
#pragma unroll
                for (int m = 0; m < 4; ++m)
#pragma unroll
                    for (int n = 0; n < 2; ++n) acc[a][b][m][n] = (f32x4){0.f, 0.f, 0.f, 0.f};
        cur = nxt; cA = nA; cB = nB; ++ui;
    }
    G_WAIT_V(0);
    if (wr == 0) G_BAR;
    G_BAR;
}

struct EpiPlanes {
    static constexpr bool PERM = true;
    bf16_t* xbase; bf16_t* cbase;
    DI void operator()(const f32x4 (&acc)[2][2][4][2], const Unit& u, int wr, int wc, int fr, int fq) const {
        const int plane = u.pn >> 2, colt = (u.pn & 3) * 256;
        bf16_t* base; int row0;
        if (u.pm < 128) { base = xbase + (size_t)plane * NX * 1024; row0 = u.pm * 256 + wr * 64 + fr; }
        else { base = cbase + (size_t)plane * NCX * 1024; row0 = (u.pm - 128) * 256 + wr * 64 + fr; }
        const int col0 = colt + wc * 32 + 8 * fq;
#pragma unroll
        for (int ai = 0; ai < 2; ++ai)
#pragma unroll
            for (int m = 0; m < 4; ++m) { bf16_t* rowp = base + (size_t)(row0 + ai * 128 + m * 16) * 1024 + col0;
#pragma unroll
                for (int bj = 0; bj < 2; ++bj) { const f32x4 v0 = acc[ai][bj][m][0], v1 = acc[ai][bj][m][1];
                    u32x4 w; w.x = pk2(v0[0], v0[1]); w.y = pk2(v0[2], v0[3]); w.z = pk2(v1[0], v1[1]); w.w = pk2(v1[2], v1[3]);
                    *(u32x4*)(rowp + bj * 128) = w; } }
    }
};
struct EpiBf {
    static constexpr bool PERM = true;
    bf16_t* O; bf16_t* O2; int ldc; int gcol; int mode; const float* scale; const bf16_t* zc;
    DI void operator()(const f32x4 (&acc)[2][2][4][2], const Unit& u, int wr, int wc, int fr, int fq) const {
        const int row0 = u.pm * 256 + wr * 64 + fr;
        bf16_t* base = O; int pn = u.pn; bool act = false;
        if (mode == 1 && pn >= 8) { base = O2; pn -= 8; act = true; }
        const int col0 = u.g * gcol + pn * 256 + wc * 32 + 8 * fq;
        f32x4 sc[2][2];
#pragma unroll
        for (int bj = 0; bj < 2; ++bj) { sc[bj][0] = (mode == 2) ? *(const f32x4*)(scale + col0 + bj * 128) : (f32x4){1.f, 1.f, 1.f, 1.f}; sc[bj][1] = (mode == 2) ? *(const f32x4*)(scale + col0 + bj * 128 + 4) : (f32x4){1.f, 1.f, 1.f, 1.f}; }
        u32x4 zq[2][4][2];
        if (mode == 2) {
#pragma unroll
            for (int ai = 0; ai < 2; ++ai)
#pragma unroll
                for (int m = 0; m < 4; ++m)
#pragma unroll
                    for (int bj = 0; bj < 2; ++bj) zq[ai][m][bj] = *(const volatile u32x4*)(zc + (size_t)(row0 + ai * 128 + m * 16) * ldc + col0 + bj * 128); }
#pragma unroll
        for (int ai = 0; ai < 2; ++ai) {
            u32x4 (&zz)[4][2] = zq[ai];
#pragma unroll
            for (int m = 0; m < 4; ++m) { const size_t ro = (size_t)(row0 + ai * 128 + m * 16) * ldc + col0;
#pragma unroll
                for (int bj = 0; bj < 2; ++bj) { f32x4 v0 = acc[ai][bj][m][0], v1 = acc[ai][bj][m][1];
                    if (act) {
#pragma unroll
                        for (int j = 0; j < 4; ++j) { v0[j] = silu_f(v0[j]); v1[j] = silu_f(v1[j]); } }
                    if (mode == 2) {
                        const u32x4 z = zz[m][bj]; const f32x4 s0 = sc[bj][0], s1 = sc[bj][1];
                        v0[0] *= s0[0] * lo_f(z.x); v0[1] *= s0[1] * hi_f(z.x); v0[2] *= s0[2] * lo_f(z.y); v0[3] *= s0[3] * hi_f(z.y);
                        v1[0] *= s1[0] * lo_f(z.z); v1[1] *= s1[1] * hi_f(z.z); v1[2] *= s1[2] * lo_f(z.w); v1[3] *= s1[3] * hi_f(z.w);
                    }
                    u32x4 w; w.x = pk2(v0[0], v0[1]); w.y = pk2(v0[2], v0[3]); w.z = pk2(v1[0], v1[1]); w.w = pk2(v1[2], v1[3]);
                    *(u32x4*)(base + ro + bj * 128) = w; } } }
    }
};
struct EpiGate {
    static constexpr bool PERM = true;
    bf16_t* O; const float* gate;
    DI void operator()(const f32x4 (&acc)[2][2][4][2], const Unit& u, int wr, int wc, int fr, int fq) const {
        const int row0 = u.pm * 256 + wr * 64 + fr, col0 = u.pn * 256 + wc * 32 + 8 * fq;
        const float* gp = gate + (size_t)(u.pm >> 4) * 3072 + col0;
        f32x4 gv[2][2];
#pragma unroll
        for (int bj = 0; bj < 2; ++bj) { gv[bj][0] = *(const f32x4*)(gp + bj * 128); gv[bj][1] = *(const f32x4*)(gp + bj * 128 + 4); }
#pragma unroll
        for (int ai = 0; ai < 2; ++ai)
#pragma unroll
            for (int m = 0; m < 4; ++m) { bf16_t* rowp = O + (size_t)(row0 + ai * 128 + m * 16) * 1024 + col0;
#pragma unroll
                for (int bj = 0; bj < 2; ++bj) { const f32x4 v0 = acc[ai][bj][m][0] * gv[bj][0], v1 = acc[ai][bj][m][1] * gv[bj][1];
                    u32x4 w; w.x = pk2(v0[0], v0[1]); w.y = pk2(v0[2], v0[3]); w.z = pk2(v1[0], v1[1]); w.w = pk2(v1[2], v1[3]);
                    *(u32x4*)(rowp + bj * 128) = w; } }
    }
};
struct EpiRes {
    static constexpr bool PERM = false;
    float* O; const float* res; const float* gate;
    DI void operator()(const f32x4 (&acc)[2][2][4][2], const Unit& u, int wr, int wc, int fr, int fq) const {
        const int row0 = u.pm * 256 + wr * 64 + fr, col0 = u.pn * 256 + wc * 32 + 4 * fq;
        const float* gp = gate + (size_t)(u.pm >> 4) * 3072 + col0;
        f32x4 gv[2][2];
#pragma unroll
        for (int bj = 0; bj < 2; ++bj)
#pragma unroll
            for (int n = 0; n < 2; ++n) gv[bj][n] = *(const f32x4*)(gp + bj * 128 + n * 16);
#pragma unroll
        for (int ai = 0; ai < 2; ++ai)
#pragma unroll
            for (int mp = 0; mp < 2; ++mp) {
                f32x4 r[2][2][2];
#pragma unroll
                for (int mm = 0; mm < 2; ++mm) { const size_t ro = (size_t)(row0 + ai * 128 + (2 * mp + mm) * 16) * 1024 + col0;
#pragma unroll
                    for (int bj = 0; bj < 2; ++bj)
#pragma unroll
                        for (int n = 0; n < 2; ++n) r[mm][bj][n] = *(const volatile f32x4*)(res + ro + bj * 128 + n * 16); }
#pragma unroll
                for (int mm = 0; mm < 2; ++mm) { const size_t ro = (size_t)(row0 + ai * 128 + (2 * mp + mm) * 16) * 1024 + col0;
#pragma unroll
                    for (int bj = 0; bj < 2; ++bj)
#pragma unroll
                        for (int n = 0; n < 2; ++n) *(f32x4*)(O + ro + bj * 128 + n * 16) = r[mm][bj][n] + gv[bj][n] * acc[ai][bj][2 * mp + mm][n]; }
            }
    }
};

DI void transpose_jobs(const Params& p, LAS unsigned char* lds, int tid, int j_lo, int j_hi, int w, int nw) {
    LAS float* tile = (LAS float*)lds;
    {
        auto job_desc = [&](int job, const float*& src, bf16_t*& dst, int& K, int& Nt, int& k0, int& n0) {
            int j = job, tk, tn;
            if (j < 1792) { src = p.win_even; dst = (bf16_t*)(p.ws + WS_WINE); K = 1024; Nt = 7184; tk = j & 15; tn = j >> 4; }
            else if ((j -= 1792) < 512) { src = p.wout_even; dst = (bf16_t*)(p.ws + WS_WOUTE); K = 2048; Nt = 1024; tk = j & 31; tn = j >> 5; }
            else if ((j -= 512) < 1024) { src = p.win_odd; dst = (bf16_t*)(p.ws + WS_WINO); K = 1024; Nt = 4096; tk = j & 15; tn = j >> 4; }
            else if ((j -= 1024) < 256) { const int g = j >> 6, jj = j & 63; src = p.pool_w + (size_t)g * 512 * 512; dst = (bf16_t*)(p.ws + WS_WPOOL) + (size_t)g * 512 * 512; K = 512; Nt = 512; tk = jj & 7; tn = jj >> 3; }
            else { j -= 256; src = p.wout_odd; dst = (bf16_t*)(p.ws + WS_WOUTO); K = 2048; Nt = 1024; tk = j & 31; tn = j >> 5; }
            k0 = tk * 64; n0 = tn * 64; };
        float rg[8];
        int job = j_lo + w;
        if (job < j_hi) { const float* src; bf16_t* dst; int K, Nt, k0, n0; job_desc(job, src, dst, K, Nt, k0, n0);
#pragma unroll
            for (int i = 0; i < 8; ++i) { const int idx = tid + 512 * i, k = idx >> 6, n = idx & 63; rg[i] = src[(size_t)(k0 + k) * Nt + n0 + n]; } }
        for (; job < j_hi; job += nw) {
            const float* src; bf16_t* dst; int K, Nt, k0, n0; job_desc(job, src, dst, K, Nt, k0, n0);
            __syncthreads();
#pragma unroll
            for (int i = 0; i < 8; ++i) { const int idx = tid + 512 * i, k = idx >> 6, n = idx & 63; tile[k * 65 + n] = rg[i]; }
            __syncthreads();
            const int nj = job + nw;
            if (nj < j_hi) { const float* s2; bf16_t* d2; int K2, Nt2, k2, n2; job_desc(nj, s2, d2, K2, Nt2, k2, n2);
#pragma unroll
                for (int i = 0; i < 8; ++i) { const int idx = tid + 512 * i, k = idx >> 6, n = idx & 63; rg[i] = s2[(size_t)(k2 + k) * Nt2 + n2 + n]; } }
#pragma unroll
            for (int i = 0; i < 4; ++i) { const int idx = tid + 512 * i, n = idx >> 5, k = (idx & 31) * 2;
                *(unsigned*)(dst + (size_t)(n0 + n) * K + k0 + k) = pk2(tile[k * 65 + n], tile[(k + 1) * 65 + n]); }
        }
        __syncthreads();
    }
}
DI void ph_prep(const Params& p, LAS unsigned char* lds) {
    const int tid = opaque_tid();
    transpose_jobs(p, lds, tid, 0, 2304, blockIdx.x, gridDim.x);
    LAS float* sv = (LAS float*)(lds + 32768);
    LAS float* red = (LAS float*)(lds + 32768 + 36864);
    LAS float* ct = (LAS float*)(lds + 90112); LAS float* st = ct + 256;
    for (int idx = tid; idx < 9216; idx += 512) { const int v = idx >> 10, k = idx & 1023; const float cv = (v < 8) ? p.c[v * 1024 + k] : p.c_ctx[k]; sv[idx] = silu_f(cv); }
    if (tid < 256) { float s, c; sincospif((float)tid / 128.0f, &s, &c); ct[tid] = c; st[tid] = s; }
    __syncthreads();
    float* MOD = (float*)(p.ws + WS_MOD);
    for (int item = blockIdx.x; item < 192; item += gridDim.x) {
        const int l = item / 96, c0 = (item % 96) * 32, kg = tid >> 5, col = tid & 31;
        float a[9];
#pragma unroll
        for (int v = 0; v < 9; ++v) a[v] = 0.f;
        const float* w = p.ada_w + (size_t)l * 1024 * 3072 + c0 + col;
#pragma unroll 16
        for (int k = kg; k < 1024; k += 16) { const float wv = w[(size_t)k * 3072];
#pragma unroll
            for (int v = 0; v < 9; ++v) a[v] += sv[v * 1024 + k] * wv; }
#pragma unroll
        for (int v = 0; v < 9; ++v) red[(kg * 32 + col) * 9 + v] = a[v];
        __syncthreads();
        if (tid < 288) { const int v = tid >> 5, cc = tid & 31; float s = 0.f; for (int q = 0; q < 16; ++q) s += red[(q * 32 + cc) * 9 + v];
            MOD[(size_t)(l * 9 + v) * 3072 + c0 + cc] = s + p.ada_b[l * 3072 + c0 + cc]; }
        __syncthreads();
    }
    bf16_t* WF = (bf16_t*)(p.ws + WS_WF);
    for (int it = blockIdx.x; it < 512; it += gridDim.x) {
        const int idx = it * 512 + tid, d = idx & 255, c = (idx >> 8) & 255, g = idx >> 16;
        const float* f = p.fourier_w + (size_t)g * 65536 + d;
        float aP = 0.f, aQ = 0.f;
#pragma unroll 16
        for (int cp = 0; cp < 256; ++cp) { const float fv = f[cp * 256]; const int a = (c * cp) & 255; aP += ct[a] * fv; aQ += st[a] * fv; }
        WF[(size_t)(g * 512 + d) * 256 + c] = (bf16_t)(pk2(aP * 0.0625f, 0.f) & 0xffffu);
        WF[(size_t)(g * 512 + 256 + d) * 256 + c] = (bf16_t)(pk2(-aQ * 0.0625f, 0.f) & 0xffffu);
    }
}

DI void ph_norm0(const Params& p, LAS unsigned char* lds) {
    const int tid = opaque_tid(), wid = tid >> 6, lane = tid & 63;
    LAS float* wg = (LAS float*)lds;
#pragma unroll 4
    for (int i = 0; i < 32; ++i) { const int idx = tid + 512 * i, k = idx >> 4, j = idx & 15; wg[j * 1024 + k] = p.win_even[(size_t)k * 7184 + 7168 + j]; }
    __syncthreads();
    f32x4 g[4];
#pragma unroll
    for (int i = 0; i < 4; ++i) g[i] = *(const f32x4*)(p.norm_g + lane * 4 + 256 * i);
    const float* MOD = (const float*)(p.ws + WS_MOD);
    bf16_t* HX = (bf16_t*)p.out;
    float* GATES = (float*)(p.ws + WS_GATES);
    f32x4 vn[4];
    { const int r = blockIdx.x * 8 + wid; if (r < NR) { const float* src = (r < NX) ? p.x + (size_t)r * 1024 : p.ctx + (size_t)(r - NX) * 1024;
#pragma unroll
        for (int i = 0; i < 4; ++i) vn[i] = *(const f32x4*)(src + lane * 4 + 256 * i); } }
    for (int r = blockIdx.x * 8 + wid; r < NR; r += gridDim.x * 8) {
        const float* md;
        if (r < NX) { md = MOD + (size_t)(r >> 12) * 3072; } else { md = MOD + (size_t)8 * 3072; }
        f32x4 v[4]; float ss = 0.f;
#pragma unroll
        for (int i = 0; i < 4; ++i) { v[i] = vn[i]; ss += v[i][0] * v[i][0] + v[i][1] * v[i][1] + v[i][2] * v[i][2] + v[i][3] * v[i][3]; }
        { const int r2 = r + gridDim.x * 8; if (r2 < NR) { const float* s2 = (r2 < NX) ? p.x + (size_t)r2 * 1024 : p.ctx + (size_t)(r2 - NX) * 1024;
#pragma unroll
            for (int i = 0; i < 4; ++i) vn[i] = *(const f32x4*)(s2 + lane * 4 + 256 * i); } }
        ss = wave_sum(ss);
        const float rstd = rsqrtf(ss * (1.0f / 1024.0f) + 1e-6f);
#pragma unroll
        for (int i = 0; i < 4; ++i) { const f32x4 sh = *(const f32x4*)(md + lane * 4 + 256 * i), sc = *(const f32x4*)(md + 1024 + lane * 4 + 256 * i);
            v[i] = v[i] * rstd * g[i] * (sc + 1.0f) + sh; }
#pragma unroll
        for (int i = 0; i < 4; i += 2) { u32x2 wa, wb; wa.x = pk2(v[i][0], v[i][1]); wa.y = pk2(v[i][2], v[i][3]); wb.x = pk2(v[i + 1][0], v[i + 1][1]); wb.y = pk2(v[i + 1][2], v[i + 1][3]);
            bf16_t* hp = HX + (size_t)r * 1024 + lane * 4 + 256 * i; st_adj16(hp, hp + 256, wa, wb, lane); }
        float pt[16];
#pragma unroll
        for (int j = 0; j < 16; ++j) { float a = 0.f;
#pragma unroll
            for (int i = 0; i < 4; ++i) { const f32x4 w4 = *(const LAS f32x4*)(wg + j * 1024 + lane * 4 + 256 * i); a += v[i][0] * w4[0] + v[i][1] * w4[1] + v[i][2] * w4[2] + v[i][3] * w4[3]; }
            pt[j] = a; if ((j & 3) == 3) __builtin_amdgcn_sched_barrier(0); }
        { const bool b5 = lane & 32;
#pragma unroll
          for (int j = 0; j < 8; ++j) { const float snd = b5 ? pt[j] : pt[j + 8], kp = b5 ? pt[j + 8] : pt[j]; pt[j] = kp + __shfl_xor(snd, 32); } }
        { const bool b4 = lane & 16;
#pragma unroll
          for (int j = 0; j < 4; ++j) { const float snd = b4 ? pt[j] : pt[j + 4], kp = b4 ? pt[j + 4] : pt[j]; pt[j] = kp + __shfl_xor(snd, 16); } }
        { const bool b3 = lane & 8;
#pragma unroll
          for (int j = 0; j < 2; ++j) { const float snd = b3 ? pt[j] : pt[j + 2], kp = b3 ? pt[j + 2] : pt[j]; pt[j] = kp + __shfl_xor(snd, 8); } }
        { const bool b2 = lane & 4; const float snd = b2 ? pt[0] : pt[1], kp = b2 ? pt[1] : pt[0]; pt[0] = kp + __shfl_xor(snd, 4); }
        pt[0] += __shfl_xor(pt[0], 2); pt[0] += __shfl_xor(pt[0], 1);
        if ((lane & 3) == 0) { const int j = ((lane >> 5) & 1) * 8 + ((lane >> 4) & 1) * 4 + ((lane >> 3) & 1) * 2 + ((lane >> 2) & 1);
            float val = pt[0] + p.gate_b[j];
            if ((j >> 2) & 1) val = fminf(val, 0.f) - log1pf(__expf(-fabsf(val)));
            GATES[(size_t)r * 16 + j] = val; }
    }
}
DI void ph_norm1(const Params& p, int mode) {
    const int tid = opaque_tid(), wid = tid >> 6, lane = tid & 63;
    const float* gsrc = mode ? p.final_g : p.norm_g + 1024;
    f32x4 g[4];
#pragma unroll
    for (int i = 0; i < 4; ++i) g[i] = *(const f32x4*)(gsrc + lane * 4 + 256 * i);
    const float* MOD = (const float*)(p.ws + WS_MOD) + (size_t)9 * 3072;
    const bf16_t* D0 = (const bf16_t*)p.ws; const bf16_t* D1 = (const bf16_t*)(p.ws + PLANE);
    bf16_t* HX1 = (bf16_t*)(p.ws + 2 * PLANE);
    f32x4 vn[4];
#define N1_LOAD(RR) do { const size_t _o = (size_t)(RR) * 1024 + lane * 4; \
        _Pragma("unroll") for (int i = 0; i < 4; ++i) vn[i] = *(const f32x4*)(p.x + _o + 256 * i); \
        _Pragma("unroll") for (int i = 0; i < 4; i += 2) { u32x2 qa, qb; ld_adj16(D0 + _o + 256 * i, D0 + _o + 256 * i + 256, lane, qa, qb); \
            vn[i] += (f32x4){lo_f(qa.x), hi_f(qa.x), lo_f(qa.y), hi_f(qa.y)}; vn[i + 1] += (f32x4){lo_f(qb.x), hi_f(qb.x), lo_f(qb.y), hi_f(qb.y)}; \
            if (mode) { ld_adj16(D1 + _o + 256 * i, D1 + _o + 256 * i + 256, lane, qa, qb); \
                vn[i] += (f32x4){lo_f(qa.x), hi_f(qa.x), lo_f(qa.y), hi_f(qa.y)}; vn[i + 1] += (f32x4){lo_f(qb.x), hi_f(qb.x), lo_f(qb.y), hi_f(qb.y)}; } } } while (0)
    { const int r = blockIdx.x * 8 + wid; if (r < NX) N1_LOAD(r); }
    for (int r = blockIdx.x * 8 + wid; r < NX; r += gridDim.x * 8) {
        const float* md = MOD + (size_t)(r >> 12) * 3072;
        f32x4 v[4]; float ss = 0.f;
#pragma unroll
        for (int i = 0; i < 4; ++i) { v[i] = vn[i]; ss += v[i][0] * v[i][0] + v[i][1] * v[i][1] + v[i][2] * v[i][2] + v[i][3] * v[i][3]; }
        { const int r2 = r + gridDim.x * 8; if (r2 < NX) N1_LOAD(r2); }
        ss = wave_sum(ss);
        const float rstd = rsqrtf(ss * (1.0f / 1024.0f) + 1e-6f);
        if (mode) {
#pragma unroll
            for (int i = 0; i < 4; ++i) *(f32x4*)(p.out + (size_t)r * 1024 + lane * 4 + 256 * i) = v[i] * rstd * g[i];
        } else {
            u32x2 w[4];
#pragma unroll
            for (int i = 0; i < 4; ++i) { const f32x4 sh = *(const f32x4*)(md + lane * 4 + 256 * i), sc = *(const f32x4*)(md + 1024 + lane * 4 + 256 * i);
                const f32x4 h = v[i] * rstd * g[i] * (sc + 1.0f) + sh; w[i].x = pk2(h[0], h[1]); w[i].y = pk2(h[2], h[3]); }
#pragma unroll
            for (int i = 0; i < 4; i += 2) { bf16_t* hp = HX1 + (size_t)r * 1024 + lane * 4 + 256 * i; st_adj16(hp, hp + 256, w[i], w[i + 1], lane); }
        }
    }
#undef N1_LOAD
}

DI void ph_conv(const Params& p) {
    const bf16_t* QRAW = (const bf16_t*)p.ws; const bf16_t* KRAW = (const bf16_t*)(p.ws + PLANE);
    const bf16_t* CQ = (const bf16_t*)(p.ws + WS_CRAW); const bf16_t* CK = CQ + (size_t)NCX * 1024;
    bf16_t* QC = (bf16_t*)p.out; bf16_t* KC = QC + (size_t)NX * 1024;
    bf16_t* CQC = (bf16_t*)(p.ws + WS_CQC); bf16_t* CKC = (bf16_t*)(p.ws + WS_CKC);
    const int tid = opaque_tid();
    const bool scanner = (blockIdx.x < 64) && (tid < 64) && (gridDim.x >= 64);
    const int nscan = gridDim.x >= 64 ? 64 : 0;
    const int active_id = (int)blockIdx.x < nscan ? (int)blockIdx.x * 448 + (tid - 64) : nscan * 448 + ((int)blockIdx.x - nscan) * 512 + tid;
    const int active_n = nscan * 448 + ((int)gridDim.x - nscan) * 512;
    if (!scanner)
    for (int idx = active_id; idx < (NR / 8) * 256; idx += active_n) {
        const int oct = idx & 127, which = (idx >> 7) & 1, r0 = (idx >> 8) * 8, ch = oct * 8;
        const bf16_t* src; bf16_t* dst; int t0, T;
        if (r0 < NX) { src = (which ? KRAW : QRAW) + (size_t)r0 * 1024 + ch; dst = (which ? KC : QC) + (size_t)r0 * 1024 + ch; t0 = r0 & 4095; T = 4096; }
        else { const int rr = r0 - NX; src = (which ? CK : CQ) + (size_t)rr * 1024 + ch; dst = (which ? CKC : CQC) + (size_t)rr * 1024 + ch; t0 = rr & 255; T = 256; }
        const u32x4 z = {0u, 0u, 0u, 0u};
        u32x4 v[10];
        v[0] = (t0 > 0) ? *(const u32x4*)(src - 1024) : z;
#pragma unroll
        for (int i = 0; i < 8; ++i) v[i + 1] = *(const u32x4*)(src + (size_t)i * 1024);
        v[9] = (t0 + 8 < T) ? *(const u32x4*)(src + (size_t)8 * 1024) : z;
        const float* w = p.conv_qk + which * 1024 + ch;
        float wt[3][8];
#pragma unroll
        for (int j = 0; j < 3; ++j) { const f32x4 wa = *(const f32x4*)(w + j * 2048), wb = *(const f32x4*)(w + j * 2048 + 4);
#pragma unroll
            for (int e = 0; e < 4; ++e) { wt[j][e] = wa[e]; wt[j][4 + e] = wb[e]; } }
        const float qs = which ? 1.0f : 0.0625f;
#pragma unroll
        for (int i = 0; i < 8; ++i) {
            float o[8];
#pragma unroll
            for (int e = 0; e < 4; ++e) {
                float lo = wt[0][2 * e] * lo_f(v[i][e]) + wt[1][2 * e] * lo_f(v[i + 1][e]) + wt[2][2 * e] * lo_f(v[i + 2][e]);
                float hi = wt[0][2 * e + 1] * hi_f(v[i][e]) + wt[1][2 * e + 1] * hi_f(v[i + 1][e]) + wt[2][2 * e + 1] * hi_f(v[i + 2][e]);
                o[2 * e] = silu_f(lo) * qs; o[2 * e + 1] = silu_f(hi) * qs;
            }
            u32x4 wv; wv.x = pk2(o[0], o[1]); wv.y = pk2(o[2], o[3]); wv.z = pk2(o[4], o[5]); wv.w = pk2(o[6], o[7]);
            *(u32x4*)(dst + (size_t)i * 1024) = wv;
        }
    }
    const int lane = tid & 63;
    const int n_sc = nscan ? 1 : 64;
    if (scanner || (nscan == 0 && blockIdx.x == 0 && tid < 64))
    for (int sc = 0; sc < n_sc; ++sc) {
        const int gw = nscan ? (int)blockIdx.x : sc;
        const int b = gw >> 3, h = (gw >> 1) & 3, dir = gw & 1;
        const float* GATES = (const float*)(p.ws + WS_GATES);
        float* GP = (float*)(p.ws + WS_GPRE) + (size_t)gw * 68 * 384;
        float m_prev = 0.f;
        auto grow_of = [&](int st) -> size_t { if (st < 4) { const int cc = dir ? 3 - st : st; return (size_t)NX + (size_t)b * 256 + cc * 64; } const int xc = st - 4, cc = dir ? 63 - xc : xc; return (size_t)b * 4096 + cc * 64; };
        const int oi = (dir ? 8 : 0) + h, of = (dir ? 12 : 4) + h;
        float nig = GATES[(grow_of(0) + lane) * 16 + oi], nlf = GATES[(grow_of(0) + lane) * 16 + of];
        for (int st = 0; st < 68; ++st) {
            const float ig = nig, lf = nlf;
            if (st + 1 < 68) { const size_t g2 = grow_of(st + 1); nig = GATES[(g2 + lane) * 16 + oi]; nlf = GATES[(g2 + lane) * 16 + of]; }
            float bs = lf;
#pragma unroll
            for (int o = 1; o < 64; o <<= 1) { const float ov = dir ? __shfl_down(bs, o) : __shfl_up(bs, o); const bool ok = dir ? (lane + o < 64) : (lane >= o); if (ok) bs += ov; }
            const float a = ig - bs;
            float mx = a;
#pragma unroll
            for (int o = 1; o < 64; o <<= 1) { const float ov = dir ? __shfl_down(mx, o) : __shfl_up(mx, o); const bool ok = dir ? (lane + o < 64) : (lane >= o); if (ok) mx = fmaxf(mx, ov); }
            const float total = __shfl(bs, dir ? 0 : 63);
            const float m_inter = bs + m_prev, m_t = fmaxf(bs + mx, m_inter);
            const float wsl = total - bs + ig;
            const float m_new = fmaxf(total + m_prev, wave_max(wsl));
            float* o = GP + (size_t)st * 384;
            o[lane] = bs - m_t; o[64 + lane] = a; o[128 + lane] = __expf(m_inter - m_t); o[192 + lane] = __expf(wsl - m_new); o[256 + lane] = __expf(-m_t);
            if (lane == 0) o[320] = __expf(total + m_prev - m_new);
            m_prev = m_new;
        }
    }
}

DI void ph_mlstm(const Params& p, LAS unsigned char* lds) {
    constexpr int QP = 528, VP = 176, SP = 144;
    LAS unsigned char* Qi = lds; LAS unsigned char* Ki = lds + 33792; LAS unsigned char* Vi0 = lds + 67584; LAS unsigned char* Vwi = Vi0 + 2 * 11264;
    LAS unsigned char* Sgi = Vwi + 11264; LAS unsigned char* Ci = Sgi + 9216; LAS float* fl0 = (LAS float*)(Ci + 42240);
    const int tid = opaque_tid(), wid = tid >> 6, lane = tid & 63, fr = lane & 15, fq = lane >> 4;
    const bf16_t* QC = (const bf16_t*)p.out; const bf16_t* KC = QC + (size_t)NX * 1024; const bf16_t* VPL = (const bf16_t*)(p.ws + 2 * PLANE);
    const bf16_t* CQC = (const bf16_t*)(p.ws + WS_CQC); const bf16_t* CKC = (const bf16_t*)(p.ws + WS_CKC); const bf16_t* CV = (const bf16_t*)(p.ws + WS_CRAW) + (size_t)2 * NCX * 1024;
    for (int wi = blockIdx.x; wi < 256; wi += gridDim.x) {
        const int b = wi >> 5, h = (wi >> 3) & 3, dir = (wi >> 2) & 1, es = wi & 3;
        bf16_t* Hout = (bf16_t*)(p.ws + (dir ? PLANE : 0));
        const float* GP = (const float*)(p.ws + WS_GPRE) + (size_t)((b * 4 + h) * 2 + dir) * 68 * 384;
        f32x4 Cst[2][5];
#pragma unroll
        for (int i = 0; i < 2; ++i)
#pragma unroll
            for (int n = 0; n < 5; ++n) Cst[i][n] = (f32x4){0.f, 0.f, 0.f, 0.f};
        __syncthreads();
        for (int i = tid; i < 64 * 8; i += 512) { const int row = i >> 3, c = i & 7;
            *(LAS unsigned*)(Vi0 + row * VP + 128 + c * 4) = 0x3F803F80u; *(LAS unsigned*)(Vi0 + 11264 + row * VP + 128 + c * 4) = 0x3F803F80u; *(LAS unsigned*)(Vwi + row * VP + 128 + c * 4) = 0u; }
        u32x4 rq[4], rk[4], rv; float pg = 0.f, pws = 0.f, pdecay = 0.f, decay = 0.f;
        const int mt = wid >> 1, nt0 = 2 * (wid & 1);
#define ML_LOAD(ST) do { const int _st = (ST); const bf16_t *_q, *_k, *_v; \
            if (_st < 4) { const int cc = dir ? 3 - _st : _st; const size_t row0 = (size_t)b * 256 + cc * 64; _q = CQC + row0 * 1024 + h * 256; _k = CKC + row0 * 1024 + h * 256; _v = CV + row0 * 1024 + h * 256 + es * 64; } \
            else { const int xc = _st - 4, cc = dir ? 63 - xc : xc; const size_t row0 = (size_t)b * 4096 + cc * 64; _q = QC + row0 * 1024 + h * 256; _k = KC + row0 * 1024 + h * 256; _v = VPL + row0 * 1024 + h * 256 + es * 64; } \
            _Pragma("unroll") for (int i = 0; i < 4; ++i) { const int id = tid + 512 * i, row = id >> 5, chk = id & 31; rq[i] = *(const u32x4*)(_q + (size_t)row * 1024 + chk * 8); rk[i] = *(const u32x4*)(_k + (size_t)row * 1024 + chk * 8); } \
            rv = *(const u32x4*)(_v + (size_t)(tid >> 3) * 1024 + (tid & 7) * 8); \
            const float* _g = GP + (size_t)_st * 384; pg = _g[tid < 320 ? tid : 0]; pws = _g[192 + (tid >> 3)]; pdecay = _g[320]; } while (0)
#define ML_WRITE(ST) do { LAS unsigned char* _Vi = Vi0 + ((ST) & 1) * 11264; LAS float* _fl = fl0 + ((ST) & 1) * 320; \
            _Pragma("unroll") for (int i = 0; i < 4; ++i) { const int id = tid + 512 * i, row = id >> 5, chk = id & 31; \
                *(LAS u32x4*)(Qi + row * QP + chk * 16) = rq[i]; *(LAS u32x4*)(Ki + row * QP + chk * 16) = rk[i]; } \
            *(LAS u32x4*)(_Vi + (tid >> 3) * VP + (tid & 7) * 16) = rv; \
            { const float w = pws; u32x4 o; \
              o.x = pk2(w * lo_f(rv.x), w * hi_f(rv.x)); o.y = pk2(w * lo_f(rv.y), w * hi_f(rv.y)); o.z = pk2(w * lo_f(rv.z), w * hi_f(rv.z)); o.w = pk2(w * lo_f(rv.w), w * hi_f(rv.w)); \
              *(LAS u32x4*)(Vwi + (tid >> 3) * VP + (tid & 7) * 16) = o; \
              if ((tid & 7) == 0) *(LAS unsigned*)(Vwi + (tid >> 3) * VP + 128) = pk2(w, 0.f); } \
            if (tid < 320) _fl[tid] = pg; \
            _Pragma("unroll") for (int i = 0; i < 2; ++i) _Pragma("unroll") for (int n = 0; n < 5; ++n) { u32x2 w; w.x = pk2(Cst[i][n][0], Cst[i][n][1]); w.y = pk2(Cst[i][n][2], Cst[i][n][3]); \
                *(LAS u32x2*)(Ci + (16 * n + fr) * QP + (16 * (2 * wid + i) + 4 * fq) * 2) = w; } \
            decay = pdecay; } while (0)
        ML_LOAD(0);
        __syncthreads();
        ML_WRITE(0);
        ML_LOAD(1);
        for (int st = 0; st < 68; ++st) {
            const bool isx = st >= 4;
            LAS unsigned char* Vi = Vi0 + (st & 1) * 11264; LAS float* fl = fl0 + (st & 1) * 320;
            LAS float* f_bt = fl; LAS float* f_aa = fl + 64; LAS float* f_inter = fl + 128; LAS float* f_enm = fl + 256;
            __syncthreads();
            const float dcy = decay;
            const int t = 16 * mt + fr;
            f32x4 accC[3];
#pragma unroll
            for (int n = 0; n < 3; ++n) accC[n] = (f32x4){0.f, 0.f, 0.f, 0.f};
            if (isx) {
                f32x4 sacc[2] = {(f32x4){0.f, 0.f, 0.f, 0.f}, (f32x4){0.f, 0.f, 0.f, 0.f}};
#pragma unroll
                for (int ks = 0; ks < 8; ++ks) { const bf16x8 qf = *(const LAS bf16x8*)(Qi + t * QP + (32 * ks + 8 * fq) * 2);
#pragma unroll
                    for (int n = 0; n < 2; ++n) { const bf16x8 kf = *(const LAS bf16x8*)(Ki + (16 * (nt0 + n) + fr) * QP + (32 * ks + 8 * fq) * 2); sacc[n] = mfma16(kf, qf, sacc[n]); }
#pragma unroll
                    for (int n = 0; n < 3; ++n) { const int et = (n < 2) ? nt0 + n : 4; const bf16x8 cf = *(const LAS bf16x8*)(Ci + (16 * et + fr) * QP + (32 * ks + 8 * fq) * 2); accC[n] = mfma16(cf, qf, accC[n]); } }
                const float btm = f_bt[t];
#pragma unroll
                for (int n = 0; n < 2; ++n) { const int s0 = 16 * (nt0 + n) + 4 * fq; const f32x4 a4 = *(const LAS f32x4*)(f_aa + s0); float vv[4];
#pragma unroll
                    for (int j = 0; j < 4; ++j) { const int s = s0 + j; const bool ok = dir ? (s >= t) : (s <= t); const float e = __expf(btm + a4[j]); vv[j] = ok ? sacc[n][j] * e : 0.f; }
                    u32x2 w; w.x = pk2(vv[0], vv[1]); w.y = pk2(vv[2], vv[3]); *(LAS u32x2*)(Sgi + t * SP + s0 * 2) = w; }
            }
#pragma unroll
            for (int i = 0; i < 2; ++i)
#pragma unroll
                for (int n = 0; n < 5; ++n) Cst[i][n] = Cst[i][n] * dcy;
#pragma unroll
            for (int ks = 0; ks < 2; ++ks) { bf16x8 kf[2];
#pragma unroll
                for (int i = 0; i < 2; ++i) kf[i] = tr_frag(Ki, QP, 32 * ks, 16 * (2 * wid + i), lane);
#pragma unroll
                for (int n = 0; n < 5; ++n) { const bf16x8 vw = tr_frag(Vwi, VP, 32 * ks, 16 * n, lane);
#pragma unroll
                    for (int i = 0; i < 2; ++i) Cst[i][n] = mfma16(kf[i], vw, Cst[i][n]); } }
            __syncthreads();
            if (isx) {
                f32x4 accD[3];
#pragma unroll
                for (int n = 0; n < 3; ++n) accD[n] = (f32x4){0.f, 0.f, 0.f, 0.f};
#pragma unroll
                for (int ks = 0; ks < 2; ++ks) { const bf16x8 sgf = *(const LAS bf16x8*)(Sgi + t * SP + (32 * ks + 8 * fq) * 2);
#pragma unroll
                    for (int n = 0; n < 3; ++n) { const int et = (n < 2) ? nt0 + n : 4; const bf16x8 vf = tr_frag(Vi, VP, 32 * ks, 16 * et, lane); accD[n] = mfma16(vf, sgf, accD[n]); } }
                const float inter_t = f_inter[t];
                const float den0 = accD[2][0] + inter_t * accC[2][0];
                const float den = __shfl(den0, fr);
                const float rden = 1.0f / fmaxf(fabsf(den), f_enm[t]);
                const int xc = st - 4, cc = dir ? 63 - xc : xc;
                bf16_t* hp = Hout + ((size_t)b * 4096 + cc * 64 + t) * 1024 + h * 256 + es * 64 + 4 * fq;
                u32x2 hw[2];
#pragma unroll
                for (int n = 0; n < 2; ++n) { const f32x4 hv = (accD[n] + accC[n] * inter_t) * rden; hw[n].x = pk2(hv[0], hv[1]); hw[n].y = pk2(hv[2], hv[3]); }
                st_pair16(hp + 16 * nt0, hw[0], hw[1], fq);
            }
            if (st + 1 < 68) { ML_WRITE(st + 1); if (st + 2 < 68) ML_LOAD(st + 2); }
        }
#undef ML_LOAD
#undef ML_WRITE
    }
}

template <int KK, int NN, class Cfg>
DI void axis_mix(const Cfg& cfg, LAS unsigned char* lds, int n_items) {
    constexpr int TP = 528, BP = KK * 2 + 16, NCH = KK / 16;
    LAS unsigned char* Ti = lds; LAS unsigned char* Bi = lds + 128 * TP;
    const int tid = opaque_tid(), wid = tid >> 6, lane = tid & 63, fr = lane & 15, fq = lane >> 4;
    __syncthreads();
    cfg.fill_tables(Bi, tid);
    u32x4 ra[NCH], rb[NCH];
    const int G = gridDim.x;
#define AX_LOAD(R, IT) do { if ((IT) < n_items) { _Pragma("unroll") for (int i = 0; i < NCH; ++i) { const int id = tid + 512 * i; R[i] = *(const u32x4*)(cfg.row_ptr((IT), id >> 5) + (id & 31) * 8); } } } while (0)
#define AX_BODY(R, IT, PRE) do { \
        __syncthreads(); \
        _Pragma("unroll") for (int i = 0; i < NCH; ++i) { const int id = tid + 512 * i; *(LAS u32x4*)(Ti + (id >> 5) * TP + (id & 31) * 16) = R[i]; } \
        __syncthreads(); \
        AX_LOAD(R, PRE); \
        f32x4 acc[2][NN / 16]; \
        _Pragma("unroll") for (int i = 0; i < 2; ++i) _Pragma("unroll") for (int n = 0; n < NN / 16; ++n) acc[i][n] = (f32x4){0.f, 0.f, 0.f, 0.f}; \
        LAS unsigned char* tb = Bi + cfg.table_off(IT); \
        _Pragma("unroll") for (int ks = 0; ks < KK / 32; ++ks) { bf16x8 af[2]; \
            _Pragma("unroll") for (int i = 0; i < 2; ++i) af[i] = tr_frag(Ti, TP, 32 * ks, 32 * wid + 16 * i, lane); \
            _Pragma("unroll") for (int n = 0; n < NN / 16; ++n) { const bf16x8 bfr = *(const LAS bf16x8*)(tb + (16 * n + fr) * BP + (32 * ks + 8 * fq) * 2); \
                _Pragma("unroll") for (int i = 0; i < 2; ++i) acc[i][n] = mfma16(af[i], bfr, acc[i][n]); } } \
        cfg.epilogue(acc, (IT), wid, fr, fq, Bi); } while (0)
    int item = blockIdx.x;
    AX_LOAD(ra, item); AX_LOAD(rb, item + G);
    for (; item < n_items; item += 2 * G) {
        AX_BODY(ra, item, item + 2 * G);
        if (item + G < n_items) AX_BODY(rb, item + G, item + 3 * G);
    }
#undef AX_LOAD
#undef AX_BODY
}
DI void fill_dft_table(LAS unsigned char* Bi, int tid, int nrows) {
    for (int idx = tid; idx < nrows * 128; idx += 512) { const int n = idx >> 7, k = idx & 127, ap = n & 63, kk = k & 63; float s, c; sincospif((float)((kk * ap) & 63) / 32.0f, &s, &c);
        float v; if (n < 64) v = (k < 64) ? c : s; else v = (k < 64) ? -s : c;
        *(LAS unsigned short*)(Bi + n * 272 + k * 2) = (unsigned short)(pk2(v * 0.125f, 0.f) & 0xffffu); }
}
struct CfgDft1 {
    const bf16_t* Z; bf16_t* S1re; bf16_t* S1im;
    DI void fill_tables(LAS unsigned char* Bi, int tid) const { fill_dft_table(Bi, tid, 128); }
    DI int table_off(int) const { return 0; }
    DI const bf16_t* row_ptr(int item, int k) const { const int g = item & 3, b = (item >> 2) & 63, batch = item >> 8;
        return Z + ((size_t)batch * 4096 + 64 * (k & 63) + b) * 2048 + g * 512 + (k >> 6) * 256; }
    DI void epilogue(const f32x4 (&acc)[2][8], int item, int wid, int fr, int fq, LAS unsigned char* Bi) const {
        const int g = item & 3, b = (item >> 2) & 63, batch = item >> 8;
#pragma unroll
        for (int ni = 0; ni < 4; ++ni) { const int ap = 16 * ni + fr; float s, c; sincospif((float)(b * ap) * (1.0f / 2048.0f), &s, &c);
            const size_t tok = (size_t)batch * 4096 + 64 * ap + b;
            u32x2 wr[2], wi[2];
#pragma unroll
            for (int i = 0; i < 2; ++i) { const f32x4 re = acc[i][ni], im = acc[i][ni + 4]; const f32x4 r2 = re * c + im * s, i2 = im * c - re * s;
                wr[i].x = pk2(r2[0], r2[1]); wr[i].y = pk2(r2[2], r2[3]); wi[i].x = pk2(i2[0], i2[1]); wi[i].y = pk2(i2[2], i2[3]); }
            { const size_t o = tok * 1024 + g * 256 + 32 * wid + 4 * fq; st_pair16(S1re + o, wr[0], wr[1], fq); st_pair16(S1im + o, wi[0], wi[1], fq); } }
    }
};
struct CfgDft2 {
    const bf16_t* S1re; const bf16_t* S1im; const bf16_t* ZB; bf16_t* Y;
    DI void fill_tables(LAS unsigned char* Bi, int tid) const { fill_dft_table(Bi, tid, 64); }
    DI int table_off(int) const { return 0; }
    DI const bf16_t* row_ptr(int item, int k) const { const int g = item & 3, ap = (item >> 2) & 63, batch = item >> 8;
        return ((k >> 6) ? S1im : S1re) + ((size_t)batch * 4096 + 64 * ap + (k & 63)) * 1024 + g * 256; }
    DI void epilogue(const f32x4 (&acc)[2][4], int item, int wid, int fr, int fq, LAS unsigned char*) const {
        const int g = item & 3, ap = (item >> 2) & 63, batch = item >> 8;
#pragma unroll
        for (int ni = 0; ni < 4; ++ni) { const size_t tok = (size_t)batch * 4096 + ap + 64 * (16 * ni + fr);
            u32x2 w[2], zz[2]; ld_pair16(ZB + tok * 1024 + g * 256 + 32 * wid + 4 * fq, fq, zz[0], zz[1]);
#pragma unroll
            for (int i = 0; i < 2; ++i) { const u32x2 z = zz[i]; const f32x4 a = acc[i][ni];
                w[i].x = pk2(a[0] * silu_f(lo_f(z.x)), a[1] * silu_f(hi_f(z.x))); w[i].y = pk2(a[2] * silu_f(lo_f(z.y)), a[3] * silu_f(hi_f(z.y))); }
            st_pair16(Y + tok * 2048 + 1024 + g * 256 + 32 * wid + 4 * fq, w[0], w[1], fq); }
    }
};
DI void fill_pool_tables(LAS unsigned char* Bi, int tid) {
    for (int idx = tid; idx < 4 * 4096; idx += 512) { const int g = idx >> 12, n = (idx >> 6) & 63, k = idx & 63, w = 2 << g, lo = n - w / 2, hi = n + w - w / 2;
        *(LAS unsigned short*)(Bi + g * 9216 + n * 144 + k * 2) = (k >= lo && k < hi) ? (unsigned short)0x3F80 : (unsigned short)0; }
}
DI float pool_rcnt(int g, int n) { const int w = 2 << g; int lo = n - w / 2, hi = n + w - w / 2; lo = lo < 0 ? 0 : lo; hi = hi > 64 ? 64 : hi; return 1.0f / (float)(hi - lo); }
struct CfgPoolA {
    const bf16_t* UC; bf16_t* PA;
    DI void fill_tables(LAS unsigned char* Bi, int tid) const { fill_pool_tables(Bi, tid); }
    DI int table_off(int item) const { return ((item & 7) >> 1) * 9216; }
    DI const bf16_t* row_ptr(int item, int k) const { const int ct = item & 7, c = (item >> 3) & 63, batch = item >> 9; return UC + ((size_t)batch * 4096 + 64 * k + c) * 2048 + ct * 256; }
    DI void epilogue(const f32x4 (&acc)[2][4], int item, int wid, int fr, int fq, LAS unsigned char*) const {
        const int ct = item & 7, c = (item >> 3) & 63, batch = item >> 9, g = ct >> 1;
#pragma unroll
        for (int ni = 0; ni < 4; ++ni) { const int n = 16 * ni + fr; const float rc = pool_rcnt(g, n); const size_t tok = (size_t)batch * 4096 + 64 * n + c;
            u32x2 w[2];
#pragma unroll
            for (int i = 0; i < 2; ++i) { const f32x4 a = acc[i][ni] * rc; w[i].x = pk2(a[0], a[1]); w[i].y = pk2(a[2], a[3]); }
            st_pair16(PA + tok * 2048 + ct * 256 + 32 * wid + 4 * fq, w[0], w[1], fq); }
    }
};
struct CfgPoolB {
    const bf16_t* PA; bf16_t* UC;
    DI void fill_tables(LAS unsigned char* Bi, int tid) const { fill_pool_tables(Bi, tid); }
    DI int table_off(int item) const { return ((item & 7) >> 1) * 9216; }
    DI const bf16_t* row_ptr(int item, int k) const { const int ct = item & 7, rp = (item >> 3) & 63, batch = item >> 9; return PA + ((size_t)batch * 4096 + 64 * rp + k) * 2048 + ct * 256; }
    DI void epilogue(const f32x4 (&acc)[2][4], int item, int wid, int fr, int fq, LAS unsigned char*) const {
        const int ct = item & 7, rp = (item >> 3) & 63, batch = item >> 9, g = ct >> 1;
#pragma unroll
        for (int ni = 0; ni < 4; ++ni) { const int n = 16 * ni + fr; const float rc = pool_rcnt(g, n); const size_t tok = (size_t)batch * 4096 + 64 * rp + n;
            u32x2 w[2]; bf16_t* up0 = UC + tok * 2048 + ct * 256 + 32 * wid + 4 * fq;
            u32x2 uu[2]; ld_pair16(up0, fq, uu[0], uu[1]);
#pragma unroll
            for (int i = 0; i < 2; ++i) { const u32x2 u = uu[i]; const f32x4 a = acc[i][ni] * rc;
                w[i].x = pk2(a[0] - lo_f(u.x), a[1] - hi_f(u.x)); w[i].y = pk2(a[2] - lo_f(u.y), a[3] - hi_f(u.y)); }
            st_pair16(up0, w[0], w[1], fq); }
    }
};

DI void ph_ya(const Params& p) {
    const int tid = opaque_tid(), wid = tid >> 6, lane = tid & 63;
    const bf16_t* HF = (const bf16_t*)p.ws; const bf16_t* HB = (const bf16_t*)(p.ws + PLANE); const bf16_t* O = (const bf16_t*)(p.ws + 3 * PLANE); const bf16_t* ZA = (const bf16_t*)(p.ws + 4 * PLANE);
    bf16_t* Y = (bf16_t*)p.out;
    f32x4 hg[4];
#pragma unroll
    for (int i = 0; i < 4; ++i) hg[i] = *(const f32x4*)(p.head_norm + lane * 16 + 4 * i);
    for (int r = blockIdx.x * 8 + wid; r < NX; r += gridDim.x * 8) {
        const size_t o = (size_t)r * 1024 + lane * 16;
        float gv[16], za[16]; float ss = 0.f;
#pragma unroll
        for (int hh = 0; hh < 2; ++hh) { const u32x4 a = *(const u32x4*)(HF + o + 8 * hh), bq = *(const u32x4*)(HB + o + 8 * hh), oo = *(const u32x4*)(O + o + 8 * hh), zz = *(const u32x4*)(ZA + o + 8 * hh);
#pragma unroll
            for (int e = 0; e < 4; ++e) { const float h0 = lo_f(a[e]) + lo_f(bq[e]), h1 = hi_f(a[e]) + hi_f(bq[e]);
                const float g0 = sigmoid_f(lo_f(oo[e])) * h0, g1 = sigmoid_f(hi_f(oo[e])) * h1;
                gv[8 * hh + 2 * e] = g0; gv[8 * hh + 2 * e + 1] = g1; ss += g0 * g0 + g1 * g1; za[8 * hh + 2 * e] = lo_f(zz[e]); za[8 * hh + 2 * e + 1] = hi_f(zz[e]); } }
        ss += __shfl_xor(ss, 1); ss += __shfl_xor(ss, 2); ss += __shfl_xor(ss, 4); ss += __shfl_xor(ss, 8);
        const float rstd = rsqrtf(ss * (1.0f / 256.0f) + 1e-6f);
        u32x4 w[2];
#pragma unroll
        for (int q = 0; q < 8; ++q) { const float y0 = gv[2 * q] * rstd * hg[q >> 1][(2 * q) & 3] * silu_f(za[2 * q]), y1 = gv[2 * q + 1] * rstd * hg[q >> 1][(2 * q + 1) & 3] * silu_f(za[2 * q + 1]);
            w[q >> 2][q & 3] = pk2(y0, y1); }
        *(u32x4*)(Y + (size_t)r * 2048 + lane * 16) = w[0]; *(u32x4*)(Y + (size_t)r * 2048 + lane * 16 + 8) = w[1];
    }
}


#define XB_TMO      128
#define XB_XCNT(j)  (256  + 64 * (j))
#define XB_XSUB(j)  (1280 + 64 * (j))
#define XB_XGEN(j)  (2304 + 64 * (j))
#define XB_TOP      3328
#define XB_TOPGEN   3392
#define XCD_BAR_WORDS 3456
#define XB_SPIN_CAP (1u << 18)
DI unsigned xb_ld(unsigned* p)              { return __hip_atomic_load(p, __ATOMIC_RELAXED, __HIP_MEMORY_SCOPE_AGENT); }
DI unsigned xb_add(unsigned* p, unsigned v) { return __hip_atomic_fetch_add(p, v, __ATOMIC_RELAXED, __HIP_MEMORY_SCOPE_AGENT); }
DI unsigned xb_xcc_id() { return (unsigned)__builtin_amdgcn_s_getreg((3 << 11) | 20) & 0xFu; }
#define XB_SPIN(cond, bar) do { unsigned _sp = 0; while (cond) { __builtin_amdgcn_s_sleep(1); \
    if ((++_sp & 255u) == 0u) { if (xb_ld(&(bar)[XB_TMO])) break; if (_sp > XB_SPIN_CAP) { atomicAdd(&(bar)[XB_TMO], 1u); break; } } } } while (0)
struct XcdBarrier { unsigned* bar; unsigned x; volatile LAS unsigned* st; };
DI XcdBarrier xcd_barrier_post(unsigned* bar, volatile LAS unsigned* st) {
    XcdBarrier b; b.bar = bar; b.x = xb_xcc_id(); b.st = st;
    if (threadIdx.x == 0) (void)xb_add(&bar[XB_XCNT(b.x)], 1u);
    return b;
}
DI void xcd_barrier_complete(unsigned* bar, unsigned x, unsigned& nloc, unsigned& nx) {
    const unsigned G = gridDim.x * gridDim.y * gridDim.z;
    unsigned sum, cnt, mine, sp = 0u;
    for (;;) {
        sum = 0u; cnt = 0u; mine = 0u;
#pragma unroll
        for (unsigned j = 0; j < 16; ++j) { const unsigned c = xb_ld(&bar[XB_XCNT(j)]); sum += c; cnt += (c > 0u) ? 1u : 0u; mine = (j == x) ? c : mine; }
        if (sum == G) break;
        __builtin_amdgcn_s_sleep(1);
        if ((++sp & 255u) == 0u) { if (xb_ld(&bar[XB_TMO])) break; if (sp > XB_SPIN_CAP) { atomicAdd(&bar[XB_TMO], 1u); break; } }
    }
    nloc = mine > 0u ? mine : 1u; nx = cnt > 0u ? cnt : 1u;
}
DI void xcd_barrier(const XcdBarrier& b) {
    asm volatile("s_waitcnt vmcnt(0)" ::: "memory");
    __syncthreads();
    if (threadIdx.x == 0) {
        unsigned* bar = b.bar;
        __builtin_amdgcn_s_waitcnt(0);
        unsigned nloc = b.st[0], nx = b.st[1];
        if (nloc == 0u) { xcd_barrier_complete(bar, b.x, nloc, nx); b.st[0] = nloc; b.st[1] = nx; }
        const unsigned old = xb_add(&bar[XB_XSUB(b.x)], 1u);
        const unsigned gen = old / nloc;
        if (old + 1u == (gen + 1u) * nloc) {
            __builtin_amdgcn_fence(__ATOMIC_RELEASE, "agent");
            asm volatile("s_waitcnt vmcnt(0)" ::: "memory");
            const unsigned og = xb_add(&bar[XB_TOP], 1u);
            const unsigned tg = og / nx;
            if (og + 1u == (tg + 1u) * nx) xb_add(&bar[XB_TOPGEN], 1u);
            else XB_SPIN(xb_ld(&bar[XB_TOPGEN]) == tg, bar);
            __builtin_amdgcn_fence(__ATOMIC_ACQUIRE, "agent");
            xb_add(&bar[XB_XGEN(b.x)], 1u);
            asm volatile("s_waitcnt vmcnt(0)" ::: "memory");
        } else {
            XB_SPIN(xb_ld(&bar[XB_XGEN(b.x)]) == gen, bar);
            __builtin_amdgcn_fence(__ATOMIC_ACQUIRE, "agent");
            asm volatile("s_waitcnt vmcnt(0)" ::: "memory");
        }
    }
    __syncthreads();
}

__global__ void __launch_bounds__(512, 2) mk_fwd(Params p, int ph_lo, int ph_hi) {
    extern __shared__ __attribute__((aligned(16))) unsigned char shm[];
    LAS unsigned char* lds = (LAS unsigned char*)shm;
    cg::grid_group grid = cg::this_grid();
    unsigned char* ws = p.ws;
    const int G = gridDim.x, c = blockIdx.x;
    volatile LAS unsigned* xst = (volatile LAS unsigned*)(lds + LDS_BYTES - 16);
    if (threadIdx.x == 0) { xst[0] = 0u; xst[1] = 0u; }
    __syncthreads();
    XcdBarrier xbar; xbar.bar = (unsigned*)(ws + WS_BAR); xbar.x = 0u; xbar.st = xst;
    if (ph_hi - ph_lo > 1) xbar = xcd_barrier_post((unsigned*)(ws + WS_BAR), xst);
    if (ph_lo > 1000) grid.sync();
#ifndef PHMASK
#define PHMASK 0xFFFF
#endif
#define GSYNC() xcd_barrier(xbar)
#ifndef REP_MASK
#define REP_MASK 0
#endif
#define PHASE(i, ...) if constexpr ((PHMASK >> (i)) & 1) if (ph_lo <= (i) && (i) < ph_hi) { __VA_ARGS__; if constexpr ((REP_MASK >> (i)) & 1) { __syncthreads(); __VA_ARGS__; } if ((i) + 1 < ph_hi) GSYNC(); }
    PHASE(0, ph_prep(p, lds));
    PHASE(1, ph_norm0(p, lds));
    PHASE(2, { GemmD g{(const bf16_t*)p.out, (const bf16_t*)(ws + WS_WINE), 1024, 1024, 0, 0, 1024}; Sched S{128, 28, 1, 8, 12, 128, G, c};
               EpiPlanes E{(bf16_t*)ws, (bf16_t*)(ws + WS_CRAW)}; gemm_phase(lds, g, S, E);
               if (G > 96 && c >= 96) transpose_jobs(p, lds, opaque_tid(), 2304, 4096, c - 96, G - 96); else if (G <= 96) transpose_jobs(p, lds, opaque_tid(), 2304, 4096, c, G); });
    PHASE(3, ph_conv(p));
    PHASE(4, ph_mlstm(p, lds));
    PHASE(5, { GemmD g{(const bf16_t*)(ws + 5 * PLANE), (const bf16_t*)(ws + WS_WF), 1024, 256, 256, 512 * 256, 256}; Sched S{128, 2, 4, 0, 0, 0, G, c};
               EpiBf E{(bf16_t*)p.out, nullptr, 2048, 512, 0, nullptr, nullptr}; gemm_phase(lds, g, S, E); });
    PHASE(6, { CfgDft1 cf{(const bf16_t*)p.out, (bf16_t*)(ws + 2 * PLANE), (bf16_t*)(ws + 5 * PLANE)}; axis_mix<128, 128>(cf, lds, 2048); });
    PHASE(7, { CfgDft2 cf{(const bf16_t*)(ws + 2 * PLANE), (const bf16_t*)(ws + 5 * PLANE), (const bf16_t*)(ws + 6 * PLANE), (bf16_t*)p.out}; axis_mix<128, 64>(cf, lds, 2048); ph_ya(p); });
    PHASE(8, { GemmD g{(const bf16_t*)p.out, (const bf16_t*)(ws + WS_WOUTE), 2048, 2048, 0, 0, 2048}; Sched S{128, 4, 1, 0, 0, 0, G, c};
               EpiGate E{(bf16_t*)ws, (const float*)(ws + WS_MOD) + 2048}; gemm_phase(lds, g, S, E); });
    PHASE(9, ph_norm1(p, 0));
    PHASE(10, { GemmD g{(const bf16_t*)(ws + 2 * PLANE), (const bf16_t*)(ws + WS_WINO), 1024, 1024, 0, 0, 1024}; Sched S{128, 16, 1, 0, 0, 0, G, c};
                EpiBf E{(bf16_t*)(ws + 3 * PLANE), (bf16_t*)(ws + 5 * PLANE), 2048, 0, 1, nullptr, nullptr}; gemm_phase(lds, g, S, E); });
    PHASE(11, { CfgPoolA cf{(const bf16_t*)(ws + 3 * PLANE), (bf16_t*)p.out}; axis_mix<64, 64>(cf, lds, 4096); });
    PHASE(12, { CfgPoolB cf{(const bf16_t*)p.out, (bf16_t*)(ws + 3 * PLANE)}; axis_mix<64, 64>(cf, lds, 4096); });
    PHASE(13, { GemmD g{(const bf16_t*)(ws + 3 * PLANE), (const bf16_t*)(ws + WS_WPOOL), 2048, 512, 512, 512 * 512, 512}; Sched S{128, 2, 4, 0, 0, 0, G, c};
                EpiBf E{(bf16_t*)p.out, nullptr, 2048, 512, 2, p.pool_scale, (const bf16_t*)(ws + 5 * PLANE)}; gemm_phase(lds, g, S, E); });
    PHASE(14, { GemmD g{(const bf16_t*)p.out, (const bf16_t*)(ws + WS_WOUTO), 2048, 2048, 0, 0, 2048}; Sched S{128, 4, 1, 0, 0, 0, G, c};
                EpiGate E{(bf16_t*)(ws + PLANE), (const float*)(ws + WS_MOD) + 9 * 3072 + 2048}; gemm_phase(lds, g, S, E); });
    PHASE(15, ph_norm1(p, 1));
#undef PHASE
#ifdef XSYNC
    for (int k = 0; k < XSYNC; ++k) GSYNC();
#endif
#ifdef DBG_STOP
    GSYNC();
    {   const size_t n = (size_t)NX * 1024; unsigned* o32 = (unsigned*)p.out;
        for (size_t i = (size_t)blockIdx.x * 512 + threadIdx.x; i < n; i += (size_t)gridDim.x * 512) {
            float v = 0.f;
            if (DBG_PLANES == -1) { const unsigned u = o32[i]; v = lo_f(u) + hi_f(u); }
            else if (DBG_PLANES == -2) { v = ((const float*)p.ws)[i]; }
            else { for (int pl = 0; pl < 7; ++pl) if ((DBG_PLANES >> pl) & 1) v += bf2f(((const bf16_t*)(p.ws + pl * PLANE))[i]); }
            if (!(fabsf(v) < 1e30f)) v = 12345.f;
            p.out[i] = v; } }
#endif
}

extern "C" void kernel_launch(void* const* d_in, const int* in_sizes, int n_in, void* d_out, int out_size, void* d_ws, size_t ws_size, hipStream_t stream) {
    static int grid = 0;
    if (grid == 0) {
        int dev = 0, cus = 0, per_cu = 0;
        hipGetDevice(&dev);
        hipDeviceGetAttribute(&cus, hipDeviceAttributeMultiprocessorCount, dev);
        if (hipFuncSetAttribute((const void*)mk_fwd, hipFuncAttributeMaxDynamicSharedMemorySize, LDS_BYTES) != hipSuccess) fprintf(stderr, "hipFuncSetAttribute failed\n");
        if (hipOccupancyMaxActiveBlocksPerMultiprocessor(&per_cu, (const void*)mk_fwd, 512, LDS_BYTES) != hipSuccess || per_cu < 1) { fprintf(stderr, "occupancy query: %d\n", per_cu); per_cu = 1; }
        (void)hipGetLastError();
        grid = cus * per_cu; if (grid > 256) grid = 256; if (grid < 1) grid = 1;
        if (ws_size < WS_END) fprintf(stderr, "workspace too small: %zu < %zu\n", ws_size, (size_t)WS_END);
    }
    Params p{};
    p.x = (const float*)d_in[0]; p.c = (const float*)d_in[1]; p.ctx = (const float*)d_in[2]; p.c_ctx = (const float*)d_in[3]; p.ada_w = (const float*)d_in[4]; p.ada_b = (const float*)d_in[5];
    p.norm_g = (const float*)d_in[6]; p.win_even = (const float*)d_in[7]; p.gate_b = (const float*)d_in[8]; p.conv_qk = (const float*)d_in[9]; p.head_norm = (const float*)d_in[10];
    p.fourier_w = (const float*)d_in[11]; p.wout_even = (const float*)d_in[12]; p.win_odd = (const float*)d_in[13]; p.pool_w = (const float*)d_in[14]; p.pool_scale = (const float*)d_in[15];
    p.wout_odd = (const float*)d_in[16]; p.final_g = (const float*)d_in[17]; p.out = (float*)d_out; p.ws = (unsigned char*)d_ws;
    (void)hipMemsetAsync((unsigned char*)d_ws + WS_BAR, 0, XCD_BAR_WORDS * 4, stream);
#if MK_MULTI
    for (int ph = 0; ph < 16; ++ph) { hipLaunchKernelGGL(mk_fwd, dim3(grid), dim3(512), LDS_BYTES, stream, p, ph, ph + 1); }
#else
#ifdef DBG_STOP
    int lo = 0, hi = DBG_STOP;
#else
    int lo = 0, hi = 16;
#endif
    void* args[] = {&p, &lo, &hi};
    hipError_t e = hipLaunchCooperativeKernel((void*)mk_fwd, dim3(grid), dim3(512), args, LDS_BYTES, stream);
    if (e != hipSuccess) fprintf(stderr, "cooperative launch failed: %s (grid %d)\n", hipGetErrorString(e), grid);
#endif
}
```

```cpp
#include <hip/hip_runtime.h>
#include <hip/hip_cooperative_groups.h>
#include <cstdio>
namespace cg = cooperative_groups;

#ifndef MK_MULTI
#define MK_MULTI 0
#endif

#define LAS __attribute__((address_space(3)))
typedef unsigned short bf16_t;
typedef short bf16x8 __attribute__((ext_vector_type(8)));
typedef short s16x4 __attribute__((ext_vector_type(4)));
typedef float f32x4 __attribute__((ext_vector_type(4)));
typedef unsigned u32x4 __attribute__((ext_vector_type(4)));
typedef unsigned u32x2 __attribute__((ext_vector_type(2)));

constexpr int NX = 32768, NCX = 2048, NR = NX + NCX;
constexpr size_t PLANE = (size_t)NX * 1024 * 2;
constexpr size_t WS_EXTRA = 7 * PLANE;
constexpr size_t WS_WINE  = WS_EXTRA;
constexpr size_t WS_WOUTE = WS_WINE  + (size_t)7168 * 1024 * 2;
constexpr size_t WS_WINO  = WS_WOUTE + (size_t)1024 * 2048 * 2;
constexpr size_t WS_WPOOL = WS_WINO  + (size_t)4096 * 1024 * 2;
constexpr size_t WS_WOUTO = WS_WPOOL + (size_t)4 * 512 * 512 * 2;
constexpr size_t WS_WF    = WS_WOUTO + (size_t)1024 * 2048 * 2;
constexpr size_t WS_MOD   = WS_WF    + (size_t)4 * 512 * 256 * 2;
constexpr size_t WS_GATES = WS_MOD   + 262144;
constexpr size_t WS_CRAW  = WS_GATES + (size_t)NR * 16 * 4;
constexpr size_t WS_CQC   = WS_CRAW  + (size_t)3 * NCX * 1024 * 2;
constexpr size_t WS_CKC   = WS_CQC   + (size_t)NCX * 1024 * 2;
constexpr size_t WS_END   = WS_CKC   + (size_t)NCX * 1024 * 2;
constexpr size_t WS_GPRE  = WS_END + 16384;
constexpr size_t WS_GPRE_END = WS_GPRE + (size_t)64 * 68 * 384 * 4;
static_assert(WS_GPRE_END <= (size_t)512 * 1024 * 1024, "gate tables exceed the workspace");
constexpr size_t WS_BAR   = WS_END;
static_assert(WS_BAR + 16384 <= (size_t)512 * 1024 * 1024, "workspace map exceeds 512 MiB");

constexpr int LDS_BYTES = 155648;

struct Params {
    const float* x; const float* c; const float* ctx; const float* c_ctx; const float* ada_w; const float* ada_b; const float* norm_g;
    const float* win_even; const float* gate_b; const float* conv_qk; const float* head_norm; const float* fourier_w; const float* wout_even;
    const float* win_odd; const float* pool_w; const float* pool_scale; const float* wout_odd; const float* final_g;
    float* out; unsigned char* ws;
};

#define DI __device__ __forceinline__
DI float bf2f(unsigned short b) { return __uint_as_float(((unsigned)b) << 16); }
DI float lo_f(unsigned u) { return __uint_as_float(u << 16); }
DI float hi_f(unsigned u) { return __uint_as_float(u & 0xffff0000u); }
typedef __bf16 bf16v2_t __attribute__((ext_vector_type(2)));
typedef float f32v2_t __attribute__((ext_vector_type(2)));
DI unsigned pk2(float lo, float hi) { const f32v2_t v = {lo, hi}; const bf16v2_t b = __builtin_convertvector(v, bf16v2_t); return __builtin_bit_cast(unsigned, b); }
DI float silu_f(float x) { return x / (1.0f + __expf(-x)); }
DI float sigmoid_f(float x) { return 1.0f / (1.0f + __expf(-x)); }
DI int opaque_tid() { int t = threadIdx.x; asm volatile("" : "+v"(t)); return t; }
DI float wave_sum(float v) { for (int o = 32; o > 0; o >>= 1) v += __shfl_xor(v, o); return v; }
DI float wave_max(float v) { for (int o = 32; o > 0; o >>= 1) v = fmaxf(v, __shfl_xor(v, o)); return v; }
DI void st_pair16(bf16_t* base0, u32x2 w0, u32x2 w1, int fq) {
    const auto rx = __builtin_amdgcn_permlane16_swap(w0.x, w1.x, false, false);
    const auto ry = __builtin_amdgcn_permlane16_swap(w0.y, w1.y, false, false);
    u32x4 v; v.x = rx[0]; v.y = ry[0]; v.z = rx[1]; v.w = ry[1];
    *(u32x4*)((fq & 1) ? base0 + 12 : base0) = v;
}
DI unsigned swap1(unsigned x) { return (unsigned)__builtin_amdgcn_mov_dpp((int)x, 0xB1, 0xF, 0xF, true); }
DI void st_adj16(bf16_t* pa, bf16_t* pb, u32x2 a, u32x2 b, int lane) {
    const bool odd = lane & 1;
    const unsigned rx = swap1(odd ? a.x : b.x), ry = swap1(odd ? a.y : b.y);
    u32x4 v; v.x = odd ? rx : a.x; v.y = odd ? ry : a.y; v.z = odd ? b.x : rx; v.w = odd ? b.y : ry;
    *(u32x4*)(odd ? pb - 4 : pa) = v;
}
DI void ld_adj16(const bf16_t* pa, const bf16_t* pb, int lane, u32x2& a, u32x2& b) {
    const bool odd = lane & 1;
    const u32x4 v = *(const u32x4*)(odd ? pb - 4 : pa);
    const unsigned rx = swap1(odd ? v.x : v.z), ry = swap1(odd ? v.y : v.w);
    a.x = odd ? rx : v.x; a.y = odd ? ry : v.y; b.x = odd ? v.z : rx; b.y = odd ? v.w : ry;
}
DI void ld_pair16(const bf16_t* base0, int fq, u32x2& w0, u32x2& w1) {
    const u32x4 v = *(const u32x4*)((fq & 1) ? base0 + 12 : base0);
    const auto rx = __builtin_amdgcn_permlane16_swap(v.x, v.z, false, false);
    const auto ry = __builtin_amdgcn_permlane16_swap(v.y, v.w, false, false);
    w0.x = rx[0]; w1.x = rx[1]; w0.y = ry[0]; w1.y = ry[1];
}
DI f32x4 mfma16(bf16x8 a, bf16x8 b, f32x4 c) { return __builtin_amdgcn_mfma_f32_16x16x32_bf16(a, b, c, 0, 0, 0); }
DI bf16x8 tr_frag(LAS unsigned char* img, int pitch, int krow0, int col0, int lane) {
    const int g = lane >> 4, q = (lane & 15) >> 2, pp = lane & 3;
    LAS unsigned char* a0 = img + (krow0 + 8 * g + q) * pitch + col0 * 2 + 8 * pp;
    s16x4 lo = __builtin_amdgcn_ds_read_tr16_b64_v4i16((LAS s16x4*)a0);
    s16x4 hi = __builtin_amdgcn_ds_read_tr16_b64_v4i16((LAS s16x4*)(a0 + 4 * pitch));
    return __builtin_shufflevector(lo, hi, 0, 1, 2, 3, 4, 5, 6, 7);
}

constexpr int HTB = 128 * 64 * 2;
DI int lds_byte(int r, int c) { const int st = (r >> 4) * 2 + (c >> 5), rr = r & 15, cc = c & 31, ob = rr * 64 + cc * 2; return st * 1024 + (ob ^ (((ob >> 9) & 1) << 5)); }
DI void stage_rc(int b, int& R, int& C) { const int st = b / 1024, sb = b % 1024, swz = sb ^ (((sb >> 9) & 1) << 5); R = (st >> 1) * 16 + swz / 64; C = (st & 1) * 32 + (swz % 64) / 2; }
DI int perm32(int rho) { const int n = rho >> 4, i = rho & 15; return 8 * (i >> 2) + 4 * n + (i & 3); }

struct Unit { int pm, pn, g; };
struct GemmD { const bf16_t* A; const bf16_t* Bt; int lda, ldb; long a_gs, b_gs; int K; };
struct Sched {
    int nM, nN, nG, nM2, nN2, pm2off, G, c;
    DI bool next(int i, Unit& u) const {
        const int L = i * G + c; const int nwg = nM * nN, tot1 = nwg * nG;
        const bool first = L < tot1;
        const int L1 = first ? L : 0;
        const int g = L1 / nwg; int wgid = L1 - g * nwg;
        { const int q = nwg / 8, r = nwg % 8, xcd = wgid % 8, off = wgid / 8; wgid = (xcd < r ? xcd * (q + 1) : r * (q + 1) + (xcd - r) * q) + off; }
        const int nig = 8 * nN, gid = wgid / nig, fm = gid * 8, gsz = (nM - fm) < 8 ? (nM - fm) : 8;
        const int pm1 = fm + ((wgid % nig) % gsz), pn1 = (wgid % nig) / gsz;
        const int L2 = first ? 0 : L - tot1, d2 = nM2 > 0 ? nM2 : 1;
        const int pm2 = pm2off + L2 % d2, pn2 = L2 / d2;
        u.pm = first ? pm1 : pm2; u.pn = first ? pn1 : pn2; u.g = first ? g : 0;
        return first || (L2 < nM2 * nN2);
    }
};

template <class Epi>
DI void gemm_phase(LAS unsigned char* lds, const GemmD g, const Sched& S, const Epi& E) {
    const int tid = opaque_tid(), wid = __builtin_amdgcn_readfirstlane(tid >> 6), lane = tid & 63, wr = wid >> 2, wc = wid & 3, fr = lane & 15, fq = lane >> 4;
    const int K = g.K, nt = K / 64;
    unsigned voffA[2], voffB[2];
#pragma unroll
    for (int i = 0; i < 2; ++i) { int R, C; stage_rc(tid * 16 + i * 8192, R, C); const int Rb = Epi::PERM ? ((R & ~31) + perm32(R & 31)) : R;
        voffA[i] = (unsigned)(R * g.lda + C) * 2u; voffB[i] = (unsigned)(Rb * g.ldb + C) * 2u; }
    const size_t kstep = 128;
    const size_t hstepA = (size_t)128 * g.lda * 2, hstepB = (size_t)128 * g.ldb * 2;
    const unsigned ldsw = (unsigned)wid * 1024u;
    const int aoff = lds_byte(wr * 64 + fr, fq * 8), boff = lds_byte(wc * 32 + fr, fq * 8);
#define G_SA(b, h) (((b) * 2 + (h)) * HTB)
#define G_SB(b, h) ((4 + (b) * 2 + (h)) * HTB)
#define G_STAGE(bufoff, gbase, voff) do { _Pragma("unroll") for (int _i = 0; _i < 2; ++_i) \
        __builtin_amdgcn_global_load_lds((const unsigned*)((const char*)(gbase) + (voff)[_i]), (LAS unsigned*)(lds + (bufoff) + ldsw + _i * 8192), 16, 0, 0); } while (0)
#define G_LDA(dst, b, h) do { _Pragma("unroll") for (int m = 0; m < 4; ++m) _Pragma("unroll") for (int k = 0; k < 2; ++k) dst[m][k] = *(const LAS bf16x8*)(lds + G_SA(b, h) + aoff + m * 2048 + k * 1024); } while (0)
#define G_LDB(dst, b, h) do { _Pragma("unroll") for (int n = 0; n < 2; ++n) _Pragma("unroll") for (int k = 0; k < 2; ++k) dst[n][k] = *(const LAS bf16x8*)(lds + G_SB(b, h) + boff + n * 2048 + k * 1024); } while (0)
#define G_MMA(ai, bj, At, Bt) do { __builtin_amdgcn_s_setprio(1); _Pragma("unroll") for (int m = 0; m < 4; ++m) _Pragma("unroll") for (int n = 0; n < 2; ++n) _Pragma("unroll") for (int k = 0; k < 2; ++k) \
        acc[ai][bj][m][n] = __builtin_amdgcn_mfma_f32_16x16x32_bf16(Bt[n][k], At[m][k], acc[ai][bj][m][n], 0, 0, 0); __builtin_amdgcn_s_setprio(0); } while (0)
#define G_WAIT_V(n) asm volatile("s_waitcnt vmcnt(" #n ")" ::: "memory")
#define G_WAIT_L(n) asm volatile("s_waitcnt lgkmcnt(" #n ")" ::: "memory")
#define G_BAR __builtin_amdgcn_s_barrier()
#define G_SCHED __builtin_amdgcn_sched_barrier(0)
    Unit cur, nxt; int ui = 0;
    if (!S.next(0, cur)) return;
    f32x4 acc[2][2][4][2];
#pragma unroll
    for (int a = 0; a < 2; ++a)
#pragma unroll
        for (int b = 0; b < 2; ++b)
#pragma unroll
            for (int m = 0; m < 4; ++m)
#pragma unroll
                for (int n = 0; n < 2; ++n) acc[a][b][m][n] = (f32x4){0.f, 0.f, 0.f, 0.f};
    bf16x8 At[4][2], B0[2][2], B1[2][2];
    const char* cA = (const char*)(g.A + (long)cur.g * g.a_gs) + (size_t)cur.pm * 2 * hstepA;
    const char* cB = (const char*)(g.Bt + (long)cur.g * g.b_gs) + (size_t)cur.pn * 2 * hstepB;
    G_STAGE(G_SB(0, 0), cB, voffB); G_STAGE(G_SA(0, 0), cA, voffA); G_STAGE(G_SB(0, 1), cB + hstepB, voffB); G_STAGE(G_SA(0, 1), cA + hstepA, voffA);
    if (wr == 1) G_BAR;
    G_WAIT_V(4); G_BAR;
    G_STAGE(G_SB(1, 0), cB + kstep, voffB); G_STAGE(G_SA(1, 0), cA + kstep, voffA); G_STAGE(G_SB(1, 1), cB + hstepB + kstep, voffB);
    G_WAIT_V(6); G_BAR;
    for (;;) {
        const bool has_next = S.next(ui + 1, nxt);
        const char* nA = has_next ? (const char*)(g.A + (long)nxt.g * g.a_gs) + (size_t)nxt.pm * 2 * hstepA : cA;
        const char* nB = has_next ? (const char*)(g.Bt + (long)nxt.g * g.b_gs) + (size_t)nxt.pn * 2 * hstepB : cB;
        for (int t = 0; t < nt; t += 2) {
            const bool last = (t == nt - 2);
            const char* a1 = cA + (size_t)(t + 1) * kstep;
            const char* a2 = last ? nA : cA + (size_t)(t + 2) * kstep; const char* b2 = last ? nB : cB + (size_t)(t + 2) * kstep;
            const char* a3 = a2 + kstep; const char* b3 = b2 + kstep;
            G_LDB(B0, 0, 0); G_SCHED; G_LDA(At, 0, 0); G_STAGE(G_SA(1, 1), a1 + hstepA, voffA);
            G_WAIT_L(8); G_BAR; G_WAIT_L(0); G_MMA(0, 0, At, B0); G_BAR; G_SCHED;
            G_LDB(B1, 0, 1); G_STAGE(G_SB(0, 0), b2, voffB);
            G_BAR; G_WAIT_L(0); G_MMA(0, 1, At, B1); G_BAR;
            G_LDA(At, 0, 1); G_STAGE(G_SA(0, 0), a2, voffA);
            G_BAR; G_WAIT_L(0); G_MMA(1, 0, At, B0); G_BAR; G_SCHED;
            G_STAGE(G_SB(0, 1), b2 + hstepB, voffB);
            G_WAIT_V(6); G_BAR; G_MMA(1, 1, At, B1); G_BAR;
            G_LDB(B0, 1, 0); G_SCHED; G_LDA(At, 1, 0); G_STAGE(G_SA(0, 1), a2 + hstepA, voffA);
            G_WAIT_L(8); G_BAR; G_WAIT_L(0); G_MMA(0, 0, At, B0); G_BAR; G_SCHED;
            G_LDB(B1, 1, 1); G_STAGE(G_SB(1, 0), b3, voffB);
            G_BAR; G_WAIT_L(0); G_MMA(0, 1, At, B1); G_BAR;
            G_LDA(At, 1, 1); G_STAGE(G_SA(1, 0), a3, voffA);
            G_BAR; G_WAIT_L(0); G_MMA(1, 0, At, B0); G_BAR; G_SCHED;
            G_STAGE(G_SB(1, 1), b3 + hstepB, voffB);
            G_WAIT_V(6); G_BAR; G_MMA(1, 1, At, B1); G_BAR;
        }
        E(acc, cur, wr, wc, fr, fq);
        if (!has_next) break;
#pragma unroll
        for (int a = 0; a < 2; ++a)
#pragma unroll
            for (int b = 0; b < 2; ++b)
#pragma unroll
                for (int m = 0; m < 4; ++m)
#pragma unroll
                    for (int n = 0; n < 2; ++n) acc[a][b][m][n] = (f32x4){0.f, 0.f, 0.f, 0.f};
        cur = nxt; cA = nA; cB = nB; ++ui;
    }
    G_WAIT_V(0);
    if (wr == 0) G_BAR;
    G_BAR;
}

struct EpiPlanes {
    static constexpr bool PERM = true;
    bf16_t* xbase; bf16_t* cbase;
    DI void operator()(const f32x4 (&acc)[2][2][4][2], const Unit& u, int wr, int wc, int fr, int fq) const {
        const int plane = u.pn >> 2, colt = (u.pn & 3) * 256;
        bf16_t* base; int row0;
        if (u.pm < 128) { base = xbase + (size_t)plane * NX * 1024; row0 = u.pm * 256 + wr * 64 + fr; }
        else { base = cbase + (size_t)plane * NCX * 1024; row0 = (u.pm - 128) * 256 + wr * 64 + fr; }
        const int col0 = colt + wc * 32 + 8 * fq;
#pragma unroll
        for (int ai = 0; ai < 2; ++ai)
#pragma unroll
            for (int m = 0; m < 4; ++m) { bf16_t* rowp = base + (size_t)(row0 + ai * 128 + m * 16) * 1024 + col0;
#pragma unroll
                for (int bj = 0; bj < 2; ++bj) { const f32x4 v0 = acc[ai][bj][m][0], v1 = acc[ai][bj][m][1];
                    u32x4 w; w.x = pk2(v0[0], v0[1]); w.y = pk2(v0[2], v0[3]); w.z = pk2(v1[0], v1[1]); w.w = pk2(v1[2], v1[3]);
                    *(u32x4*)(rowp + bj * 128) = w; } }
    }
};
struct EpiBf {
    static constexpr bool PERM = true;
    bf16_t* O; bf16_t* O2; int ldc; int gcol; int mode; const float* scale; const bf16_t* zc;
    DI void operator()(const f32x4 (&acc)[2][2][4][2], const Unit& u, int wr, int wc, int fr, int fq) const {
        const int row0 = u.pm * 256 + wr * 64 + fr;
        bf16_t* base = O; int pn = u.pn; bool act = false;
        if (mode == 1 && pn >= 8) { base = O2; pn -= 8; act = true; }
        const int col0 = u.g * gcol + pn * 256 + wc * 32 + 8 * fq;
        f32x4 sc[2][2];
#pragma unroll
        for (int bj = 0; bj < 2; ++bj) { sc[bj][0] = (mode == 2) ? *(const f32x4*)(scale + col0 + bj * 128) : (f32x4){1.f, 1.f, 1.f, 1.f}; sc[bj][1] = (mode == 2) ? *(const f32x4*)(scale + col0 + bj * 128 + 4) : (f32x4){1.f, 1.f, 1.f, 1.f}; }
        u32x4 zq[2][4][2];
        if (mode == 2) {
#pragma unroll
            for (int ai = 0; ai < 2; ++ai)
#pragma unroll
                for (int m = 0; m < 4; ++m)
#pragma unroll
                    for (int bj = 0; bj < 2; ++bj) zq[ai][m][bj] = *(const volatile u32x4*)(zc + (size_t)(row0 + ai * 128 + m * 16) * ldc + col0 + bj * 128); }
#pragma unroll
        for (int ai = 0; ai < 2; ++ai) {
            u32x4 (&zz)[4][2] = zq[ai];
#pragma unroll
            for (int m = 0; m < 4; ++m) { const size_t ro = (size_t)(row0 + ai * 128 + m * 16) * ldc + col0;
#pragma unroll
                for (int bj = 0; bj < 2; ++bj) { f32x4 v0 = acc[ai][bj][m][0], v1 = acc[ai][bj][m][1];
                    if (act) {
#pragma unroll
                        for (int j = 0; j < 4; ++j) { v0[j] = silu_f(v0[j]); v1[j] = silu_f(v1[j]); } }
                    if (mode == 2) {
                        const u32x4 z = zz[m][bj]; const f32x4 s0 = sc[bj][0], s1 = sc[bj][1];
                        v0[0] *= s0[0] * lo_f(z.x); v0[1] *= s0[1] * hi_f(z.x); v0[2] *= s0[2] * lo_f(z.y); v0[3] *= s0[3] * hi_f(z.y);
                        v1[0] *= s1[0] * lo_f(z.z); v1[1] *= s1[1] * hi_f(z.z); v1[2] *= s1[2] * lo_f(z.w); v1[3] *= s1[3] * hi_f(z.w);
                    }
                    u32x4 w; w.x = pk2(v0[0], v0[1]); w.y = pk2(v0[2], v0[3]); w.z = pk2(v1[0], v1[1]); w.w = pk2(v1[2], v1[3]);
                    *(u32x4*)(base + ro + bj * 128) = w; } } }
    }
};
struct EpiGate {
    static constexpr bool PERM = true;
    bf16_t* O; const float* gate;
    DI void operator()(const f32x4 (&acc)[2][2][4][2], const Unit& u, int wr, int wc, int fr, int fq) const {
        const int row0 = u.pm * 256 + wr * 64 + fr, col0 = u.pn * 256 + wc * 32 + 8 * fq;
        const float* gp = gate + (size_t)(u.pm >> 4) * 3072 + col0;
        f32x4 gv[2][2];
#pragma unroll
        for (int bj = 0; bj < 2; ++bj) { gv[bj][0] = *(const f32x4*)(gp + bj * 128); gv[bj][1] = *(const f32x4*)(gp + bj * 128 + 4); }
#pragma unroll
        for (int ai = 0; ai < 2; ++ai)
#pragma unroll
            for (int m = 0; m < 4; ++m) { bf16_t* rowp = O + (size_t)(row0 + ai * 128 + m * 16) * 1024 + col0;
#pragma unroll
                for (int bj = 0; bj < 2; ++bj) { const f32x4 v0 = acc[ai][bj][m][0] * gv[bj][0], v1 = acc[ai][bj][m][1] * gv[bj][1];
                    u32x4 w; w.x = pk2(v0[0], v0[1]); w.y = pk2(v0[2], v0[3]); w.z = pk2(v1[0], v1[1]); w.w = pk2(v1[2], v1[3]);
                    *(u32x4*)(rowp + bj * 128) = w; } }
    }
};
struct EpiRes {
    static constexpr bool PERM = false;
    float* O; const float* res; const float* gate;
    DI void operator()(const f32x4 (&acc)[2][2][4][2], const Unit& u, int wr, int wc, int fr, int fq) const {
        const int row0 = u.pm * 256 + wr * 64 + fr, col0 = u.pn * 256 + wc * 32 + 4 * fq;
        const float* gp = gate + (size_t)(u.pm >> 4) * 3072 + col0;
        f32x4 gv[2][2];
#pragma unroll
        for (int bj = 0; bj < 2; ++bj)
#pragma unroll
            for (int n = 0; n < 2; ++n) gv[bj][n] = *(const f32x4*)(gp + bj * 128 + n * 16);
#pragma unroll
        for (int ai = 0; ai < 2; ++ai)
#pragma unroll
            for (int mp = 0; mp < 2; ++mp) {
                f32x4 r[2][2][2];
#pragma unroll
                for (int mm = 0; mm < 2; ++mm) { const size_t ro = (size_t)(row0 + ai * 128 + (2 * mp + mm) * 16) * 1024 + col0;
#pragma unroll
                    for (int bj = 0; bj < 2; ++bj)
#pragma unroll
                        for (int n = 0; n < 2; ++n) r[mm][bj][n] = *(const volatile f32x4*)(res + ro + bj * 128 + n * 16); }
#pragma unroll
                for (int mm = 0; mm < 2; ++mm) { const size_t ro = (size_t)(row0 + ai * 128 + (2 * mp + mm) * 16) * 1024 + col0;
#pragma unroll
                    for (int bj = 0; bj < 2; ++bj)
#pragma unroll
                        for (int n = 0; n < 2; ++n) *(f32x4*)(O + ro + bj * 128 + n * 16) = r[mm][bj][n] + gv[bj][n] * acc[ai][bj][2 * mp + mm][n]; }
            }
    }
};

DI void transpose_jobs(const Params& p, LAS unsigned char* lds, int tid, int j_lo, int j_hi, int w, int nw) {
    LAS float* tile = (LAS float*)lds;
    {
        auto job_desc = [&](int job, const float*& src, bf16_t*& dst, int& K, int& Nt, int& k0, int& n0) {
            int j = job, tk, tn;
            if (j < 1792) { src = p.win_even; dst = (bf16_t*)(p.ws + WS_WINE); K = 1024; Nt = 7184; tk = j & 15; tn = j >> 4; }
            else if ((j -= 1792) < 512) { src = p.wout_even; dst = (bf16_t*)(p.ws + WS_WOUTE); K = 2048; Nt = 1024; tk = j & 31; tn = j >> 5; }
            else if ((j -= 512) < 1024) { src = p.win_odd; dst = (bf16_t*)(p.ws + WS_WINO); K = 1024; Nt = 4096; tk = j & 15; tn = j >> 4; }
            else if ((j -= 1024) < 256) { const int g = j >> 6, jj = j & 63; src = p.pool_w + (size_t)g * 512 * 512; dst = (bf16_t*)(p.ws + WS_WPOOL) + (size_t)g * 512 * 512; K = 512; Nt = 512; tk = jj & 7; tn = jj >> 3; }
            else { j -= 256; src = p.wout_odd; dst = (bf16_t*)(p.ws + WS_WOUTO); K = 2048; Nt = 1024; tk = j & 31; tn = j >> 5; }
            k0 = tk * 64; n0 = tn * 64; };
        float rg[8];
        int job = j_lo + w;
        if (job < j_hi) { const float* src; bf16_t* dst; int K, Nt, k0, n0; job_desc(job, src, dst, K, Nt, k0, n0);
#pragma unroll
            for (int i = 0; i < 8; ++i) { const int idx = tid + 512 * i, k = idx >> 6, n = idx & 63; rg[i] = src[(size_t)(k0 + k) * Nt + n0 + n]; } }
        for (; job < j_hi; job += nw) {
            const float* src; bf16_t* dst; int K, Nt, k0, n0; job_desc(job, src, dst, K, Nt, k0, n0);
            __syncthreads();
#pragma unroll
            for (int i = 0; i < 8; ++i) { const int idx = tid + 512 * i, k = idx >> 6, n = idx & 63; tile[k * 65 + n] = rg[i]; }
            __syncthreads();
            const int nj = job + nw;
            if (nj < j_hi) { const float* s2; bf16_t* d2; int K2, Nt2, k2, n2; job_desc(nj, s2, d2, K2, Nt2, k2, n2);
#pragma unroll
                for (int i = 0; i < 8; ++i) { const int idx = tid + 512 * i, k = idx >> 6, n = idx & 63; rg[i] = s2[(size_t)(k2 + k) * Nt2 + n2 + n]; } }
#pragma unroll
            for (int i = 0; i < 4; ++i) { const int idx = tid + 512 * i, n = idx >> 5, k = (idx & 31) * 2;
                *(unsigned*)(dst + (size_t)(n0 + n) * K + k0 + k) = pk2(tile[k * 65 + n], tile[(k + 1) * 65 + n]); }
        }
        __syncthreads();
    }
}
DI void ph_prep(const Params& p, LAS unsigned char* lds) {
    const int tid = opaque_tid();
    transpose_jobs(p, lds, tid, 0, 2304, blockIdx.x, gridDim.x);
    transpose_jobs(p, lds, tid, 3328, 3584, blockIdx.x, gridDim.x);
    {
        bf16_t* RAW = (bf16_t*)((unsigned char*)p.out + (size_t)96 * 1024 * 1024);
        for (int i = blockIdx.x * 512 + tid; i < 1024 * 512; i += gridDim.x * 512) { const int k = i >> 9, c4 = (i & 511) * 4;
            const f32x4 v = *(const f32x4*)(p.win_odd + (size_t)k * 4096 + c4); u32x2 w; w.x = pk2(v[0], v[1]); w.y = pk2(v[2], v[3]); *(u32x2*)(RAW + (size_t)k * 2048 + c4) = w; }
    }
    LAS float* sv = (LAS float*)(lds + 32768);
    LAS float* red = (LAS float*)(lds + 32768 + 36864);
    LAS float* ct = (LAS float*)(lds + 90112); LAS float* st = ct + 256;
    for (int idx = tid; idx < 9216; idx += 512) { const int v = idx >> 10, k = idx & 1023; const float cv = (v < 8) ? p.c[v * 1024 + k] : p.c_ctx[k]; sv[idx] = silu_f(cv); }
    if (tid < 256) { float s, c; sincospif((float)tid / 128.0f, &s, &c); ct[tid] = c; st[tid] = s; }
    __syncthreads();
    float* MOD = (float*)(p.ws + WS_MOD);
    for (int item = blockIdx.x; item < 192; item += gridDim.x) {
        const int l = item / 96, c0 = (item % 96) * 32, kg = tid >> 5, col = tid & 31;
        float a[9];
#pragma unroll
        for (int v = 0; v < 9; ++v) a[v] = 0.f;
        const float* w = p.ada_w + (size_t)l * 1024 * 3072 + c0 + col;
#pragma unroll 16
        for (int k = kg; k < 1024; k += 16) { const float wv = w[(size_t)k * 3072];
#pragma unroll
            for (int v = 0; v < 9; ++v) a[v] += sv[v * 1024 + k] * wv; }
#pragma unroll
        for (int v = 0; v < 9; ++v) red[(kg * 32 + col) * 9 + v] = a[v];
        __syncthreads();
        if (tid < 288) { const int v = tid >> 5, cc = tid & 31; float s = 0.f; for (int q = 0; q < 16; ++q) s += red[(q * 32 + cc) * 9 + v];
            MOD[(size_t)(l * 9 + v) * 3072 + c0 + cc] = s + p.ada_b[l * 3072 + c0 + cc]; }
        __syncthreads();
    }
    bf16_t* WF = (bf16_t*)(p.ws + WS_WF);
    for (int it = blockIdx.x; it < 512; it += gridDim.x) {
        const int idx = it * 512 + tid, d = idx & 255, c = (idx >> 8) & 255, g = idx >> 16;
        const float* f = p.fourier_w + (size_t)g * 65536 + d;
        float aP = 0.f, aQ = 0.f;
#pragma unroll 16
        for (int cp = 0; cp < 256; ++cp) { const float fv = f[cp * 256]; const int a = (c * cp) & 255; aP += ct[a] * fv; aQ += st[a] * fv; }
        WF[(size_t)(g * 512 + d) * 256 + c] = (bf16_t)(pk2(aP * 0.0625f, 0.f) & 0xffffu);
        WF[(size_t)(g * 512 + 256 + d) * 256 + c] = (bf16_t)(pk2(-aQ * 0.0625f, 0.f) & 0xffffu);
    }
}

DI void ph_norm0(const Params& p, LAS unsigned char* lds) {
    const int tid = opaque_tid(), wid = tid >> 6, lane = tid & 63;
    LAS float* wg = (LAS float*)lds;
#pragma unroll 4
    for (int i = 0; i < 32; ++i) { const int idx = tid + 512 * i, k = idx >> 4, j = idx & 15; wg[j * 1024 + k] = p.win_even[(size_t)k * 7184 + 7168 + j]; }
    __syncthreads();
    f32x4 g[4];
#pragma unroll
    for (int i = 0; i < 4; ++i) g[i] = *(const f32x4*)(p.norm_g + lane * 4 + 256 * i);
    const float* MOD = (const float*)(p.ws + WS_MOD);
    bf16_t* HX = (bf16_t*)p.out;
    float* GATES = (float*)(p.ws + WS_GATES);
    f32x4 vn[4];
    { const int r = blockIdx.x * 8 + wid; if (r < NR) { const float* src = (r < NX) ? p.x + (size_t)r * 1024 : p.ctx + (size_t)(r - NX) * 1024;
#pragma unroll
        for (int i = 0; i < 4; ++i) vn[i] = *(const f32x4*)(src + lane * 4 + 256 * i); } }
    for (int r = blockIdx.x * 8 + wid; r < NR; r += gridDim.x * 8) {
        const float* md;
        if (r < NX) { md = MOD + (size_t)(r >> 12) * 3072; } else { md = MOD + (size_t)8 * 3072; }
        f32x4 v[4]; float ss = 0.f;
#pragma unroll
        for (int i = 0; i < 4; ++i) { v[i] = vn[i]; ss += v[i][0] * v[i][0] + v[i][1] * v[i][1] + v[i][2] * v[i][2] + v[i][3] * v[i][3]; }
        { const int r2 = r + gridDim.x * 8; if (r2 < NR) { const float* s2 = (r2 < NX) ? p.x + (size_t)r2 * 1024 : p.ctx + (size_t)(r2 - NX) * 1024;
#pragma unroll
            for (int i = 0; i < 4; ++i) vn[i] = *(const f32x4*)(s2 + lane * 4 + 256 * i); } }
        ss = wave_sum(ss);
        const float rstd = rsqrtf(ss * (1.0f / 1024.0f) + 1e-6f);
#pragma unroll
        for (int i = 0; i < 4; ++i) { const f32x4 sh = *(const f32x4*)(md + lane * 4 + 256 * i), sc = *(const f32x4*)(md + 1024 + lane * 4 + 256 * i);
            v[i] = v[i] * rstd * g[i] * (sc + 1.0f) + sh; }
#pragma unroll
        for (int i = 0; i < 4; i += 2) { u32x2 wa, wb; wa.x = pk2(v[i][0], v[i][1]); wa.y = pk2(v[i][2], v[i][3]); wb.x = pk2(v[i + 1][0], v[i + 1][1]); wb.y = pk2(v[i + 1][2], v[i + 1][3]);
            bf16_t* hp = HX + (size_t)r * 1024 + lane * 4 + 256 * i; st_adj16(hp, hp + 256, wa, wb, lane); }
        float pt[16];
#pragma unroll
        for (int j = 0; j < 16; ++j) { float a = 0.f;
#pragma unroll
            for (int i = 0; i < 4; ++i) { const f32x4 w4 = *(const LAS f32x4*)(wg + j * 1024 + lane * 4 + 256 * i); a += v[i][0] * w4[0] + v[i][1] * w4[1] + v[i][2] * w4[2] + v[i][3] * w4[3]; }
            pt[j] = a; if ((j & 3) == 3) __builtin_amdgcn_sched_barrier(0); }
        { const bool b5 = lane & 32;
#pragma unroll
          for (int j = 0; j < 8; ++j) { const float snd = b5 ? pt[j] : pt[j + 8], kp = b5 ? pt[j + 8] : pt[j]; pt[j] = kp + __shfl_xor(snd, 32); } }
        { const bool b4 = lane & 16;
#pragma unroll
          for (int j = 0; j < 4; ++j) { const float snd = b4 ? pt[j] : pt[j + 4], kp = b4 ? pt[j + 4] : pt[j]; pt[j] = kp + __shfl_xor(snd, 16); } }
        { const bool b3 = lane & 8;
#pragma unroll
          for (int j = 0; j < 2; ++j) { const float snd = b3 ? pt[j] : pt[j + 2], kp = b3 ? pt[j + 2] : pt[j]; pt[j] = kp + __shfl_xor(snd, 8); } }
        { const bool b2 = lane & 4; const float snd = b2 ? pt[0] : pt[1], kp = b2 ? pt[1] : pt[0]; pt[0] = kp + __shfl_xor(snd, 4); }
        pt[0] += __shfl_xor(pt[0], 2); pt[0] += __shfl_xor(pt[0], 1);
        if ((lane & 3) == 0) { const int j = ((lane >> 5) & 1) * 8 + ((lane >> 4) & 1) * 4 + ((lane >> 3) & 1) * 2 + ((lane >> 2) & 1);
            float val = pt[0] + p.gate_b[j];
            if ((j >> 2) & 1) val = fminf(val, 0.f) - log1pf(__expf(-fabsf(val)));
            GATES[(size_t)r * 16 + j] = val; }
    }
}
DI void ph_norm1(const Params& p, int mode) {
    const int tid = opaque_tid(), wid = tid >> 6, lane = tid & 63;
    const float* gsrc = mode ? p.final_g : p.norm_g + 1024;
    f32x4 g[4];
#pragma unroll
    for (int i = 0; i < 4; ++i) g[i] = *(const f32x4*)(gsrc + lane * 4 + 256 * i);
    const float* MOD = (const float*)(p.ws + WS_MOD) + (size_t)9 * 3072;
    const bf16_t* D0 = (const bf16_t*)p.ws; const bf16_t* D1 = (const bf16_t*)(p.ws + PLANE);
    bf16_t* HX1 = (bf16_t*)(p.ws + 2 * PLANE);
    f32x4 vn[4];
#define N1_LOAD(RR) do { const size_t _o = (size_t)(RR) * 1024 + lane * 4; \
        _Pragma("unroll") for (int i = 0; i < 4; ++i) vn[i] = *(const f32x4*)(p.x + _o + 256 * i); \
        _Pragma("unroll") for (int i = 0; i < 4; i += 2) { u32x2 qa, qb; ld_adj16(D0 + _o + 256 * i, D0 + _o + 256 * i + 256, lane, qa, qb); \
            vn[i] += (f32x4){lo_f(qa.x), hi_f(qa.x), lo_f(qa.y), hi_f(qa.y)}; vn[i + 1] += (f32x4){lo_f(qb.x), hi_f(qb.x), lo_f(qb.y), hi_f(qb.y)}; \
            if (mode) { ld_adj16(D1 + _o + 256 * i, D1 + _o + 256 * i + 256, lane, qa, qb); \
                vn[i] += (f32x4){lo_f(qa.x), hi_f(qa.x), lo_f(qa.y), hi_f(qa.y)}; vn[i + 1] += (f32x4){lo_f(qb.x), hi_f(qb.x), lo_f(qb.y), hi_f(qb.y)}; } } } while (0)
    { const int r = blockIdx.x * 8 + wid; if (r < NX) N1_LOAD(r); }
    for (int r = blockIdx.x * 8 + wid; r < NX; r += gridDim.x * 8) {
        const float* md = MOD + (size_t)(r >> 12) * 3072;
        f32x4 v[4]; float ss = 0.f;
#pragma unroll
        for (int i = 0; i < 4; ++i) { v[i] = vn[i]; ss += v[i][0] * v[i][0] + v[i][1] * v[i][1] + v[i][2] * v[i][2] + v[i][3] * v[i][3]; }
        { const int r2 = r + gridDim.x * 8; if (r2 < NX) N1_LOAD(r2); }
        ss = wave_sum(ss);
        const float rstd = rsqrtf(ss * (1.0f / 1024.0f) + 1e-6f);
        if (mode) {
#pragma unroll
            for (int i = 0; i < 4; ++i) *(f32x4*)(p.out + (size_t)r * 1024 + lane * 4 + 256 * i) = v[i] * rstd * g[i];
        } else {
            u32x2 w[4];
#pragma unroll
            for (int i = 0; i < 4; ++i) { const f32x4 sh = *(const f32x4*)(md + lane * 4 + 256 * i), sc = *(const f32x4*)(md + 1024 + lane * 4 + 256 * i);
                const f32x4 h = v[i] * rstd * g[i] * (sc + 1.0f) + sh; w[i].x = pk2(h[0], h[1]); w[i].y = pk2(h[2], h[3]); }
#pragma unroll
            for (int i = 0; i < 4; i += 2) { bf16_t* hp = HX1 + (size_t)r * 1024 + lane * 4 + 256 * i; st_adj16(hp, hp + 256, w[i], w[i + 1], lane); }
        }
    }
#undef N1_LOAD
}

DI void ph_conv(const Params& p) {
    const bf16_t* QRAW = (const bf16_t*)p.ws; const bf16_t* KRAW = (const bf16_t*)(p.ws + PLANE);
    const bf16_t* CQ = (const bf16_t*)(p.ws + WS_CRAW); const bf16_t* CK = CQ + (size_t)NCX * 1024;
    bf16_t* QC = (bf16_t*)p.out; bf16_t* KC = QC + (size_t)NX * 1024;
    bf16_t* CQC = (bf16_t*)(p.ws + WS_CQC); bf16_t* CKC = (bf16_t*)(p.ws + WS_CKC);
    const int tid = opaque_tid();
    const bool scanner = (blockIdx.x < 64) && (tid < 64) && (gridDim.x >= 64);
    const int nscan = gridDim.x >= 64 ? 64 : 0;
    const int active_id = (int)blockIdx.x < nscan ? (int)blockIdx.x * 448 + (tid - 64) : nscan * 448 + ((int)blockIdx.x - nscan) * 512 + tid;
    const int active_n = nscan * 448 + ((int)gridDim.x - nscan) * 512;
    if (!scanner)
    for (int idx = active_id; idx < (NR / 8) * 256; idx += active_n) {
        const int oct = idx & 127, which = (idx >> 7) & 1, r0 = (idx >> 8) * 8, ch = oct * 8;
        const bf16_t* src; bf16_t* dst; int t0, T;
        if (r0 < NX) { src = (which ? KRAW : QRAW) + (size_t)r0 * 1024 + ch; dst = (which ? KC : QC) + (size_t)r0 * 1024 + ch; t0 = r0 & 4095; T = 4096; }
        else { const int rr = r0 - NX; src = (which ? CK : CQ) + (size_t)rr * 1024 + ch; dst = (which ? CKC : CQC) + (size_t)rr * 1024 + ch; t0 = rr & 255; T = 256; }
        const u32x4 z = {0u, 0u, 0u, 0u};
        u32x4 v[10];
        v[0] = (t0 > 0) ? *(const u32x4*)(src - 1024) : z;
#pragma unroll
        for (int i = 0; i < 8; ++i) v[i + 1] = *(const u32x4*)(src + (size_t)i * 1024);
        v[9] = (t0 + 8 < T) ? *(const u32x4*)(src + (size_t)8 * 1024) : z;
        const float* w = p.conv_qk + which * 1024 + ch;
        float wt[3][8];
#pragma unroll
        for (int j = 0; j < 3; ++j) { const f32x4 wa = *(const f32x4*)(w + j * 2048), wb = *(const f32x4*)(w + j * 2048 + 4);
#pragma unroll
            for (int e = 0; e < 4; ++e) { wt[j][e] = wa[e]; wt[j][4 + e] = wb[e]; } }
        const float qs = which ? 1.0f : 0.0625f;
#pragma unroll
        for (int i = 0; i < 8; ++i) {
            float o[8];
#pragma unroll
            for (int e = 0; e < 4; ++e) {
                float lo = wt[0][2 * e] * lo_f(v[i][e]) + wt[1][2 * e] * lo_f(v[i + 1][e]) + wt[2][2 * e] * lo_f(v[i + 2][e]);
                float hi = wt[0][2 * e + 1] * hi_f(v[i][e]) + wt[1][2 * e + 1] * hi_f(v[i + 1][e]) + wt[2][2 * e + 1] * hi_f(v[i + 2][e]);
                o[2 * e] = silu_f(lo) * qs; o[2 * e + 1] = silu_f(hi) * qs;
            }
            u32x4 wv; wv.x = pk2(o[0], o[1]); wv.y = pk2(o[2], o[3]); wv.z = pk2(o[4], o[5]); wv.w = pk2(o[6], o[7]);
            *(u32x4*)(dst + (size_t)i * 1024) = wv;
        }
    }
    const int lane = tid & 63;
    const int n_sc = nscan ? 1 : 64;
    if (scanner || (nscan == 0 && blockIdx.x == 0 && tid < 64))
    for (int sc = 0; sc < n_sc; ++sc) {
        const int gw = nscan ? (int)blockIdx.x : sc;
        const int b = gw >> 3, h = (gw >> 1) & 3, dir = gw & 1;
        const float* GATES = (const float*)(p.ws + WS_GATES);
        float* GP = (float*)(p.ws + WS_GPRE) + (size_t)gw * 68 * 384;
        float m_prev = 0.f;
        auto grow_of = [&](int st) -> size_t { if (st < 4) { const int cc = dir ? 3 - st : st; return (size_t)NX + (size_t)b * 256 + cc * 64; } const int xc = st - 4, cc = dir ? 63 - xc : xc; return (size_t)b * 4096 + cc * 64; };
        const int oi = (dir ? 8 : 0) + h, of = (dir ? 12 : 4) + h;
        float nig = GATES[(grow_of(0) + lane) * 16 + oi], nlf = GATES[(grow_of(0) + lane) * 16 + of];
        for (int st = 0; st < 68; ++st) {
            const float ig = nig, lf = nlf;
            if (st + 1 < 68) { const size_t g2 = grow_of(st + 1); nig = GATES[(g2 + lane) * 16 + oi]; nlf = GATES[(g2 + lane) * 16 + of]; }
            float bs = lf;
#pragma unroll
            for (int o = 1; o < 64; o <<= 1) { const float ov = dir ? __shfl_down(bs, o) : __shfl_up(bs, o); const bool ok = dir ? (lane + o < 64) : (lane >= o); if (ok) bs += ov; }
            const float a = ig - bs;
            float mx = a;
#pragma unroll
            for (int o = 1; o < 64; o <<= 1) { const float ov = dir ? __shfl_down(mx, o) : __shfl_up(mx, o); const bool ok = dir ? (lane + o < 64) : (lane >= o); if (ok) mx = fmaxf(mx, ov); }
            const float total = __shfl(bs, dir ? 0 : 63);
            const float m_inter = bs + m_prev, m_t = fmaxf(bs + mx, m_inter);
            const float wsl = total - bs + ig;
            const float m_new = fmaxf(total + m_prev, wave_max(wsl));
            float* o = GP + (size_t)st * 384;
            o[lane] = bs - m_t; o[64 + lane] = a; o[128 + lane] = __expf(m_inter - m_t); o[192 + lane] = __expf(wsl - m_new); o[256 + lane] = __expf(-m_t);
            if (lane == 0) o[320] = __expf(total + m_prev - m_new);
            m_prev = m_new;
        }
    }
}

DI void ph_mlstm(const Params& p, LAS unsigned char* lds) {
    constexpr int QP = 528, VP = 176, SP = 144;
    LAS unsigned char* Qi = lds; LAS unsigned char* Ki = lds + 33792; LAS unsigned char* Vi0 = lds + 67584; LAS unsigned char* Vwi = Vi0 + 2 * 11264;
    LAS unsigned char* Sgi = Vwi + 11264; LAS unsigned char* Ci = Sgi + 9216; LAS float* fl0 = (LAS float*)(Ci + 42240);
    const int tid = opaque_tid(), wid = tid >> 6, lane = tid & 63, fr = lane & 15, fq = lane >> 4;
    const bf16_t* QC = (const bf16_t*)p.out; const bf16_t* KC = QC + (size_t)NX * 1024; const bf16_t* VPL = (const bf16_t*)(p.ws + 2 * PLANE);
    const bf16_t* CQC = (const bf16_t*)(p.ws + WS_CQC); const bf16_t* CKC = (const bf16_t*)(p.ws + WS_CKC); const bf16_t* CV = (const bf16_t*)(p.ws + WS_CRAW) + (size_t)2 * NCX * 1024;
    for (int wi = blockIdx.x; wi < 256; wi += gridDim.x) {
        const int b = wi >> 5, h = (wi >> 3) & 3, dir = (wi >> 2) & 1, es = wi & 3;
        bf16_t* Hout = (bf16_t*)(p.ws + (dir ? PLANE : 0));
        const float* GP = (const float*)(p.ws + WS_GPRE) + (size_t)((b * 4 + h) * 2 + dir) * 68 * 384;
        f32x4 Cst[2][5];
#pragma unroll
        for (int i = 0; i < 2; ++i)
#pragma unroll
            for (int n = 0; n < 5; ++n) Cst[i][n] = (f32x4){0.f, 0.f, 0.f, 0.f};
        __syncthreads();
        for (int i = tid; i < 64 * 8; i += 512) { const int row = i >> 3, c = i & 7;
            *(LAS unsigned*)(Vi0 + row * VP + 128 + c * 4) = 0x3F803F80u; *(LAS unsigned*)(Vi0 + 11264 + row * VP + 128 + c * 4) = 0x3F803F80u; *(LAS unsigned*)(Vwi + row * VP + 128 + c * 4) = 0u; }
        u32x4 rq[4], rk[4], rv; float pg = 0.f, pws = 0.f, pdecay = 0.f, decay = 0.f;
        const int mt = wid >> 1, nt0 = 2 * (wid & 1);
#define ML_LOAD(ST) do { const int _st = (ST); const bf16_t *_q, *_k, *_v; \
            if (_st < 4) { const int cc = dir ? 3 - _st : _st; const size_t row0 = (size_t)b * 256 + cc * 64; _q = CQC + row0 * 1024 + h * 256; _k = CKC + row0 * 1024 + h * 256; _v = CV + row0 * 1024 + h * 256 + es * 64; } \
            else { const int xc = _st - 4, cc = dir ? 63 - xc : xc; const size_t row0 = (size_t)b * 4096 + cc * 64; _q = QC + row0 * 1024 + h * 256; _k = KC + row0 * 1024 + h * 256; _v = VPL + row0 * 1024 + h * 256 + es * 64; } \
            _Pragma("unroll") for (int i = 0; i < 4; ++i) { const int id = tid + 512 * i, row = id >> 5, chk = id & 31; rq[i] = *(const u32x4*)(_q + (size_t)row * 1024 + chk * 8); rk[i] = *(const u32x4*)(_k + (size_t)row * 1024 + chk * 8); } \
            rv = *(const u32x4*)(_v + (size_t)(tid >> 3) * 1024 + (tid & 7) * 8); \
            const float* _g = GP + (size_t)_st * 384; pg = _g[tid < 320 ? tid : 0]; pws = _g[192 + (tid >> 3)]; pdecay = _g[320]; } while (0)
#define ML_WRITE(ST) do { LAS unsigned char* _Vi = Vi0 + ((ST) & 1) * 11264; LAS float* _fl = fl0 + ((ST) & 1) * 320; \
            _Pragma("unroll") for (int i = 0; i < 4; ++i) { const int id = tid + 512 * i, row = id >> 5, chk = id & 31; \
                *(LAS u32x4*)(Qi + row * QP + chk * 16) = rq[i]; *(LAS u32x4*)(Ki + row * QP + chk * 16) = rk[i]; } \
            *(LAS u32x4*)(_Vi + (tid >> 3) * VP + (tid & 7) * 16) = rv; \
            { const float w = pws; u32x4 o; \
              o.x = pk2(w * lo_f(rv.x), w * hi_f(rv.x)); o.y = pk2(w * lo_f(rv.y), w * hi_f(rv.y)); o.z = pk2(w * lo_f(rv.z), w * hi_f(rv.z)); o.w = pk2(w * lo_f(rv.w), w * hi_f(rv.w)); \
              *(LAS u32x4*)(Vwi + (tid >> 3) * VP + (tid & 7) * 16) = o; \
              if ((tid & 7) == 0) *(LAS unsigned*)(Vwi + (tid >> 3) * VP + 128) = pk2(w, 0.f); } \
            if (tid < 320) _fl[tid] = pg; \
            _Pragma("unroll") for (int i = 0; i < 2; ++i) _Pragma("unroll") for (int n = 0; n < 5; ++n) { u32x2 w; w.x = pk2(Cst[i][n][0], Cst[i][n][1]); w.y = pk2(Cst[i][n][2], Cst[i][n][3]); \
                *(LAS u32x2*)(Ci + (16 * n + fr) * QP + (16 * (2 * wid + i) + 4 * fq) * 2) = w; } \
            decay = pdecay; } while (0)
        ML_LOAD(0);
        __syncthreads();
        ML_WRITE(0);
        ML_LOAD(1);
        for (int st = 0; st < 68; ++st) {
            const bool isx = st >= 4;
            LAS unsigned char* Vi = Vi0 + (st & 1) * 11264; LAS float* fl = fl0 + (st & 1) * 320;
            LAS float* f_bt = fl; LAS float* f_aa = fl + 64; LAS float* f_inter = fl + 128; LAS float* f_enm = fl + 256;
            __syncthreads();
            const float dcy = decay;
            const int t = 16 * mt + fr;
            f32x4 accC[3];
#pragma unroll
            for (int n = 0; n < 3; ++n) accC[n] = (f32x4){0.f, 0.f, 0.f, 0.f};
            if (isx) {
                f32x4 sacc[2] = {(f32x4){0.f, 0.f, 0.f, 0.f}, (f32x4){0.f, 0.f, 0.f, 0.f}};
#pragma unroll
                for (int ks = 0; ks < 8; ++ks) { const bf16x8 qf = *(const LAS bf16x8*)(Qi + t * QP + (32 * ks + 8 * fq) * 2);
#pragma unroll
                    for (int n = 0; n < 2; ++n) { const bf16x8 kf = *(const LAS bf16x8*)(Ki + (16 * (nt0 + n) + fr) * QP + (32 * ks + 8 * fq) * 2); sacc[n] = mfma16(kf, qf, sacc[n]); }
#pragma unroll
                    for (int n = 0; n < 3; ++n) { const int et = (n < 2) ? nt0 + n : 4; const bf16x8 cf = *(const LAS bf16x8*)(Ci + (16 * et + fr) * QP + (32 * ks + 8 * fq) * 2); accC[n] = mfma16(cf, qf, accC[n]); } }
                const float btm = f_bt[t];
#pragma unroll
                for (int n = 0; n < 2; ++n) { const int s0 = 16 * (nt0 + n) + 4 * fq; const f32x4 a4 = *(const LAS f32x4*)(f_aa + s0); float vv[4];
#pragma unroll
                    for (int j = 0; j < 4; ++j) { const int s = s0 + j; const bool ok = dir ? (s >= t) : (s <= t); const float e = __expf(btm + a4[j]); vv[j] = ok ? sacc[n][j] * e : 0.f; }
                    u32x2 w; w.x = pk2(vv[0], vv[1]); w.y = pk2(vv[2], vv[3]); *(LAS u32x2*)(Sgi + t * SP + s0 * 2) = w; }
            }
#pragma unroll
            for (int i = 0; i < 2; ++i)
#pragma unroll
                for (int n = 0; n < 5; ++n) Cst[i][n] = Cst[i][n] * dcy;
#pragma unroll
            for (int ks = 0; ks < 2; ++ks) { bf16x8 kf[2];
#pragma unroll
                for (int i = 0; i < 2; ++i) kf[i] = tr_frag(Ki, QP, 32 * ks, 16 * (2 * wid + i), lane);
#pragma unroll
                for (int n = 0; n < 5; ++n) { const bf16x8 vw = tr_frag(Vwi, VP, 32 * ks, 16 * n, lane);
#pragma unroll
                    for (int i = 0; i < 2; ++i) Cst[i][n] = mfma16(kf[i], vw, Cst[i][n]); } }
            __syncthreads();
            if (isx) {
                f32x4 accD[3];
#pragma unroll
                for (int n = 0; n < 3; ++n) accD[n] = (f32x4){0.f, 0.f, 0.f, 0.f};
#pragma unroll
                for (int ks = 0; ks < 2; ++ks) { const bf16x8 sgf = *(const LAS bf16x8*)(Sgi + t * SP + (32 * ks + 8 * fq) * 2);
#pragma unroll
                    for (int n = 0; n < 3; ++n) { const int et = (n < 2) ? nt0 + n : 4; const bf16x8 vf = tr_frag(Vi, VP, 32 * ks, 16 * et, lane); accD[n] = mfma16(vf, sgf, accD[n]); } }
                const float inter_t = f_inter[t];
                const float den0 = accD[2][0] + inter_t * accC[2][0];
                const float den = __shfl(den0, fr);
                const float rden = 1.0f / fmaxf(fabsf(den), f_enm[t]);
                const int xc = st - 4, cc = dir ? 63 - xc : xc;
                bf16_t* hp = Hout + ((size_t)b * 4096 + cc * 64 + t) * 1024 + h * 256 + es * 64 + 4 * fq;
                u32x2 hw[2];
#pragma unroll
                for (int n = 0; n < 2; ++n) { const f32x4 hv = (accD[n] + accC[n] * inter_t) * rden; hw[n].x = pk2(hv[0], hv[1]); hw[n].y = pk2(hv[2], hv[3]); }
                st_pair16(hp + 16 * nt0, hw[0], hw[1], fq);
            }
            if (st + 1 < 68) { ML_WRITE(st + 1); if (st + 2 < 68) ML_LOAD(st + 2); }
        }
#undef ML_LOAD
#undef ML_WRITE
    }
}

template <int KK, int NN, class Cfg>
DI void axis_mix(const Cfg& cfg, LAS unsigned char* lds, int n_items) {
    constexpr int TP = 528, BP = KK * 2 + 16, NCH = KK / 16;
    LAS unsigned char* Ti = lds; LAS unsigned char* Bi = lds + 128 * TP;
    const int tid = opaque_tid(), wid = tid >> 6, lane = tid & 63, fr = lane & 15, fq = lane >> 4;
    __syncthreads();
    cfg.fill_tables(Bi, tid);
    u32x4 ra[NCH], rb[NCH];
    const int G = gridDim.x;
#define AX_LOAD(R, IT) do { if ((IT) < n_items) { _Pragma("unroll") for (int i = 0; i < NCH; ++i) { const int id = tid + 512 * i; R[i] = *(const u32x4*)(cfg.row_ptr((IT), id >> 5) + (id & 31) * 8); } } } while (0)
#define AX_BODY(R, IT, PRE) do { \
        __syncthreads(); \
        _Pragma("unroll") for (int i = 0; i < NCH; ++i) { const int id = tid + 512 * i; *(LAS u32x4*)(Ti + (id >> 5) * TP + (id & 31) * 16) = R[i]; } \
        __syncthreads(); \
        AX_LOAD(R, PRE); \
        f32x4 acc[2][NN / 16]; \
        _Pragma("unroll") for (int i = 0; i < 2; ++i) _Pragma("unroll") for (int n = 0; n < NN / 16; ++n) acc[i][n] = (f32x4){0.f, 0.f, 0.f, 0.f}; \
        LAS unsigned char* tb = Bi + cfg.table_off(IT); \
        _Pragma("unroll") for (int ks = 0; ks < KK / 32; ++ks) { bf16x8 af[2]; \
            _Pragma("unroll") for (int i = 0; i < 2; ++i) af[i] = tr_frag(Ti, TP, 32 * ks, 32 * wid + 16 * i, lane); \
            _Pragma("unroll") for (int n = 0; n < NN / 16; ++n) { const bf16x8 bfr = *(const LAS bf16x8*)(tb + (16 * n + fr) * BP + (32 * ks + 8 * fq) * 2); \
                _Pragma("unroll") for (int i = 0; i < 2; ++i) acc[i][n] = mfma16(af[i], bfr, acc[i][n]); } } \
        cfg.epilogue(acc, (IT), wid, fr, fq, Bi); } while (0)
    int item = blockIdx.x;
    AX_LOAD(ra, item); AX_LOAD(rb, item + G);
    for (; item < n_items; item += 2 * G) {
        AX_BODY(ra, item, item + 2 * G);
        if (item + G < n_items) AX_BODY(rb, item + G, item + 3 * G);
    }
#undef AX_LOAD
#undef AX_BODY
}
DI void fill_dft_table(LAS unsigned char* Bi, int tid, int nrows) {
    for (int idx = tid; idx < nrows * 128; idx += 512) { const int n = idx >> 7, k = idx & 127, ap = n & 63, kk = k & 63; float s, c; sincospif((float)((kk * ap) & 63) / 32.0f, &s, &c);
        float v; if (n < 64) v = (k < 64) ? c : s; else v = (k < 64) ? -s : c;
        *(LAS unsigned short*)(Bi + n * 272 + k * 2) = (unsigned short)(pk2(v * 0.125f, 0.f) & 0xffffu); }
}
struct CfgDft1 {
    const bf16_t* Z; bf16_t* S1re; bf16_t* S1im;
    DI void fill_tables(LAS unsigned char* Bi, int tid) const { fill_dft_table(Bi, tid, 128); }
    DI int table_off(int) const { return 0; }
    DI const bf16_t* row_ptr(int item, int k) const { const int g = item & 3, b = (item >> 2) & 63, batch = item >> 8;
        return Z + ((size_t)batch * 4096 + 64 * (k & 63) + b) * 2048 + g * 512 + (k >> 6) * 256; }
    DI void epilogue(const f32x4 (&acc)[2][8], int item, int wid, int fr, int fq, LAS unsigned char* Bi) const {
        const int g = item & 3, b = (item >> 2) & 63, batch = item >> 8;
#pragma unroll
        for (int ni = 0; ni < 4; ++ni) { const int ap = 16 * ni + fr; float s, c; sincospif((float)(b * ap) * (1.0f / 2048.0f), &s, &c);
            const size_t tok = (size_t)batch * 4096 + 64 * ap + b;
            u32x2 wr[2], wi[2];
#pragma unroll
            for (int i = 0; i < 2; ++i) { const f32x4 re = acc[i][ni], im = acc[i][ni + 4]; const f32x4 r2 = re * c + im * s, i2 = im * c - re * s;
                wr[i].x = pk2(r2[0], r2[1]); wr[i].y = pk2(r2[2], r2[3]); wi[i].x = pk2(i2[0], i2[1]); wi[i].y = pk2(i2[2], i2[3]); }
            { const size_t o = tok * 1024 + g * 256 + 32 * wid + 4 * fq; st_pair16(S1re + o, wr[0], wr[1], fq); st_pair16(S1im + o, wi[0], wi[1], fq); } }
    }
};
struct CfgDft2 {
    const bf16_t* S1re; const bf16_t* S1im; const bf16_t* ZB; bf16_t* Y;
    DI void fill_tables(LAS unsigned char* Bi, int tid) const { fill_dft_table(Bi, tid, 64); }
    DI int table_off(int) const { return 0; }
    DI const bf16_t* row_ptr(int item, int k) const { const int g = item & 3, ap = (item >> 2) & 63, batch = item >> 8;
        return ((k >> 6) ? S1im : S1re) + ((size_t)batch * 4096 + 64 * ap + (k & 63)) * 1024 + g * 256; }
    DI void epilogue(const f32x4 (&acc)[2][4], int item, int wid, int fr, int fq, LAS unsigned char*) const {
        const int g = item & 3, ap = (item >> 2) & 63, batch = item >> 8;
#pragma unroll
        for (int ni = 0; ni < 4; ++ni) { const size_t tok = (size_t)batch * 4096 + ap + 64 * (16 * ni + fr);
            u32x2 w[2], zz[2]; ld_pair16(ZB + tok * 1024 + g * 256 + 32 * wid + 4 * fq, fq, zz[0], zz[1]);
#pragma unroll
            for (int i = 0; i < 2; ++i) { const u32x2 z = zz[i]; const f32x4 a = acc[i][ni];
                w[i].x = pk2(a[0] * silu_f(lo_f(z.x)), a[1] * silu_f(hi_f(z.x))); w[i].y = pk2(a[2] * silu_f(lo_f(z.y)), a[3] * silu_f(hi_f(z.y))); }
            st_pair16(Y + tok * 2048 + 1024 + g * 256 + 32 * wid + 4 * fq, w[0], w[1], fq); }
    }
};
DI void fill_pool_tables(LAS unsigned char* Bi, int tid) {
    for (int idx = tid; idx < 4 * 4096; idx += 512) { const int g = idx >> 12, n = (idx >> 6) & 63, k = idx & 63, w = 2 << g, lo = n - w / 2, hi = n + w - w / 2;
        *(LAS unsigned short*)(Bi + g * 9216 + n * 144 + k * 2) = (k >= lo && k < hi) ? (unsigned short)0x3F80 : (unsigned short)0; }
}
DI float pool_rcnt(int g, int n) { const int w = 2 << g; int lo = n - w / 2, hi = n + w - w / 2; lo = lo < 0 ? 0 : lo; hi = hi > 64 ? 64 : hi; return 1.0f / (float)(hi - lo); }
struct CfgPoolA {
    const bf16_t* UC; bf16_t* PA;
    DI void fill_tables(LAS unsigned char* Bi, int tid) const { fill_pool_tables(Bi, tid); }
    DI int table_off(int item) const { return ((item & 7) >> 1) * 9216; }
    DI const bf16_t* row_ptr(int item, int k) const { const int ct = item & 7, c = (item >> 3) & 63, batch = item >> 9; return UC + ((size_t)batch * 4096 + 64 * k + c) * 2048 + ct * 256; }
    DI void epilogue(const f32x4 (&acc)[2][4], int item, int wid, int fr, int fq, LAS unsigned char*) const {
        const int ct = item & 7, c = (item >> 3) & 63, batch = item >> 9, g = ct >> 1;
#pragma unroll
        for (int ni = 0; ni < 4; ++ni) { const int n = 16 * ni + fr; const float rc = pool_rcnt(g, n); const size_t tok = (size_t)batch * 4096 + 64 * n + c;
            u32x2 w[2];
#pragma unroll
            for (int i = 0; i < 2; ++i) { const f32x4 a = acc[i][ni] * rc; w[i].x = pk2(a[0], a[1]); w[i].y = pk2(a[2], a[3]); }
            st_pair16(PA + tok * 2048 + ct * 256 + 32 * wid + 4 * fq, w[0], w[1], fq); }
    }
};
struct CfgPoolB {
    const bf16_t* PA; bf16_t* UC; const bf16_t* ZC; const float* scale;
    DI void fill_tables(LAS unsigned char* Bi, int tid) const { fill_pool_tables(Bi, tid); }
    DI int table_off(int item) const { return ((item & 7) >> 1) * 9216; }
    DI const bf16_t* row_ptr(int item, int k) const { const int ct = item & 7, rp = (item >> 3) & 63, batch = item >> 9; return PA + ((size_t)batch * 4096 + 64 * rp + k) * 2048 + ct * 256; }
    DI void epilogue(const f32x4 (&acc)[2][4], int item, int wid, int fr, int fq, LAS unsigned char*) const {
        const int ct = item & 7, rp = (item >> 3) & 63, batch = item >> 9, g = ct >> 1;
        const int ch0 = ct * 256 + 32 * wid + 4 * fq;
        const f32x4 sc0 = *(const f32x4*)(scale + ch0), sc1 = *(const f32x4*)(scale + ch0 + 16);
#pragma unroll
        for (int ni = 0; ni < 4; ++ni) { const int n = 16 * ni + fr; const float rc = pool_rcnt(g, n); const size_t tok = (size_t)batch * 4096 + 64 * rp + n;
            u32x2 w[2], uu[2], zz[2]; bf16_t* up0 = UC + tok * 2048 + ch0;
            ld_pair16(up0, fq, uu[0], uu[1]); ld_pair16(ZC + tok * 2048 + ch0, fq, zz[0], zz[1]);
#pragma unroll
            for (int i = 0; i < 2; ++i) { const u32x2 u = uu[i], z = zz[i]; const f32x4 a = acc[i][ni] * rc; const f32x4 sc = i ? sc1 : sc0;
                w[i].x = pk2((a[0] - lo_f(u.x)) * sc[0] * lo_f(z.x), (a[1] - hi_f(u.x)) * sc[1] * hi_f(z.x));
                w[i].y = pk2((a[2] - lo_f(u.y)) * sc[2] * lo_f(z.y), (a[3] - hi_f(u.y)) * sc[3] * hi_f(z.y)); }
            st_pair16(up0, w[0], w[1], fq); }
    }
};

DI void ph_ya(const Params& p) {
    const int tid = opaque_tid(), wid = tid >> 6, lane = tid & 63;
    const bf16_t* HF = (const bf16_t*)p.ws; const bf16_t* HB = (const bf16_t*)(p.ws + PLANE); const bf16_t* O = (const bf16_t*)(p.ws + 3 * PLANE); const bf16_t* ZA = (const bf16_t*)(p.ws + 4 * PLANE);
    bf16_t* Y = (bf16_t*)p.out;
    f32x4 hg[4];
#pragma unroll
    for (int i = 0; i < 4; ++i) hg[i] = *(const f32x4*)(p.head_norm + lane * 16 + 4 * i);
    for (int r = blockIdx.x * 8 + wid; r < NX; r += gridDim.x * 8) {
        const size_t o = (size_t)r * 1024 + lane * 16;
        float gv[16], za[16]; float ss = 0.f;
#pragma unroll
        for (int hh = 0; hh < 2; ++hh) { const u32x4 a = *(const u32x4*)(HF + o + 8 * hh), bq = *(const u32x4*)(HB + o + 8 * hh), oo = *(const u32x4*)(O + o + 8 * hh), zz = *(const u32x4*)(ZA + o + 8 * hh);
#pragma unroll
            for (int e = 0; e < 4; ++e) { const float h0 = lo_f(a[e]) + lo_f(bq[e]), h1 = hi_f(a[e]) + hi_f(bq[e]);
                const float g0 = sigmoid_f(lo_f(oo[e])) * h0, g1 = sigmoid_f(hi_f(oo[e])) * h1;
                gv[8 * hh + 2 * e] = g0; gv[8 * hh + 2 * e + 1] = g1; ss += g0 * g0 + g1 * g1; za[8 * hh + 2 * e] = lo_f(zz[e]); za[8 * hh + 2 * e + 1] = hi_f(zz[e]); } }
        ss += __shfl_xor(ss, 1); ss += __shfl_xor(ss, 2); ss += __shfl_xor(ss, 4); ss += __shfl_xor(ss, 8);
        const float rstd = rsqrtf(ss * (1.0f / 256.0f) + 1e-6f);
        u32x4 w[2];
#pragma unroll
        for (int q = 0; q < 8; ++q) { const float y0 = gv[2 * q] * rstd * hg[q >> 1][(2 * q) & 3] * silu_f(za[2 * q]), y1 = gv[2 * q + 1] * rstd * hg[q >> 1][(2 * q + 1) & 3] * silu_f(za[2 * q + 1]);
            w[q >> 2][q & 3] = pk2(y0, y1); }
        *(u32x4*)(Y + (size_t)r * 2048 + lane * 16) = w[0]; *(u32x4*)(Y + (size_t)r * 2048 + lane * 16 + 8) = w[1];
    }
}


#define XB_TMO      128
#define XB_XCNT(j)  (256  + 64 * (j))
#define XB_XSUB(j)  (1280 + 64 * (j))
#define XB_XGEN(j)  (2304 + 64 * (j))
#define XB_TOP      3328
#define XB_TOPGEN   3392
#define XCD_BAR_WORDS 3456
#define XB_SPIN_CAP (1u << 18)
DI unsigned xb_ld(unsigned* p)              { return __hip_atomic_load(p, __ATOMIC_RELAXED, __HIP_MEMORY_SCOPE_AGENT); }
DI unsigned xb_add(unsigned* p, unsigned v) { return __hip_atomic_fetch_add(p, v, __ATOMIC_RELAXED, __HIP_MEMORY_SCOPE_AGENT); }
DI unsigned xb_xcc_id() { return (unsigned)__builtin_amdgcn_s_getreg((3 << 11) | 20) & 0xFu; }
#define XB_SPIN(cond, bar) do { unsigned _sp = 0; while (cond) { __builtin_amdgcn_s_sleep(1); \
    if ((++_sp & 255u) == 0u) { if (xb_ld(&(bar)[XB_TMO])) break; if (_sp > XB_SPIN_CAP) { atomicAdd(&(bar)[XB_TMO], 1u); break; } } } } while (0)
struct XcdBarrier { unsigned* bar; unsigned x; volatile LAS unsigned* st; };
DI XcdBarrier xcd_barrier_post(unsigned* bar, volatile LAS unsigned* st) {
    XcdBarrier b; b.bar = bar; b.x = xb_xcc_id(); b.st = st;
    if (threadIdx.x == 0) (void)xb_add(&bar[XB_XCNT(b.x)], 1u);
    return b;
}
DI void xcd_barrier_complete(unsigned* bar, unsigned x, unsigned& nloc, unsigned& nx) {
    const unsigned G = gridDim.x * gridDim.y * gridDim.z;
    unsigned sum, cnt, mine, sp = 0u;
    for (;;) {
        sum = 0u; cnt = 0u; mine = 0u;
#pragma unroll
        for (unsigned j = 0; j < 16; ++j) { const unsigned c = xb_ld(&bar[XB_XCNT(j)]); sum += c; cnt += (c > 0u) ? 1u : 0u; mine = (j == x) ? c : mine; }
        if (sum == G) break;
        __builtin_amdgcn_s_sleep(1);
        if ((++sp & 255u) == 0u) { if (xb_ld(&bar[XB_TMO])) break; if (sp > XB_SPIN_CAP) { atomicAdd(&bar[XB_TMO], 1u); break; } }
    }
    nloc = mine > 0u ? mine : 1u; nx = cnt > 0u ? cnt : 1u;
}
DI void xcd_barrier(const XcdBarrier& b) {
    asm volatile("s_waitcnt vmcnt(0)" ::: "memory");
    __syncthreads();
    if (threadIdx.x == 0) {
        unsigned* bar = b.bar;
        __builtin_amdgcn_s_waitcnt(0);
        unsigned nloc = b.st[0], nx = b.st[1];
        if (nloc == 0u) { xcd_barrier_complete(bar, b.x, nloc, nx); b.st[0] = nloc; b.st[1] = nx; }
        const unsigned old = xb_add(&bar[XB_XSUB(b.x)], 1u);
        const unsigned gen = old / nloc;
        if (old + 1u == (gen + 1u) * nloc) {
            __builtin_amdgcn_fence(__ATOMIC_RELEASE, "agent");
            asm volatile("s_waitcnt vmcnt(0)" ::: "memory");
            const unsigned og = xb_add(&bar[XB_TOP], 1u);
            const unsigned tg = og / nx;
            if (og + 1u == (tg + 1u) * nx) xb_add(&bar[XB_TOPGEN], 1u);
            else XB_SPIN(xb_ld(&bar[XB_TOPGEN]) == tg, bar);
            __builtin_amdgcn_fence(__ATOMIC_ACQUIRE, "agent");
            xb_add(&bar[XB_XGEN(b.x)], 1u);
            asm volatile("s_waitcnt vmcnt(0)" ::: "memory");
        } else {
            XB_SPIN(xb_ld(&bar[XB_XGEN(b.x)]) == gen, bar);
            __builtin_amdgcn_fence(__ATOMIC_ACQUIRE, "agent");
            asm volatile("s_waitcnt vmcnt(0)" ::: "memory");
        }
    }
    __syncthreads();
}

__global__ void __launch_bounds__(512, 2) mk_fwd(Params p, int ph_lo, int ph_hi) {
    extern __shared__ __attribute__((aligned(16))) unsigned char shm[];
    LAS unsigned char* lds = (LAS unsigned char*)shm;
    cg::grid_group grid = cg::this_grid();
    unsigned char* ws = p.ws;
    const int G = gridDim.x, c = blockIdx.x;
    volatile LAS unsigned* xst = (volatile LAS unsigned*)(lds + LDS_BYTES - 16);
    if (threadIdx.x == 0) { xst[0] = 0u; xst[1] = 0u; }
    __syncthreads();
    XcdBarrier xbar; xbar.bar = (unsigned*)(ws + WS_BAR); xbar.x = 0u; xbar.st = xst;
    if (ph_hi - ph_lo > 1) xbar = xcd_barrier_post((unsigned*)(ws + WS_BAR), xst);
    if (ph_lo > 1000) grid.sync();
#ifndef PHMASK
#define PHMASK 0xFFFF
#endif
#define GSYNC() xcd_barrier(xbar)
#ifndef REP_MASK
#define REP_MASK 0
#endif
#define PHASE(i, ...) if constexpr ((PHMASK >> (i)) & 1) if (ph_lo <= (i) && (i) < ph_hi) { __VA_ARGS__; if constexpr ((REP_MASK >> (i)) & 1) { __syncthreads(); __VA_ARGS__; } if ((i) + 1 < ph_hi) GSYNC(); }
    PHASE(0, ph_prep(p, lds));
    PHASE(1, ph_norm0(p, lds));
    PHASE(2, { GemmD g{(const bf16_t*)p.out, (const bf16_t*)(ws + WS_WINE), 1024, 1024, 0, 0, 1024}; Sched S{128, 28, 1, 8, 12, 128, G, c};
               EpiPlanes E{(bf16_t*)ws, (bf16_t*)(ws + WS_CRAW)}; gemm_phase(lds, g, S, E);
               if (G == 256) {
                   if (c >= 96 && c < 128) { GemmD gf{(const bf16_t*)(ws + WS_WPOOL), (const bf16_t*)((const unsigned char*)p.out + (size_t)96 * 1024 * 1024), 512, 2048, (long)512 * 512, 512, 512};
                       Sched Sf{2, 4, 4, 0, 0, 0, 32, c - 96}; EpiBf Ef{(bf16_t*)(ws + WS_WINO), nullptr, 1024, 512 * 1024, 0, nullptr, nullptr}; gemm_phase(lds, gf, Sf, Ef); }
                   else if (c >= 128) { transpose_jobs(p, lds, opaque_tid(), 2816, 3328, c - 128, 128); transpose_jobs(p, lds, opaque_tid(), 3584, 4096, c - 128, 128); }
               } });
    PHASE(3, ph_conv(p));
    PHASE(4, ph_mlstm(p, lds));
    PHASE(5, { GemmD g{(const bf16_t*)(ws + 5 * PLANE), (const bf16_t*)(ws + WS_WF), 1024, 256, 256, 512 * 256, 256}; Sched S{128, 2, 4, 0, 0, 0, G, c};
               EpiBf E{(bf16_t*)p.out, nullptr, 2048, 512, 0, nullptr, nullptr}; gemm_phase(lds, g, S, E); });
    PHASE(6, { CfgDft1 cf{(const bf16_t*)p.out, (bf16_t*)(ws + 2 * PLANE), (bf16_t*)(ws + 5 * PLANE)}; axis_mix<128, 128>(cf, lds, 2048); });
    PHASE(7, { CfgDft2 cf{(const bf16_t*)(ws + 2 * PLANE), (const bf16_t*)(ws + 5 * PLANE), (const bf16_t*)(ws + 6 * PLANE), (bf16_t*)p.out}; axis_mix<128, 64>(cf, lds, 2048); ph_ya(p); });
    PHASE(8, { GemmD g{(const bf16_t*)p.out, (const bf16_t*)(ws + WS_WOUTE), 2048, 2048, 0, 0, 2048}; Sched S{128, 4, 1, 0, 0, 0, G, c};
               EpiGate E{(bf16_t*)ws, (const float*)(ws + WS_MOD) + 2048}; gemm_phase(lds, g, S, E); });
    PHASE(9, ph_norm1(p, 0));
    PHASE(10, { GemmD g{(const bf16_t*)(ws + 2 * PLANE), (const bf16_t*)(ws + WS_WINO), 1024, 1024, 0, 0, 1024}; Sched S{128, 16, 1, 0, 0, 0, G, c};
                EpiBf E{(bf16_t*)(ws + 3 * PLANE), (bf16_t*)(ws + 5 * PLANE), 2048, 0, 1, nullptr, nullptr}; gemm_phase(lds, g, S, E); });
    PHASE(11, { CfgPoolA cf{(const bf16_t*)(ws + 3 * PLANE), (bf16_t*)p.out}; axis_mix<64, 64>(cf, lds, 4096); });
    PHASE(12, { CfgPoolB cf{(const bf16_t*)p.out, (bf16_t*)(ws + 3 * PLANE), (const bf16_t*)(ws + 5 * PLANE), p.pool_scale}; axis_mix<64, 64>(cf, lds, 4096); });
    PHASE(14, { GemmD g{(const bf16_t*)(ws + 3 * PLANE), (const bf16_t*)(ws + WS_WOUTO), 2048, 2048, 0, 0, 2048}; Sched S{128, 4, 1, 0, 0, 0, G, c};
                EpiGate E{(bf16_t*)(ws + PLANE), (const float*)(ws + WS_MOD) + 9 * 3072 + 2048}; gemm_phase(lds, g, S, E); });
    PHASE(15, ph_norm1(p, 1));
#undef PHASE
#ifdef XSYNC
    for (int k = 0; k < XSYNC; ++k) GSYNC();
#endif
#ifdef DBG_STOP
    GSYNC();
    {   const size_t n = (size_t)NX * 1024; unsigned* o32 = (unsigned*)p.out;
        for (size_t i = (size_t)blockIdx.x * 512 + threadIdx.x; i < n; i += (size_t)gridDim.x * 512) {
            float v = 0.f;
            if (DBG_PLANES == -1) { const unsigned u = o32[i]; v = lo_f(u) + hi_f(u); }
            else if (DBG_PLANES == -2) { v = ((const float*)p.ws)[i]; }
            else { for (int pl = 0; pl < 7; ++pl) if ((DBG_PLANES >> pl) & 1) v += bf2f(((const bf16_t*)(p.ws + pl * PLANE))[i]); }
            if (!(fabsf(v) < 1e30f)) v = 12345.f;
            p.out[i] = v; } }
#endif
}

extern "C" void kernel_launch(void* const* d_in, const int* in_sizes, int n_in, void* d_out, int out_size, void* d_ws, size_t ws_size, hipStream_t stream) {
    static int grid = 0;
    if (grid == 0) {
        int dev = 0, cus = 0, per_cu = 0;
        hipGetDevice(&dev);
        hipDeviceGetAttribute(&cus, hipDeviceAttributeMultiprocessorCount, dev);
        if (hipFuncSetAttribute((const void*)mk_fwd, hipFuncAttributeMaxDynamicSharedMemorySize, LDS_BYTES) != hipSuccess) fprintf(stderr, "hipFuncSetAttribute failed\n");
        if (hipOccupancyMaxActiveBlocksPerMultiprocessor(&per_cu, (const void*)mk_fwd, 512, LDS_BYTES) != hipSuccess || per_cu < 1) { fprintf(stderr, "occupancy query: %d\n", per_cu); per_cu = 1; }
        (void)hipGetLastError();
        grid = cus * per_cu; if (grid > 256) grid = 256; if (grid < 1) grid = 1;
        if (ws_size < WS_END) fprintf(stderr, "workspace too small: %zu < %zu\n", ws_size, (size_t)WS_END);
    }
    Params p{};
    p.x = (const float*)d_in[0]; p.c = (const float*)d_in[1]; p.ctx = (const float*)d_in[2]; p.c_ctx = (const float*)d_in[3]; p.ada_w = (const float*)d_in[4]; p.ada_b = (const float*)d_in[5];
    p.norm_g = (const float*)d_in[6]; p.win_even = (const float*)d_in[7]; p.gate_b = (const float*)d_in[8]; p.conv_qk = (const float*)d_in[9]; p.head_norm = (const float*)d_in[10];
    p.fourier_w = (const float*)d_in[11]; p.wout_even = (const float*)d_in[12]; p.win_odd = (const float*)d_in[13]; p.pool_w = (const float*)d_in[14]; p.pool_scale = (const float*)d_in[15];
    p.wout_odd = (const float*)d_in[16]; p.final_g = (const float*)d_in[17]; p.out = (float*)d_out; p.ws = (unsigned char*)d_ws;
    (void)hipMemsetAsync((unsigned char*)d_ws + WS_BAR, 0, XCD_BAR_WORDS * 4, stream);
#if MK_MULTI
    for (int ph = 0; ph < 16; ++ph) { hipLaunchKernelGGL(mk_fwd, dim3(grid), dim3(512), LDS_BYTES, stream, p, ph, ph + 1); }
#else
#ifdef DBG_STOP
    int lo = 0, hi = DBG_STOP;
#else
    int lo = 0, hi = 16;
#endif
    void* args[] = {&p, &lo, &hi};
    hipError_t e = hipLaunchCooperativeKernel((void*)mk_fwd, dim3(grid), dim3(512), args, LDS_BYTES, stream);
    if (e != hipSuccess) fprintf(stderr, "cooperative launch failed: %s (grid %d)\n", hipGetErrorString(e), grid);
#endif
}
```

```cpp
#include <hip/hip_runtime.h>
#include <hip/hip_cooperative_groups.h>
#include <cstdio>
namespace cg = cooperative_groups;

#ifndef MK_MULTI
#define MK_MULTI 0
#endif

#define LAS __attribute__((address_space(3)))
typedef unsigned short bf16_t;
typedef short bf16x8 __attribute__((ext_vector_type(8)));
typedef short s16x4 __attribute__((ext_vector_type(4)));
typedef float f32x4 __attribute__((ext_vector_type(4)));
typedef unsigned u32x4 __attribute__((ext_vector_type(4)));
typedef unsigned u32x2 __attribute__((ext_vector_type(2)));

constexpr int NX = 32768, NCX = 2048, NR = NX + NCX;
constexpr size_t PLANE = (size_t)NX * 1024 * 2;
constexpr size_t WS_EXTRA = 7 * PLANE;
constexpr size_t WS_WINE  = WS_EXTRA;
constexpr size_t WS_WOUTE = WS_WINE  + (size_t)7168 * 1024 * 2;
constexpr size_t WS_WINO  = WS_WOUTE + (size_t)1024 * 2048 * 2;
constexpr size_t WS_WPOOL = WS_WINO  + (size_t)4096 * 1024 * 2;
constexpr size_t WS_WOUTO = WS_WPOOL + (size_t)4 * 512 * 512 * 2;
constexpr size_t WS_WF    = WS_WOUTO + (size_t)1024 * 2048 * 2;
constexpr size_t WS_MOD   = WS_WF    + (size_t)4 * 512 * 256 * 2;
constexpr size_t WS_GATES = WS_MOD   + 262144;
constexpr size_t WS_CRAW  = WS_GATES + (size_t)NR * 16 * 4;
constexpr size_t WS_CQC   = WS_CRAW  + (size_t)3 * NCX * 1024 * 2;
constexpr size_t WS_CKC   = WS_CQC   + (size_t)NCX * 1024 * 2;
constexpr size_t WS_END   = WS_CKC   + (size_t)NCX * 1024 * 2;
constexpr size_t WS_GPRE  = WS_END + 16384;
constexpr size_t WS_GPRE_END = WS_GPRE + (size_t)64 * 68 * 384 * 4;
static_assert(WS_GPRE_END <= (size_t)512 * 1024 * 1024, "gate tables exceed the workspace");
constexpr size_t WS_BAR   = WS_END;
static_assert(WS_BAR + 16384 <= (size_t)512 * 1024 * 1024, "workspace map exceeds 512 MiB");

constexpr int LDS_BYTES = 155648;

struct Params {
    const float* x; const float* c; const float* ctx; const float* c_ctx; const float* ada_w; const float* ada_b; const float* norm_g;
    const float* win_even; const float* gate_b; const float* conv_qk; const float* head_norm; const float* fourier_w; const float* wout_even;
    const float* win_odd; const float* pool_w; const float* pool_scale; const float* wout_odd; const float* final_g;
    float* out; unsigned char* ws;
};

#define DI __device__ __forceinline__
DI float bf2f(unsigned short b) { return __uint_as_float(((unsigned)b) << 16); }
DI float lo_f(unsigned u) { return __uint_as_float(u << 16); }
DI float hi_f(unsigned u) { return __uint_as_float(u & 0xffff0000u); }
typedef __bf16 bf16v2_t __attribute__((ext_vector_type(2)));
typedef float f32v2_t __attribute__((ext_vector_type(2)));
DI unsigned pk2(float lo, float hi) { const f32v2_t v = {lo, hi}; const bf16v2_t b = __builtin_convertvector(v, bf16v2_t); return __builtin_bit_cast(unsigned, b); }
DI float silu_f(float x) { return x / (1.0f + __expf(-x)); }
DI float sigmoid_f(float x) { return 1.0f / (1.0f + __expf(-x)); }
DI int opaque_tid() { int t = threadIdx.x; asm volatile("" : "+v"(t)); return t; }
DI float wave_sum(float v) { for (int o = 32; o > 0; o >>= 1) v += __shfl_xor(v, o); return v; }
DI float wave_max(float v) { for (int o = 32; o > 0; o >>= 1) v = fmaxf(v, __shfl_xor(v, o)); return v; }
DI void st_pair16(bf16_t* base0, u32x2 w0, u32x2 w1, int fq) {
    const auto rx = __builtin_amdgcn_permlane16_swap(w0.x, w1.x, false, false);
    const auto ry = __builtin_amdgcn_permlane16_swap(w0.y, w1.y, false, false);
    u32x4 v; v.x = rx[0]; v.y = ry[0]; v.z = rx[1]; v.w = ry[1];
    *(u32x4*)((fq & 1) ? base0 + 12 : base0) = v;
}
DI unsigned swap1(unsigned x) { return (unsigned)__builtin_amdgcn_mov_dpp((int)x, 0xB1, 0xF, 0xF, true); }
DI void st_adj16(bf16_t* pa, bf16_t* pb, u32x2 a, u32x2 b, int lane) {
    const bool odd = lane & 1;
    const unsigned rx = swap1(odd ? a.x : b.x), ry = swap1(odd ? a.y : b.y);
    u32x4 v; v.x = odd ? rx : a.x; v.y = odd ? ry : a.y; v.z = odd ? b.x : rx; v.w = odd ? b.y : ry;
    *(u32x4*)(odd ? pb - 4 : pa) = v;
}
DI void ld_adj16(const bf16_t* pa, const bf16_t* pb, int lane, u32x2& a, u32x2& b) {
    const bool odd = lane & 1;
    const u32x4 v = *(const u32x4*)(odd ? pb - 4 : pa);
    const unsigned rx = swap1(odd ? v.x : v.z), ry = swap1(odd ? v.y : v.w);
    a.x = odd ? rx : v.x; a.y = odd ? ry : v.y; b.x = odd ? v.z : rx; b.y = odd ? v.w : ry;
}
DI void ld_pair16(const bf16_t* base0, int fq, u32x2& w0, u32x2& w1) {
    const u32x4 v = *(const u32x4*)((fq & 1) ? base0 + 12 : base0);
    const auto rx = __builtin_amdgcn_permlane16_swap(v.x, v.z, false, false);
    const auto ry = __builtin_amdgcn_permlane16_swap(v.y, v.w, false, false);
    w0.x = rx[0]; w1.x = rx[1]; w0.y = ry[0]; w1.y = ry[1];
}
DI f32x4 mfma16(bf16x8 a, bf16x8 b, f32x4 c) { return __builtin_amdgcn_mfma_f32_16x16x32_bf16(a, b, c, 0, 0, 0); }
DI bf16x8 tr_frag(LAS unsigned char* img, int pitch, int krow0, int col0, int lane) {
    const int g = lane >> 4, q = (lane & 15) >> 2, pp = lane & 3;
    LAS unsigned char* a0 = img + (krow0 + 8 * g + q) * pitch + col0 * 2 + 8 * pp;
    s16x4 lo = __builtin_amdgcn_ds_read_tr16_b64_v4i16((LAS s16x4*)a0);
    s16x4 hi = __builtin_amdgcn_ds_read_tr16_b64_v4i16((LAS s16x4*)(a0 + 4 * pitch));
    return __builtin_shufflevector(lo, hi, 0, 1, 2, 3, 4, 5, 6, 7);
}

constexpr int HTB = 128 * 64 * 2;
DI int lds_byte(int r, int c) { const int st = (r >> 4) * 2 + (c >> 5), rr = r & 15, cc = c & 31, ob = rr * 64 + cc * 2; return st * 1024 + (ob ^ (((ob >> 9) & 1) << 5)); }
DI void stage_rc(int b, int& R, int& C) { const int st = b / 1024, sb = b % 1024, swz = sb ^ (((sb >> 9) & 1) << 5); R = (st >> 1) * 16 + swz / 64; C = (st & 1) * 32 + (swz % 64) / 2; }
DI int perm32(int rho) { const int n = rho >> 4, i = rho & 15; return 8 * (i >> 2) + 4 * n + (i & 3); }

struct Unit { int pm, pn, g; };
struct GemmD { const bf16_t* A; const bf16_t* Bt; int lda, ldb; long a_gs, b_gs; int K; };
struct Sched {
    int nM, nN, nG, nM2, nN2, pm2off, G, c;
    DI bool next(int i, Unit& u) const {
        const int L = i * G + c; const int nwg = nM * nN, tot1 = nwg * nG;
        const bool first = L < tot1;
        const int L1 = first ? L : 0;
        const int g = L1 / nwg; int wgid = L1 - g * nwg;
        { const int q = nwg / 8, r = nwg % 8, xcd = wgid % 8, off = wgid / 8; wgid = (xcd < r ? xcd * (q + 1) : r * (q + 1) + (xcd - r) * q) + off; }
        const int nig = 8 * nN, gid = wgid / nig, fm = gid * 8, gsz = (nM - fm) < 8 ? (nM - fm) : 8;
        const int pm1 = fm + ((wgid % nig) % gsz), pn1 = (wgid % nig) / gsz;
        const int L2 = first ? 0 : L - tot1, d2 = nM2 > 0 ? nM2 : 1;
        const int pm2 = pm2off + L2 % d2, pn2 = L2 / d2;
        u.pm = first ? pm1 : pm2; u.pn = first ? pn1 : pn2; u.g = first ? g : 0;
        return first || (L2 < nM2 * nN2);
    }
};

template <class Epi>
DI void gemm_phase(LAS unsigned char* lds, const GemmD g, const Sched& S, const Epi& E) {
    const int tid = opaque_tid(), wid = __builtin_amdgcn_readfirstlane(tid >> 6), lane = tid & 63, wr = wid >> 2, wc = wid & 3, fr = lane & 15, fq = lane >> 4;
    const int K = g.K, nt = K / 64;
    unsigned voffA[2], voffB[2];
#pragma unroll
    for (int i = 0; i < 2; ++i) { int R, C; stage_rc(tid * 16 + i * 8192, R, C); const int Rb = Epi::PERM ? ((R & ~31) + perm32(R & 31)) : R;
        voffA[i] = (unsigned)(R * g.lda + C) * 2u; voffB[i] = (unsigned)(Rb * g.ldb + C) * 2u; }
    const size_t kstep = 128;
    const size_t hstepA = (size_t)128 * g.lda * 2, hstepB = (size_t)128 * g.ldb * 2;
    const unsigned ldsw = (unsigned)wid * 1024u;
    const int aoff = lds_byte(wr * 64 + fr, fq * 8), boff = lds_byte(wc * 32 + fr, fq * 8);
#define G_SA(b, h) (((b) * 2 + (h)) * HTB)
#define G_SB(b, h) ((4 + (b) * 2 + (h)) * HTB)
#define G_STAGE(bufoff, gbase, voff) do { _Pragma("unroll") for (int _i = 0; _i < 2; ++_i) \
        __builtin_amdgcn_global_load_lds((const unsigned*)((const char*)(gbase) + (voff)[_i]), (LAS unsigned*)(lds + (bufoff) + ldsw + _i * 8192), 16, 0, 0); } while (0)
#define G_LDA(dst, b, h) do { _Pragma("unroll") for (int m = 0; m < 4; ++m) _Pragma("unroll") for (int k = 0; k < 2; ++k) dst[m][k] = *(const LAS bf16x8*)(lds + G_SA(b, h) + aoff + m * 2048 + k * 1024); } while (0)
#define G_LDB(dst, b, h) do { _Pragma("unroll") for (int n = 0; n < 2; ++n) _Pragma("unroll") for (int k = 0; k < 2; ++k) dst[n][k] = *(const LAS bf16x8*)(lds + G_SB(b, h) + boff + n * 2048 + k * 1024); } while (0)
#define G_MMA(ai, bj, At, Bt) do { __builtin_amdgcn_s_setprio(1); _Pragma("unroll") for (int m = 0; m < 4; ++m) _Pragma("unroll") for (int n = 0; n < 2; ++n) _Pragma("unroll") for (int k = 0; k < 2; ++k) \
        acc[ai][bj][m][n] = __builtin_amdgcn_mfma_f32_16x16x32_bf16(Bt[n][k], At[m][k], acc[ai][bj][m][n], 0, 0, 0); __builtin_amdgcn_s_setprio(0); } while (0)
#define G_WAIT_V(n) asm volatile("s_waitcnt vmcnt(" #n ")" ::: "memory")
#define G_WAIT_L(n) asm volatile("s_waitcnt lgkmcnt(" #n ")" ::: "memory")
#define G_BAR __builtin_amdgcn_s_barrier()
#define G_SCHED __builtin_amdgcn_sched_barrier(0)
    Unit cur, nxt; int ui = 0;
    if (!S.next(0, cur)) return;
    f32x4 acc[2][2][4][2];
#pragma unroll
    for (int a = 0; a < 2; ++a)
#pragma unroll
        for (int b = 0; b < 2; ++b)
#pragma unroll
            for (int m = 0; m < 4; ++m)
#pragma unroll
                for (int n = 0; n < 2; ++n) acc[a][b][m][n] = (f32x4){0.f, 0.f, 0.f, 0.f};
    bf16x8 At[4][2], B0[2][2], B1[2][2];
    const char* cA = (const char*)(g.A + (long)cur.g * g.a_gs) + (size_t)cur.pm * 2 * hstepA;
    const char* cB = (const char*)(g.Bt + (long)cur.g * g.b_gs) + (size_t)cur.pn * 2 * hstepB;
    G_STAGE(G_SB(0, 0), cB, voffB); G_STAGE(G_SA(0, 0), cA, voffA); G_STAGE(G_SB(0, 1), cB + hstepB, voffB); G_STAGE(G_SA(0, 1), cA + hstepA, voffA);
    if (wr == 1) G_BAR;
    G_WAIT_V(4); G_BAR;
    G_STAGE(G_SB(1, 0), cB + kstep, voffB); G_STAGE(G_SA(1, 0), cA + kstep, voffA); G_STAGE(G_SB(1, 1), cB + hstepB + kstep, voffB);
    G_WAIT_V(6); G_BAR;
    for (;;) {
        const bool has_next = S.next(ui + 1, nxt);
        const char* nA = has_next ? (const char*)(g.A + (long)nxt.g * g.a_gs) + (size_t)nxt.pm * 2 * hstepA : cA;
        const char* nB = has_next ? (const char*)(g.Bt + (long)nxt.g * g.b_gs) + (size_t)nxt.pn * 2 * hstepB : cB;
        for (int t = 0; t < nt; t += 2) {
            const bool last = (t == nt - 2);
            const char* a1 = cA + (size_t)(t + 1) * kstep;
            const char* a2 = last ? nA : cA + (size_t)(t + 2) * kstep; const char* b2 = last ? nB : cB + (size_t)(t + 2) * kstep;
            const char* a3 = a2 + kstep; const char* b3 = b2 + kstep;
            G_LDB(B0, 0, 0); G_SCHED; G_LDA(At, 0, 0); G_STAGE(G_SA(1, 1), a1 + hstepA, voffA);
            G_WAIT_L(8); G_BAR; G_WAIT_L(0); G_MMA(0, 0, At, B0); G_BAR; G_SCHED;
            G_LDB(B1, 0, 1); G_STAGE(G_SB(0, 0), b2, voffB);
            G_BAR; G_WAIT_L(0); G_MMA(0, 1, At, B1); G_BAR;
            G_LDA(At, 0, 1); G_STAGE(G_SA(0, 0), a2, voffA);
            G_BAR; G_WAIT_L(0); G_MMA(1, 0, At, B0); G_BAR; G_SCHED;
            G_STAGE(G_SB(0, 1), b2 + hstepB, voffB);
            G_WAIT_V(6); G_BAR; G_MMA(1, 1, At, B1); G_BAR;
            G_LDB(B0, 1, 0); G_SCHED; G_LDA(At, 1, 0); G_STAGE(G_SA(0, 1), a2 + hstepA, voffA);
            G_WAIT_L(8); G_BAR; G_WAIT_L(0); G_MMA(0, 0, At, B0); G_BAR; G_SCHED;
            G_LDB(B1, 1, 1); G_STAGE(G_SB(1, 0), b3, voffB);
            G_BAR; G_WAIT_L(0); G_MMA(0, 1, At, B1); G_BAR;
            G_LDA(At, 1, 1); G_STAGE(G_SA(1, 0), a3, voffA);
            G_BAR; G_WAIT_L(0); G_MMA(1, 0, At, B0); G_BAR; G_SCHED;
            G_STAGE(G_SB(1, 1), b3 + hstepB, voffB);
            G_WAIT_V(6); G_BAR; G_MMA(1, 1, At, B1); G_BAR;
        }
        E(acc, cur, wr, wc, fr, fq);
        if (!has_next) break;
#pragma unroll
        for (int a = 0; a < 2; ++a)
#pragma unroll
            for (int b = 0; b < 2; ++b)
#pragma unroll
                for (int m = 0; m < 4; ++m)
#pragma unroll
                    for (int n = 0; n < 2; ++n) acc[a][b][m][n] = (f32x4){0.f, 0.f, 0.f, 0.f};
        cur = nxt; cA = nA; cB = nB; ++ui;
    }
    G_WAIT_V(0);
    if (wr == 0) G_BAR;
    G_BAR;
}

struct EpiPlanes {
    static constexpr bool PERM = true;
    bf16_t* xbase; bf16_t* cbase;
    DI void operator()(const f32x4 (&acc)[2][2][4][2], const Unit& u, int wr, int wc, int fr, int fq) const {
        const int plane = u.pn >> 2, colt = (u.pn & 3) * 256;
        bf16_t* base; int row0;
        if (u.pm < 128) { base = xbase + (size_t)plane * NX * 1024; row0 = u.pm * 256 + wr * 64 + fr; }
        else { base = cbase + (size_t)plane * NCX * 1024; row0 = (u.pm - 128) * 256 + wr * 64 + fr; }
        const int col0 = colt + wc * 32 + 8 * fq;
#pragma unroll
        for (int ai = 0; ai < 2; ++ai)
#pragma unroll
            for (int m = 0; m < 4; ++m) { bf16_t* rowp = base + (size_t)(row0 + ai * 128 + m * 16) * 1024 + col0;
#pragma unroll
                for (int bj = 0; bj < 2; ++bj) { const f32x4 v0 = acc[ai][bj][m][0], v1 = acc[ai][bj][m][1];
                    u32x4 w; w.x = pk2(v0[0], v0[1]); w.y = pk2(v0[2], v0[3]); w.z = pk2(v1[0], v1[1]); w.w = pk2(v1[2], v1[3]);
                    *(u32x4*)(rowp + bj * 128) = w; } }
    }
};
struct EpiBf {
    static constexpr bool PERM = true;
    bf16_t* O; bf16_t* O2; int ldc; int gcol; int mode; const float* scale; const bf16_t* zc;
    DI void operator()(const f32x4 (&acc)[2][2][4][2], const Unit& u, int wr, int wc, int fr, int fq) const {
        const int row0 = u.pm * 256 + wr * 64 + fr;
        bf16_t* base = O; int pn = u.pn; bool act = false;
        if (mode == 1 && pn >= 8) { base = O2; pn -= 8; act = true; }
        const int col0 = u.g * gcol + pn * 256 + wc * 32 + 8 * fq;
        f32x4 sc[2][2];
#pragma unroll
        for (int bj = 0; bj < 2; ++bj) { sc[bj][0] = (mode == 2) ? *(const f32x4*)(scale + col0 + bj * 128) : (f32x4){1.f, 1.f, 1.f, 1.f}; sc[bj][1] = (mode == 2) ? *(const f32x4*)(scale + col0 + bj * 128 + 4) : (f32x4){1.f, 1.f, 1.f, 1.f}; }
        u32x4 zq[2][4][2];
        if (mode == 2) {
#pragma unroll
            for (int ai = 0; ai < 2; ++ai)
#pragma unroll
                for (int m = 0; m < 4; ++m)
#pragma unroll
                    for (int bj = 0; bj < 2; ++bj) zq[ai][m][bj] = *(const volatile u32x4*)(zc + (size_t)(row0 + ai * 128 + m * 16) * ldc + col0 + bj * 128); }
#pragma unroll
        for (int ai = 0; ai < 2; ++ai) {
            u32x4 (&zz)[4][2] = zq[ai];
#pragma unroll
            for (int m = 0; m < 4; ++m) { const size_t ro = (size_t)(row0 + ai * 128 + m * 16) * ldc + col0;
#pragma unroll
                for (int bj = 0; bj < 2; ++bj) { f32x4 v0 = acc[ai][bj][m][0], v1 = acc[ai][bj][m][1];
                    if (act) {
#pragma unroll
                        for (int j = 0; j < 4; ++j) { v0[j] = silu_f(v0[j]); v1[j] = silu_f(v1[j]); } }
                    if (mode == 2) {
                        const u32x4 z = zz[m][bj]; const f32x4 s0 = sc[bj][0], s1 = sc[bj][1];
                        v0[0] *= s0[0] * lo_f(z.x); v0[1] *= s0[1] * hi_f(z.x); v0[2] *= s0[2] * lo_f(z.y); v0[3] *= s0[3] * hi_f(z.y);
                        v1[0] *= s1[0] * lo_f(z.z); v1[1] *= s1[1] * hi_f(z.z); v1[2] *= s1[2] * lo_f(z.w); v1[3] *= s1[3] * hi_f(z.w);
                    }
                    u32x4 w; w.x = pk2(v0[0], v0[1]); w.y = pk2(v0[2], v0[3]); w.z = pk2(v1[0], v1[1]); w.w = pk2(v1[2], v1[3]);
                    *(u32x4*)(base + ro + bj * 128) = w; } } }
    }
};
struct EpiGate {
    static constexpr bool PERM = true;
    bf16_t* O; const float* gate;
    DI void operator()(const f32x4 (&acc)[2][2][4][2], const Unit& u, int wr, int wc, int fr, int fq) const {
        const int row0 = u.pm * 256 + wr * 64 + fr, col0 = u.pn * 256 + wc * 32 + 8 * fq;
        const float* gp = gate + (size_t)(u.pm >> 4) * 3072 + col0;
        f32x4 gv[2][2];
#pragma unroll
        for (int bj = 0; bj < 2; ++bj) { gv[bj][0] = *(const f32x4*)(gp + bj * 128); gv[bj][1] = *(const f32x4*)(gp + bj * 128 + 4); }
#pragma unroll
        for (int ai = 0; ai < 2; ++ai)
#pragma unroll
            for (int m = 0; m < 4; ++m) { bf16_t* rowp = O + (size_t)(row0 + ai * 128 + m * 16) * 1024 + col0;
#pragma unroll
                for (int bj = 0; bj < 2; ++bj) { const f32x4 v0 = acc[ai][bj][m][0] * gv[bj][0], v1 = acc[ai][bj][m][1] * gv[bj][1];
                    u32x4 w; w.x = pk2(v0[0], v0[1]); w.y = pk2(v0[2], v0[3]); w.z = pk2(v1[0], v1[1]); w.w = pk2(v1[2], v1[3]);
                    *(u32x4*)(rowp + bj * 128) = w; } }
    }
};
struct EpiRes {
    static constexpr bool PERM = false;
    float* O; const float* res; const float* gate;
    DI void operator()(const f32x4 (&acc)[2][2][4][2], const Unit& u, int wr, int wc, int fr, int fq) const {
        const int row0 = u.pm * 256 + wr * 64 + fr, col0 = u.pn * 256 + wc * 32 + 4 * fq;
        const float* gp = gate + (size_t)(u.pm >> 4) * 3072 + col0;
        f32x4 gv[2][2];
#pragma unroll
        for (int bj = 0; bj < 2; ++bj)
#pragma unroll
            for (int n = 0; n < 2; ++n) gv[bj][n] = *(const f32x4*)(gp + bj * 128 + n * 16);
#pragma unroll
        for (int ai = 0; ai < 2; ++ai)
#pragma unroll
            for (int mp = 0; mp < 2; ++mp) {
                f32x4 r[2][2][2];
#pragma unroll
                for (int mm = 0; mm < 2; ++mm) { const size_t ro = (size_t)(row0 + ai * 128 + (2 * mp + mm) * 16) * 1024 + col0;
#pragma unroll
                    for (int bj = 0; bj < 2; ++bj)
#pragma unroll
                        for (int n = 0; n < 2; ++n) r[mm][bj][n] = *(const volatile f32x4*)(res + ro + bj * 128 + n * 16); }
#pragma unroll
                for (int mm = 0; mm < 2; ++mm) { const size_t ro = (size_t)(row0 + ai * 128 + (2 * mp + mm) * 16) * 1024 + col0;
#pragma unroll
                    for (int bj = 0; bj < 2; ++bj)
#pragma unroll
                        for (int n = 0; n < 2; ++n) *(f32x4*)(O + ro + bj * 128 + n * 16) = r[mm][bj][n] + gv[bj][n] * acc[ai][bj][2 * mp + mm][n]; }
            }
    }
};

DI void transpose_jobs(const Params& p, LAS unsigned char* lds, int tid, int j_lo, int j_hi, int w, int nw) {
    LAS float* tile = (LAS float*)lds;
    {
        auto job_desc = [&](int job, const float*& src, bf16_t*& dst, int& K, int& Nt, int& k0, int& n0) {
            int j = job, tk, tn;
            if (j < 1792) { src = p.win_even; dst = (bf16_t*)(p.ws + WS_WINE); K = 1024; Nt = 7184; tk = j & 15; tn = j >> 4; }
            else if ((j -= 1792) < 512) { src = p.wout_even; dst = (bf16_t*)(p.ws + WS_WOUTE); K = 2048; Nt = 1024; tk = j & 31; tn = j >> 5; }
            else if ((j -= 512) < 1024) { src = p.win_odd; dst = (bf16_t*)(p.ws + WS_WINO); K = 1024; Nt = 4096; tk = j & 15; tn = j >> 4; }
            else if ((j -= 1024) < 256) { const int g = j >> 6, jj = j & 63; src = p.pool_w + (size_t)g * 512 * 512; dst = (bf16_t*)(p.ws + WS_WPOOL) + (size_t)g * 512 * 512; K = 512; Nt = 512; tk = jj & 7; tn = jj >> 3; }
            else { j -= 256; src = p.wout_odd; dst = (bf16_t*)(p.ws + WS_WOUTO); K = 2048; Nt = 1024; tk = j & 31; tn = j >> 5; }
            k0 = tk * 64; n0 = tn * 64; };
        float rg[8];
        int job = j_lo + w;
        if (job < j_hi) { const float* src; bf16_t* dst; int K, Nt, k0, n0; job_desc(job, src, dst, K, Nt, k0, n0);
#pragma unroll
            for (int i = 0; i < 8; ++i) { const int idx = tid + 512 * i, k = idx >> 6, n = idx & 63; rg[i] = src[(size_t)(k0 + k) * Nt + n0 + n]; } }
        for (; job < j_hi; job += nw) {
            const float* src; bf16_t* dst; int K, Nt, k0, n0; job_desc(job, src, dst, K, Nt, k0, n0);
            __syncthreads();
#pragma unroll
            for (int i = 0; i < 8; ++i) { const int idx = tid + 512 * i, k = idx >> 6, n = idx & 63; tile[k * 65 + n] = rg[i]; }
            __syncthreads();
            const int nj = job + nw;
            if (nj < j_hi) { const float* s2; bf16_t* d2; int K2, Nt2, k2, n2; job_desc(nj, s2, d2, K2, Nt2, k2, n2);
#pragma unroll
                for (int i = 0; i < 8; ++i) { const int idx = tid + 512 * i, k = idx >> 6, n = idx & 63; rg[i] = s2[(size_t)(k2 + k) * Nt2 + n2 + n]; } }
#pragma unroll
            for (int i = 0; i < 4; ++i) { const int idx = tid + 512 * i, n = idx >> 5, k = (idx & 31) * 2;
                *(unsigned*)(dst + (size_t)(n0 + n) * K + k0 + k) = pk2(tile[k * 65 + n], tile[(k + 1) * 65 + n]); }
        }
        __syncthreads();
    }
}
DI void ph_prep(const Params& p, LAS unsigned char* lds) {
    const int tid = opaque_tid();
    transpose_jobs(p, lds, tid, 0, 2304, blockIdx.x, gridDim.x);
    transpose_jobs(p, lds, tid, 3328, 3584, blockIdx.x, gridDim.x);
    {
        bf16_t* RAW = (bf16_t*)((unsigned char*)p.out + (size_t)96 * 1024 * 1024);
        for (int i = blockIdx.x * 512 + tid; i < 1024 * 512; i += gridDim.x * 512) { const int k = i >> 9, c4 = (i & 511) * 4;
            const f32x4 v = *(const f32x4*)(p.win_odd + (size_t)k * 4096 + c4); u32x2 w; w.x = pk2(v[0], v[1]); w.y = pk2(v[2], v[3]); *(u32x2*)(RAW + (size_t)k * 2048 + c4) = w; }
    }
    LAS float* sv = (LAS float*)(lds + 32768);
    LAS float* red = (LAS float*)(lds + 32768 + 36864);
    LAS float* ct = (LAS float*)(lds + 90112); LAS float* st = ct + 256;
    for (int idx = tid; idx < 9216; idx += 512) { const int v = idx >> 10, k = idx & 1023; const float cv = (v < 8) ? p.c[v * 1024 + k] : p.c_ctx[k]; sv[idx] = silu_f(cv); }
    if (tid < 256) { float s, c; sincospif((float)tid / 128.0f, &s, &c); ct[tid] = c; st[tid] = s; }
    __syncthreads();
    float* MOD = (float*)(p.ws + WS_MOD);
    for (int item = blockIdx.x; item < 192; item += gridDim.x) {
        const int l = item / 96, c0 = (item % 96) * 32, kg = tid >> 5, col = tid & 31;
        float a[9];
#pragma unroll
        for (int v = 0; v < 9; ++v) a[v] = 0.f;
        const float* w = p.ada_w + (size_t)l * 1024 * 3072 + c0 + col;
#pragma unroll 16
        for (int k = kg; k < 1024; k += 16) { const float wv = w[(size_t)k * 3072];
#pragma unroll
            for (int v = 0; v < 9; ++v) a[v] += sv[v * 1024 + k] * wv; }
#pragma unroll
        for (int v = 0; v < 9; ++v) red[(kg * 32 + col) * 9 + v] = a[v];
        __syncthreads();
        if (tid < 288) { const int v = tid >> 5, cc = tid & 31; float s = 0.f; for (int q = 0; q < 16; ++q) s += red[(q * 32 + cc) * 9 + v];
            MOD[(size_t)(l * 9 + v) * 3072 + c0 + cc] = s + p.ada_b[l * 3072 + c0 + cc]; }
        __syncthreads();
    }
    bf16_t* WF = (bf16_t*)(p.ws + WS_WF);
    for (int it = blockIdx.x; it < 512; it += gridDim.x) {
        const int idx = it * 512 + tid, d = idx & 255, c = (idx >> 8) & 255, g = idx >> 16;
        const float* f = p.fourier_w + (size_t)g * 65536 + d;
        float aP = 0.f, aQ = 0.f;
#pragma unroll 16
        for (int cp = 0; cp < 256; ++cp) { const float fv = f[cp * 256]; const int a = (c * cp) & 255; aP += ct[a] * fv; aQ += st[a] * fv; }
        WF[(size_t)(g * 512 + d) * 256 + c] = (bf16_t)(pk2(aP * 0.0625f, 0.f) & 0xffffu);
        WF[(size_t)(g * 512 + 256 + d) * 256 + c] = (bf16_t)(pk2(-aQ * 0.0625f, 0.f) & 0xffffu);
    }
}

DI void ph_norm0(const Params& p, LAS unsigned char* lds) {
    const int tid = opaque_tid(), wid = tid >> 6, lane = tid & 63;
    LAS float* wg = (LAS float*)lds;
#pragma unroll 4
    for (int i = 0; i < 32; ++i) { const int idx = tid + 512 * i, k = idx >> 4, j = idx & 15; wg[j * 1024 + k] = p.win_even[(size_t)k * 7184 + 7168 + j]; }
    __syncthreads();
    f32x4 g[4];
#pragma unroll
    for (int i = 0; i < 4; ++i) g[i] = *(const f32x4*)(p.norm_g + lane * 4 + 256 * i);
    const float* MOD = (const float*)(p.ws + WS_MOD);
    bf16_t* HX = (bf16_t*)p.out;
    float* GATES = (float*)(p.ws + WS_GATES);
    f32x4 vn[4];
    { const int r = blockIdx.x * 8 + wid; if (r < NR) { const float* src = (r < NX) ? p.x + (size_t)r * 1024 : p.ctx + (size_t)(r - NX) * 1024;
#pragma unroll
        for (int i = 0; i < 4; ++i) vn[i] = *(const f32x4*)(src + lane * 4 + 256 * i); } }
    for (int r = blockIdx.x * 8 + wid; r < NR; r += gridDim.x * 8) {
        const float* md;
        if (r < NX) { md = MOD + (size_t)(r >> 12) * 3072; } else { md = MOD + (size_t)8 * 3072; }
        f32x4 v[4]; float ss = 0.f;
#pragma unroll
        for (int i = 0; i < 4; ++i) { v[i] = vn[i]; ss += v[i][0] * v[i][0] + v[i][1] * v[i][1] + v[i][2] * v[i][2] + v[i][3] * v[i][3]; }
        { const int r2 = r + gridDim.x * 8; if (r2 < NR) { const float* s2 = (r2 < NX) ? p.x + (size_t)r2 * 1024 : p.ctx + (size_t)(r2 - NX) * 1024;
#pragma unroll
            for (int i = 0; i < 4; ++i) vn[i] = *(const f32x4*)(s2 + lane * 4 + 256 * i); } }
        ss = wave_sum(ss);
        const float rstd = rsqrtf(ss * (1.0f / 1024.0f) + 1e-6f);
#pragma unroll
        for (int i = 0; i < 4; ++i) { const f32x4 sh = *(const f32x4*)(md + lane * 4 + 256 * i), sc = *(const f32x4*)(md + 1024 + lane * 4 + 256 * i);
            v[i] = v[i] * rstd * g[i] * (sc + 1.0f) + sh; }
#pragma unroll
        for (int i = 0; i < 4; i += 2) { u32x2 wa, wb; wa.x = pk2(v[i][0], v[i][1]); wa.y = pk2(v[i][2], v[i][3]); wb.x = pk2(v[i + 1][0], v[i + 1][1]); wb.y = pk2(v[i + 1][2], v[i + 1][3]);
            bf16_t* hp = HX + (size_t)r * 1024 + lane * 4 + 256 * i; st_adj16(hp, hp + 256, wa, wb, lane); }
        float pt[16];
#pragma unroll
        for (int j = 0; j < 16; ++j) { float a = 0.f;
#pragma unroll
            for (int i = 0; i < 4; ++i) { const f32x4 w4 = *(const LAS f32x4*)(wg + j * 1024 + lane * 4 + 256 * i); a += v[i][0] * w4[0] + v[i][1] * w4[1] + v[i][2] * w4[2] + v[i][3] * w4[3]; }
            pt[j] = a; if ((j & 3) == 3) __builtin_amdgcn_sched_barrier(0); }
        { const bool b5 = lane & 32;
#pragma unroll
          for (int j = 0; j < 8; ++j) { const float snd = b5 ? pt[j] : pt[j + 8], kp = b5 ? pt[j + 8] : pt[j]; pt[j] = kp + __shfl_xor(snd, 32); } }
        { const bool b4 = lane & 16;
#pragma unroll
          for (int j = 0; j < 4; ++j) { const float snd = b4 ? pt[j] : pt[j + 4], kp = b4 ? pt[j + 4] : pt[j]; pt[j] = kp + __shfl_xor(snd, 16); } }
        { const bool b3 = lane & 8;
#pragma unroll
          for (int j = 0; j < 2; ++j) { const float snd = b3 ? pt[j] : pt[j + 2], kp = b3 ? pt[j + 2] : pt[j]; pt[j] = kp + __shfl_xor(snd, 8); } }
        { const bool b2 = lane & 4; const float snd = b2 ? pt[0] : pt[1], kp = b2 ? pt[1] : pt[0]; pt[0] = kp + __shfl_xor(snd, 4); }
        pt[0] += __shfl_xor(pt[0], 2); pt[0] += __shfl_xor(pt[0], 1);
        if ((lane & 3) == 0) { const int j = ((lane >> 5) & 1) * 8 + ((lane >> 4) & 1) * 4 + ((lane >> 3) & 1) * 2 + ((lane >> 2) & 1);
            float val = pt[0] + p.gate_b[j];
            if ((j >> 2) & 1) val = fminf(val, 0.f) - log1pf(__expf(-fabsf(val)));
            GATES[(size_t)r * 16 + j] = val; }
    }
}
DI void ph_norm1(const Params& p, int mode) {
    const int tid = opaque_tid(), wid = tid >> 6, lane = tid & 63;
    const float* gsrc = mode ? p.final_g : p.norm_g + 1024;
    f32x4 g[4];
#pragma unroll
    for (int i = 0; i < 4; ++i) g[i] = *(const f32x4*)(gsrc + lane * 4 + 256 * i);
    const float* MOD = (const float*)(p.ws + WS_MOD) + (size_t)9 * 3072;
    const bf16_t* D0 = (const bf16_t*)p.ws; const bf16_t* D1 = (const bf16_t*)(p.ws + PLANE);
    bf16_t* HX1 = (bf16_t*)(p.ws + 2 * PLANE);
    f32x4 vn[4];
#define N1_LOAD(RR) do { const size_t _o = (size_t)(RR) * 1024 + lane * 4; \
        _Pragma("unroll") for (int i = 0; i < 4; ++i) vn[i] = *(const f32x4*)(p.x + _o + 256 * i); \
        _Pragma("unroll") for (int i = 0; i < 4; i += 2) { u32x2 qa, qb; ld_adj16(D0 + _o + 256 * i, D0 + _o + 256 * i + 256, lane, qa, qb); \
            vn[i] += (f32x4){lo_f(qa.x), hi_f(qa.x), lo_f(qa.y), hi_f(qa.y)}; vn[i + 1] += (f32x4){lo_f(qb.x), hi_f(qb.x), lo_f(qb.y), hi_f(qb.y)}; \
            if (mode) { ld_adj16(D1 + _o + 256 * i, D1 + _o + 256 * i + 256, lane, qa, qb); \
                vn[i] += (f32x4){lo_f(qa.x), hi_f(qa.x), lo_f(qa.y), hi_f(qa.y)}; vn[i + 1] += (f32x4){lo_f(qb.x), hi_f(qb.x), lo_f(qb.y), hi_f(qb.y)}; } } } while (0)
    { const int r = blockIdx.x * 8 + wid; if (r < NX) N1_LOAD(r); }
    for (int r = blockIdx.x * 8 + wid; r < NX; r += gridDim.x * 8) {
        const float* md = MOD + (size_t)(r >> 12) * 3072;
        f32x4 v[4]; float ss = 0.f;
#pragma unroll
        for (int i = 0; i < 4; ++i) { v[i] = vn[i]; ss += v[i][0] * v[i][0] + v[i][1] * v[i][1] + v[i][2] * v[i][2] + v[i][3] * v[i][3]; }
        { const int r2 = r + gridDim.x * 8; if (r2 < NX) N1_LOAD(r2); }
        ss = wave_sum(ss);
        const float rstd = rsqrtf(ss * (1.0f / 1024.0f) + 1e-6f);
        if (mode) {
#pragma unroll
            for (int i = 0; i < 4; ++i) *(f32x4*)(p.out + (size_t)r * 1024 + lane * 4 + 256 * i) = v[i] * rstd * g[i];
        } else {
            u32x2 w[4];
#pragma unroll
            for (int i = 0; i < 4; ++i) { const f32x4 sh = *(const f32x4*)(md + lane * 4 + 256 * i), sc = *(const f32x4*)(md + 1024 + lane * 4 + 256 * i);
                const f32x4 h = v[i] * rstd * g[i] * (sc + 1.0f) + sh; w[i].x = pk2(h[0], h[1]); w[i].y = pk2(h[2], h[3]); }
#pragma unroll
            for (int i = 0; i < 4; i += 2) { bf16_t* hp = HX1 + (size_t)r * 1024 + lane * 4 + 256 * i; st_adj16(hp, hp + 256, w[i], w[i + 1], lane); }
        }
    }
#undef N1_LOAD
}

DI void ph_conv(const Params& p) {
    const bf16_t* QRAW = (const bf16_t*)p.ws; const bf16_t* KRAW = (const bf16_t*)(p.ws + PLANE);
    const bf16_t* CQ = (const bf16_t*)(p.ws + WS_CRAW); const bf16_t* CK = CQ + (size_t)NCX * 1024;
    bf16_t* QC = (bf16_t*)p.out; bf16_t* KC = QC + (size_t)NX * 1024;
    bf16_t* CQC = (bf16_t*)(p.ws + WS_CQC); bf16_t* CKC = (bf16_t*)(p.ws + WS_CKC);
    const int tid = opaque_tid();
    const bool scanner = (blockIdx.x < 64) && (tid < 64) && (gridDim.x >= 64);
    const int nscan = gridDim.x >= 64 ? 64 : 0;
    const int active_id = (int)blockIdx.x < nscan ? (int)blockIdx.x * 448 + (tid - 64) : nscan * 448 + ((int)blockIdx.x - nscan) * 512 + tid;
    const int active_n = nscan * 448 + ((int)gridDim.x - nscan) * 512;
    if (!scanner)
    for (int idx = active_id; idx < (NR / 8) * 256; idx += active_n) {
        const int oct = idx & 127, which = (idx >> 7) & 1, r0 = (idx >> 8) * 8, ch = oct * 8;
        const bf16_t* src; bf16_t* dst; int t0, T;
        if (r0 < NX) { src = (which ? KRAW : QRAW) + (size_t)r0 * 1024 + ch; dst = (which ? KC : QC) + (size_t)r0 * 1024 + ch; t0 = r0 & 4095; T = 4096; }
        else { const int rr = r0 - NX; src = (which ? CK : CQ) + (size_t)rr * 1024 + ch; dst = (which ? CKC : CQC) + (size_t)rr * 1024 + ch; t0 = rr & 255; T = 256; }
        const u32x4 z = {0u, 0u, 0u, 0u};
        u32x4 v[10];
        v[0] = (t0 > 0) ? *(const u32x4*)(src - 1024) : z;
#pragma unroll
        for (int i = 0; i < 8; ++i) v[i + 1] = *(const u32x4*)(src + (size_t)i * 1024);
        v[9] = (t0 + 8 < T) ? *(const u32x4*)(src + (size_t)8 * 1024) : z;
        const float* w = p.conv_qk + which * 1024 + ch;
        float wt[3][8];
#pragma unroll
        for (int j = 0; j < 3; ++j) { const f32x4 wa = *(const f32x4*)(w + j * 2048), wb = *(const f32x4*)(w + j * 2048 + 4);
#pragma unroll
            for (int e = 0; e < 4; ++e) { wt[j][e] = wa[e]; wt[j][4 + e] = wb[e]; } }
        const float qs = which ? 1.0f : 0.0625f;
#pragma unroll
        for (int i = 0; i < 8; ++i) {
            float o[8];
#pragma unroll
            for (int e = 0; e < 4; ++e) {
                float lo = wt[0][2 * e] * lo_f(v[i][e]) + wt[1][2 * e] * lo_f(v[i + 1][e]) + wt[2][2 * e] * lo_f(v[i + 2][e]);
                float hi = wt[0][2 * e + 1] * hi_f(v[i][e]) + wt[1][2 * e + 1] * hi_f(v[i + 1][e]) + wt[2][2 * e + 1] * hi_f(v[i + 2][e]);
                o[2 * e] = silu_f(lo) * qs; o[2 * e + 1] = silu_f(hi) * qs;
            }
            u32x4 wv; wv.x = pk2(o[0], o[1]); wv.y = pk2(o[2], o[3]); wv.z = pk2(o[4], o[5]); wv.w = pk2(o[6], o[7]);
            *(u32x4*)(dst + (size_t)i * 1024) = wv;
        }
    }
    const int lane = tid & 63;
    const int n_sc = nscan ? 1 : 64;
    if (scanner || (nscan == 0 && blockIdx.x == 0 && tid < 64))
    for (int sc = 0; sc < n_sc; ++sc) {
        const int gw = nscan ? (int)blockIdx.x : sc;
        const int b = gw >> 3, h = (gw >> 1) & 3, dir = gw & 1;
        const float* GATES = (const float*)(p.ws + WS_GATES);
        float* GP = (float*)(p.ws + WS_GPRE) + (size_t)gw * 68 * 384;
        float m_prev = 0.f;
        auto grow_of = [&](int st) -> size_t { if (st < 4) { const int cc = dir ? 3 - st : st; return (size_t)NX + (size_t)b * 256 + cc * 64; } const int xc = st - 4, cc = dir ? 63 - xc : xc; return (size_t)b * 4096 + cc * 64; };
        const int oi = (dir ? 8 : 0) + h, of = (dir ? 12 : 4) + h;
        float nig = GATES[(grow_of(0) + lane) * 16 + oi], nlf = GATES[(grow_of(0) + lane) * 16 + of];
        for (int st = 0; st < 68; ++st) {
            const float ig = nig, lf = nlf;
            if (st + 1 < 68) { const size_t g2 = grow_of(st + 1); nig = GATES[(g2 + lane) * 16 + oi]; nlf = GATES[(g2 + lane) * 16 + of]; }
            float bs = lf;
#pragma unroll
            for (int o = 1; o < 64; o <<= 1) { const float ov = dir ? __shfl_down(bs, o) : __shfl_up(bs, o); const bool ok = dir ? (lane + o < 64) : (lane >= o); if (ok) bs += ov; }
            const float a = ig - bs;
            float mx = a;
#pragma unroll
            for (int o = 1; o < 64; o <<= 1) { const float ov = dir ? __shfl_down(mx, o) : __shfl_up(mx, o); const bool ok = dir ? (lane + o < 64) : (lane >= o); if (ok) mx = fmaxf(mx, ov); }
            const float total = __shfl(bs, dir ? 0 : 63);
            const float m_inter = bs + m_prev, m_t = fmaxf(bs + mx, m_inter);
            const float wsl = total - bs + ig;
            const float m_new = fmaxf(total + m_prev, wave_max(wsl));
            float* o = GP + (size_t)st * 384;
            o[lane] = bs - m_t; o[64 + lane] = a; o[128 + lane] = __expf(m_inter - m_t); o[192 + lane] = __expf(wsl - m_new); o[256 + lane] = __expf(-m_t);
            if (lane == 0) o[320] = __expf(total + m_prev - m_new);
            m_prev = m_new;
        }
    }
}

DI void ph_mlstm(const Params& p, LAS unsigned char* lds) {
    constexpr int QP = 528, VP = 176, SP = 144;
    LAS unsigned char* Qi = lds; LAS unsigned char* Ki = lds + 33792; LAS unsigned char* Vi0 = lds + 67584; LAS unsigned char* Vwi = Vi0 + 2 * 11264;
    LAS unsigned char* Sgi = Vwi + 11264; LAS unsigned char* Ci = Sgi + 9216; LAS float* fl0 = (LAS float*)(Ci + 42240);
    const int tid = opaque_tid(), wid = tid >> 6, lane = tid & 63, fr = lane & 15, fq = lane >> 4;
    const bf16_t* QC = (const bf16_t*)p.out; const bf16_t* KC = QC + (size_t)NX * 1024; const bf16_t* VPL = (const bf16_t*)(p.ws + 2 * PLANE);
    const bf16_t* CQC = (const bf16_t*)(p.ws + WS_CQC); const bf16_t* CKC = (const bf16_t*)(p.ws + WS_CKC); const bf16_t* CV = (const bf16_t*)(p.ws + WS_CRAW) + (size_t)2 * NCX * 1024;
    for (int wi = blockIdx.x; wi < 256; wi += gridDim.x) {
        const int b = wi >> 5, h = (wi >> 3) & 3, dir = (wi >> 2) & 1, es = wi & 3;
        bf16_t* Hout = (bf16_t*)(p.ws + (dir ? PLANE : 0));
        const float* GP = (const float*)(p.ws + WS_GPRE) + (size_t)((b * 4 + h) * 2 + dir) * 68 * 384;
        f32x4 Cst[2][5];
#pragma unroll
        for (int i = 0; i < 2; ++i)
#pragma unroll
            for (int n = 0; n < 5; ++n) Cst[i][n] = (f32x4){0.f, 0.f, 0.f, 0.f};
        __syncthreads();
        for (int i = tid; i < 64 * 8; i += 512) { const int row = i >> 3, c = i & 7;
            *(LAS unsigned*)(Vi0 + row * VP + 128 + c * 4) = 0x3F803F80u; *(LAS unsigned*)(Vi0 + 11264 + row * VP + 128 + c * 4) = 0x3F803F80u; *(LAS unsigned*)(Vwi + row * VP + 128 + c * 4) = 0u; }
        u32x4 rq[4], rk[4], rv; float pg = 0.f, pws = 0.f, pdecay = 0.f, decay = 0.f;
        const int mt = wid >> 1, nt0 = 2 * (wid & 1);
#define ML_LOAD(ST) do { const int _st = (ST); const bf16_t *_q, *_k, *_v; \
            if (_st < 4) { const int cc = dir ? 3 - _st : _st; const size_t row0 = (size_t)b * 256 + cc * 64; _q = CQC + row0 * 1024 + h * 256; _k = CKC + row0 * 1024 + h * 256; _v = CV + row0 * 1024 + h * 256 + es * 64; } \
            else { const int xc = _st - 4, cc = dir ? 63 - xc : xc; const size_t row0 = (size_t)b * 4096 + cc * 64; _q = QC + row0 * 1024 + h * 256; _k = KC + row0 * 1024 + h * 256; _v = VPL + row0 * 1024 + h * 256 + es * 64; } \
            _Pragma("unroll") for (int i = 0; i < 4; ++i) { const int id = tid + 512 * i, row = id >> 5, chk = id & 31; rq[i] = *(const u32x4*)(_q + (size_t)row * 1024 + chk * 8); rk[i] = *(const u32x4*)(_k + (size_t)row * 1024 + chk * 8); } \
            rv = *(const u32x4*)(_v + (size_t)(tid >> 3) * 1024 + (tid & 7) * 8); \
            const float* _g = GP + (size_t)_st * 384; pg = _g[tid < 320 ? tid : 0]; pws = _g[192 + (tid >> 3)]; pdecay = _g[320]; } while (0)
#define ML_WRITE(ST) do { LAS unsigned char* _Vi = Vi0 + ((ST) & 1) * 11264; LAS float* _fl = fl0 + ((ST) & 1) * 320; \
            _Pragma("unroll") for (int i = 0; i < 4; ++i) { const int id = tid + 512 * i, row = id >> 5, chk = id & 31; \
                *(LAS u32x4*)(Qi + row * QP + chk * 16) = rq[i]; *(LAS u32x4*)(Ki + row * QP + chk * 16) = rk[i]; } \
            *(LAS u32x4*)(_Vi + (tid >> 3) * VP + (tid & 7) * 16) = rv; \
            { const float w = pws; u32x4 o; \
              o.x = pk2(w * lo_f(rv.x), w * hi_f(rv.x)); o.y = pk2(w * lo_f(rv.y), w * hi_f(rv.y)); o.z = pk2(w * lo_f(rv.z), w * hi_f(rv.z)); o.w = pk2(w * lo_f(rv.w), w * hi_f(rv.w)); \
              *(LAS u32x4*)(Vwi + (tid >> 3) * VP + (tid & 7) * 16) = o; \
              if ((tid & 7) == 0) *(LAS unsigned*)(Vwi + (tid >> 3) * VP + 128) = pk2(w, 0.f); } \
            if (tid < 320) _fl[tid] = pg; \
            _Pragma("unroll") for (int i = 0; i < 2; ++i) _Pragma("unroll") for (int n = 0; n < 5; ++n) { u32x2 w; w.x = pk2(Cst[i][n][0], Cst[i][n][1]); w.y = pk2(Cst[i][n][2], Cst[i][n][3]); \
                *(LAS u32x2*)(Ci + (16 * n + fr) * QP + (16 * (2 * wid + i) + 4 * fq) * 2) = w; } \
            decay = pdecay; } while (0)
        ML_LOAD(0);
        __syncthreads();
        ML_WRITE(0);
        ML_LOAD(1);
        for (int st = 0; st < 68; ++st) {
            const bool isx = st >= 4;
            LAS unsigned char* Vi = Vi0 + (st & 1) * 11264; LAS float* fl = fl0 + (st & 1) * 320;
            LAS float* f_bt = fl; LAS float* f_aa = fl + 64; LAS float* f_inter = fl + 128; LAS float* f_enm = fl + 256;
            __syncthreads();
            const float dcy = decay;
            const int t = 16 * mt + fr;
            f32x4 accC[3];
#pragma unroll
            for (int n = 0; n < 3; ++n) accC[n] = (f32x4){0.f, 0.f, 0.f, 0.f};
            if (isx) {
                f32x4 sacc[2] = {(f32x4){0.f, 0.f, 0.f, 0.f}, (f32x4){0.f, 0.f, 0.f, 0.f}};
#pragma unroll
                for (int ks = 0; ks < 8; ++ks) { const bf16x8 qf = *(const LAS bf16x8*)(Qi + t * QP + (32 * ks + 8 * fq) * 2);
#pragma unroll
                    for (int n = 0; n < 2; ++n) { const bf16x8 kf = *(const LAS bf16x8*)(Ki + (16 * (nt0 + n) + fr) * QP + (32 * ks + 8 * fq) * 2); sacc[n] = mfma16(kf, qf, sacc[n]); }
#pragma unroll
                    for (int n = 0; n < 3; ++n) { const int et = (n < 2) ? nt0 + n : 4; const bf16x8 cf = *(const LAS bf16x8*)(Ci + (16 * et + fr) * QP + (32 * ks + 8 * fq) * 2); accC[n] = mfma16(cf, qf, accC[n]); } }
                const float btm = f_bt[t];
#pragma unroll
                for (int n = 0; n < 2; ++n) { const int s0 = 16 * (nt0 + n) + 4 * fq; const f32x4 a4 = *(const LAS f32x4*)(f_aa + s0); float vv[4];
#pragma unroll
                    for (int j = 0; j < 4; ++j) { const int s = s0 + j; const bool ok = dir ? (s >= t) : (s <= t); const float e = __expf(btm + a4[j]); vv[j] = ok ? sacc[n][j] * e : 0.f; }
                    u32x2 w; w.x = pk2(vv[0], vv[1]); w.y = pk2(vv[2], vv[3]); *(LAS u32x2*)(Sgi + t * SP + s0 * 2) = w; }
            }
#pragma unroll
            for (int i = 0; i < 2; ++i)
#pragma unroll
                for (int n = 0; n < 5; ++n) Cst[i][n] = Cst[i][n] * dcy;
#pragma unroll
            for (int ks = 0; ks < 2; ++ks) { bf16x8 kf[2];
#pragma unroll
                for (int i = 0; i < 2; ++i) kf[i] = tr_frag(Ki, QP, 32 * ks, 16 * (2 * wid + i), lane);
#pragma unroll
                for (int n = 0; n < 5; ++n) { const bf16x8 vw = tr_frag(Vwi, VP, 32 * ks, 16 * n, lane);
#pragma unroll
                    for (int i = 0; i < 2; ++i) Cst[i][n] = mfma16(kf[i], vw, Cst[i][n]); } }
            __syncthreads();
            if (isx) {
                f32x4 accD[3];
#pragma unroll
                for (int n = 0; n < 3; ++n) accD[n] = (f32x4){0.f, 0.f, 0.f, 0.f};
#pragma unroll
                for (int ks = 0; ks < 2; ++ks) { const bf16x8 sgf = *(const LAS bf16x8*)(Sgi + t * SP + (32 * ks + 8 * fq) * 2);
#pragma unroll
                    for (int n = 0; n < 3; ++n) { const int et = (n < 2) ? nt0 + n : 4; const bf16x8 vf = tr_frag(Vi, VP, 32 * ks, 16 * et, lane); accD[n] = mfma16(vf, sgf, accD[n]); } }
                const float inter_t = f_inter[t];
                const float den0 = accD[2][0] + inter_t * accC[2][0];
                const float den = __shfl(den0, fr);
                const float rden = 1.0f / fmaxf(fabsf(den), f_enm[t]);
                const int xc = st - 4, cc = dir ? 63 - xc : xc;
                bf16_t* hp = Hout + ((size_t)b * 4096 + cc * 64 + t) * 1024 + h * 256 + es * 64 + 4 * fq;
                u32x2 hw[2];
#pragma unroll
                for (int n = 0; n < 2; ++n) { const f32x4 hv = (accD[n] + accC[n] * inter_t) * rden; hw[n].x = pk2(hv[0], hv[1]); hw[n].y = pk2(hv[2], hv[3]); }
                st_pair16(hp + 16 * nt0, hw[0], hw[1], fq);
            }
            if (st + 1 < 68) { ML_WRITE(st + 1); if (st + 2 < 68) ML_LOAD(st + 2); }
        }
#undef ML_LOAD
#undef ML_WRITE
    }
}

template <int KK, int NN, class Cfg>
DI void axis_mix(const Cfg& cfg, LAS unsigned char* lds, int n_items) {
    constexpr int TP = 528, BP = KK * 2 + 16, NCH = KK / 16;
    LAS unsigned char* Ti = lds; LAS unsigned char* Bi = lds + 128 * TP;
    const int tid = opaque_tid(), wid = tid >> 6, lane = tid & 63, fr = lane & 15, fq = lane >> 4;
    __syncthreads();
    cfg.fill_tables(Bi, tid);
    u32x4 ra[NCH], rb[NCH];
    const int G = gridDim.x;
#define AX_LOAD(R, IT) do { if ((IT) < n_items) { _Pragma("unroll") for (int i = 0; i < NCH; ++i) { const int id = tid + 512 * i; R[i] = *(const u32x4*)(cfg.row_ptr((IT), id >> 5) + (id & 31) * 8); } } } while (0)
#define AX_BODY(R, IT, PRE) do { \
        __syncthreads(); \
        _Pragma("unroll") for (int i = 0; i < NCH; ++i) { const int id = tid + 512 * i; *(LAS u32x4*)(Ti + (id >> 5) * TP + (id & 31) * 16) = R[i]; } \
        __syncthreads(); \
        AX_LOAD(R, PRE); \
        f32x4 acc[2][NN / 16]; \
        _Pragma("unroll") for (int i = 0; i < 2; ++i) _Pragma("unroll") for (int n = 0; n < NN / 16; ++n) acc[i][n] = (f32x4){0.f, 0.f, 0.f, 0.f}; \
        LAS unsigned char* tb = Bi + cfg.table_off(IT); \
        _Pragma("unroll") for (int ks = 0; ks < KK / 32; ++ks) { bf16x8 af[2]; \
            _Pragma("unroll") for (int i = 0; i < 2; ++i) af[i] = tr_frag(Ti, TP, 32 * ks, 32 * wid + 16 * i, lane); \
            _Pragma("unroll") for (int n = 0; n < NN / 16; ++n) { const bf16x8 bfr = *(const LAS bf16x8*)(tb + (16 * n + fr) * BP + (32 * ks + 8 * fq) * 2); \
                _Pragma("unroll") for (int i = 0; i < 2; ++i) acc[i][n] = mfma16(af[i], bfr, acc[i][n]); } } \
        cfg.epilogue(acc, (IT), wid, fr, fq, Bi); } while (0)
    int item = blockIdx.x;
    AX_LOAD(ra, item); AX_LOAD(rb, item + G);
    for (; item < n_items; item += 2 * G) {
        AX_BODY(ra, item, item + 2 * G);
        if (item + G < n_items) AX_BODY(rb, item + G, item + 3 * G);
    }
#undef AX_LOAD
#undef AX_BODY
}
DI void fill_dft_table(LAS unsigned char* Bi, int tid, int nrows) {
    for (int idx = tid; idx < nrows * 128; idx += 512) { const int n = idx >> 7, k = idx & 127, ap = n & 63, kk = k & 63; float s, c; sincospif((float)((kk * ap) & 63) / 32.0f, &s, &c);
        float v; if (n < 64) v = (k < 64) ? c : s; else v = (k < 64) ? -s : c;
        *(LAS unsigned short*)(Bi + n * 272 + k * 2) = (unsigned short)(pk2(v * 0.125f, 0.f) & 0xffffu); }
}
struct CfgDft1 {
    const bf16_t* Z; bf16_t* S1re; bf16_t* S1im;
    DI void fill_tables(LAS unsigned char* Bi, int tid) const { fill_dft_table(Bi, tid, 128); }
    DI int table_off(int) const { return 0; }
    DI const bf16_t* row_ptr(int item, int k) const { const int g = item & 3, b = (item >> 2) & 63, batch = item >> 8;
        return Z + ((size_t)batch * 4096 + 64 * (k & 63) + b) * 2048 + g * 512 + (k >> 6) * 256; }
    DI void epilogue(const f32x4 (&acc)[2][8], int item, int wid, int fr, int fq, LAS unsigned char* Bi) const {
        const int g = item & 3, b = (item >> 2) & 63, batch = item >> 8;
#pragma unroll
        for (int ni = 0; ni < 4; ++ni) { const int ap = 16 * ni + fr; float s, c; sincospif((float)(b * ap) * (1.0f / 2048.0f), &s, &c);
            const size_t tok = (size_t)batch * 4096 + 64 * ap + b;
            u32x2 wr[2], wi[2];
#pragma unroll
            for (int i = 0; i < 2; ++i) { const f32x4 re = acc[i][ni], im = acc[i][ni + 4]; const f32x4 r2 = re * c + im * s, i2 = im * c - re * s;
                wr[i].x = pk2(r2[0], r2[1]); wr[i].y = pk2(r2[2], r2[3]); wi[i].x = pk2(i2[0], i2[1]); wi[i].y = pk2(i2[2], i2[3]); }
            { const size_t o = tok * 1024 + g * 256 + 32 * wid + 4 * fq; st_pair16(S1re + o, wr[0], wr[1], fq); st_pair16(S1im + o, wi[0], wi[1], fq); } }
    }
};
struct CfgDft2 {
    const bf16_t* S1re; const bf16_t* S1im; const bf16_t* ZB; bf16_t* Y;
    DI void fill_tables(LAS unsigned char* Bi, int tid) const { fill_dft_table(Bi, tid, 64); }
    DI int table_off(int) const { return 0; }
    DI const bf16_t* row_ptr(int item, int k) const { const int g = item & 3, ap = (item >> 2) & 63, batch = item >> 8;
        return ((k >> 6) ? S1im : S1re) + ((size_t)batch * 4096 + 64 * ap + (k & 63)) * 1024 + g * 256; }
    DI void epilogue(const f32x4 (&acc)[2][4], int item, int wid, int fr, int fq, LAS unsigned char*) const {
        const int g = item & 3, ap = (item >> 2) & 63, batch = item >> 8;
#pragma unroll
        for (int ni = 0; ni < 4; ++ni) { const size_t tok = (size_t)batch * 4096 + ap + 64 * (16 * ni + fr);
            u32x2 w[2], zz[2]; ld_pair16(ZB + tok * 1024 + g * 256 + 32 * wid + 4 * fq, fq, zz[0], zz[1]);
#pragma unroll
            for (int i = 0; i < 2; ++i) { const u32x2 z = zz[i]; const f32x4 a = acc[i][ni];
                w[i].x = pk2(a[0] * silu_f(lo_f(z.x)), a[1] * silu_f(hi_f(z.x))); w[i].y = pk2(a[2] * silu_f(lo_f(z.y)), a[3] * silu_f(hi_f(z.y))); }
            st_pair16(Y + tok * 2048 + 1024 + g * 256 + 32 * wid + 4 * fq, w[0], w[1], fq); }
    }
};
DI void fill_pool_tables(LAS unsigned char* Bi, int tid) {
    for (int idx = tid; idx < 4 * 4096; idx += 512) { const int g = idx >> 12, n = (idx >> 6) & 63, k = idx & 63, w = 2 << g, lo = n - w / 2, hi = n + w - w / 2;
        *(LAS unsigned short*)(Bi + g * 9216 + n * 144 + k * 2) = (k >= lo && k < hi) ? (unsigned short)0x3F80 : (unsigned short)0; }
}
DI float pool_rcnt(int g, int n) { const int w = 2 << g; int lo = n - w / 2, hi = n + w - w / 2; lo = lo < 0 ? 0 : lo; hi = hi > 64 ? 64 : hi; return 1.0f / (float)(hi - lo); }
struct CfgPoolA {
    const bf16_t* UC; bf16_t* PA;
    DI void fill_tables(LAS unsigned char* Bi, int tid) const { fill_pool_tables(Bi, tid); }
    DI int table_off(int item) const { return ((item & 7) >> 1) * 9216; }
    DI const bf16_t* row_ptr(int item, int k) const { const int ct = item & 7, c = (item >> 3) & 63, batch = item >> 9; return UC + ((size_t)batch * 4096 + 64 * k + c) * 2048 + ct * 256; }
    DI void epilogue(const f32x4 (&acc)[2][4], int item, int wid, int fr, int fq, LAS unsigned char*) const {
        const int ct = item & 7, c = (item >> 3) & 63, batch = item >> 9, g = ct >> 1;
#pragma unroll
        for (int ni = 0; ni < 4; ++ni) { const int n = 16 * ni + fr; const float rc = pool_rcnt(g, n); const size_t tok = (size_t)batch * 4096 + 64 * n + c;
            u32x2 w[2];
#pragma unroll
            for (int i = 0; i < 2; ++i) { const f32x4 a = acc[i][ni] * rc; w[i].x = pk2(a[0], a[1]); w[i].y = pk2(a[2], a[3]); }
            st_pair16(PA + tok * 2048 + ct * 256 + 32 * wid + 4 * fq, w[0], w[1], fq); }
    }
};
struct CfgPoolB {
    const bf16_t* PA; bf16_t* UC; const bf16_t* ZC; const float* scale;
    DI void fill_tables(LAS unsigned char* Bi, int tid) const { fill_pool_tables(Bi, tid); }
    DI int table_off(int item) const { return ((item & 7) >> 1) * 9216; }
    DI const bf16_t* row_ptr(int item, int k) const { const int ct = item & 7, rp = (item >> 3) & 63, batch = item >> 9; return PA + ((size_t)batch * 4096 + 64 * rp + k) * 2048 + ct * 256; }
    DI void epilogue(const f32x4 (&acc)[2][4], int item, int wid, int fr, int fq, LAS unsigned char*) const {
        const int ct = item & 7, rp = (item >> 3) & 63, batch = item >> 9, g = ct >> 1;
        const int ch0 = ct * 256 + 32 * wid + 4 * fq;
        const f32x4 sc0 = *(const f32x4*)(scale + ch0), sc1 = *(const f32x4*)(scale + ch0 + 16);
#pragma unroll
        for (int ni = 0; ni < 4; ++ni) { const int n = 16 * ni + fr; const float rc = pool_rcnt(g, n); const size_t tok = (size_t)batch * 4096 + 64 * rp + n;
            u32x2 w[2], uu[2], zz[2]; bf16_t* up0 = UC + tok * 2048 + ch0;
            ld_pair16(up0, fq, uu[0], uu[1]); ld_pair16(ZC + tok * 2048 + ch0, fq, zz[0], zz[1]);
#pragma unroll
            for (int i = 0; i < 2; ++i) { const u32x2 u = uu[i], z = zz[i]; const f32x4 a = acc[i][ni] * rc; const f32x4 sc = i ? sc1 : sc0;
                w[i].x = pk2((a[0] - lo_f(u.x)) * sc[0] * lo_f(z.x), (a[1] - hi_f(u.x)) * sc[1] * hi_f(z.x));
                w[i].y = pk2((a[2] - lo_f(u.y)) * sc[2] * lo_f(z.y), (a[3] - hi_f(u.y)) * sc[3] * hi_f(z.y)); }
            st_pair16(up0, w[0], w[1], fq); }
    }
};

DI void ph_ya(const Params& p) {
    const int tid = opaque_tid(), wid = tid >> 6, lane = tid & 63;
    const bf16_t* HF = (const bf16_t*)p.ws; const bf16_t* HB = (const bf16_t*)(p.ws + PLANE); const bf16_t* O = (const bf16_t*)(p.ws + 3 * PLANE); const bf16_t* ZA = (const bf16_t*)(p.ws + 4 * PLANE);
    bf16_t* Y = (bf16_t*)p.out;
    f32x4 hg[4];
#pragma unroll
    for (int i = 0; i < 4; ++i) hg[i] = *(const f32x4*)(p.head_norm + lane * 16 + 4 * i);
    for (int r = blockIdx.x * 8 + wid; r < NX; r += gridDim.x * 8) {
        const size_t o = (size_t)r * 1024 + lane * 16;
        float gv[16], za[16]; float ss = 0.f;
#pragma unroll
        for (int hh = 0; hh < 2; ++hh) { const u32x4 a = *(const u32x4*)(HF + o + 8 * hh), bq = *(const u32x4*)(HB + o + 8 * hh), oo = *(const u32x4*)(O + o + 8 * hh), zz = *(const u32x4*)(ZA + o + 8 * hh);
#pragma unroll
            for (int e = 0; e < 4; ++e) { const float h0 = lo_f(a[e]) + lo_f(bq[e]), h1 = hi_f(a[e]) + hi_f(bq[e]);
                const float g0 = sigmoid_f(lo_f(oo[e])) * h0, g1 = sigmoid_f(hi_f(oo[e])) * h1;
                gv[8 * hh + 2 * e] = g0; gv[8 * hh + 2 * e + 1] = g1; ss += g0 * g0 + g1 * g1; za[8 * hh + 2 * e] = lo_f(zz[e]); za[8 * hh + 2 * e + 1] = hi_f(zz[e]); } }
        ss += __shfl_xor(ss, 1); ss += __shfl_xor(ss, 2); ss += __shfl_xor(ss, 4); ss += __shfl_xor(ss, 8);
        const float rstd = rsqrtf(ss * (1.0f / 256.0f) + 1e-6f);
        u32x4 w[2];
#pragma unroll
        for (int q = 0; q < 8; ++q) { const float y0 = gv[2 * q] * rstd * hg[q >> 1][(2 * q) & 3] * silu_f(za[2 * q]), y1 = gv[2 * q + 1] * rstd * hg[q >> 1][(2 * q + 1) & 3] * silu_f(za[2 * q + 1]);
            w[q >> 2][q & 3] = pk2(y0, y1); }
        *(u32x4*)(Y + (size_t)r * 2048 + lane * 16) = w[0]; *(u32x4*)(Y + (size_t)r * 2048 + lane * 16 + 8) = w[1];
    }
}


#define XB_TMO      128
#define XB_XCNT(j)  (256  + 64 * (j))
#define XB_XSUB(j)  (1280 + 64 * (j))
#define XB_XGEN(j)  (2304 + 64 * (j))
#define XB_TOP      3328
#define XB_TOPGEN   3392
#define XCD_BAR_WORDS 3456
#define XB_SPIN_CAP (1u << 18)
DI unsigned xb_ld(unsigned* p)              { return __hip_atomic_load(p, __ATOMIC_RELAXED, __HIP_MEMORY_SCOPE_AGENT); }
DI unsigned xb_add(unsigned* p, unsigned v) { return __hip_atomic_fetch_add(p, v, __ATOMIC_RELAXED, __HIP_MEMORY_SCOPE_AGENT); }
DI unsigned xb_xcc_id() { return (unsigned)__builtin_amdgcn_s_getreg((3 << 11) | 20) & 0xFu; }
#define XB_SPIN(cond, bar) do { unsigned _sp = 0; while (cond) { __builtin_amdgcn_s_sleep(1); \
    if ((++_sp & 255u) == 0u) { if (xb_ld(&(bar)[XB_TMO])) break; if (_sp > XB_SPIN_CAP) { atomicAdd(&(bar)[XB_TMO], 1u); break; } } } } while (0)
struct XcdBarrier { unsigned* bar; unsigned x; volatile LAS unsigned* st; };
DI XcdBarrier xcd_barrier_post(unsigned* bar, volatile LAS unsigned* st) {
    XcdBarrier b; b.bar = bar; b.x = xb_xcc_id(); b.st = st;
    if (threadIdx.x == 0) (void)xb_add(&bar[XB_XCNT(b.x)], 1u);
    return b;
}
DI void xcd_barrier_complete(unsigned* bar, unsigned x, unsigned& nloc, unsigned& nx) {
    const unsigned G = gridDim.x * gridDim.y * gridDim.z;
    unsigned sum, cnt, mine, sp = 0u;
    for (;;) {
        sum = 0u; cnt = 0u; mine = 0u;
#pragma unroll
        for (unsigned j = 0; j < 16; ++j) { const unsigned c = xb_ld(&bar[XB_XCNT(j)]); sum += c; cnt += (c > 0u) ? 1u : 0u; mine = (j == x) ? c : mine; }
        if (sum == G) break;
        __builtin_amdgcn_s_sleep(1);
        if ((++sp & 255u) == 0u) { if (xb_ld(&bar[XB_TMO])) break; if (sp > XB_SPIN_CAP) { atomicAdd(&bar[XB_TMO], 1u); break; } }
    }
    nloc = mine > 0u ? mine : 1u; nx = cnt > 0u ? cnt : 1u;
}
DI void xcd_barrier(const XcdBarrier& b) {
    asm volatile("s_waitcnt vmcnt(0)" ::: "memory");
    __syncthreads();
    if (threadIdx.x == 0) {
        unsigned* bar = b.bar;
        __builtin_amdgcn_s_waitcnt(0);
        unsigned nloc = b.st[0], nx = b.st[1];
        if (nloc == 0u) { xcd_barrier_complete(bar, b.x, nloc, nx); b.st[0] = nloc; b.st[1] = nx; }
        const unsigned old = xb_add(&bar[XB_XSUB(b.x)], 1u);
        const unsigned gen = old / nloc;
        if (old + 1u == (gen + 1u) * nloc) {
            __builtin_amdgcn_fence(__ATOMIC_RELEASE, "agent");
            asm volatile("s_waitcnt vmcnt(0)" ::: "memory");
            const unsigned og = xb_add(&bar[XB_TOP], 1u);
            const unsigned tg = og / nx;
            if (og + 1u == (tg + 1u) * nx) xb_add(&bar[XB_TOPGEN], 1u);
            else XB_SPIN(xb_ld(&bar[XB_TOPGEN]) == tg, bar);
            __builtin_amdgcn_fence(__ATOMIC_ACQUIRE, "agent");
            xb_add(&bar[XB_XGEN(b.x)], 1u);
            asm volatile("s_waitcnt vmcnt(0)" ::: "memory");
        } else {
            XB_SPIN(xb_ld(&bar[XB_XGEN(b.x)]) == gen, bar);
            __builtin_amdgcn_fence(__ATOMIC_ACQUIRE, "agent");
            asm volatile("s_waitcnt vmcnt(0)" ::: "memory");
        }
    }
    __syncthreads();
}

__global__ void __launch_bounds__(512, 2) mk_fwd(Params p, int ph_lo, int ph_hi) {
    extern __shared__ __attribute__((aligned(16))) unsigned char shm[];
    LAS unsigned char* lds = (LAS unsigned char*)shm;
    cg::grid_group grid = cg::this_grid();
    unsigned char* ws = p.ws;
    const int G = gridDim.x, c = blockIdx.x;
    volatile LAS unsigned* xst = (volatile LAS unsigned*)(lds + LDS_BYTES - 16);
    if (threadIdx.x == 0) { xst[0] = 0u; xst[1] = 0u; }
    __syncthreads();
    XcdBarrier xbar; xbar.bar = (unsigned*)(ws + WS_BAR); xbar.x = 0u; xbar.st = xst;
    if (ph_hi - ph_lo > 1) xbar = xcd_barrier_post((unsigned*)(ws + WS_BAR), xst);
    if (ph_lo > 1000) grid.sync();
#ifndef PHMASK
#define PHMASK 0xFFFF
#endif
#define GSYNC() xcd_barrier(xbar)
#ifndef REP_MASK
#define REP_MASK 0
#endif
#define PHASE(i, ...) if constexpr ((PHMASK >> (i)) & 1) if (ph_lo <= (i) && (i) < ph_hi) { __VA_ARGS__; if constexpr ((REP_MASK >> (i)) & 1) { __syncthreads(); __VA_ARGS__; } if ((i) + 1 < ph_hi) GSYNC(); }
    PHASE(0, ph_prep(p, lds));
    PHASE(1, ph_norm0(p, lds));
    PHASE(2, { GemmD g{(const bf16_t*)p.out, (const bf16_t*)(ws + WS_WINE), 1024, 1024, 0, 0, 1024}; Sched S{128, 28, 1, 8, 12, 128, G, c};
               EpiPlanes E{(bf16_t*)ws, (bf16_t*)(ws + WS_CRAW)}; gemm_phase(lds, g, S, E);
               { const bool split = (G == 256);
                 if (!split || (c >= 96 && c < 128)) { GemmD gf{(const bf16_t*)(ws + WS_WPOOL), (const bf16_t*)((const unsigned char*)p.out + (size_t)96 * 1024 * 1024), 512, 2048, (long)512 * 512, 512, 512};
                     Sched Sf{2, 4, 4, 0, 0, 0, split ? 32 : G, split ? c - 96 : c}; EpiBf Ef{(bf16_t*)(ws + WS_WINO), nullptr, 1024, 512 * 1024, 0, nullptr, nullptr}; gemm_phase(lds, gf, Sf, Ef); }
                 if (!split || c >= 128) { const int w = split ? c - 128 : c, nw = split ? 128 : G;
                     transpose_jobs(p, lds, opaque_tid(), 2816, 3328, w, nw); transpose_jobs(p, lds, opaque_tid(), 3584, 4096, w, nw); } } });
    PHASE(3, ph_conv(p));
    PHASE(4, ph_mlstm(p, lds));
    PHASE(5, { GemmD g{(const bf16_t*)(ws + 5 * PLANE), (const bf16_t*)(ws + WS_WF), 1024, 256, 256, 512 * 256, 256}; Sched S{128, 2, 4, 0, 0, 0, G, c};
               EpiBf E{(bf16_t*)p.out, nullptr, 2048, 512, 0, nullptr, nullptr}; gemm_phase(lds, g, S, E); });
    PHASE(6, { CfgDft1 cf{(const bf16_t*)p.out, (bf16_t*)(ws + 2 * PLANE), (bf16_t*)(ws + 5 * PLANE)}; axis_mix<128, 128>(cf, lds, 2048); });
    PHASE(7, { CfgDft2 cf{(const bf16_t*)(ws + 2 * PLANE), (const bf16_t*)(ws + 5 * PLANE), (const bf16_t*)(ws + 6 * PLANE), (bf16_t*)p.out}; axis_mix<128, 64>(cf, lds, 2048); ph_ya(p); });
    PHASE(8, { GemmD g{(const bf16_t*)p.out, (const bf16_t*)(ws + WS_WOUTE), 2048, 2048, 0, 0, 2048}; Sched S{128, 4, 1, 0, 0, 0, G, c};
               EpiGate E{(bf16_t*)ws, (const float*)(ws + WS_MOD) + 2048}; gemm_phase(lds, g, S, E); });
    PHASE(9, ph_norm1(p, 0));
    PHASE(10, { GemmD g{(const bf16_t*)(ws + 2 * PLANE), (const bf16_t*)(ws + WS_WINO), 1024, 1024, 0, 0, 1024}; Sched S{128, 16, 1, 0, 0, 0, G, c};
                EpiBf E{(bf16_t*)(ws + 3 * PLANE), (bf16_t*)(ws + 5 * PLANE), 2048, 0, 1, nullptr, nullptr}; gemm_phase(lds, g, S, E); });
    PHASE(11, { CfgPoolA cf{(const bf16_t*)(ws + 3 * PLANE), (bf16_t*)p.out}; axis_mix<64, 64>(cf, lds, 4096); });
    PHASE(12, { CfgPoolB cf{(const bf16_t*)p.out, (bf16_t*)(ws + 3 * PLANE), (const bf16_t*)(ws + 5 * PLANE), p.pool_scale}; axis_mix<64, 64>(cf, lds, 4096); });
    PHASE(14, { GemmD g{(const bf16_t*)(ws + 3 * PLANE), (const bf16_t*)(ws + WS_WOUTO), 2048, 2048, 0, 0, 2048}; Sched S{128, 4, 1, 0, 0, 0, G, c};
                EpiGate E{(bf16_t*)(ws + PLANE), (const float*)(ws + WS_MOD) + 9 * 3072 + 2048}; gemm_phase(lds, g, S, E); });
    PHASE(15, ph_norm1(p, 1));
#undef PHASE
#ifdef XSYNC
    for (int k = 0; k < XSYNC; ++k) GSYNC();
#endif
#ifdef DBG_STOP
    GSYNC();
    {   const size_t n = (size_t)NX * 1024; unsigned* o32 = (unsigned*)p.out;
        for (size_t i = (size_t)blockIdx.x * 512 + threadIdx.x; i < n; i += (size_t)gridDim.x * 512) {
            float v = 0.f;
            if (DBG_PLANES == -1) { const unsigned u = o32[i]; v = lo_f(u) + hi_f(u); }
            else if (DBG_PLANES == -2) { v = ((const float*)p.ws)[i]; }
            else { for (int pl = 0; pl < 7; ++pl) if ((DBG_PLANES >> pl) & 1) v += bf2f(((const bf16_t*)(p.ws + pl * PLANE))[i]); }
            if (!(fabsf(v) < 1e30f)) v = 12345.f;
            p.out[i] = v; } }
#endif
}

extern "C" void kernel_launch(void* const* d_in, const int* in_sizes, int n_in, void* d_out, int out_size, void* d_ws, size_t ws_size, hipStream_t stream) {
    static int grid = 0;
    if (grid == 0) {
        int dev = 0, cus = 0, per_cu = 0;
        hipGetDevice(&dev);
        hipDeviceGetAttribute(&cus, hipDeviceAttributeMultiprocessorCount, dev);
        if (hipFuncSetAttribute((const void*)mk_fwd, hipFuncAttributeMaxDynamicSharedMemorySize, LDS_BYTES) != hipSuccess) fprintf(stderr, "hipFuncSetAttribute failed\n");
        if (hipOccupancyMaxActiveBlocksPerMultiprocessor(&per_cu, (const void*)mk_fwd, 512, LDS_BYTES) != hipSuccess || per_cu < 1) { fprintf(stderr, "occupancy query: %d\n", per_cu); per_cu = 1; }
        (void)hipGetLastError();
        grid = cus * per_cu; if (grid > 256) grid = 256; if (grid < 1) grid = 1;
        if (ws_size < WS_END) fprintf(stderr, "workspace too small: %zu < %zu\n", ws_size, (size_t)WS_END);
    }
    Params p{};
    p.x = (const float*)d_in[0]; p.c = (const float*)d_in[1]; p.ctx = (const float*)d_in[2]; p.c_ctx = (const float*)d_in[3]; p.ada_w = (const float*)d_in[4]; p.ada_b = (const float*)d_in[5];
    p.norm_g = (const float*)d_in[6]; p.win_even = (const float*)d_in[7]; p.gate_b = (const float*)d_in[8]; p.conv_qk = (const float*)d_in[9]; p.head_norm = (const float*)d_in[10];
    p.fourier_w = (const float*)d_in[11]; p.wout_even = (const float*)d_in[12]; p.win_odd = (const float*)d_in[13]; p.pool_w = (const float*)d_in[14]; p.pool_scale = (const float*)d_in[15];
    p.wout_odd = (const float*)d_in[16]; p.final_g = (const float*)d_in[17]; p.out = (float*)d_out; p.ws = (unsigned char*)d_ws;
    (void)hipMemsetAsync((unsigned char*)d_ws + WS_BAR, 0, XCD_BAR_WORDS * 4, stream);
#if MK_MULTI
    for (int ph = 0; ph < 16; ++ph) { hipLaunchKernelGGL(mk_fwd, dim3(grid), dim3(512), LDS_BYTES, stream, p, ph, ph + 1); }
#else
#ifdef DBG_STOP
    int lo = 0, hi = DBG_STOP;
#else
    int lo = 0, hi = 16;
#endif
    void* args[] = {&p, &lo, &hi};
    hipError_t e = hipLaunchCooperativeKernel((void*)mk_fwd, dim3(grid), dim3(512), args, LDS_BYTES, stream);
    if (e != hipSuccess) fprintf(stderr, "cooperative launch failed: %s (grid %d)\n", hipGetErrorString(e), grid);
#endif
}
```
